# Optimizing an MI355X kernel written in HIP

```python
import math
import jax, jax.numpy as jnp
from jax import lax
import numpy as np

D_MODEL = 1024
BATCH = 2
SEQ = 8192
DEPTH = 4

N_MEM = 256
D_FF = 2816
EPS = 1e-6
ROPE_THETA = 10000.0
GLA_HEADS = 4
GLA_DK = 64
GLA_DV = 128
GLA_RANK = 16
GLA_TAU = 16.0
GLA_CHUNK = 64
GLA_WIDTH = GLA_HEADS * GLA_DV
S5_GROUP = 16
S5_WIDTH = D_MODEL - GLA_WIDTH
S5_GROUPS = S5_WIDTH // S5_GROUP
S5_STATE = 64
S5_DT_MIN = 0.001
S5_DT_MAX = 0.1
ATT_HEADS = 8
ATT_KV_HEADS = 2
ATT_HEAD_DIM = D_MODEL // ATT_HEADS
IDX_HEADS = 8
IDX_DIM = 64
TOPK_MAX = 256
Q_BLOCK = 128
XA_HEADS = 4
XA_HEAD_DIM = D_MODEL // XA_HEADS

N_EVEN = (DEPTH + 1) // 2
N_ODD = DEPTH // 2
EV_SIZES = (GLA_HEADS * GLA_DK, GLA_HEADS * GLA_DK, GLA_WIDTH, GLA_WIDTH, GLA_RANK, S5_WIDTH)
OD_SIZES = (ATT_HEADS * ATT_HEAD_DIM, ATT_KV_HEADS * ATT_HEAD_DIM, ATT_KV_HEADS * ATT_HEAD_DIM,
            IDX_HEADS * IDX_DIM, IDX_DIM, IDX_HEADS)
EV_IN = sum(EV_SIZES)
OD_IN = sum(OD_SIZES)

kernel_name = "hybrid_gla_s5_dsa_macaron_memxattn"


def _splits(sizes):
    out, acc = [], 0
    for s in sizes[:-1]:
        acc += s
        out.append(acc)
    return out


def rmsnorm(x, g):
    xf = x.astype(jnp.float32)
    y = xf * lax.rsqrt(jnp.mean(xf * xf, axis=-1, keepdims=True) + EPS)
    return (y * g.astype(jnp.float32)).astype(x.dtype)


def rope_tables(positions, dim):
    inv = ROPE_THETA ** (-jnp.arange(0, dim, 2, dtype=jnp.float32) / dim)
    ang = positions.astype(jnp.float32)[..., None] * inv
    cos = jnp.cos(ang)
    sin = jnp.sin(ang)
    return jnp.concatenate([cos, cos], -1), jnp.concatenate([sin, sin], -1)


def apply_rope(x, cos, sin):
    xf = x.astype(jnp.float32)
    half = xf.shape[-1] // 2
    rot = jnp.concatenate([-xf[..., half:], xf[..., :half]], -1)
    return (xf * cos[:, :, None, :] + rot * sin[:, :, None, :]).astype(x.dtype)


def swiglu(h, w_gate, w_up, w_down):
    return (jax.nn.silu(h @ w_gate) * (h @ w_up)) @ w_down


def gla_mixer(q, k, v, r, a_low, w_a2, b_a, g_norm):
    f32 = jnp.float32
    Bsz, L, _ = q.shape
    C = GLA_CHUNK
    N = L // C
    log_a = jax.nn.log_sigmoid((a_low @ w_a2 + b_a).astype(f32)) / GLA_TAU

    def chunks(t, d):
        return t.reshape(Bsz, N, C, GLA_HEADS, d)

    qc = chunks(q.astype(f32), GLA_DK) * GLA_DK ** -0.5
    kc = chunks(k.astype(f32), GLA_DK)
    vc = chunks(v.astype(f32), GLA_DV)
    bc = jnp.cumsum(chunks(log_a, GLA_DK), axis=2)
    b_last = bc[:, :, -1]
    q_dec = qc * jnp.exp(bc)
    k_inv = kc * jnp.exp(-bc)
    k_end = kc * jnp.exp(b_last[:, :, None] - bc)
    causal = jnp.tril(jnp.ones((C, C), dtype=bool))
    scores = jnp.where(causal, jnp.einsum('bnihd,bnjhd->bnhij', q_dec, k_inv), 0.0)
    o_intra = jnp.einsum('bnhij,bnjhe->bnihe', scores, vc)
    dS = jnp.einsum('bnjhd,bnjhe->nbhde', k_end, vc)
    decay = jnp.exp(b_last).transpose(1, 0, 2, 3)

    def step(S, inp):
        dec, ds = inp
        return dec[..., None] * S + ds, S

    S0 = jnp.zeros((Bsz, GLA_HEADS, GLA_DK, GLA_DV), f32)
    _, S_prev = lax.scan(step, S0, (decay, dS))
    o_inter = jnp.einsum('bnihd,nbhde->bnihe', q_dec, S_prev)
    o = (o_intra + o_inter).reshape(Bsz, L, GLA_HEADS, GLA_DV)
    o = o * lax.rsqrt(jnp.mean(o * o, axis=-1, keepdims=True) + EPS) * g_norm.astype(f32)
    o = o.reshape(Bsz, L, GLA_WIDTH) * jax.nn.silu(r.astype(f32))
    return o.astype(q.dtype)


def s5_mixer(u, lam_re, lam_im, log_dt, B_re, B_im, C_re, C_im, D, w_glu, b_glu):
    f32 = jnp.float32
    Bsz, L, _ = u.shape
    uf = u.astype(f32).reshape(Bsz, L, S5_GROUPS, S5_GROUP)
    lr = jnp.minimum(lam_re.astype(f32), -1e-4)
    li = lam_im.astype(f32)
    dt = jnp.exp(log_dt.astype(f32))[:, None]
    mag = jnp.exp(lr * dt)
    ab_re = mag * jnp.cos(li * dt)
    ab_im = mag * jnp.sin(li * dt)
    den = lr * lr + li * li
    nr = ab_re - 1.0
    f_re = (nr * lr + ab_im * li) / den
    f_im = (ab_im * lr - nr * li) / den
    Br = B_re.astype(f32)
    Bi = B_im.astype(f32)
    bb_re = f_re[..., None] * Br - f_im[..., None] * Bi
    bb_im = f_re[..., None] * Bi + f_im[..., None] * Br
    bu_re = jnp.einsum('gpc,blgc->blgp', bb_re, uf)
    bu_im = jnp.einsum('gpc,blgc->blgp', bb_im, uf)
    a_re = jnp.broadcast_to(ab_re, bu_re.shape)
    a_im = jnp.broadcast_to(ab_im, bu_im.shape)

    def combine(e1, e2):
        a1r, a1i, b1r, b1i = e1
        a2r, a2i, b2r, b2i = e2
        return (a1r * a2r - a1i * a2i,
                a1r * a2i + a1i * a2r,
                a2r * b1r - a2i * b1i + b2r,
                a2r * b1i + a2i * b1r + b2i)

    _, _, xr, xi = lax.associative_scan(combine, (a_re, a_im, bu_re, bu_im), axis=1)
    y = (jnp.einsum('gcp,blgp->blgc', C_re.astype(f32), xr)
         - jnp.einsum('gcp,blgp->blgc', C_im.astype(f32), xi)
         + D.astype(f32) * uf)
    y = jax.nn.gelu(y.reshape(Bsz, L, S5_WIDTH))
    y = y * jax.nn.sigmoid(y @ w_glu.astype(f32) + b_glu.astype(f32))
    return y.astype(u.dtype)


def dsa_mixer(hn, w_in, w_out, cos_a, sin_a, cos_i, sin_i):
    f32 = jnp.float32
    Bsz, L, _ = hn.shape
    q, k, v, qi, ki, wi = jnp.split(hn @ w_in, _splits(OD_SIZES), axis=-1)
    q = apply_rope(q.reshape(Bsz, L, ATT_HEADS, ATT_HEAD_DIM), cos_a, sin_a) * ATT_HEAD_DIM ** -0.5
    k = apply_rope(k.reshape(Bsz, L, ATT_KV_HEADS, ATT_HEAD_DIM), cos_a, sin_a)
    v = v.reshape(Bsz, L, ATT_KV_HEADS, ATT_HEAD_DIM)
    qi = apply_rope(qi.reshape(Bsz, L, IDX_HEADS, IDX_DIM), cos_i, sin_i)
    ki = apply_rope(ki.reshape(Bsz, L, 1, IDX_DIM), cos_i, sin_i)[:, :, 0]
    wi = wi * (IDX_HEADS ** -0.5 * IDX_DIM ** -0.5)
    topk = min(TOPK_MAX, L // 4)
    nb = L // Q_BLOCK
    group = ATT_HEADS // ATT_KV_HEADS

    def to_blocks(t):
        return t.reshape(Bsz, nb, Q_BLOCK, *t.shape[2:]).swapaxes(0, 1)

    qpos = jnp.arange(L, dtype=jnp.int32).reshape(nb, Q_BLOCK)
    kpos = jnp.arange(L, dtype=jnp.int32)
    bidx = jnp.arange(Bsz)[:, None, None]

    def block(args):
        qb, qib, wib, tq = args
        logits = jnp.einsum('bqhd,bsd->bqhs', qib, ki)
        score = jnp.einsum('bqhs,bqh->bqs', jax.nn.relu(logits).astype(f32), wib.astype(f32))
        score = jnp.where(kpos[None, None, :] <= tq[None, :, None], score, -jnp.inf)
        _, idx = lax.top_k(score, topk)
        valid = idx <= tq[None, :, None]
        k_sel = k[bidx, idx]
        v_sel = v[bidx, idx]
        qg = qb.reshape(Bsz, Q_BLOCK, ATT_KV_HEADS, group, ATT_HEAD_DIM)
        s = jnp.einsum('bqkgd,bqnkd->bqkgn', qg, k_sel).astype(f32)
        s = jnp.where(valid[:, :, None, None, :], s, -jnp.inf)
        p = jax.nn.softmax(s, axis=-1).astype(v.dtype)
        o = jnp.einsum('bqkgn,bqnkd->bqkgd', p, v_sel)
        return o.reshape(Bsz, Q_BLOCK, ATT_HEADS * ATT_HEAD_DIM)

    out = lax.map(block, (to_blocks(q), to_blocks(qi), to_blocks(wi), qpos))
    out = out.swapaxes(0, 1).reshape(Bsz, L, ATT_HEADS * ATT_HEAD_DIM)
    return out @ w_out


def cross_attn(hn, mem_n, wq, wk, wv, wo):
    Bsz, L, _ = hn.shape
    M = mem_n.shape[1]
    q = (hn @ wq).reshape(Bsz, L, XA_HEADS, XA_HEAD_DIM) * XA_HEAD_DIM ** -0.5
    k = (mem_n @ wk).reshape(Bsz, M, XA_HEADS, XA_HEAD_DIM)
    v = (mem_n @ wv).reshape(Bsz, M, XA_HEADS, XA_HEAD_DIM)
    s = jnp.einsum('bqhd,bmhd->bhqm', q, k).astype(jnp.float32)
    p = jax.nn.softmax(s, axis=-1).astype(hn.dtype)
    o = jnp.einsum('bhqm,bmhd->bqhd', p, v).reshape(Bsz, L, XA_HEADS * XA_HEAD_DIM)
    return o @ wo


def setup_inputs(seed: int = 0) -> dict:
    key = jax.random.key(seed)
    ks = iter(jax.random.split(key, 48))
    f32 = jnp.float32

    def w(shape, fan_in):
        return jax.random.normal(next(ks), shape, f32) * fan_in ** -0.5

    def gain(shape):
        return 1.0 + 0.02 * jax.random.normal(next(ks), shape, f32)

    def small(shape, s=0.01):
        return s * jax.random.normal(next(ks), shape, f32)

    x = jax.random.normal(next(ks), (BATCH, SEQ, D_MODEL), f32)
    mem = jax.random.normal(next(ks), (BATCH, N_MEM, D_MODEL), f32)
    offset = jax.random.randint(next(ks), (BATCH, 1), 0, 1024, dtype=jnp.int32)
    positions = offset + jnp.arange(SEQ, dtype=jnp.int32)[None, :]
    n_idx = jnp.arange(S5_STATE, dtype=f32)
    lam_re = -0.5 + small((N_EVEN, S5_GROUPS, S5_STATE))
    lam_im = math.pi * n_idx + small((N_EVEN, S5_GROUPS, S5_STATE))
    log_dt = jax.random.uniform(next(ks), (N_EVEN, S5_GROUPS), f32,
                                math.log(S5_DT_MIN), math.log(S5_DT_MAX))
    return {
        "x": x,
        "mem": mem,
        "positions": positions,
        "ffn1_norm": gain((DEPTH, D_MODEL)),
        "ffn1_w_gate": w((DEPTH, D_MODEL, D_FF), D_MODEL),
        "ffn1_w_up": w((DEPTH, D_MODEL, D_FF), D_MODEL),
        "ffn1_w_down": w((DEPTH, D_FF, D_MODEL), D_FF),
        "mix_norm": gain((DEPTH, D_MODEL)),
        "ev_w_in": w((N_EVEN, D_MODEL, EV_IN), D_MODEL),
        "ev_w_out": w((N_EVEN, GLA_WIDTH + S5_WIDTH, D_MODEL), GLA_WIDTH + S5_WIDTH),
        "gla_w_alpha": w((N_EVEN, GLA_RANK, GLA_HEADS * GLA_DK), GLA_RANK),
        "gla_b_alpha": small((N_EVEN, GLA_HEADS * GLA_DK), 0.1),
        "gla_norm": gain((N_EVEN, GLA_DV)),
        "s5_lambda_re": lam_re,
        "s5_lambda_im": lam_im,
        "s5_log_dt": log_dt,
        "s5_B_re": w((N_EVEN, S5_GROUPS, S5_STATE, S5_GROUP), 2 * S5_GROUP),
        "s5_B_im": w((N_EVEN, S5_GROUPS, S5_STATE, S5_GROUP), 2 * S5_GROUP),
        "s5_C_re": 0.5 * jax.random.normal(next(ks), (N_EVEN, S5_GROUPS, S5_GROUP, S5_STATE), f32),
        "s5_C_im": 0.5 * jax.random.normal(next(ks), (N_EVEN, S5_GROUPS, S5_GROUP, S5_STATE), f32),
        "s5_D": jax.random.normal(next(ks), (N_EVEN, S5_GROUPS, S5_GROUP), f32),
        "s5_w_glu": w((N_EVEN, S5_WIDTH, S5_WIDTH), S5_WIDTH),
        "s5_b_glu": small((N_EVEN, S5_WIDTH)),
        "od_w_in": w((N_ODD, D_MODEL, OD_IN), D_MODEL),
        "od_w_out": w((N_ODD, ATT_HEADS * ATT_HEAD_DIM, D_MODEL), ATT_HEADS * ATT_HEAD_DIM),
        "xa_norm": gain((DEPTH, D_MODEL)),
        "mem_norm": gain((D_MODEL,)),
        "xa_wq": w((DEPTH, D_MODEL, D_MODEL), D_MODEL),
        "xa_wk": w((DEPTH, D_MODEL, D_MODEL), D_MODEL),
        "xa_wv": w((DEPTH, D_MODEL, D_MODEL), D_MODEL),
        "xa_wo": w((DEPTH, D_MODEL, D_MODEL), D_MODEL),
        "ffn2_norm": gain((DEPTH, D_MODEL)),
        "ffn2_w_gate": w((DEPTH, D_MODEL, D_FF), D_MODEL),
        "ffn2_w_up": w((DEPTH, D_MODEL, D_FF), D_MODEL),
        "ffn2_w_down": w((DEPTH, D_FF, D_MODEL), D_FF),
        "final_norm": gain((D_MODEL,)),
    }


def reference(x, mem, positions, ffn1_norm, ffn1_w_gate, ffn1_w_up, ffn1_w_down, mix_norm,
              ev_w_in, ev_w_out, gla_w_alpha, gla_b_alpha, gla_norm, s5_lambda_re, s5_lambda_im,
              s5_log_dt, s5_B_re, s5_B_im, s5_C_re, s5_C_im, s5_D, s5_w_glu, s5_b_glu,
              od_w_in, od_w_out, xa_norm, mem_norm, xa_wq, xa_wk, xa_wv, xa_wo,
              ffn2_norm, ffn2_w_gate, ffn2_w_up, ffn2_w_down, final_norm):
    cos_a, sin_a = rope_tables(positions, ATT_HEAD_DIM)
    cos_i, sin_i = rope_tables(positions, IDX_DIM)
    mem_n = rmsnorm(mem, mem_norm)
    h = x
    for layer in range(DEPTH):
        h = h + 0.5 * swiglu(rmsnorm(h, ffn1_norm[layer]),
                             ffn1_w_gate[layer], ffn1_w_up[layer], ffn1_w_down[layer])
        hn = rmsnorm(h, mix_norm[layer])
        if layer % 2 == 0:
            e = layer // 2
            q, k, v, r, a_low, u = jnp.split(hn @ ev_w_in[e], _splits(EV_SIZES), axis=-1)
            o_gla = gla_mixer(q, k, v, r, a_low, gla_w_alpha[e], gla_b_alpha[e], gla_norm[e])
            o_s5 = s5_mixer(u, s5_lambda_re[e], s5_lambda_im[e], s5_log_dt[e], s5_B_re[e],
                            s5_B_im[e], s5_C_re[e], s5_C_im[e], s5_D[e], s5_w_glu[e], s5_b_glu[e])
            mix = jnp.concatenate([o_gla, o_s5], axis=-1) @ ev_w_out[e]
        else:
            o = layer // 2
            mix = dsa_mixer(hn, od_w_in[o], od_w_out[o], cos_a, sin_a, cos_i, sin_i)
        h = h + mix
        h = h + cross_attn(rmsnorm(h, xa_norm[layer]), mem_n,
                           xa_wq[layer], xa_wk[layer], xa_wv[layer], xa_wo[layer])
        h = h + 0.5 * swiglu(rmsnorm(h, ffn2_norm[layer]),
                             ffn2_w_gate[layer], ffn2_w_up[layer], ffn2_w_down[layer])
    return rmsnorm(h, final_norm)
```

```cpp
#include <hip/hip_runtime.h>
#include <cstdio>
#include <cstdint>
namespace pg8 {
#define PG8_LAS __attribute__((address_space(3)))
typedef unsigned short bf16_t;
typedef short bf16x8 __attribute__((ext_vector_type(8)));
typedef float f32x4 __attribute__((ext_vector_type(4)));
typedef unsigned u32x4 __attribute__((ext_vector_type(4)));
constexpr int BM = 256, BK = 64, HALF = 128, HTB = HALF * BK * 2  , STAGE_BYTES = 8 * HTB, NXCD = 8, WGM = 8;

__host__ __device__ __forceinline__ int lds_byte(int r, int c) { const int st = (r >> 4) * 2 + (c >> 5), rr = r & 15, cc = c & 31, ob = rr * 64 + cc * 2; return st * 1024 + (ob ^ (((ob >> 9) & 1) << 5)); }
__host__ __device__ __forceinline__ void stage_rc(int b, int& R, int& C) { const int st = b / 1024, sb = b % 1024, swz = sb ^ (((sb >> 9) & 1) << 5); R = (st >> 1) * 16 + swz / 64; C = (st & 1) * 32 + (swz % 64) / 2; }
__host__ __device__ __forceinline__ int perm32(int rho) { const int n = rho >> 4, i = rho & 15; return 8 * (i >> 2) + 4 * n + (i & 3); }

struct Unit { int pm, pn, ui; };
struct Gemm { const bf16_t* A; const bf16_t* Bt; int M, N, K; };

struct StaticOrder {
    int nM, nN, nwg, G, c;
    __host__ __device__ void init(int M, int N, int G_, int c_) { nM = M / BM; nN = N / BM; nwg = nM * nN; G = G_; c = c_; }
    __host__ __device__ bool next(int i, Unit& u) const {
        const long L = (long)i * G + c; if (L >= nwg) return false;
        int wgid = (int)L; { const int q = nwg / NXCD, r = nwg % NXCD, xcd = wgid % NXCD, off = wgid / NXCD; wgid = (xcd < r ? xcd * (q + 1) : r * (q + 1) + (xcd - r) * q) + off; }
        const int nig = WGM * nN, gid = wgid / nig, fm = gid * WGM, gsz = (nM - fm) < WGM ? (nM - fm) : WGM;
        u.pm = fm + ((wgid % nig) % gsz); u.pn = (wgid % nig) / gsz; return true;
    }
    __device__ __forceinline__ void a_ready(const Unit&) const {}
    __device__ __forceinline__ void done(const Unit&) const {}
};

__device__ __forceinline__ unsigned cvt_pk_bf16(float lo, float hi) { unsigned r; asm volatile("v_cvt_pk_bf16_f32 %0, %1, %2" : "=v"(r) : "v"(lo), "v"(hi)); return r; }
typedef float f32x2 __attribute__((ext_vector_type(2)));
typedef unsigned u32x2 __attribute__((ext_vector_type(2)));
#define PG8_GAS __attribute__((address_space(1)))
#define PG8_ST16_WT(ptr_, val_) do { PG8_GAS u32x4* dp__ = (PG8_GAS u32x4*)(ptr_); asm volatile("global_store_dwordx4 %0, %1, off sc1\n\ts_nop 4" : : "v"(dp__), "v"(val_) : "memory"); } while (0)
#define PG8_ST8_WT(ptr_, val_) do { PG8_GAS u32x2* dp__ = (PG8_GAS u32x2*)(ptr_); asm volatile("global_store_dwordx2 %0, %1, off sc1\n\ts_nop 4" : : "v"(dp__), "v"(val_) : "memory"); } while (0)
__device__ __forceinline__ u32x2 pack8_fp8(const float (&x)[8]) { int w0 = 0, w1 = 0; w0 = __builtin_amdgcn_cvt_pk_fp8_f32(x[0], x[1], w0, false); w0 = __builtin_amdgcn_cvt_pk_fp8_f32(x[2], x[3], w0, true);
    w1 = __builtin_amdgcn_cvt_pk_fp8_f32(x[4], x[5], w1, false); w1 = __builtin_amdgcn_cvt_pk_fp8_f32(x[6], x[7], w1, true); u32x2 r; r.x = (unsigned)w0; r.y = (unsigned)w1; return r; }
__device__ __forceinline__ u32x4 split8_hilo(const float (&x)[8]) { const u32x2 h = pack8_fp8(x);
    const f32x2 a = __builtin_amdgcn_cvt_pk_f32_fp8((int)h.x, false), b = __builtin_amdgcn_cvt_pk_f32_fp8((int)h.x, true), c = __builtin_amdgcn_cvt_pk_f32_fp8((int)h.y, false), d = __builtin_amdgcn_cvt_pk_f32_fp8((int)h.y, true);
    const float r[8] = {x[0] - a.x, x[1] - a.y, x[2] - b.x, x[3] - b.y, x[4] - c.x, x[5] - c.y, x[6] - d.x, x[7] - d.y}; const u32x2 l = pack8_fp8(r);
    u32x4 w; w.x = h.x; w.y = h.y; w.z = l.x; w.w = l.y; return w; }
__device__ __forceinline__ float bf_lo(unsigned w) { return __uint_as_float(w << 16); }
__device__ __forceinline__ float bf_hi(unsigned w) { return __uint_as_float(w & 0xffff0000u); }
__device__ __forceinline__ float fast_sigmoid(float x) { return __builtin_amdgcn_rcpf(1.0f + __expf(-x)); }
struct EpiSwiGLU {
    static constexpr bool PERM = true, AFTER_DRAIN = false;
    bf16_t* O; int ldc; const PG8_LAS float* rsl;
    __device__ __forceinline__ void operator()(const f32x4 (&acc)[2][2][4][2], const Unit& u, int wr, int wc, int fr, int fq) const {
        const int col0 = u.pn * HALF + wc * 32 + 8 * fq; const PG8_LAS float* rp = rsl + u.ui * 256 + wr * 64 + fr;
#pragma unroll
        for (int ai = 0; ai < 2; ++ai)
#pragma unroll
            for (int m = 0; m < 4; ++m) {
                const int row = u.pm * BM + ai * HALF + wr * 64 + m * 16 + fr; const float r = rp[ai * HALF + m * 16];
                float h[8];
#pragma unroll
                for (int n = 0; n < 2; ++n)
#pragma unroll
                    for (int j = 0; j < 4; ++j) { const float g = acc[ai][0][m][n][j] * r, up = acc[ai][1][m][n][j] * r; h[n * 4 + j] = g * fast_sigmoid(g) * up; }
                u32x4 w; w.x = cvt_pk_bf16(h[0], h[1]); w.y = cvt_pk_bf16(h[2], h[3]); w.z = cvt_pk_bf16(h[4], h[5]); w.w = cvt_pk_bf16(h[6], h[7]);
                { PG8_GAS u32x4* dp_ = (PG8_GAS u32x4*)(O + (size_t)row * ldc + col0); asm volatile("global_store_dwordx4 %0, %1, off sc1\n\ts_nop 4" : : "v"(dp_), "v"(w) : "memory"); }
            }
    }
};
struct EpiResid {
    static constexpr bool PERM = false, AFTER_DRAIN = false;
    bf16_t* HB; float* ss; float scale;
    __device__ __forceinline__ void operator()(const f32x4 (&acc)[2][2][4][2], const Unit& u, int wr, int wc, int fr, int fq) const {
        const int col0 = u.pn * BM + wc * 32 + 4 * fq;
        PG8_GAS bf16_t* hb = (PG8_GAS bf16_t*)HB + (size_t)(u.pm * BM + wr * 64 + fr) * 1024 + col0;
        const int L = fr + 16 * fq, perm = 4 * (4 * fr + fq);
        const PG8_GAS bf16_t* hl = (const PG8_GAS bf16_t*)HB + (size_t)(u.pm * BM + wr * 64 + (L >> 2)) * 1024 + u.pn * BM + wc * 32 + 4 * (L & 3);
        u32x2 hv[2][4][2][2];
#pragma unroll
        for (int ai = 0; ai < 2; ++ai)
#pragma unroll
            for (int m = 0; m < 4; ++m)
#pragma unroll
                for (int bj = 0; bj < 2; ++bj)
#pragma unroll
                    for (int n = 0; n < 2; ++n) hv[ai][m][bj][n] = *(const PG8_GAS u32x2*)(hl + (size_t)(ai * HALF + m * 16) * 1024 + bj * HALF + n * 16);

#pragma unroll
        for (int ai = 0; ai < 2; ++ai)
#pragma unroll
            for (int m = 0; m < 4; ++m) {
                const int row = u.pm * BM + ai * HALF + wr * 64 + m * 16 + fr; float sq = 0.f;
#pragma unroll
                for (int bj = 0; bj < 2; ++bj)
#pragma unroll
                    for (int n = 0; n < 2; ++n) {
                        u32x2 x = hv[ai][m][bj][n]; x.x = (unsigned)__builtin_amdgcn_ds_bpermute(perm, (int)x.x); x.y = (unsigned)__builtin_amdgcn_ds_bpermute(perm, (int)x.y);
                        f32x4 h = {bf_lo(x.x), bf_hi(x.x), bf_lo(x.y), bf_hi(x.y)}; h = h + acc[ai][bj][m][n] * scale;
                        u32x2 w; w.x = cvt_pk_bf16(h[0], h[1]); w.y = cvt_pk_bf16(h[2], h[3]); PG8_ST8_WT(hb + (size_t)(ai * HALF + m * 16) * 1024 + bj * HALF + n * 16, w);
                        const float r0 = bf_lo(w.x), r1 = bf_hi(w.x), r2 = bf_lo(w.y), r3 = bf_hi(w.y);
                        sq += (r0 * r0 + r1 * r1) + (r2 * r2 + r3 * r3);
                    }
                sq += __shfl_xor(sq, 16); sq += __shfl_xor(sq, 32);
                if (fq == 0) ((PG8_GAS float*)ss)[(size_t)row * 16 + u.pn * 4 + wc] = sq;
            }
    }
};
template <bool USE_RS> struct EpiScaleBf16 {
    static constexpr bool PERM = true, AFTER_DRAIN = false;
    bf16_t* O; int ldc; const PG8_LAS float* rsl; float cscale;
    __device__ __forceinline__ void operator()(const f32x4 (&acc)[2][2][4][2], const Unit& u, int wr, int wc, int fr, int fq) const {
        const int col0 = u.pn * BM + wc * 32 + 8 * fq; const PG8_LAS float* rp = rsl + u.ui * 256 + wr * 64 + fr;
#pragma unroll
        for (int ai = 0; ai < 2; ++ai)
#pragma unroll
            for (int m = 0; m < 4; ++m) {
                const int row = u.pm * BM + ai * HALF + wr * 64 + m * 16 + fr; const float s = (USE_RS ? rp[ai * HALF + m * 16] : 1.0f) * cscale;
                PG8_GAS bf16_t* rowp = (PG8_GAS bf16_t*)O + (size_t)row * ldc + col0;
#pragma unroll
                for (int bj = 0; bj < 2; ++bj) { const f32x4 v0 = acc[ai][bj][m][0] * s, v1 = acc[ai][bj][m][1] * s;
                    u32x4 w; w.x = cvt_pk_bf16(v0[0], v0[1]); w.y = cvt_pk_bf16(v0[2], v0[3]); w.z = cvt_pk_bf16(v1[0], v1[1]); w.w = cvt_pk_bf16(v1[2], v1[3]);
                    PG8_ST16_WT(rowp + bj * HALF, w); }
            }
    }
};
struct EpiRope {
    static constexpr bool PERM = true, AFTER_DRAIN = false;
    bf16_t* O; const PG8_LAS float* rsl; const float* cA; const float* sA; const float* cI; const float* sI; unsigned char* K8; unsigned char* V8;
    __device__ __forceinline__ void operator()(const f32x4 (&acc)[2][2][4][2], const Unit& u, int wr, int wc, int fr, int fq) const {
        const int x0 = wc * 32 + 8 * fq, pn = u.pn; const PG8_LAS float* rp = rsl + u.ui * 256 + wr * 64 + fr;
        const bool rot = !(pn == 5 || (pn == 8 && x0 >= 32)); const bool tA = pn < 5; const int half = tA ? 64 : 32, i0 = x0 & (half - 1);
#pragma unroll
        for (int ai = 0; ai < 2; ++ai) {
            f32x4 tc[4][2], ts[4][2];
            if (rot) {
#pragma unroll
                for (int m = 0; m < 4; ++m) { const int row = u.pm * BM + ai * HALF + wr * 64 + m * 16 + fr;
                    const PG8_GAS float* cp = (const PG8_GAS float*)(tA ? cA + (size_t)row * 64 : cI + (size_t)row * 32) + i0; const PG8_GAS float* sp = (const PG8_GAS float*)(tA ? sA + (size_t)row * 64 : sI + (size_t)row * 32) + i0;
                    tc[m][0] = *(const PG8_GAS f32x4*)cp; tc[m][1] = *(const PG8_GAS f32x4*)(cp + 4); ts[m][0] = *(const PG8_GAS f32x4*)sp; ts[m][1] = *(const PG8_GAS f32x4*)(sp + 4); }
            }
#pragma unroll
            for (int m = 0; m < 4; ++m) {
                const int row = u.pm * BM + ai * HALF + wr * 64 + m * 16 + fr; const float r = rp[ai * HALF + m * 16];
                PG8_GAS bf16_t* orow = (PG8_GAS bf16_t*)O + (size_t)row * 2304;
                float a[8], b[8];
#pragma unroll
                for (int n = 0; n < 2; ++n)
#pragma unroll
                    for (int j = 0; j < 4; ++j) { a[4 * n + j] = acc[ai][0][m][n][j] * r; b[4 * n + j] = acc[ai][1][m][n][j] * r; }
                if (pn == 5) {
                    const size_t cr = (size_t)((row >> 13) * 2) * 8192 + (row & 8191);
                    *(PG8_GAS u32x2*)(V8 + cr * 128 + x0) = pack8_fp8(a); *(PG8_GAS u32x2*)(V8 + (cr + 8192) * 128 + x0) = pack8_fp8(b);
                } else if (pn == 8 && x0 >= 32) {
                    if (x0 == 32) { u32x4 w0; w0.x = cvt_pk_bf16(a[0], a[1]); w0.y = cvt_pk_bf16(a[2], a[3]); w0.z = cvt_pk_bf16(a[4], a[5]); w0.w = cvt_pk_bf16(a[6], a[7]); *(PG8_GAS u32x4*)(orow + 2112) = w0; }
                } else {
                    const int hh = tA ? (x0 >> 6) : (x0 >> 5);
                    const int base = pn < 4 ? 256 * pn + 128 * hh : (pn == 4 ? 1024 + 128 * hh : (pn == 8 ? 2048 : 1536 + 256 * (pn - 6) + 64 * hh));
                    const float sc = pn < 4 ? 0.08838834764831845f * 32.0f : 1.0f;
                    const f32x4 c0 = tc[m][0], c1 = tc[m][1], s0 = ts[m][0], s1 = ts[m][1];
                    const float cs[8] = {c0[0], c0[1], c0[2], c0[3], c1[0], c1[1], c1[2], c1[3]}, sn[8] = {s0[0], s0[1], s0[2], s0[3], s1[0], s1[1], s1[2], s1[3]};
                    float o1[8], o2[8];
#pragma unroll
                    for (int k = 0; k < 8; ++k) { o1[k] = (a[k] * cs[k] - b[k] * sn[k]) * sc; o2[k] = (b[k] * cs[k] + a[k] * sn[k]) * sc; }
                    u32x4 w0, w1; w0.x = cvt_pk_bf16(o1[0], o1[1]); w0.y = cvt_pk_bf16(o1[2], o1[3]); w0.z = cvt_pk_bf16(o1[4], o1[5]); w0.w = cvt_pk_bf16(o1[6], o1[7]);
                    w1.x = cvt_pk_bf16(o2[0], o2[1]); w1.y = cvt_pk_bf16(o2[2], o2[3]); w1.z = cvt_pk_bf16(o2[4], o2[5]); w1.w = cvt_pk_bf16(o2[6], o2[7]);
                    if (pn < 4) { w0 = split8_hilo(o1); w1 = split8_hilo(o2); }
                    if (pn == 4) { const size_t cr = (size_t)((row >> 13) * 2 + hh) * 8192 + (row & 8191); *(PG8_GAS u32x2*)(K8 + cr * 128 + i0) = pack8_fp8(o1); *(PG8_GAS u32x2*)(K8 + cr * 128 + 64 + i0) = pack8_fp8(o2); }
                    else { PG8_ST16_WT(orow + base + i0, w0); PG8_ST16_WT(orow + base + half + i0, w1); }
                }
            }
        }
    }
};
struct EpiGLU {
    static constexpr bool PERM = true, AFTER_DRAIN = false;
    const bf16_t* Y; const float* bias; bf16_t* CAT;
    __device__ __forceinline__ void operator()(const f32x4 (&acc)[2][2][4][2], const Unit& u, int wr, int wc, int fr, int fq) const {
        const int col0 = u.pn * BM + wc * 32 + 8 * fq;
        const PG8_GAS bf16_t* yb = (const PG8_GAS bf16_t*)Y + (size_t)(u.pm * BM + wr * 64 + fr) * 512 + col0;
        u32x4 yv[2][4][2]; f32x4 bb[2][2];
#pragma unroll
        for (int bj = 0; bj < 2; ++bj) { bb[bj][0] = *(const PG8_GAS f32x4*)(bias + col0 + bj * HALF); bb[bj][1] = *(const PG8_GAS f32x4*)(bias + col0 + bj * HALF + 4); }
#pragma unroll
        for (int ai = 0; ai < 2; ++ai)
#pragma unroll
            for (int m = 0; m < 4; ++m)
#pragma unroll
                for (int bj = 0; bj < 2; ++bj) yv[ai][m][bj] = *(const PG8_GAS u32x4*)(yb + (size_t)(ai * HALF + m * 16) * 512 + bj * HALF);
#pragma unroll
        for (int ai = 0; ai < 2; ++ai)
#pragma unroll
            for (int m = 0; m < 4; ++m) {
                const int row = u.pm * BM + ai * HALF + wr * 64 + m * 16 + fr;
#pragma unroll
                for (int bj = 0; bj < 2; ++bj) { const int c = col0 + bj * HALF; const u32x4 y4 = yv[ai][m][bj];
                    const f32x4 z0 = acc[ai][bj][m][0] + bb[bj][0], z1 = acc[ai][bj][m][1] + bb[bj][1];
                    float o[8];
                    o[0] = bf_lo(y4.x) * fast_sigmoid(z0[0]); o[1] = bf_hi(y4.x) * fast_sigmoid(z0[1]); o[2] = bf_lo(y4.y) * fast_sigmoid(z0[2]); o[3] = bf_hi(y4.y) * fast_sigmoid(z0[3]);
                    o[4] = bf_lo(y4.z) * fast_sigmoid(z1[0]); o[5] = bf_hi(y4.z) * fast_sigmoid(z1[1]); o[6] = bf_lo(y4.w) * fast_sigmoid(z1[2]); o[7] = bf_hi(y4.w) * fast_sigmoid(z1[3]);
                    u32x4 w; w.x = cvt_pk_bf16(o[0], o[1]); w.y = cvt_pk_bf16(o[2], o[3]); w.z = cvt_pk_bf16(o[4], o[5]); w.w = cvt_pk_bf16(o[6], o[7]);
                    *(PG8_GAS u32x4*)(CAT + (size_t)row * 1024 + 512 + c) = w; }
            }
    }
};
template <int NM, int NN> struct TileOrder {
    static constexpr int nwg = NM * NN, WG = NM < 8 ? NM : 8, nig = WG * NN;
    static_assert(nwg % 8 == 0 && NM % WG == 0, "TileOrder shapes");
    int G, c;
    __device__ __forceinline__ bool next(int i, Unit& u) const {
        const int L = i * G + c; if (c < 0 || L >= nwg) return false;
        const int wgid = (L & 7) * (nwg / 8) + (L >> 3), gid = wgid / nig, r = wgid % nig;
        u.pm = gid * WG + (r % WG); u.pn = r / WG; u.ui = i; return true;
    }
    __device__ __forceinline__ void a_ready(const Unit&) const {}
    __device__ __forceinline__ void done(const Unit&) const {}
};
template <class Epi, class Sched, bool ALIGN_EPI = false, bool SP2 = false>
__device__ __forceinline__ void gemm_phase(PG8_LAS unsigned char* lds, const Gemm g, const Sched& S, const Epi& E, int tid_in) {
    int tid_ = tid_in; asm volatile("" : "+v"(tid_));
    const int tid = tid_, wid = __builtin_amdgcn_readfirstlane(tid >> 6), lane = tid & 63, wr = wid >> 2, wc = wid & 3, fr = lane & 15, fq = lane >> 4;
    const int K = g.K, nt = K / BK;
    unsigned voffA[2], voffB[2];
#pragma unroll
    for (int i = 0; i < 2; ++i) { int R, C; stage_rc(tid * 16 + i * 8192, R, C); const int Rb = Epi::PERM ? ((R & ~31) + perm32(R & 31)) : R;
        voffA[i] = (unsigned)(R * K + C) * 2u; voffB[i] = (unsigned)(Rb * K + C) * 2u; }
    const size_t kstep = (size_t)(BK * 2);
    const size_t hstep = (size_t)HALF * K * 2;
    const size_t tstep = 2 * hstep;
    const unsigned ldsw = (unsigned)wid * 1024u;
    const int aoff = lds_byte(wr * 64 + fr, fq * 8), boff = lds_byte(wc * 32 + fr, fq * 8);
#define PG8_SA(b, h) (((b) * 2 + (h)) * HTB)
#define PG8_SB(b, h) ((4 + (b) * 2 + (h)) * HTB)
#define PG8_STAGE(bufoff, gbase, voff) do { _Pragma("unroll") for (int _i = 0; _i < 2; ++_i) \
        __builtin_amdgcn_global_load_lds((const unsigned*)((const char*)(gbase) + (voff)[_i]), (PG8_LAS unsigned*)(lds + (bufoff) + ldsw + _i * 8192), 16, 0, 0); } while (0)
#define PG8_LDA(dst, b, h) do { _Pragma("unroll") for (int m = 0; m < 4; ++m) _Pragma("unroll") for (int k = 0; k < 2; ++k) dst[m][k] = *(const PG8_LAS bf16x8*)(lds + PG8_SA(b, h) + aoff + m * 2048 + k * 1024); } while (0)
#define PG8_LDB(dst, b, h) do { _Pragma("unroll") for (int n = 0; n < 2; ++n) _Pragma("unroll") for (int k = 0; k < 2; ++k) dst[n][k] = *(const PG8_LAS bf16x8*)(lds + PG8_SB(b, h) + boff + n * 2048 + k * 1024); } while (0)
#define PG8_MMA(ai, bj, At, Bt) do { __builtin_amdgcn_s_setprio(1); _Pragma("unroll") for (int m = 0; m < 4; ++m) _Pragma("unroll") for (int n = 0; n < 2; ++n) _Pragma("unroll") for (int k = 0; k < 2; ++k) \
        acc[ai][bj][m][n] = __builtin_amdgcn_mfma_f32_16x16x32_bf16(Bt[n][k], At[m][k], acc[ai][bj][m][n], 0, 0, 0); __builtin_amdgcn_s_setprio(0); } while (0)
#define PG8_WAIT_V(n) asm volatile("s_waitcnt vmcnt(" #n ")" ::: "memory")
#define PG8_WAIT_L(n) asm volatile("s_waitcnt lgkmcnt(" #n ")" ::: "memory")
#define PG8_BAR __builtin_amdgcn_s_barrier()
#define PG8_SCHED __builtin_amdgcn_sched_barrier(0)
    Unit cur, nxt; int ui = 0;
    if (!S.next(0, cur)) return;
    f32x4 acc[2][2][4][2];
#pragma unroll
    for (int a = 0; a < 2; ++a)
#pragma unroll
        for (int b = 0; b < 2; ++b)
#pragma unroll
            for (int m = 0; m < 4; ++m)
#pragma unroll
                for (int n = 0; n < 2; ++n) acc[a][b][m][n] = (f32x4){0.f, 0.f, 0.f, 0.f};
    bf16x8 At[4][2], B0[2][2], B1[2][2];
    const char* cA = (const char*)g.A + (size_t)cur.pm * tstep; const char* cB = (const char*)g.Bt + (size_t)cur.pn * tstep;
    S.a_ready(cur);
    if constexpr (SP2) {
        PG8_STAGE(PG8_SB(0, 0), cB, voffB); PG8_STAGE(PG8_SB(0, 1), cB + hstep, voffB); PG8_STAGE(PG8_SA(0, 0), cA, voffA); PG8_STAGE(PG8_SA(0, 1), cA + hstep, voffA);
        if (wr == 1) PG8_BAR;
        PG8_WAIT_V(2); PG8_BAR;
        PG8_STAGE(PG8_SB(1, 0), cB + kstep, voffB); PG8_STAGE(PG8_SA(1, 0), cA + kstep, voffA); PG8_STAGE(PG8_SB(1, 1), cB + hstep + kstep, voffB);
        PG8_WAIT_V(6); PG8_BAR;
    } else {
        PG8_STAGE(PG8_SB(0, 0), cB, voffB); PG8_STAGE(PG8_SA(0, 0), cA, voffA); PG8_STAGE(PG8_SB(0, 1), cB + hstep, voffB); PG8_STAGE(PG8_SA(0, 1), cA + hstep, voffA);
        if (wr == 1) PG8_BAR;
        PG8_WAIT_V(4); PG8_BAR;
        PG8_STAGE(PG8_SB(1, 0), cB + kstep, voffB); PG8_STAGE(PG8_SA(1, 0), cA + kstep, voffA); PG8_STAGE(PG8_SB(1, 1), cB + hstep + kstep, voffB);
        PG8_WAIT_V(6); PG8_BAR;
    }
    for (;;) {
        const bool has_next = S.next(ui + 1, nxt);
        const char* nA = has_next ? (const char*)g.A + (size_t)nxt.pm * tstep : cA; const char* nB = has_next ? (const char*)g.Bt + (size_t)nxt.pn * tstep : cB;
        for (int t = 0; t < nt; t += 2) {
            const bool last = (t == nt - 2);
            const char* a1 = cA + (size_t)(t + 1) * kstep;
            const char* a2 = last ? nA : cA + (size_t)(t + 2) * kstep; const char* b2 = last ? nB : cB + (size_t)(t + 2) * kstep;
            const char* a3 = a2 + kstep; const char* b3 = b2 + kstep;
            if (last && has_next) S.a_ready(nxt);
            if constexpr (SP2) {
            PG8_LDB(B0, 0, 0); PG8_LDB(B1, 0, 1); PG8_SCHED; PG8_LDA(At, 0, 0); PG8_STAGE(PG8_SA(1, 1), a1 + hstep, voffA);
            PG8_WAIT_V(8); PG8_WAIT_L(0); PG8_BAR; PG8_MMA(0, 0, At, B0); PG8_MMA(0, 1, At, B1); PG8_BAR; PG8_SCHED;
            PG8_LDA(At, 0, 1); PG8_STAGE(PG8_SB(0, 0), b2, voffB); PG8_STAGE(PG8_SB(0, 1), b2 + hstep, voffB); PG8_STAGE(PG8_SA(0, 0), a2, voffA);
            PG8_WAIT_V(8); PG8_WAIT_L(0); PG8_BAR; PG8_MMA(1, 0, At, B0); PG8_MMA(1, 1, At, B1); PG8_BAR; PG8_SCHED;
            PG8_LDB(B0, 1, 0); PG8_LDB(B1, 1, 1); PG8_SCHED; PG8_LDA(At, 1, 0); PG8_STAGE(PG8_SA(0, 1), a2 + hstep, voffA);
            PG8_WAIT_V(8); PG8_WAIT_L(0); PG8_BAR; PG8_MMA(0, 0, At, B0); PG8_MMA(0, 1, At, B1); PG8_BAR; PG8_SCHED;
            PG8_LDA(At, 1, 1); PG8_STAGE(PG8_SB(1, 0), b3, voffB); PG8_STAGE(PG8_SB(1, 1), b3 + hstep, voffB); PG8_STAGE(PG8_SA(1, 0), a3, voffA);
            PG8_WAIT_V(8); PG8_WAIT_L(0); PG8_BAR; PG8_MMA(1, 0, At, B0); PG8_MMA(1, 1, At, B1); PG8_BAR; PG8_SCHED;
            } else {
            PG8_LDB(B0, 0, 0); PG8_SCHED; PG8_LDA(At, 0, 0); PG8_STAGE(PG8_SA(1, 1), a1 + hstep, voffA);
            PG8_WAIT_L(8); PG8_BAR; PG8_WAIT_L(0); PG8_MMA(0, 0, At, B0); PG8_BAR; PG8_SCHED;
            PG8_LDB(B1, 0, 1); PG8_STAGE(PG8_SB(0, 0), b2, voffB);
            PG8_BAR; PG8_WAIT_L(0); PG8_MMA(0, 1, At, B1); PG8_BAR;
            PG8_LDA(At, 0, 1); PG8_STAGE(PG8_SA(0, 0), a2, voffA);
            PG8_BAR; PG8_WAIT_L(0); PG8_MMA(1, 0, At, B0); PG8_BAR; PG8_SCHED;
            PG8_STAGE(PG8_SB(0, 1), b2 + hstep, voffB);
            PG8_WAIT_V(6); PG8_BAR; PG8_MMA(1, 1, At, B1); PG8_BAR;
            PG8_LDB(B0, 1, 0); PG8_SCHED; PG8_LDA(At, 1, 0); PG8_STAGE(PG8_SA(0, 1), a2 + hstep, voffA);
            PG8_WAIT_L(8); PG8_BAR; PG8_WAIT_L(0); PG8_MMA(0, 0, At, B0); PG8_BAR; PG8_SCHED;
            PG8_LDB(B1, 1, 1); PG8_STAGE(PG8_SB(1, 0), b3, voffB);
            PG8_BAR; PG8_WAIT_L(0); PG8_MMA(0, 1, At, B1); PG8_BAR;
            PG8_LDA(At, 1, 1); PG8_STAGE(PG8_SA(1, 0), a3, voffA);
            PG8_BAR; PG8_WAIT_L(0); PG8_MMA(1, 0, At, B0); PG8_BAR; PG8_SCHED;
            PG8_STAGE(PG8_SB(1, 1), b3 + hstep, voffB);
            PG8_WAIT_V(6); PG8_BAR; PG8_MMA(1, 1, At, B1); PG8_BAR;
            }
        }
        if constexpr (ALIGN_EPI) { if (wr == 0) PG8_BAR; }
        if constexpr (!Epi::AFTER_DRAIN) { E(acc, cur, wr, wc, fr, fq); S.done(cur); }
        if (!has_next) break;
#pragma unroll
        for (int a = 0; a < 2; ++a)
#pragma unroll
            for (int b = 0; b < 2; ++b)
#pragma unroll
                for (int m = 0; m < 4; ++m)
#pragma unroll
                    for (int n = 0; n < 2; ++n) acc[a][b][m][n] = (f32x4){0.f, 0.f, 0.f, 0.f};
        cur = nxt; cA = nA; cB = nB; ++ui;
        if constexpr (ALIGN_EPI) { if (wr == 1) PG8_BAR; }
    }
    PG8_WAIT_V(0);
    if constexpr (!ALIGN_EPI) { if (wr == 0) PG8_BAR; }
    PG8_BAR;
    if constexpr (Epi::AFTER_DRAIN) { E.fused(acc, cur, wr, wc, fr, fq, lds, wid, lane); S.done(cur); }
#undef PG8_SA
#undef PG8_SB
#undef PG8_STAGE
#undef PG8_LDA
#undef PG8_LDB
#undef PG8_MMA
#undef PG8_WAIT_V
#undef PG8_WAIT_L
#undef PG8_BAR
#undef PG8_SCHED
}
}

constexpr int NB = 2, SEQ = 8192, DM = 1024, MTOK = NB * SEQ, DEPTH = 4, NMEM = 256, DFF = 2816;
constexpr int PROJW = 2304;
constexpr int EV_IN = 2064, OD_IN = 2120;
constexpr float EPS = 1e-6f;
constexpr int S5T = 64, S5NC = SEQ / S5T;
constexpr int TOPK = 256;
constexpr int PH_LAYER0 = 2, PH_PER_LAYER = 14, PH_FINAL = PH_LAYER0 + DEPTH * PH_PER_LAYER, N_PHASES = PH_FINAL + 1;

constexpr size_t MiB = 1u << 20;
constexpr size_t WS_CTL = 0, CTL_ZERO_BYTES = 1 * MiB;
constexpr size_t WS_H = 1 * MiB, WS_HB = 65 * MiB, WS_SS = 97 * MiB;
constexpr size_t WS_COSA = 98 * MiB, WS_SINA = 102 * MiB, WS_COSI = 106 * MiB, WS_SINI = 108 * MiB;
constexpr size_t WS_MEMN = 110 * MiB, WS_MK = 111 * MiB, WS_MVT = 115 * MiB, WS_S5P = 119 * MiB;
constexpr size_t WS_W = 121 * MiB, WS_SCR = 169 * MiB, WS_END = 345 * MiB;
constexpr size_t WO_GU1 = 0, WO_D1 = 11 * MiB, WO_IN = WO_D1 + 5632 * 1024, WO_OUT = WO_IN + 4608 * 1024, WO_GLU = WO_OUT + 2 * MiB, WO_XQ = WO_GLU + 512 * 1024,
                 WO_XO = WO_XQ + 2 * MiB, WO_GU2 = WO_XO + 2 * MiB, WO_D2 = WO_GU2 + 11 * MiB, WO_END = WO_D2 + 5632 * 1024;
static_assert(WO_END <= 48 * MiB, "weights region");
constexpr size_t SC_HID = 0, SC_PROJ = 0, SC_XQ = 0, SC_XO = 32 * MiB, SC_KVW = 96 * MiB;
constexpr size_t SC_DS = 72 * MiB, SC_BC = 104 * MiB, SC_DEC = 120 * MiB, SC_S5E = 121 * MiB, SC_Y = 125 * MiB, SC_CAT = 141 * MiB;
constexpr size_t SC_SEL = 72 * MiB, SC_SELN = 80 * MiB, SC_K8 = 81 * MiB, SC_V8 = 85 * MiB;
static_assert(SC_CAT + 32 * MiB <= WS_END - WS_SCR, "scratch region");
constexpr int S5P_A = 0, S5P_AT = 2 * 32 * 64 * 2, S5P_BB = 2 * S5P_AT, S5P_BBH = S5P_BB + 2 * 32 * 64 * 16 * 2, S5P_END = S5P_BBH + 2 * 32 * 128 * 16 / 2;
constexpr int CW_BAR = 1024;

constexpr int RING_BYTES = 131072;
constexpr int LDS_BYTES = 163840, LDSCTL_OFF = LDS_BYTES - 1024;

#define GAS __attribute__((address_space(1)))
#define LAS __attribute__((address_space(3)))
#define DI __device__ __forceinline__
typedef unsigned short bf16;
typedef unsigned v4u __attribute__((ext_vector_type(4)));
typedef unsigned v2u __attribute__((ext_vector_type(2)));
typedef float f32x4 __attribute__((ext_vector_type(4)));
typedef float f32x2 __attribute__((ext_vector_type(2)));
typedef short bf16x8 __attribute__((ext_vector_type(8)));
#define LDS_WAIT() asm volatile("s_waitcnt lgkmcnt(0)" ::: "memory")
#define VM_WAIT() asm volatile("s_waitcnt vmcnt(0)" ::: "memory")
DI unsigned f2bf(float f) { unsigned u = __builtin_bit_cast(unsigned, f); return (u + 0x7fffu + ((u >> 16) & 1u)) >> 16; }
DI unsigned pk2(float lo, float hi) { return f2bf(lo) | (f2bf(hi) << 16); }
DI float bflo(unsigned w) { return __uint_as_float(w << 16); }
DI float bfhi(unsigned w) { return __uint_as_float(w & 0xffff0000u); }
DI float bf2f(bf16 x) { return __uint_as_float(((unsigned)x) << 16); }
DI float wave_sum(float v) {
#pragma unroll
    for (int o = 1; o < 64; o <<= 1) v += __shfl_xor(v, o);
    return v;
}
DI f32x4 mfma16(bf16x8 a, bf16x8 b, f32x4 c) { return __builtin_amdgcn_mfma_f32_16x16x32_bf16(a, b, c, 0, 0, 0); }

#define XB_TMO      128
#define XB_XCNT(j)  (256  + 64 * (j))
#define XB_XSUB(j)  (1280 + 64 * (j))
#define XB_XGEN(j)  (2304 + 64 * (j))
#define XB_TOP      3328
#define XB_TOPGEN   3392
#define XCD_BAR_WORDS 3456
#define XB_SPIN_CAP (1u << 18)
__device__ __forceinline__ unsigned xb_ld(unsigned* p)              { return __hip_atomic_load(p, __ATOMIC_RELAXED, __HIP_MEMORY_SCOPE_AGENT); }
__device__ __forceinline__ unsigned xb_add(unsigned* p, unsigned v) { return __hip_atomic_fetch_add(p, v, __ATOMIC_RELAXED, __HIP_MEMORY_SCOPE_AGENT); }
__device__ __forceinline__ unsigned xb_xcc_id() { return (unsigned)__builtin_amdgcn_s_getreg((3 << 11) | 20) & 0xFu; }
#define XB_SPIN(cond, bar) do { unsigned _sp = 0; while (cond) { __builtin_amdgcn_s_sleep(1); \
    if ((++_sp & 255u) == 0u) { if (xb_ld(&(bar)[XB_TMO])) break; if (_sp > XB_SPIN_CAP) { atomicAdd(&(bar)[XB_TMO], 1u); break; } } } } while (0)
struct XcdBarrier { unsigned* bar; unsigned x; volatile LAS unsigned* st; };
__device__ __forceinline__ XcdBarrier xcd_barrier_post(unsigned* bar, volatile LAS unsigned* st) {
    XcdBarrier b; b.bar = bar; b.x = xb_xcc_id(); b.st = st;
    if (threadIdx.x == 0) (void)xb_add(&bar[XB_XCNT(b.x)], 1u);
    return b;
}
__device__ __forceinline__ void xcd_barrier_complete(unsigned* bar, unsigned x, unsigned& nloc, unsigned& nx) {
    const unsigned G = gridDim.x * gridDim.y * gridDim.z;
    unsigned sum, cnt, mine, sp = 0u;
    for (;;) {
        sum = 0u; cnt = 0u; mine = 0u;
#pragma unroll
        for (unsigned j = 0; j < 16; ++j) { const unsigned c = xb_ld(&bar[XB_XCNT(j)]); sum += c; cnt += (c > 0u) ? 1u : 0u; mine = (j == x) ? c : mine; }
        if (sum == G) break;
        __builtin_amdgcn_s_sleep(1);
        if ((++sp & 255u) == 0u) { if (xb_ld(&bar[XB_TMO])) break; if (sp > XB_SPIN_CAP) { atomicAdd(&bar[XB_TMO], 1u); break; } }
    }
    nloc = mine > 0u ? mine : 1u; nx = cnt > 0u ? cnt : 1u;
}
__device__ __forceinline__ void xcd_barrier(const XcdBarrier& b) {
    asm volatile("s_waitcnt vmcnt(0)" ::: "memory");
    __syncthreads();
    if (threadIdx.x == 0) {
        unsigned* bar = b.bar;
        __builtin_amdgcn_s_waitcnt(0);
        unsigned nloc = b.st[0], nx = b.st[1];
        if (nloc == 0u) { xcd_barrier_complete(bar, b.x, nloc, nx); b.st[0] = nloc; b.st[1] = nx; }
        const unsigned old = xb_add(&bar[XB_XSUB(b.x)], 1u);
        const unsigned gen = old / nloc;
        if (old + 1u == (gen + 1u) * nloc) {
            __builtin_amdgcn_fence(__ATOMIC_RELEASE, "agent");
            asm volatile("s_waitcnt vmcnt(0)" ::: "memory");
            const unsigned og = xb_add(&bar[XB_TOP], 1u);
            const unsigned tg = og / nx;
            if (og + 1u == (tg + 1u) * nx) xb_add(&bar[XB_TOPGEN], 1u);
            else XB_SPIN(xb_ld(&bar[XB_TOPGEN]) == tg, bar);
            __builtin_amdgcn_fence(__ATOMIC_ACQUIRE, "agent");
            xb_add(&bar[XB_XGEN(b.x)], 1u);
            asm volatile("s_waitcnt vmcnt(0)" ::: "memory");
        } else {
            XB_SPIN(xb_ld(&bar[XB_XGEN(b.x)]) == gen, bar);
            __builtin_amdgcn_fence(__ATOMIC_ACQUIRE, "agent");
            asm volatile("s_waitcnt vmcnt(0)" ::: "memory");
        }
    }
    __syncthreads();
}

struct Ctx { LAS unsigned char* lds; int tid, lane, wave, vcu, G; };

DI void cvt_store(bf16* dst, int K, int drow0, int k0, LAS float* scr, int lane) {
    LDS_WAIT(); asm volatile("" ::: "memory");
    const int c = lane & 7;
#pragma unroll
    for (int j = 0; j < 4; ++j) { const int n = (lane >> 3) + 8 * j; const LAS float* s = scr + (8 * c) * 33 + n;
        v4u o; o.x = pk2(s[0 * 33], s[1 * 33]); o.y = pk2(s[2 * 33], s[3 * 33]); o.z = pk2(s[4 * 33], s[5 * 33]); o.w = pk2(s[6 * 33], s[7 * 33]);
        *(v4u*)(dst + (size_t)(drow0 + n) * K + k0 + 8 * c) = o; }
    LDS_WAIT(); asm volatile("" ::: "memory");
}
DI void cvt_item(const float* src, int ldsrc, int scol0, int nvalid, const float* gain, bf16* dst, int K, int drow0, int k0, LAS float* scr, int lane) {
    const int kr = lane >> 3, n4 = 4 * (lane & 7); const bool ok = n4 < nvalid;
    const float* sp = src + (size_t)(k0 + kr) * ldsrc + scol0 + n4;
    f32x4 v[8];
#pragma unroll
    for (int i = 0; i < 8; ++i) v[i] = ok ? *(const f32x4*)(sp + (size_t)(8 * i) * ldsrc) : (f32x4){0.f, 0.f, 0.f, 0.f};
    if (gain) {
#pragma unroll
        for (int i = 0; i < 8; ++i) v[i] = v[i] * gain[k0 + kr + 8 * i];
    }
#pragma unroll
    for (int i = 0; i < 8; ++i) { LAS float* d = scr + (kr + 8 * i) * 33 + n4; d[0] = v[i].x; d[1] = v[i].y; d[2] = v[i].z; d[3] = v[i].w; }
    cvt_store(dst, K, drow0, k0, scr, lane);
}
DI void cvt_job(const Ctx& c, const float* src, int ldsrc, int scol0, int nvalid, const float* gain, bf16* dst, int K, int N, int drow0, int rot) {
    LAS float* scr = (LAS float*)(c.lds + c.wave * 8448);
    const int NGW = c.G * 8, gw = (c.vcu * 8 + c.wave + rot) % NGW, nblk = N / 32, nitems = (K / 64) * nblk;
    for (int it = gw; it < nitems; it += NGW) { const int kb = it / nblk, nb = it % nblk; int nv = nvalid - nb * 32; nv = nv < 0 ? 0 : (nv > 32 ? 32 : nv);
        cvt_item(src, ldsrc, scol0 + nb * 32, nv, gain, dst, K, drow0 + nb * 32, kb * 64, scr, c.lane); }
}
DI void cvt_job_gu(const Ctx& c, const float* gate, const float* up, const float* gain, bf16* dst, int rot) {
    LAS float* scr = (LAS float*)(c.lds + c.wave * 8448);
    const int NGW = c.G * 8, gw = (c.vcu * 8 + c.wave + rot) % NGW, nblk = 5632 / 32, nitems = (1024 / 64) * nblk;
    for (int it = gw; it < nitems; it += NGW) { const int kb = it / nblk, nb = it % nblk, n0 = nb * 32;
        const float* src = ((n0 >> 7) & 1) ? up : gate; const int sc = (n0 >> 8) * 128 + (n0 & 127);
        cvt_item(src, DFF, sc, 32, gain, dst, 1024, n0, kb * 64, scr, c.lane); }
}
DI void cvt_job_rope(const Ctx& c, const float* src, const float* gain, bf16* dst, int rot) {
    LAS float* scr = (LAS float*)(c.lds + c.wave * 8448);
    const int NGW = c.G * 8, gw = (c.vcu * 8 + c.wave + rot) % NGW, nblk = PROJW / 32, nitems = (1024 / 64) * nblk;
    for (int it = gw; it < nitems; it += NGW) { const int kb = it / nblk, nb = it % nblk, R = nb * 32, t = R >> 8, bj = (R >> 7) & 1, x = R & 127;
        int L, nv = 32;
        if (t < 4) L = 256 * t + 128 * (x >> 6) + 64 * bj + (x & 63);
        else if (t == 4) L = 1024 + 128 * (x >> 6) + 64 * bj + (x & 63);
        else if (t == 5) L = 1280 + 128 * bj + x;
        else if (t < 8) L = 1536 + 256 * (t - 6) + 64 * (x >> 5) + 32 * bj;
        else { if (x == 0) L = 2048 + 32 * bj; else if (x == 32 && bj == 0) { L = 2112; nv = 8; } else { L = 0; nv = 0; } }
        cvt_item(src, OD_IN, L, nv, gain, dst, 1024, R, kb * 64, scr, c.lane); }
}
DI void cvt_job_comb(const Ctx& c, const float* win, const float* wa, const float* gain, bf16* dst, int drow0, int rot) {
    LAS float* scr = (LAS float*)(c.lds + c.wave * 8448);
    const int NGW = c.G * 8, gw = (c.vcu * 8 + c.wave + rot) % NGW, nblk = 256 / 32, nitems = (1024 / 64) * nblk;
    for (int it = gw; it < nitems; it += NGW) { const int kb = it / nblk, nb = it % nblk, n0 = nb * 32, k0 = kb * 64; const int nn = c.lane & 31;
        float wcol[16];
#pragma unroll
        for (int j = 0; j < 16; ++j) wcol[j] = wa[j * 256 + n0 + nn];
        for (int i = 0; i < 32; ++i) { const int kk = 2 * i + (c.lane >> 5); const float* wr = win + (size_t)(k0 + kk) * EV_IN + 1536; float s = 0.f;
#pragma unroll
            for (int j = 0; j < 16; ++j) s += wr[j] * wcol[j];
            scr[kk * 33 + nn] = s * gain[k0 + kk]; }
        cvt_store(dst, 1024, drow0 + n0, k0, scr, c.lane); }
}

DI void row_init(const float* xrow, bf16* hbrow, float* ssrow, int lane) {
    float s = 0.f;
#pragma unroll
    for (int j = 0; j < 4; ++j) { const f32x4 v = ((const f32x4*)xrow)[lane + 64 * j]; v2u w; w.x = pk2(v.x, v.y); w.y = pk2(v.z, v.w); ((v2u*)hbrow)[lane + 64 * j] = w;
        const float r0 = bflo(w.x), r1 = bfhi(w.x), r2 = bflo(w.y), r3 = bfhi(w.y); s += (r0 * r0 + r1 * r1) + (r2 * r2 + r3 * r3); }
    s = wave_sum(s);
    if (lane < 16) ssrow[lane] = (lane == 0) ? s : 0.f;
}
DI void row_norm_bf16(const float* xrow, const float* g, bf16* orow, int lane) {
    f32x4 v[4]; float s = 0.f;
#pragma unroll
    for (int j = 0; j < 4; ++j) { v[j] = ((const f32x4*)xrow)[lane + 64 * j]; s += (v[j].x * v[j].x + v[j].y * v[j].y) + (v[j].z * v[j].z + v[j].w * v[j].w); }
    const float r = rsqrtf(wave_sum(s) * (1.0f / 1024.0f) + EPS);
#pragma unroll
    for (int j = 0; j < 4; ++j) { const f32x4 gg = ((const f32x4*)g)[lane + 64 * j]; v2u w; w.x = pk2(v[j].x * r * gg.x, v[j].y * r * gg.y); w.y = pk2(v[j].z * r * gg.z, v[j].w * r * gg.w); ((v2u*)orow)[lane + 64 * j] = w; }
}
DI void row_final(const bf16* hrow, const float* ssrow, const float* g, float* orow, int lane) {
    float s = (lane < 16) ? ssrow[lane] : 0.f; s = wave_sum(s);
    const float r = rsqrtf(s * (1.0f / 1024.0f) + EPS);
#pragma unroll
    for (int j = 0; j < 4; ++j) { const v2u w = ((const v2u*)hrow)[lane + 64 * j]; const f32x4 v = {bflo(w.x), bfhi(w.x), bflo(w.y), bfhi(w.y)}, gg = ((const f32x4*)g)[lane + 64 * j]; ((f32x4*)orow)[lane + 64 * j] = v * r * gg; }
}

DI void unpack8(const v4u w, float (&x)[8]) { x[0] = bflo(w.x); x[1] = bfhi(w.x); x[2] = bflo(w.y); x[3] = bfhi(w.y); x[4] = bflo(w.z); x[5] = bfhi(w.z); x[6] = bflo(w.w); x[7] = bfhi(w.w); }
DI void gla1_unit(const Ctx& c, int u, const bf16* PROJ, const float* b_a, float* DS, float* BCg, float* DEC) {
    const int n = u & 127, bh = u >> 7, h = bh & 3, b = bh >> 2, row0 = b * SEQ + n * 64;
    LAS float* BCl = (LAS float*)c.lds; LAS float* SEG = BCl + 4096; LAS unsigned char* KEt = c.lds + 18432; LAS unsigned char* VT = KEt + 9216;
    const int t = c.tid >> 3, s8 = c.tid & 7;
    const bf16* prow = PROJ + (size_t)(row0 + t) * PROJW;
    float kk[8];
    { float x[8]; unpack8(*(const v4u*)(prow + 1536 + h * 64 + s8 * 8), x);
      float ls[8];
#pragma unroll
      for (int j = 0; j < 8; ++j) { const float xx = x[j] + b_a[h * 64 + s8 * 8 + j]; ls[j] = (fminf(xx, 0.f) - __logf(1.0f + __expf(-fabsf(xx)))) * (1.0f / 16.0f); }
      *(LAS f32x4*)(BCl + t * 64 + s8 * 8) = (f32x4){ls[0], ls[1], ls[2], ls[3]}; *(LAS f32x4*)(BCl + t * 64 + s8 * 8 + 4) = (f32x4){ls[4], ls[5], ls[6], ls[7]};
      unpack8(*(const v4u*)(prow + 256 + h * 64 + s8 * 8), kk);
      const v4u v0 = *(const v4u*)(prow + 512 + h * 128 + s8 * 16), v1 = *(const v4u*)(prow + 512 + h * 128 + s8 * 16 + 8);
      const unsigned vw[8] = {v0.x, v0.y, v0.z, v0.w, v1.x, v1.y, v1.z, v1.w};
      LAS unsigned char* vt = VT + (16 * s8) * 144 + t * 2;
#pragma unroll
      for (int j = 0; j < 8; ++j) { *(LAS bf16*)(vt + (2 * j) * 144) = (bf16)(vw[j] & 0xffffu); *(LAS bf16*)(vt + (2 * j + 1) * 144) = (bf16)(vw[j] >> 16); } }
    __syncthreads();
    { const int d = c.tid & 63, seg = c.tid >> 6; float v[8]; float run = 0.f;
#pragma unroll
      for (int j = 0; j < 8; ++j) { run += BCl[(8 * seg + j) * 64 + d]; v[j] = run; }
      SEG[seg * 64 + d] = run;
      __syncthreads();
      float off = 0.f;
#pragma unroll
      for (int q = 0; q < 7; ++q) off += (q < seg) ? SEG[q * 64 + d] : 0.f;
#pragma unroll
      for (int j = 0; j < 8; ++j) BCl[(8 * seg + j) * 64 + d] = v[j] + off; }
    __syncthreads();
    { float bcv[8];
#pragma unroll
      for (int j = 0; j < 8; ++j) { const int d = s8 * 8 + j; const float bc = BCl[t * 64 + d], bl = BCl[63 * 64 + d]; bcv[j] = bc;
          *(LAS bf16*)(KEt + d * 144 + t * 2) = (bf16)f2bf(kk[j] * __expf(bl - bc)); }
      float* bp = BCg + (size_t)(row0 + t) * 256 + h * 64 + s8 * 8;
      *(f32x4*)bp = (f32x4){bcv[0], bcv[1], bcv[2], bcv[3]}; *(f32x4*)(bp + 4) = (f32x4){bcv[4], bcv[5], bcv[6], bcv[7]};
      if (c.tid < 64) DEC[(size_t)u * 64 + c.tid] = __expf(BCl[63 * 64 + c.tid]); }
    __syncthreads();
    { const int r16 = c.lane & 15, q4 = c.lane >> 4, w = c.wave;
      bf16x8 vb[2];
#pragma unroll
      for (int ks = 0; ks < 2; ++ks) vb[ks] = *(const LAS bf16x8*)(VT + (16 * w + r16) * 144 + (32 * ks + 8 * q4) * 2);
#pragma unroll
      for (int df = 0; df < 4; ++df) { f32x4 acc = {0.f, 0.f, 0.f, 0.f};
#pragma unroll
          for (int ks = 0; ks < 2; ++ks) acc = mfma16(*(const LAS bf16x8*)(KEt + (16 * df + r16) * 144 + (32 * ks + 8 * q4) * 2), vb[ks], acc);
          float* dp = DS + (size_t)u * 8192 + (size_t)(16 * df + 4 * q4) * 128 + 16 * w + r16;
#pragma unroll
          for (int i = 0; i < 4; ++i) dp[i * 128] = acc[i]; } }
    __syncthreads();
}
DI void gla2_scan(const Ctx& c, float* DS, const float* DEC) {
    for (int el = c.vcu * 512 + c.tid; el < 8 * 64 * 128; el += c.G * 512) {
        const int bh = el >> 13, d = (el >> 7) & 63, e = el & 127; float S = 0.f;
        float* p0 = DS + (size_t)(bh * 128) * 8192 + d * 128 + e; const float* q0 = DEC + (size_t)(bh * 128) * 64 + d;
        for (int n0 = 0; n0 < 128; n0 += 16) {
            float ds[16], dc[16];
#pragma unroll
            for (int j = 0; j < 16; ++j) { ds[j] = p0[(size_t)(n0 + j) * 8192]; dc[j] = q0[(n0 + j) * 64]; }
#pragma unroll
            for (int j = 0; j < 16; ++j) { p0[(size_t)(n0 + j) * 8192] = S; S = dc[j] * S + ds[j]; }
        }
    }
}
DI bf16x8 pack8(const f32x4 a, const f32x4 b) { v4u w; w.x = pk2(a[0], a[1]); w.y = pk2(a[2], a[3]); w.z = pk2(b[0], b[1]); w.w = pk2(b[2], b[3]); return __builtin_bit_cast(bf16x8, w); }
DI void gla3_unit(const Ctx& c, int u, const bf16* PROJ, const float* BCg, const float* DS, const float* gnorm, bf16* CAT) {
    const int n = u & 127, bh = u >> 7, h = bh & 3, b = bh >> 2, row0 = b * SEQ + n * 64;
    LAS unsigned char* QD = c.lds; LAS unsigned char* KI = QD + 9216; LAS unsigned char* VT = KI + 9216; LAS unsigned char* SPT = VT + 18432; LAS float* PART = (LAS float*)(SPT + 18432);
    { const int t = c.tid >> 3, s8 = c.tid & 7; const bf16* prow = PROJ + (size_t)(row0 + t) * PROJW;
      float q[8], k[8]; unpack8(*(const v4u*)(prow + h * 64 + s8 * 8), q); unpack8(*(const v4u*)(prow + 256 + h * 64 + s8 * 8), k);
      const float* bp = BCg + (size_t)(row0 + t) * 256 + h * 64 + s8 * 8; const f32x4 b0 = *(const f32x4*)bp, b1 = *(const f32x4*)(bp + 4);
      const float bc[8] = {b0.x, b0.y, b0.z, b0.w, b1.x, b1.y, b1.z, b1.w};
#pragma unroll
      for (int j = 0; j < 8; ++j) { q[j] = q[j] * 0.125f * __expf(bc[j]); k[j] = k[j] * __expf(-bc[j]); }
      v4u wq, wk; wq.x = pk2(q[0], q[1]); wq.y = pk2(q[2], q[3]); wq.z = pk2(q[4], q[5]); wq.w = pk2(q[6], q[7]); wk.x = pk2(k[0], k[1]); wk.y = pk2(k[2], k[3]); wk.z = pk2(k[4], k[5]); wk.w = pk2(k[6], k[7]);
      *(LAS v4u*)(QD + t * 144 + s8 * 16) = wq; *(LAS v4u*)(KI + t * 144 + s8 * 16) = wk;
      const v4u v0 = *(const v4u*)(prow + 512 + h * 128 + s8 * 16), v1 = *(const v4u*)(prow + 512 + h * 128 + s8 * 16 + 8);
      const unsigned vw[8] = {v0.x, v0.y, v0.z, v0.w, v1.x, v1.y, v1.z, v1.w};
      LAS unsigned char* vt = VT + (16 * s8) * 144 + t * 2;
#pragma unroll
      for (int j = 0; j < 8; ++j) { *(LAS bf16*)(vt + (2 * j) * 144) = (bf16)(vw[j] & 0xffffu); *(LAS bf16*)(vt + (2 * j + 1) * 144) = (bf16)(vw[j] >> 16); }
      const int d = t; const f32x4* sp = (const f32x4*)(DS + (size_t)u * 8192 + d * 128 + s8 * 16);
      LAS unsigned char* st = SPT + (16 * s8) * 144 + d * 2;
#pragma unroll
      for (int i = 0; i < 4; ++i) { const f32x4 x = sp[i];
#pragma unroll
          for (int j = 0; j < 4; ++j) *(LAS bf16*)(st + (4 * i + j) * 144) = (bf16)f2bf(x[j]); } }
    __syncthreads();
    const int r16 = c.lane & 15, q4 = c.lane >> 4, w = c.wave;
    bf16x8 qd[4][2];
#pragma unroll
    for (int tf = 0; tf < 4; ++tf)
#pragma unroll
        for (int ks = 0; ks < 2; ++ks) qd[tf][ks] = *(const LAS bf16x8*)(QD + (16 * tf + r16) * 144 + (32 * ks + 8 * q4) * 2);
    f32x4 sc[4][4];
#pragma unroll
    for (int sf = 0; sf < 4; ++sf) {
        bf16x8 ki[2];
#pragma unroll
        for (int ks = 0; ks < 2; ++ks) ki[ks] = *(const LAS bf16x8*)(KI + (16 * sf + r16) * 144 + (32 * ks + 8 * q4) * 2);
#pragma unroll
        for (int tf = 0; tf < 4; ++tf) {
            f32x4 a = {0.f, 0.f, 0.f, 0.f};
            if (sf <= tf) {
#pragma unroll
                for (int ks = 0; ks < 2; ++ks) a = mfma16(ki[ks], qd[tf][ks], a);
                if (sf == tf) {
#pragma unroll
                    for (int i = 0; i < 4; ++i) a[i] = (4 * q4 + i <= r16) ? a[i] : 0.f;
                }
            }
            sc[sf][tf] = a;
        }
    }
    f32x4 o[4];
#pragma unroll
    for (int tf = 0; tf < 4; ++tf) o[tf] = (f32x4){0.f, 0.f, 0.f, 0.f};
    const LAS unsigned char* vrow = VT + (16 * w + r16) * 144; const LAS unsigned char* srow = SPT + (16 * w + r16) * 144;
#pragma unroll
    for (int kk = 0; kk < 2; ++kk) {
        const v2u lo = *(const LAS v2u*)(vrow + (32 * kk + 4 * q4) * 2), hi = *(const LAS v2u*)(vrow + (32 * kk + 16 + 4 * q4) * 2);
        v4u aw; aw.x = lo.x; aw.y = lo.y; aw.z = hi.x; aw.w = hi.y; const bf16x8 a = __builtin_bit_cast(bf16x8, aw);
#pragma unroll
        for (int tf = 0; tf < 4; ++tf) if (2 * kk <= tf) o[tf] = mfma16(a, pack8(sc[2 * kk][tf], sc[2 * kk + 1][tf]), o[tf]);
    }
#pragma unroll
    for (int ks = 0; ks < 2; ++ks) { const bf16x8 a = *(const LAS bf16x8*)(srow + (32 * ks + 8 * q4) * 2);
#pragma unroll
        for (int tf = 0; tf < 4; ++tf) o[tf] = mfma16(a, qd[tf][ks], o[tf]); }
#pragma unroll
    for (int tf = 0; tf < 4; ++tf) { float ssq = (o[tf][0] * o[tf][0] + o[tf][1] * o[tf][1]) + (o[tf][2] * o[tf][2] + o[tf][3] * o[tf][3]);
        ssq += __shfl_xor(ssq, 16); ssq += __shfl_xor(ssq, 32); if (q4 == 0) PART[w * 64 + 16 * tf + r16] = ssq; }
    __syncthreads();
    const f32x4 gg = *(const f32x4*)(gnorm + 16 * w + 4 * q4);
#pragma unroll
    for (int tf = 0; tf < 4; ++tf) { const int t = 16 * tf + r16; float ssq = 0.f;
#pragma unroll
        for (int ww = 0; ww < 8; ++ww) ssq += PART[ww * 64 + t];
        const float rn = rsqrtf(ssq * (1.0f / 128.0f) + EPS);
        const v2u rv = *(const v2u*)(PROJ + (size_t)(row0 + t) * PROJW + 1024 + h * 128 + 16 * w + 4 * q4);
        const float rr[4] = {bflo(rv.x), bfhi(rv.x), bflo(rv.y), bfhi(rv.y)}; float res[4];
#pragma unroll
        for (int i = 0; i < 4; ++i) res[i] = o[tf][i] * rn * gg[i] * (rr[i] * __builtin_amdgcn_rcpf(1.0f + __expf(-rr[i])));
        v2u ow; ow.x = pk2(res[0], res[1]); ow.y = pk2(res[2], res[3]);
        *(v2u*)(CAT + (size_t)(row0 + t) * 1024 + h * 128 + 16 * w + 4 * q4) = ow; }
    __syncthreads();
}

DI void s5_params(const Ctx& c, const float* lam_re, const float* lam_im, const float* log_dt, const float* B_re, const float* B_im, float* P) {
    for (int idx = c.vcu * 512 + c.tid; idx < 2 * 32 * 64; idx += c.G * 512) {
        const float lr = fminf(lam_re[idx], -1e-4f), li = lam_im[idx], dt = expf(log_dt[idx >> 6]);
        const float mag = expf(lr * dt), ar = mag * cosf(li * dt), ai = mag * sinf(li * dt);
        const float den = lr * lr + li * li, nr = ar - 1.0f, fre = (nr * lr + ai * li) / den, fim = (ai * lr - nr * li) / den;
        P[S5P_A + 2 * idx] = ar; P[S5P_A + 2 * idx + 1] = ai;
        float tr = ar, ti = ai;
#pragma unroll
        for (int s = 0; s < 6; ++s) { const float nr2 = tr * tr - ti * ti, ni2 = 2.0f * tr * ti; tr = nr2; ti = ni2; }
        P[S5P_AT + 2 * idx] = tr; P[S5P_AT + 2 * idx + 1] = ti;
        bf16* BBH = (bf16*)(P + S5P_BBH); const int eg = idx >> 6, pp = idx & 63;
        for (int cc = 0; cc < 16; ++cc) { const float Br = B_re[idx * 16 + cc], Bi = B_im[idx * 16 + cc]; const float br = fre * Br - fim * Bi, bi = fre * Bi + fim * Br;
            P[S5P_BB + 2 * (idx * 16 + cc)] = br; P[S5P_BB + 2 * (idx * 16 + cc) + 1] = bi;
            BBH[(eg * 128 + pp) * 16 + cc] = (bf16)f2bf(br); BBH[(eg * 128 + 64 + pp) * 16 + cc] = (bf16)f2bf(bi); }
    }
}
DI void s5_load_u(const bf16* PROJ, int row0, int g, LAS float* U, int lane) {
    const bf16* p = PROJ + (size_t)(row0 + lane) * PROJW + 1792 + g * 16; float x[8];
    unpack8(*(const v4u*)p, x); ((LAS f32x4*)(U + lane * 16))[0] = (f32x4){x[0], x[1], x[2], x[3]}; ((LAS f32x4*)(U + lane * 16))[1] = (f32x4){x[4], x[5], x[6], x[7]};
    unpack8(*(const v4u*)(p + 8), x); ((LAS f32x4*)(U + lane * 16))[2] = (f32x4){x[0], x[1], x[2], x[3]}; ((LAS f32x4*)(U + lane * 16))[3] = (f32x4){x[4], x[5], x[6], x[7]};
}
DI void s5_frags(const bf16* PROJ, const float* P, int e, int g, int row0, int r16, int q4, bf16x8 (&ua)[4], bf16x8 (&bb)[8]) {
    const bf16x8 zf = {0, 0, 0, 0, 0, 0, 0, 0}; const bf16* BBH = (const bf16*)(P + S5P_BBH);
#pragma unroll
    for (int tf = 0; tf < 4; ++tf) ua[tf] = (q4 < 2) ? *(const bf16x8*)(PROJ + (size_t)(row0 + 16 * tf + r16) * PROJW + 1792 + g * 16 + 8 * q4) : zf;
#pragma unroll
    for (int pf = 0; pf < 8; ++pf) bb[pf] = (q4 < 2) ? *(const bf16x8*)(BBH + ((size_t)(e * 32 + g) * 128 + 16 * pf + r16) * 16 + 8 * q4) : zf;
}
DI void s5_bu16(const bf16x8 ua, const bf16x8 (&bb)[8], LAS float* BUs, int r16, int q4) {
    LAS float* wp = BUs + (4 * q4) * 128 + r16;
#pragma unroll
    for (int pf = 0; pf < 8; ++pf) { const f32x4 d = mfma16(ua, bb[pf], (f32x4){0.f, 0.f, 0.f, 0.f});
#pragma unroll
        for (int i = 0; i < 4; ++i) wp[i * 128 + 16 * pf] = d[i]; }
}
#define S5_BU(t) do { const LAS f32x4* up_ = (const LAS f32x4*)(U + (t) * 16); const f32x4 u0 = up_[0], u1 = up_[1], u2 = up_[2], u3 = up_[3]; \
    const float uu[16] = {u0.x, u0.y, u0.z, u0.w, u1.x, u1.y, u1.z, u1.w, u2.x, u2.y, u2.z, u2.w, u3.x, u3.y, u3.z, u3.w}; bur = 0.f; bui = 0.f; \
    _Pragma("unroll") for (int cc = 0; cc < 16; ++cc) { bur += bbr[cc] * uu[cc]; bui += bbi[cc] * uu[cc]; } } while (0)
DI void s5_phase1(const Ctx& c, int e, const bf16* PROJ, const float* P, float* S5E) {
    LAS float* U = (LAS float*)(c.lds + c.wave * 4096);
    const int NGW = c.G * 8, gw = c.vcu * 8 + c.wave;
    const bool reg = (NGW == 2 * 32 * S5NC / 4);
    int gcur = -1; float ar = 0.f, ai = 0.f, bbr[16], bbi[16];
#pragma unroll
    for (int cc = 0; cc < 16; ++cc) { bbr[cc] = 0.f; bbi[cc] = 0.f; }
    for (int it = 0;; ++it) {
        int wt; if (reg) { if (it >= 4) break; wt = (gw >> 5) * S5NC + (gw & 31) + 32 * it; } else { wt = gw + it * NGW; if (wt >= 2 * 32 * S5NC) break; }
        const int cch = wt & (S5NC - 1), bg = wt >> 7, g = bg & 31, b = bg >> 5, row0 = b * SEQ + cch * S5T, pi = (e * 32 + g) * 64 + c.lane;
        s5_load_u(PROJ, row0, g, U, c.lane);
        if (g != gcur) { gcur = g; ar = P[S5P_A + 2 * pi]; ai = P[S5P_A + 2 * pi + 1];
#pragma unroll
            for (int cc = 0; cc < 16; ++cc) { bbr[cc] = P[S5P_BB + 2 * (pi * 16 + cc)]; bbi[cc] = P[S5P_BB + 2 * (pi * 16 + cc) + 1]; } }
        LDS_WAIT();
        float xr = 0.f, xi = 0.f, bur, bui;
        for (int t = 0; t < S5T; ++t) { S5_BU(t); const float nxr = ar * xr - ai * xi + bur, nxi = ar * xi + ai * xr + bui; xr = nxr; xi = nxi; }
        *(f32x2*)(S5E + 2 * ((size_t)wt * 64 + c.lane)) = (f32x2){xr, xi};
        LDS_WAIT();
    }
}
DI void s5_phase2(const Ctx& c, int e, const float* P, float* S5E) {
    for (int sq = (c.G - 1 - c.vcu) * 512 + c.tid; sq < 2 * 32 * 64; sq += c.G * 512) {
        const int p = sq & 63, bg = sq >> 6, g = bg & 31, pi = (e * 32 + g) * 64 + p; const float tr = P[S5P_AT + 2 * pi], ti = P[S5P_AT + 2 * pi + 1];
        float xr = 0.f, xi = 0.f; f32x2* q0 = (f32x2*)(S5E + 2 * (((size_t)bg * S5NC) * 64 + p));
        for (int c0 = 0; c0 < S5NC; c0 += 16) {
            f32x2 ev[16];
#pragma unroll
            for (int j = 0; j < 16; ++j) ev[j] = q0[(c0 + j) * 64];
#pragma unroll
            for (int j = 0; j < 16; ++j) { q0[(c0 + j) * 64] = (f32x2){xr, xi}; const float nxr = tr * xr - ti * xi + ev[j].x, nxi = tr * xi + ti * xr + ev[j].y; xr = nxr; xi = nxi; }
        }
    }
}
DI void s5_phase3(const Ctx& c, int e, const bf16* PROJ, const float* P, const float* S5E, const float* C_re, const float* C_im, const float* Dp, bf16* Y) {
    LAS float* BUs = (LAS float*)(c.lds + c.wave * 12544);
    LAS unsigned char* XB = c.lds + c.wave * 12544 + 8192;
    const int NGW = c.G * 8, gw = c.vcu * 8 + c.wave; const int r16 = c.lane & 15, q4 = c.lane >> 4;
    const bool reg = (NGW == 2 * 32 * S5NC / 4);
    const bf16x8 zf = {0, 0, 0, 0, 0, 0, 0, 0};
    int gcur = -1; float ar = 0.f, ai = 0.f, Dg = 0.f; bf16x8 bb[8], cf[4];
#pragma unroll
    for (int pf = 0; pf < 8; ++pf) bb[pf] = zf;
#pragma unroll
    for (int ks = 0; ks < 4; ++ks) cf[ks] = zf;
    for (int it = 0;; ++it) {
        int wt; if (reg) { if (it >= 4) break; wt = (gw >> 5) * S5NC + (gw & 31) + 32 * it; } else { wt = gw + it * NGW; if (wt >= 2 * 32 * S5NC) break; }
        const int cch = wt & (S5NC - 1), bg = wt >> 7, g = bg & 31, b = bg >> 5, row0 = b * SEQ + cch * S5T, pi = (e * 32 + g) * 64 + c.lane;
        bf16x8 ua[4];
#pragma unroll
        for (int tf = 0; tf < 4; ++tf) ua[tf] = (q4 < 2) ? *(const bf16x8*)(PROJ + (size_t)(row0 + 16 * tf + r16) * PROJW + 1792 + g * 16 + 8 * q4) : zf;
        if (g != gcur) { gcur = g;
            const bf16* BBH = (const bf16*)(P + S5P_BBH);
#pragma unroll
            for (int pf = 0; pf < 8; ++pf) bb[pf] = (q4 < 2) ? *(const bf16x8*)(BBH + ((size_t)(e * 32 + g) * 128 + 16 * pf + r16) * 16 + 8 * q4) : zf;
            ar = P[S5P_A + 2 * pi]; ai = P[S5P_A + 2 * pi + 1];
            const size_t gi = ((size_t)(e * 32 + g) * 16 + r16) * 64 + 8 * q4;
#pragma unroll
            for (int ks = 0; ks < 4; ++ks) { const float* src = (ks < 2 ? C_re : C_im) + gi + 32 * (ks & 1); const float sg = ks < 2 ? 1.0f : -1.0f;
                const f32x4 x0 = *(const f32x4*)src, x1 = *(const f32x4*)(src + 4); cf[ks] = pack8(x0 * sg, x1 * sg); }
            Dg = Dp[(e * 32 + g) * 16 + r16]; }
        const f32x2 x0 = *(const f32x2*)(S5E + 2 * ((size_t)wt * 64 + c.lane));
        float xr = x0.x, xi = x0.y;
#pragma unroll
        for (int sc = 0; sc < 4; ++sc) {
            s5_bu16(ua[sc], bb, BUs, r16, q4);
            LDS_WAIT();
#pragma unroll
            for (int tt = 0; tt < 16; ++tt) { const float bur = BUs[tt * 128 + c.lane], bui = BUs[tt * 128 + 64 + c.lane]; const float nxr = ar * xr - ai * xi + bur, nxi = ar * xi + ai * xr + bui; xr = nxr; xi = nxi;
                *(LAS bf16*)(XB + tt * 272 + c.lane * 2) = (bf16)f2bf(xr); *(LAS bf16*)(XB + tt * 272 + 128 + c.lane * 2) = (bf16)f2bf(xi); }
            LDS_WAIT();
            f32x4 y = {0.f, 0.f, 0.f, 0.f};
#pragma unroll
            for (int ks = 0; ks < 4; ++ks) y = mfma16(*(const LAS bf16x8*)(XB + r16 * 272 + (32 * ks + 8 * q4) * 2), cf[ks], y);
#pragma unroll
            for (int i = 0; i < 4; ++i) { const int t = sc * 16 + 4 * q4 + i; const float yy = y[i] + Dg * bf2f(PROJ[(size_t)(row0 + t) * PROJW + 1792 + g * 16 + r16]);
                const float z = 0.7978845608f * (yy + 0.044715f * yy * yy * yy); const float th = 1.0f - 2.0f * __builtin_amdgcn_rcpf(__expf(2.0f * z) + 1.0f);
                Y[(size_t)(row0 + t) * 512 + g * 16 + r16] = (bf16)f2bf(0.5f * yy * (1.0f + th)); }
            LDS_WAIT();
        }
    }
}

constexpr int XA_KSLOT = 256 * 144, XA_VSLOT = 64 * 528, XA_VOFF = 2 * XA_KSLOT;
DI void xattn_unit(const Ctx& c, int uidx, int layer, const bf16* XQ, const bf16* MK, const bf16* MVT, bf16* XO) {
    const int h = uidx & 3, tile = uidx >> 2, b = tile >> 5, row0 = tile * 256;
    LAS unsigned char* KS = c.lds; LAS unsigned char* VS = c.lds + XA_VOFF;
    const int r16 = c.lane & 15, q4 = c.lane >> 4, w = c.wave;
    const bf16* kg = MK + (size_t)(b * 256) * 4096 + layer * 1024 + h * 256;
    const bf16* vg = MVT + (size_t)(layer * 1024 + h * 256) * 512 + b * 256;
    v4u st[4];
#define XA_LOADK(dc_) do { _Pragma("unroll") for (int i = 0; i < 4; ++i) { const int idx = c.tid + 512 * i; st[i] = *(const v4u*)(kg + (size_t)(idx >> 3) * 4096 + (dc_) * 64 + (idx & 7) * 8); } } while (0)
#define XA_STOREK(slot_) do { _Pragma("unroll") for (int i = 0; i < 4; ++i) { const int idx = c.tid + 512 * i; *(LAS v4u*)(KS + (slot_) * XA_KSLOT + (idx >> 3) * 144 + (idx & 7) * 16) = st[i]; } } while (0)
#define XA_LOADV(dc_) do { _Pragma("unroll") for (int i = 0; i < 4; ++i) { const int idx = c.tid + 512 * i; st[i] = *(const v4u*)(vg + (size_t)((dc_) * 64 + (idx >> 5)) * 512 + (idx & 31) * 8); } } while (0)
#define XA_STOREV(slot_) do { _Pragma("unroll") for (int i = 0; i < 4; ++i) { const int idx = c.tid + 512 * i; *(LAS v4u*)(VS + (slot_) * XA_VSLOT + (idx >> 5) * 528 + (idx & 31) * 16) = st[i]; } } while (0)
    __syncthreads();
    XA_LOADK(0); XA_STOREK(0);
    __syncthreads();
    f32x4 sa[16][2];
#pragma unroll
    for (int mf = 0; mf < 16; ++mf) { sa[mf][0] = (f32x4){0.f, 0.f, 0.f, 0.f}; sa[mf][1] = sa[mf][0]; }
    const bf16* qg = XQ + (size_t)(row0 + 32 * w + r16) * 1024 + h * 256 + 8 * q4;
#pragma unroll 1
    for (int dc = 0; dc < 4; ++dc) {
        bf16x8 qf[2][2];
#pragma unroll
        for (int tf = 0; tf < 2; ++tf)
#pragma unroll
            for (int ks = 0; ks < 2; ++ks) qf[tf][ks] = *(const bf16x8*)(qg + (size_t)(16 * tf) * 1024 + dc * 64 + ks * 32);
        if (dc < 3) XA_LOADK(dc + 1); else XA_LOADV(0);
        const LAS unsigned char* kc = KS + (dc & 1) * XA_KSLOT + r16 * 144 + 16 * q4;
#pragma unroll
        for (int mf = 0; mf < 16; ++mf)
#pragma unroll
            for (int ks = 0; ks < 2; ++ks) { const bf16x8 a = *(const LAS bf16x8*)(kc + mf * (16 * 144) + ks * 64);
                sa[mf][0] = mfma16(a, qf[0][ks], sa[mf][0]); sa[mf][1] = mfma16(a, qf[1][ks], sa[mf][1]); }
        if (dc < 3) XA_STOREK((dc + 1) & 1); else XA_STOREV(0);
        __syncthreads();
    }
    bf16x8 pp[8][2];
#pragma unroll
    for (int tf = 0; tf < 2; ++tf) {
        float m = sa[0][tf][0];
#pragma unroll
        for (int mf = 0; mf < 16; ++mf)
#pragma unroll
            for (int i = 0; i < 4; ++i) m = fmaxf(m, sa[mf][tf][i]);
        m = fmaxf(m, __shfl_xor(m, 16)); m = fmaxf(m, __shfl_xor(m, 32));
        float l = 0.f;
#pragma unroll
        for (int mf = 0; mf < 16; ++mf)
#pragma unroll
            for (int i = 0; i < 4; ++i) { const float p = __expf(sa[mf][tf][i] - m); sa[mf][tf][i] = p; l += p; }
        l += __shfl_xor(l, 16); l += __shfl_xor(l, 32);
        const float inv = 1.0f / l;
#pragma unroll
        for (int kk = 0; kk < 8; ++kk) pp[kk][tf] = pack8(sa[2 * kk][tf] * inv, sa[2 * kk + 1][tf] * inv);
    }
    bf16* og = XO + (size_t)(row0 + 32 * w + r16) * 1024 + h * 256 + 4 * q4;
#pragma unroll 1
    for (int dc = 0; dc < 4; ++dc) {
        if (dc < 3) XA_LOADV(dc + 1);
        f32x4 o[4][2];
#pragma unroll
        for (int df = 0; df < 4; ++df) { o[df][0] = (f32x4){0.f, 0.f, 0.f, 0.f}; o[df][1] = o[df][0]; }
        const LAS unsigned char* vc = VS + (dc & 1) * XA_VSLOT + r16 * 528 + 8 * q4;
#pragma unroll
        for (int kk = 0; kk < 8; ++kk)
#pragma unroll
            for (int df = 0; df < 4; ++df) { const v2u lo = *(const LAS v2u*)(vc + df * (16 * 528) + kk * 64), hi = *(const LAS v2u*)(vc + df * (16 * 528) + kk * 64 + 32);
                v4u aw; aw.x = lo.x; aw.y = lo.y; aw.z = hi.x; aw.w = hi.y; const bf16x8 a = __builtin_bit_cast(bf16x8, aw);
                o[df][0] = mfma16(a, pp[kk][0], o[df][0]); o[df][1] = mfma16(a, pp[kk][1], o[df][1]); }
#pragma unroll
        for (int tf = 0; tf < 2; ++tf)
#pragma unroll
            for (int df = 0; df < 4; ++df) { v2u ow; ow.x = pk2(o[df][tf][0], o[df][tf][1]); ow.y = pk2(o[df][tf][2], o[df][tf][3]); *(v2u*)(og + (size_t)(16 * tf) * 1024 + dc * 64 + 16 * df) = ow; }
        if (dc < 3) { XA_STOREV((dc + 1) & 1); __syncthreads(); }
    }
#undef XA_LOADK
#undef XA_STOREK
#undef XA_LOADV
#undef XA_STOREV
}

DI void rope_row(bf16* prow, const float* cA, const float* sA, const float* cI, const float* sI, int lane) {
    int c1[15], hf[15]; float x1[15], x2[15], cs[15], sn[15], sc[15];
#pragma unroll
    for (int k = 0; k < 15; ++k) {
        const int pi = lane + 64 * k; int i; bool tabA; sc[k] = 1.0f;
        if (pi < 512) { i = pi & 63; c1[k] = (pi >> 6) * 128 + i; hf[k] = 64; tabA = true; sc[k] = 0.08838834764831845f; }
        else if (pi < 640) { const int pp = pi - 512; i = pp & 63; c1[k] = 1024 + (pp >> 6) * 128 + i; hf[k] = 64; tabA = true; }
        else if (pi < 896) { const int pp = pi - 640; i = pp & 31; c1[k] = 1536 + (pp >> 5) * 64 + i; hf[k] = 32; tabA = false; }
        else { i = (pi - 896) & 31; c1[k] = 2048 + i; hf[k] = 32; tabA = false; }
        cs[k] = tabA ? cA[i] : cI[i]; sn[k] = tabA ? sA[i] : sI[i];
        x1[k] = bf2f(prow[c1[k]]); x2[k] = bf2f(prow[c1[k] + hf[k]]);
    }
#pragma unroll
    for (int k = 0; k < 15; ++k) { if (lane + 64 * k < 928) { prow[c1[k]] = (bf16)f2bf((x1[k] * cs[k] - x2[k] * sn[k]) * sc[k]); prow[c1[k] + hf[k]] = (bf16)f2bf((x2[k] * cs[k] + x1[k] * sn[k]) * sc[k]); } }
}
DI unsigned wave_select(LAS unsigned* buf, int count, int lane) {
    unsigned k[16];
#pragma unroll
    for (int j = 0; j < 16; ++j) { const int idx = j * 64 + lane; k[j] = idx < count ? buf[idx] : 0u; }
    unsigned tau = 0u;
    for (int bit = 31; bit >= 0; --bit) { const unsigned cand = tau | (1u << bit); int cn = 0;
#pragma unroll
        for (int j = 0; j < 16; ++j) cn += __popcll(__ballot(k[j] >= cand));
        if (cn >= TOPK) tau = cand;
        if (cn == TOPK) break; }
    int off = 0; const unsigned long long lt = (1ull << lane) - 1ull;
#pragma unroll
    for (int j = 0; j < 16; ++j) { const bool pred = k[j] >= tau; const unsigned long long bal = __ballot(pred); if (pred) buf[off + __popcll(bal & lt)] = k[j]; off += __popcll(bal); }
    LDS_WAIT();
    return tau;
}
constexpr int IDX_KT = 131072, IDX_KT_SLOT = 64 * 144, IDX_FL = IDX_KT + 2 * IDX_KT_SLOT;
#define IDX_BODY(slot_, kb_) do { \
    bf16x8 R[4][2]; \
    _Pragma("unroll") for (int jb = 0; jb < 4; ++jb) _Pragma("unroll") for (int ks = 0; ks < 2; ++ks) R[jb][ks] = *(const LAS bf16x8*)((slot_) + (16 * jb + r16) * 144 + (ks * 32 + 8 * q4) * 2); \
    f32x4 lo_[4], hi_[4]; \
    _Pragma("unroll") for (int jb = 0; jb < 4; ++jb) { lo_[jb] = (f32x4){0.f, 0.f, 0.f, 0.f}; hi_[jb] = lo_[jb]; \
        _Pragma("unroll") for (int ks = 0; ks < 2; ++ks) { lo_[jb] = mfma16(Alo[ks], R[jb][ks], lo_[jb]); hi_[jb] = mfma16(Ahi[ks], R[jb][ks], hi_[jb]); } } \
    const int rev0_ = 8191 - r16 - 16 * (kb_); \
    _Pragma("unroll") for (int jb = 0; jb < 4; ++jb) { \
        float s0_ = 0.f, s1_ = 0.f; \
        _Pragma("unroll") for (int i = 0; i < 4; ++i) { s0_ = fmaf(__int_as_float(max(__float_as_int(lo_[jb][i]), 0)), w[i], s0_); s1_ = fmaf(__int_as_float(max(__float_as_int(hi_[jb][i]), 0)), w[4 + i], s1_); } \
        const unsigned u_ = __float_as_uint(s0_ + s1_), mono_ = u_ ^ ((unsigned)((int)u_ >> 31) | 0x80000000u); \
        const int rev_ = rev0_ - 16 * jb; const unsigned key_ = (mono_ & 0xFFFFE000u) | (unsigned)rev_; \
        const bool pred_ = (rev_ >= revq) && (key_ > tau); \
        const unsigned long long bal_ = __ballot(pred_); const unsigned grp_ = (unsigned)(bal_ >> (16 * q4)) & 0xFFFFu; \
        if (MODE == 0) { if (pred_) mybuf[cnt + __popc(grp_ & lmask)] = key_; cnt += __popc(grp_); } else { chk ^= key_ & (pred_ ? 0xffffffffu : 0x0fu); } } } while (0)
template <int MODE> DI void dsa_index_unit(const Ctx& c, int uidx, const bf16* PROJ, unsigned short* SEL, int* SELN) {
    const int pr = uidx & 255, b = pr >> 7, jj = pr & 127, qblk = uidx < 256 ? jj : 255 - jj, t0 = qblk * 32;
    LAS unsigned* CAND = (LAS unsigned*)c.lds;
    LAS unsigned char* KT = c.lds + IDX_KT; LAS unsigned* FL = (LAS unsigned*)(c.lds + IDX_FL);
    const int r16 = c.lane & 15, q4 = c.lane >> 4;
    const bf16* qrowA = PROJ + (size_t)(b * SEQ + t0 + 4 * c.wave + (r16 >> 2)) * PROJW + 1536 + 8 * q4;
    bf16x8 Alo[2], Ahi[2];
#pragma unroll
    for (int ks = 0; ks < 2; ++ks) { Alo[ks] = *(const bf16x8*)(qrowA + (r16 & 3) * 64 + ks * 32); Ahi[ks] = *(const bf16x8*)(qrowA + ((r16 & 3) + 4) * 64 + ks * 32); }
    const int tq = t0 + 4 * c.wave + q4, revq = 8191 - tq; const unsigned lmask = (1u << r16) - 1u;
    float w[8]; unpack8(*(const v4u*)(PROJ + (size_t)(b * SEQ + tq) * PROJW + 2112), w);
#pragma unroll
    for (int j = 0; j < 8; ++j) w[j] *= 0.04419417382415922f;
    int cnt = 0; unsigned tau = 0u, chk = 0u;
    LAS unsigned* mybuf = CAND + (4 * c.wave + q4) * 1024;
    const int nit = (qblk >> 1) + 1;
    const bf16* ksrc = PROJ + (size_t)(b * SEQ + (c.tid >> 3)) * PROJW + 2048 + 8 * (c.tid & 7); const int kdst = (c.tid >> 3) * 144 + (c.tid & 7) * 16;
    __syncthreads();
    v4u pre = *(const v4u*)ksrc;
    *(LAS v4u*)(KT + kdst) = pre;
    if (nit > 1) pre = *(const v4u*)(ksrc + (size_t)64 * PROJW);
    for (int it = 0; it < nit; ++it) {
        LAS unsigned char* slot = KT + (it & 1) * IDX_KT_SLOT;
        { const unsigned long long nb = __ballot(cnt > 1024 - 64); if (c.lane == 0) FL[(it & 1) * 8 + c.wave] = nb != 0ull ? 1u : 0u; }
        __syncthreads();
        { const v4u f0 = *(const LAS v4u*)(FL + (it & 1) * 8), f1 = *(const LAS v4u*)(FL + (it & 1) * 8 + 4);
          if (MODE == 0 && (f0.x | f0.y | f0.z | f0.w | f1.x | f1.y | f1.z | f1.w)) {
#pragma unroll
              for (int g4 = 0; g4 < 4; ++g4) { const int cg = __shfl(cnt, 16 * g4); if (cg > TOPK) { const unsigned tn = wave_select(CAND + (4 * c.wave + g4) * 1024, cg, c.lane); if (q4 == g4) { tau = tn; cnt = TOPK; } } } } }
        IDX_BODY(slot, 4 * it);
        if (it + 1 < nit) { *(LAS v4u*)(KT + ((it + 1) & 1) * IDX_KT_SLOT + kdst) = pre; if (it + 2 < nit) pre = *(const v4u*)(ksrc + (size_t)(64 * (it + 2)) * PROJW); }
    }
    LDS_WAIT();
    if (MODE != 0) { if (chk == 0x12345u) SELN[uidx] = (int)chk; return; }
#pragma unroll
    for (int g4 = 0; g4 < 4; ++g4) {
        int cg = __shfl(cnt, 16 * g4); LAS unsigned* bufg = CAND + (4 * c.wave + g4) * 1024;
        if (cg > TOPK) { (void)wave_select(bufg, cg, c.lane); cg = TOPK; }
        const size_t qg = (size_t)(b * SEQ + t0 + 4 * c.wave + g4);
#pragma unroll
        for (int i = 0; i < 4; ++i) { const int slot = c.lane + 64 * i; if (slot < cg) SEL[qg * 256 + slot] = (unsigned short)(8191u - (bufg[slot] & 0x1FFFu)); }
        if (c.lane == 0) SELN[qg] = cg;
    }
    LDS_WAIT();
}
#define SB() __builtin_amdgcn_sched_barrier(0)
DI f32x4 mfma8(const v2u a, const v2u b, const f32x4 c) { return __builtin_amdgcn_mfma_f32_16x16x32_fp8_fp8(__builtin_bit_cast(long, a), __builtin_bit_cast(long, b), c, 0, 0, 0); }
#define DSA_QS 32.0f
#define DSA_RDW(pb_, tv_) asm volatile("s_waitcnt lgkmcnt(0)" : "+v"(pb_), "+v"(tv_[0]), "+v"(tv_[1]), "+v"(tv_[2]), "+v"(tv_[3]), "+v"(tv_[4]), "+v"(tv_[5]), "+v"(tv_[6]), "+v"(tv_[7]) : : "memory")
#define DSA_VWAIT(n) asm volatile("s_waitcnt vmcnt(" #n ")" ::: "memory")
#define DSA3_WS 17152
#define DSA3_KLD(dst_, off_, imm_, kb_) asm volatile("global_load_dwordx4 %0, %1, %2 offset:" #imm_ : "=&v"(dst_) : "v"(off_), "s"(kb_) : "memory")
#define DSA3_LOADK(dst, blk) do { const unsigned koff_ = kix[blk] * 128u + kofs; DSA3_KLD(dst[0][0], koff_, 0, k8g0); DSA3_KLD(dst[0][1], koff_, 64, k8g0); DSA3_KLD(dst[1][0], koff_, 0, k8g1); DSA3_KLD(dst[1][1], koff_, 64, k8g1); } while (0)
#define DSA3_KWAIT(n, dst) asm volatile("s_waitcnt vmcnt(" #n ")" : "+v"(dst[0][0]), "+v"(dst[0][1]), "+v"(dst[1][0]), "+v"(dst[1][1]) : : "memory")
#define DSA3_KPERM(dst) do { _Pragma("unroll") for (int kvi = 0; kvi < 2; ++kvi) _Pragma("unroll") for (int hf = 0; hf < 2; ++hf) { v4u w_ = dst[kvi][hf]; \
    w_.x = (unsigned)__builtin_amdgcn_ds_bpermute(kperm, (int)w_.x); w_.y = (unsigned)__builtin_amdgcn_ds_bpermute(kperm, (int)w_.y); w_.z = (unsigned)__builtin_amdgcn_ds_bpermute(kperm, (int)w_.z); w_.w = (unsigned)__builtin_amdgcn_ds_bpermute(kperm, (int)w_.w); \
    dst[kvi][hf] = w_; } } while (0)
#define DSA3_QK(blk, src) do { f32x4 a0_ = {0.f, 0.f, 0.f, 0.f}, a1_ = {0.f, 0.f, 0.f, 0.f}; \
    _Pragma("unroll") for (int ks = 0; ks < 4; ++ks) { const v4u w0_ = src[0][ks >> 1], w1_ = src[1][ks >> 1]; v2u p0_, p1_; p0_.x = (ks & 1) ? w0_.z : w0_.x; p0_.y = (ks & 1) ? w0_.w : w0_.y; p1_.x = (ks & 1) ? w1_.z : w1_.x; p1_.y = (ks & 1) ? w1_.w : w1_.y; \
        a0_ = mfma8(p0_, q2[0][ks], a0_); a1_ = mfma8(p1_, q2[1][ks], a1_); } acc[blk] = a0_ + a1_; } while (0)
#define DSA3_DMAV(u_) do { _Pragma("unroll") for (int j = 0; j < 4; ++j) \
    __builtin_amdgcn_global_load_lds((const unsigned*)((((u_) & 1) ? v8b1 : v8b0) + vix[(u_) >> 1][j] * 128u + ((j & 1) ? vsw1 : vsw0)), (LAS unsigned*)(Vb + ((u_) % 3) * 4096 + j * 1024), 16, 0, 0); } while (0)
#define DSA3_RD(pb_, tv_, soff_, poff_) asm volatile( \
    "ds_read_b64 %0, %9 offset:%19\n\tds_read_b64_tr_b8 %1, %10 offset:%18\n\tds_read_b64_tr_b8 %2, %11 offset:%18\n\tds_read_b64_tr_b8 %3, %12 offset:%18\n\tds_read_b64_tr_b8 %4, %13 offset:%18\n\t" \
    "ds_read_b64_tr_b8 %5, %14 offset:%18\n\tds_read_b64_tr_b8 %6, %15 offset:%18\n\tds_read_b64_tr_b8 %7, %16 offset:%18\n\tds_read_b64_tr_b8 %8, %17 offset:%18" \
    : "=&v"(pb_), "=&v"(tv_[0]), "=&v"(tv_[1]), "=&v"(tv_[2]), "=&v"(tv_[3]), "=&v"(tv_[4]), "=&v"(tv_[5]), "=&v"(tv_[6]), "=&v"(tv_[7]) \
    : "v"(prdA), "v"(va[0]), "v"(va[1]), "v"(va[2]), "v"(va[3]), "v"(va[4]), "v"(va[5]), "v"(va[6]), "v"(va[7]), "i"(soff_), "i"(poff_) : "memory")
#define DSA3_PV(u_) do { v2u pA_, tA_[8]; DSA3_RD(pA_, tA_, ((u_) % 3) * 4096, 32 * ((u_) >> 1)); DSA_RDW(pA_, tA_); \
    v2u pm_; pm_.x = (((u_) & 1) == mykv) ? pA_.x : 0u; pm_.y = (((u_) & 1) == mykv) ? pA_.y : 0u; \
    _Pragma("unroll") for (int nt = 0; nt < 8; ++nt) o[nt] = mfma8(tA_[nt], pm_, o[nt]); } while (0)
template <int MODE> DI void dsa_attn_item(const Ctx& c, int qg, const bf16* PROJ, const unsigned char* K8, const unsigned char* V8, const unsigned short* SEL, const int* SELN, bf16* AO) {
    typedef const __attribute__((address_space(1))) char* gcp;
    LAS unsigned char* Vb = c.lds + c.wave * DSA3_WS; LAS unsigned char* Pb = Vb + 12288; LAS unsigned short* IDXw = (LAS unsigned short*)(Vb + 12288 + 4352);
    int ln = c.lane; asm volatile("" : "+v"(ln));
    const int b = qg >> 13, n = __builtin_amdgcn_readfirstlane(SELN[qg]); const int r16 = ln & 15, q4 = ln >> 4;
    { unsigned short sv[4];
#pragma unroll
      for (int i = 0; i < 4; ++i) sv[i] = SEL[(size_t)qg * 256 + ln + 64 * i];
#pragma unroll
      for (int i = 0; i < 4; ++i) { const int slot = ln + 64 * i; IDXw[slot] = slot < n ? sv[i] : (unsigned short)0; } }
    v2u q2[2][4];
#pragma unroll
    for (int ks = 0; ks < 4; ++ks) { const v4u w = *(const v4u*)(PROJ + (size_t)qg * PROJW + (r16 & 7) * 128 + 64 * (ks >> 1) + 16 * q4 + 8 * (ks & 1));
        v2u v_; v_.x = (r16 & 8) ? w.z : w.x; v_.y = (r16 & 8) ? w.w : w.y; const bool k0_ = (r16 & 4) == 0;
        q2[0][ks].x = k0_ ? v_.x : 0u; q2[0][ks].y = k0_ ? v_.y : 0u; q2[1][ks].x = k0_ ? 0u : v_.x; q2[1][ks].y = k0_ ? 0u : v_.y; }
    LDS_WAIT();
    unsigned kix[16], vix[8][4];
#pragma unroll
    for (int blk = 0; blk < 16; ++blk) kix[blk] = IDXw[16 * blk + (ln >> 2)];
#pragma unroll
    for (int cc = 0; cc < 8; ++cc)
#pragma unroll
        for (int j = 0; j < 4; ++j) vix[cc][j] = IDXw[32 * cc + 8 * j + (ln >> 3)];
    LDS_WAIT(); SB();
    const size_t pl0 = (size_t)(b * 2) * SEQ * 128, pl1 = pl0 + (size_t)SEQ * 128;
    const gcp k8g0 = (gcp)((const char*)K8 + pl0), k8g1 = (gcp)((const char*)K8 + pl1); const char* v8b0 = (const char*)V8 + pl0; const char* v8b1 = (const char*)V8 + pl1;
    const unsigned kofs = (unsigned)(16 * (ln & 3)); const int kperm = 4 * (4 * r16 + q4);
    const unsigned vsw0 = 16u * (unsigned)((ln & 7) ^ (ln >> 4)), vsw1 = 16u * (unsigned)((ln & 7) ^ ((ln >> 4) | 4));
    DSA3_DMAV(0); SB(); DSA3_DMAV(1); SB(); DSA3_DMAV(2); SB();
    f32x4 acc[16]; v4u kA[2][2], kB[2][2], kC[2][2];
    DSA3_LOADK(kA, 0); DSA3_LOADK(kB, 1); DSA3_LOADK(kC, 2); SB();
#define DSA3_STEP(blk, kk, w_) do { DSA3_KWAIT(w_, kk); SB(); DSA3_KPERM(kk); DSA3_QK(blk, kk); SB(); if ((blk) + 3 < 16) { DSA3_LOADK(kk, (blk) + 3); SB(); } } while (0)
    DSA3_STEP(0, kA, 8); DSA3_STEP(1, kB, 8); DSA3_STEP(2, kC, 8); DSA3_STEP(3, kA, 8); DSA3_STEP(4, kB, 8); DSA3_STEP(5, kC, 8); DSA3_STEP(6, kA, 8); DSA3_STEP(7, kB, 8);
    DSA3_STEP(8, kC, 8); DSA3_STEP(9, kA, 8); DSA3_STEP(10, kB, 8); DSA3_STEP(11, kC, 8); DSA3_STEP(12, kA, 8); DSA3_STEP(13, kB, 8); DSA3_STEP(14, kC, 4); DSA3_STEP(15, kA, 0);
    float m = -3.0e38f; const int nq = n - 4 * q4; const float cexp = 1.4426950408889634f / DSA_QS;
#pragma unroll
    for (int kb = 0; kb < 16; ++kb)
#pragma unroll
        for (int i = 0; i < 4; ++i) { const bool ok = (16 * kb + i) < nq; const float s_ = acc[kb][i] + __int_as_float(__builtin_amdgcn_update_dpp(0, __float_as_int(acc[kb][i]), 0x128, 0xf, 0xf, false));
            acc[kb][i] = ok ? s_ : -3.0e38f; m = fmaxf(m, acc[kb][i]); }
    m = fmaxf(m, __shfl_xor(m, 16)); m = fmaxf(m, __shfl_xor(m, 32));
    float l = 0.f; const float mc = 8.0f - m * cexp;
#pragma unroll
    for (int kb = 0; kb < 16; ++kb)
#pragma unroll
        for (int i = 0; i < 4; ++i) { const float p = __builtin_amdgcn_exp2f(fmaf(acc[kb][i], cexp, mc)); acc[kb][i] = p; l += p; }
    l += __shfl_xor(l, 16); l += __shfl_xor(l, 32);
    const float oscale = 1.0f / l;
    if (r16 < 8) {
        LAS unsigned char* pwl = Pb + 272 * r16 + 4 * q4; asm volatile("" : "+v"(pwl));
#pragma unroll
        for (int kb = 0; kb < 16; ++kb) {
            const float p0 = acc[kb][0], p1 = acc[kb][1], p2 = acc[kb][2], p3 = acc[kb][3];
            int wh = 0; wh = __builtin_amdgcn_cvt_pk_fp8_f32(p0, p1, wh, false); wh = __builtin_amdgcn_cvt_pk_fp8_f32(p2, p3, wh, true);
            const f32x2 d0 = __builtin_amdgcn_cvt_pk_f32_fp8(wh, false), d1 = __builtin_amdgcn_cvt_pk_f32_fp8(wh, true);
            int wl = 0; wl = __builtin_amdgcn_cvt_pk_fp8_f32(p0 - d0.x, p1 - d0.y, wl, false); wl = __builtin_amdgcn_cvt_pk_fp8_f32(p2 - d1.x, p3 - d1.y, wl, true);
            *(LAS int*)(pwl + 16 * kb) = wh; *(LAS int*)(pwl + 2176 + 16 * kb) = wl; }
    }
    unsigned va[8];
    { const unsigned q_ = (unsigned)(r16 >> 1), rel = 128u * (8u * (unsigned)q4 + q_) + 8u * (unsigned)(ln & 1) + 16u * ((((unsigned)q4 & 1u) << 2) | (q_ >> 1)); const unsigned vb_ = (unsigned)(size_t)Vb;
#pragma unroll
      for (int nt = 0; nt < 8; ++nt) va[nt] = vb_ + (rel ^ (16u * (unsigned)nt)); }
    const unsigned prdA = (unsigned)(size_t)(Pb + 2176 * (r16 >> 3) + 272 * (r16 & 7) + 8 * q4); const int mykv = (r16 >> 2) & 1;
    f32x4 o[8];
#pragma unroll
    for (int nt = 0; nt < 8; ++nt) o[nt] = (f32x4){0.f, 0.f, 0.f, 0.f};
    LDS_WAIT(); SB();
#pragma unroll
    for (int u = 0; u < 16; ++u) {
        if (u < 14) DSA_VWAIT(8); else if (u == 14) DSA_VWAIT(4); else DSA_VWAIT(0);
        SB(); DSA3_PV(u); SB();
        if (u + 3 < 16) { LDS_WAIT(); SB(); DSA3_DMAV(u + 3); SB(); }
    }
#pragma unroll
    for (int nt = 0; nt < 8; ++nt)
#pragma unroll
        for (int i = 0; i < 4; ++i) o[nt][i] += __int_as_float(__builtin_amdgcn_update_dpp(0, __float_as_int(o[nt][i]), 0x128, 0xf, 0xf, false));
    if (r16 < 8) {
        bf16* op = AO + (size_t)qg * 1024 + r16 * 128 + 4 * q4;
#pragma unroll
        for (int nt = 0; nt < 8; ++nt) { v2u w; w.x = pk2(o[nt][0] * oscale, o[nt][1] * oscale); w.y = pk2(o[nt][2] * oscale, o[nt][3] * oscale); *(v2u*)(op + 16 * nt) = w; }
    }
    LDS_WAIT();
}
template <int MODE> DI void dsa_attn_phase(const Ctx& c, const bf16* PROJ, const unsigned char* K8, const unsigned char* V8, const unsigned short* SEL, const int* SELN, bf16* AO) {
    for (int x = c.vcu * 8 + c.wave; x < MTOK; x += c.G * 8) dsa_attn_item<MODE>(c, x, PROJ, K8, V8, SEL, SELN, AO);
}

#ifndef SKIPM
#define SKIPM 0
#endif
#ifndef PROBE_IDX_MODE
#define PROBE_IDX_MODE 0
#endif
#ifndef PROBE_ATTN_MODE
#define PROBE_ATTN_MODE 0
#endif
#ifndef PROBE_MASK
#define PROBE_MASK 0u
#endif
struct Args { const float* in[36]; float* out; unsigned char* ws; int ph_lo, ph_hi, li, pad; };
enum { I_X = 0, I_MEM, I_POS, I_F1N, I_F1G, I_F1U, I_F1D, I_MIXN, I_EVIN, I_EVOUT, I_GLAWA, I_GLABA, I_GLAN, I_S5LR, I_S5LI, I_S5DT, I_S5BR, I_S5BI, I_S5CR, I_S5CI, I_S5D, I_S5WG, I_S5BG,
       I_ODIN, I_ODOUT, I_XAN, I_MEMNORM, I_XAWQ, I_XAWK, I_XAWV, I_XAWO, I_F2N, I_F2G, I_F2U, I_F2D, I_FINN };

#define GEMM_CALL(EPI, A_, Bt_, M_, N_, K_, E_) do { const pg8::Gemm g_{(const pg8::bf16_t*)(A_), (const pg8::bf16_t*)(Bt_), (M_), (N_), (K_)}; typedef pg8::TileOrder<(M_) / 256, (N_) / 256> Ord_; Ord_ S_; S_.G = c.G; S_.c = (int)blockIdx.x; \
    pg8::gemm_phase<EPI, Ord_, true, true>(c.lds, g_, S_, (E_), MYTID()); } while (0)

#define RSL_PTR() ((const PG8_LAS float*)(c.lds + RING_BYTES))
#define GEMM_CALL_RS(EPI, A_, Bt_, M_, N_, K_, E_) do { const pg8::Gemm g_{(const pg8::bf16_t*)(A_), (const pg8::bf16_t*)(Bt_), (M_), (N_), (K_)}; typedef pg8::TileOrder<(M_) / 256, (N_) / 256> Ord_; Ord_ S_; S_.G = c.G; S_.c = (int)blockIdx.x; \
    { const int t_ = MYTID(); LAS float* rsl_ = (LAS float*)(c.lds + RING_BYTES); \
      for (int i0_ = 0; ; i0_ += 2) { pg8::Unit u0_; if (!S_.next(i0_, u0_)) break; pg8::Unit u_; const int i_ = i0_ + (t_ >> 8); \
          if (S_.next(i_, u_)) { const f32x4* sp_ = (const f32x4*)(SS + (size_t)(u_.pm * 256 + (t_ & 255)) * 16); const f32x4 a0_ = sp_[0], a1_ = sp_[1], a2_ = sp_[2], a3_ = sp_[3]; \
              const f32x4 q_ = (a0_ + a1_) + (a2_ + a3_); rsl_[i_ * 256 + (t_ & 255)] = rsqrtf(((q_[0] + q_[1]) + (q_[2] + q_[3])) * (1.0f / 1024.0f) + EPS); } } \
      __syncthreads(); } \
    pg8::gemm_phase<EPI, Ord_, true, true>(c.lds, g_, S_, (E_), MYTID()); } while (0)

#define MK_GAS __attribute__((address_space(1)))
DI unsigned char* launder_ptr(unsigned char* p) { MK_GAS unsigned char* g = (MK_GAS unsigned char*)p; asm volatile("" : "+s"(g)); return (unsigned char*)g; }
DI const float* gin_(const float* p) { MK_GAS const float* g = (MK_GAS const float*)p; asm volatile("" : "+s"(g)); return (const float*)g; }
DI float* gout_(float* p) { MK_GAS float* g = (MK_GAS float*)p; asm volatile("" : "+s"(g)); return (float*)g; }
#define AIN(k) gin_(a.in[launder_idx(k)])
DI int launder_idx(int i) { asm volatile("" : "+s"(i)); return i; }
#define DECL_PTRS() float* H = (float*)(ws + WS_H); bf16* HB = (bf16*)(ws + WS_HB); float* SS = (float*)(ws + WS_SS); \
    float* COSA = (float*)(ws + WS_COSA); float* SINA = (float*)(ws + WS_SINA); float* COSI = (float*)(ws + WS_COSI); float* SINI = (float*)(ws + WS_SINI); \
    bf16* MEMN = (bf16*)(ws + WS_MEMN); bf16* MK = (bf16*)(ws + WS_MK); bf16* MVT = (bf16*)(ws + WS_MVT); float* S5P = (float*)(ws + WS_S5P); \
    unsigned char* scr = ws + WS_SCR; \
    bf16* HID = (bf16*)(scr + SC_HID); bf16* PROJ = (bf16*)(scr + SC_PROJ); bf16* XQ = (bf16*)(scr + SC_XQ); bf16* XO = (bf16*)(scr + SC_XO); bf16* KVW = (bf16*)(scr + SC_KVW); \
    float* DS = (float*)(scr + SC_DS); float* BCg = (float*)(scr + SC_BC); float* DEC = (float*)(scr + SC_DEC); float* S5E = (float*)(scr + SC_S5E); \
    bf16* Y = (bf16*)(scr + SC_Y); bf16* CAT = (bf16*)(scr + SC_CAT); unsigned short* SEL = (unsigned short*)(scr + SC_SEL); int* SELN = (int*)(scr + SC_SELN); \
    unsigned char* W = ws + WS_W; \
    bf16* Wgu1 = (bf16*)(W + WO_GU1); bf16* Wd1 = (bf16*)(W + WO_D1); bf16* Win = (bf16*)(W + WO_IN); bf16* Wout = (bf16*)(W + WO_OUT); bf16* Wglu = (bf16*)(W + WO_GLU); \
    bf16* Wxq = (bf16*)(W + WO_XQ); bf16* Wxo = (bf16*)(W + WO_XO); bf16* Wgu2 = (bf16*)(W + WO_GU2); bf16* Wd2 = (bf16*)(W + WO_D2);
#define CVT_LAYER_BODY() do { const size_t fo = (size_t)l * DM * DFF; cvt_job_gu(c, AIN(I_F1G) + fo, AIN(I_F1U) + fo, AIN(I_F1N) + l * DM, Wgu1, 0); cvt_job(c, AIN(I_F1D) + fo, DM, 0, DM, nullptr, Wd1, DFF, DM, 0, 512); if (even) { const float* win = AIN(I_EVIN) + (size_t)e * DM * EV_IN; const float* gn = AIN(I_MIXN) + l * DM; cvt_job(c, win, EV_IN, 0, 1536, gn, Win, DM, 1536, 0, 1024); cvt_job_comb(c, win, AIN(I_GLAWA) + e * 16 * 256, gn, Win, 1536, 1536); cvt_job(c, win, EV_IN, 1552, 512, gn, Win, DM, 512, 1792, 1664); cvt_job(c, AIN(I_EVOUT) + (size_t)e * DM * DM, DM, 0, DM, nullptr, Wout, DM, DM, 0, 256); cvt_job(c, AIN(I_S5WG) + (size_t)e * 512 * 512, 512, 0, 512, nullptr, Wglu, 512, 512, 0, 1920); } else { cvt_job_rope(c, AIN(I_ODIN) + (size_t)e * DM * OD_IN, AIN(I_MIXN) + l * DM, Win, 1024); cvt_job(c, AIN(I_ODOUT) + (size_t)e * DM * DM, DM, 0, DM, nullptr, Wout, DM, DM, 0, 256); } cvt_job(c, AIN(I_XAWQ) + (size_t)l * DM * DM, DM, 0, DM, AIN(I_XAN) + l * DM, Wxq, DM, DM, 0, 768); cvt_job(c, AIN(I_XAWO) + (size_t)l * DM * DM, DM, 0, DM, nullptr, Wxo, DM, DM, 0, 1280); cvt_job_gu(c, AIN(I_F2G) + fo, AIN(I_F2U) + fo, AIN(I_F2N) + l * DM, Wgu2, 1024); cvt_job(c, AIN(I_F2D) + fo, DM, 0, DM, nullptr, Wd2, DFF, DM, 0, 1536); } while (0)
__global__ void __launch_bounds__(512, 2) mk_fwd(Args a) {
    extern __shared__ __attribute__((aligned(16))) unsigned char lds_raw[];
    Ctx c; c.lds = (LAS unsigned char*)lds_raw;
    c.tid = threadIdx.x; c.lane = c.tid & 63; c.wave = __builtin_amdgcn_readfirstlane(c.tid >> 6);
    const unsigned wave_s = (unsigned)c.wave;
    c.G = gridDim.x; { const int bx = blockIdx.x; c.vcu = (c.G % 8 == 0) ? (bx % 8) * (c.G / 8) + bx / 8 : bx; }
    for (int u = c.tid; u < (LDS_BYTES - LDSCTL_OFF) / 4; u += 512) ((LAS unsigned*)(c.lds + LDSCTL_OFF))[u] = 0u;
    __syncthreads();
    unsigned char* ws0 = a.ws;
    const int lo = a.ph_lo, hi = a.ph_hi;
    XcdBarrier bar; bar.bar = (unsigned*)(ws0 + WS_CTL) + CW_BAR + a.li * XCD_BAR_WORDS; bar.x = 0; bar.st = (volatile LAS unsigned*)(c.lds + LDSCTL_OFF);
    if (hi - lo > 1) bar = xcd_barrier_post(bar.bar, (volatile LAS unsigned*)(c.lds + LDSCTL_OFF));
#define IN(k) (launder_idx(lo) <= (k) && (k) < launder_idx(hi))
#define MYTID() ((int)(wave_s * 64u + __builtin_amdgcn_mbcnt_hi(~0u, __builtin_amdgcn_mbcnt_lo(~0u, 0u))))
#define FRESH() do { int t_ = MYTID(); asm volatile("" : "+v"(t_)); c.tid = t_; c.lane = t_ & 63; c.wave = (int)wave_s; } while (0)
#define SEAM(k) do { if (IN(k) && IN((k) + 1)) xcd_barrier(bar); } while (0)
    const int NGW = c.G * 8, gw = c.vcu * 8 + c.wave;

#define PHASE(k, q, ...) do { if (IN(k)) { { const bool dup_ = false; (void)dup_; unsigned char* ws = launder_ptr(a.ws); DECL_PTRS(); __VA_ARGS__ } if ((PROBE_MASK >> (q)) & 1u) { xcd_barrier(bar); { const bool dup_ = true; (void)dup_; unsigned char* ws = launder_ptr(a.ws); DECL_PTRS(); __VA_ARGS__ } } } SEAM(k); } while (0)
    PHASE(0, 30, {
        FRESH();
        const int* pos = (const int*)AIN(I_POS);
        for (int e = c.vcu * 512 + c.tid; e < MTOK * 96; e += c.G * 512) {
            if (e < MTOK * 64) { const int tok = e >> 6, i = e & 63; const float inv = powf(10000.0f, -(float)(2 * i) / 128.0f), ang = (float)pos[tok] * inv; COSA[e] = cosf(ang); SINA[e] = sinf(ang); }
            else { const int e2 = e - MTOK * 64, tok = e2 >> 5, i = e2 & 31; const float inv = powf(10000.0f, -(float)(2 * i) / 64.0f), ang = (float)pos[tok] * inv; COSI[e2] = cosf(ang); SINI[e2] = sinf(ang); }
        }
        for (int m = gw; m < MTOK; m += NGW) row_init(AIN(I_X) + (size_t)m * DM, HB + (size_t)m * DM, SS + (size_t)m * 16, c.lane);
        for (int m = gw; m < NB * NMEM; m += NGW) row_norm_bf16(AIN(I_MEM) + (size_t)m * DM, AIN(I_MEMNORM), MEMN + (size_t)m * DM, c.lane);
        for (int l = 0; l < DEPTH; ++l) {
            cvt_job(c, AIN(I_XAWK) + (size_t)l * DM * DM, DM, 0, DM, nullptr, KVW, DM, DM, l * DM, l * 256);
            cvt_job(c, AIN(I_XAWV) + (size_t)l * DM * DM, DM, 0, DM, nullptr, KVW + (size_t)4096 * DM, DM, DM, l * DM, l * 256 + 128);
        }
        s5_params(c, AIN(I_S5LR), AIN(I_S5LI), AIN(I_S5DT), AIN(I_S5BR), AIN(I_S5BI), S5P);
        { const int l = 0, e = 0; const bool even = true; CVT_LAYER_BODY(); }
    });
#pragma clang loop unroll(full)
    for (int l = 0; l < DEPTH; ++l) {
        const int pb = PH_LAYER0 + l * PH_PER_LAYER, e = l >> 1; const bool even = (l & 1) == 0;
        if (l > 0) PHASE(pb + 0, 0, { FRESH(); CVT_LAYER_BODY(); });
#define MEMKV_TAIL() if (l == 0) { const int bx_ = (int)blockIdx.x - ((MTOK / 256) * (2 * DFF / 256) - 5 * c.G);     \
            { const pg8::Gemm g{(const pg8::bf16_t*)MEMN, (const pg8::bf16_t*)KVW, 512, 4096, 1024}; typedef pg8::TileOrder<2, 16> Ord; Ord S; S.G = c.G; S.c = (c.G == 256) ? bx_ : (int)blockIdx.x; \
              const pg8::EpiScaleBf16<false> E2{(pg8::bf16_t*)MK, 4096, nullptr, 1.0f}; pg8::gemm_phase<pg8::EpiScaleBf16<false>, Ord, true, true>(c.lds, g, S, E2, MYTID()); } \
            { const pg8::Gemm g{(const pg8::bf16_t*)(KVW + (size_t)4096 * DM), (const pg8::bf16_t*)MEMN, 4096, 512, 1024}; typedef pg8::TileOrder<16, 2> Ord; Ord S; S.G = c.G; S.c = ((c.G == 256) ? bx_ : (int)blockIdx.x) - 32; \
              const pg8::EpiScaleBf16<false> E2{(pg8::bf16_t*)MVT, 512, nullptr, 1.0f}; pg8::gemm_phase<pg8::EpiScaleBf16<false>, Ord, true, true>(c.lds, g, S, E2, MYTID()); } }
        PHASE(pb + 1, 1, { const pg8::EpiSwiGLU E{(pg8::bf16_t*)HID, DFF, RSL_PTR()}; GEMM_CALL_RS(pg8::EpiSwiGLU, HB, Wgu1, MTOK, 2 * DFF, DM, E); MEMKV_TAIL(); });
        PHASE(pb + 2, 2, { const pg8::EpiResid E{(pg8::bf16_t*)HB, SS, dup_ ? 0.f : 0.5f}; GEMM_CALL(pg8::EpiResid, HID, Wd1, MTOK, DM, DFF, E); });
        if (even) PHASE(pb + 3, 3, { const pg8::EpiScaleBf16<true> E{(pg8::bf16_t*)PROJ, PROJW, RSL_PTR(), 1.0f}; GEMM_CALL_RS(pg8::EpiScaleBf16<true>, HB, Win, MTOK, PROJW, DM, E); });
        else PHASE(pb + 3, 3, { const pg8::EpiRope E{(pg8::bf16_t*)PROJ, RSL_PTR(), COSA, SINA, COSI, SINI, scr + SC_K8, scr + SC_V8}; GEMM_CALL_RS(pg8::EpiRope, HB, Win, MTOK, PROJW, DM, E); });
        if (even) {
            PHASE(pb + 4, 4, {
                FRESH();
                for (int u = c.vcu; u < 1024; u += c.G) gla1_unit(c, u, PROJ, AIN(I_GLABA) + e * 256, DS, BCg, DEC);
                s5_phase1(c, e, PROJ, S5P, S5E);
            });
            PHASE(pb + 5, 29, { FRESH(); gla2_scan(c, DS, DEC); s5_phase2(c, e, S5P, S5E); });
            PHASE(pb + 6, 6, {
                FRESH();
                for (int u = c.vcu; u < 1024; u += c.G) gla3_unit(c, u, PROJ, BCg, DS, AIN(I_GLAN) + e * 128, CAT);
                s5_phase3(c, e, PROJ, S5P, S5E, AIN(I_S5CR), AIN(I_S5CI), AIN(I_S5D), Y);
            });
            PHASE(pb + 7, 7, { const pg8::EpiGLU E{(const pg8::bf16_t*)Y, AIN(I_S5BG) + e * 512, (pg8::bf16_t*)CAT}; GEMM_CALL(pg8::EpiGLU, Y, Wglu, MTOK, 512, 512, E); });
        } else {
            PHASE(pb + 5, 15, { FRESH(); if (!dup_) { for (int u = c.vcu; u < 512; u += c.G) dsa_index_unit<0>(c, u, PROJ, SEL, SELN); } else { for (int u = c.vcu; u < 512; u += c.G) dsa_index_unit<PROBE_IDX_MODE>(c, u, PROJ, (unsigned short*)(scr + 81 * MiB), (int*)(scr + 90 * MiB)); } });
            PHASE(pb + 6, 16, { FRESH(); if (!dup_) dsa_attn_phase<0>(c, PROJ, scr + SC_K8, scr + SC_V8, SEL, SELN, CAT); else dsa_attn_phase<PROBE_ATTN_MODE>(c, PROJ, scr + SC_K8, scr + SC_V8, SEL, SELN, (bf16*)(scr + 100 * MiB)); });
        }
        PHASE(pb + 8, 8, { const pg8::EpiResid E{(pg8::bf16_t*)HB, SS, dup_ ? 0.f : 1.0f}; GEMM_CALL(pg8::EpiResid, CAT, Wout, MTOK, DM, DM, E); });
        PHASE(pb + 9, 9, { const pg8::EpiScaleBf16<true> E{(pg8::bf16_t*)XQ, DM, RSL_PTR(), 0.0625f}; GEMM_CALL_RS(pg8::EpiScaleBf16<true>, HB, Wxq, MTOK, DM, DM, E); });
        PHASE(pb + 10, 10, { FRESH(); for (int u = c.vcu; u < 256; u += c.G) xattn_unit(c, u, l, XQ, MK, MVT, XO); });
        PHASE(pb + 11, 11, { const pg8::EpiResid E{(pg8::bf16_t*)HB, SS, dup_ ? 0.f : 1.0f}; GEMM_CALL(pg8::EpiResid, XO, Wxo, MTOK, DM, DM, E); });
        PHASE(pb + 12, 12, { const pg8::EpiSwiGLU E{(pg8::bf16_t*)HID, DFF, RSL_PTR()}; GEMM_CALL_RS(pg8::EpiSwiGLU, HB, Wgu2, MTOK, 2 * DFF, DM, E); });
        PHASE(pb + 13, 13, { const pg8::EpiResid E{(pg8::bf16_t*)HB, SS, dup_ ? 0.f : 0.5f}; GEMM_CALL(pg8::EpiResid, HID, Wd2, MTOK, DM, DFF, E); });
    }
    if (IN(PH_FINAL)) { FRESH(); unsigned char* ws = launder_ptr(a.ws); DECL_PTRS(); for (int m = gw; m < MTOK; m += NGW) row_final(HB + (size_t)m * DM, SS + (size_t)m * 16, AIN(I_FINN), gout_(a.out) + (size_t)m * DM, c.lane); }
#undef PHASE
#undef IN
#undef SEAM
}

#ifndef MK_ONE_LAUNCH
#define MK_ONE_LAUNCH 1
#endif
extern "C" void kernel_launch(void* const* d_in, const int* in_sizes, int n_in, void* d_out, int out_size, void* d_ws, size_t ws_size, hipStream_t stream) {
    static int grid = 0;
    if (grid == 0) {
        if (n_in != 36 || out_size != MTOK * DM || ws_size < WS_END) { fprintf(stderr, "kernel_launch: unexpected shapes (n_in %d out %d ws %zu)\n", n_in, out_size, ws_size); grid = -1; return; }
        int dev = 0, cus = 0, per_cu = 0;
        if (hipGetDevice(&dev) != hipSuccess || hipDeviceGetAttribute(&cus, hipDeviceAttributeMultiprocessorCount, dev) != hipSuccess) { grid = -1; return; }
        if (hipFuncSetAttribute((const void*)mk_fwd, hipFuncAttributeMaxDynamicSharedMemorySize, LDS_BYTES) != hipSuccess) { fprintf(stderr, "kernel_launch: hipFuncSetAttribute failed\n"); grid = -1; return; }
        if (hipOccupancyMaxActiveBlocksPerMultiprocessor(&per_cu, (const void*)mk_fwd, 512, LDS_BYTES) != hipSuccess || per_cu < 1) fprintf(stderr, "kernel_launch: occupancy query reports %d\n", per_cu);
        (void)hipGetLastError();
        grid = cus;
    }
    if (grid < 0) return;
    (void)hipMemsetAsync((char*)d_ws + WS_CTL, 0, CTL_ZERO_BYTES, stream);
    Args a{};
    for (int i = 0; i < 36; ++i) a.in[i] = (const float*)d_in[i];
    a.out = (float*)d_out; a.ws = (unsigned char*)d_ws; a.pad = 0;
#if MK_ONE_LAUNCH
    a.ph_lo = 0; a.ph_hi = N_PHASES; a.li = 0;
    hipLaunchKernelGGL(mk_fwd, dim3(grid), dim3(512), LDS_BYTES, stream, a);
#else
    for (int p = 0; p < N_PHASES; ++p) {
        if (p >= PH_LAYER0 && p < PH_FINAL) { const int l = (p - PH_LAYER0) / PH_PER_LAYER, q = (p - PH_LAYER0) % PH_PER_LAYER; if ((l & 1) && q == 7) continue; }
        a.ph_lo = p; a.ph_hi = p + 1; a.li = 0;
        hipLaunchKernelGGL(mk_fwd, dim3(grid), dim3(512), LDS_BYTES, stream, a);
    }
#endif
}
```

```cpp
#include <hip/hip_runtime.h>
#include <cstdio>
#include <cstdint>
namespace pg8 {
#define PG8_LAS __attribute__((address_space(3)))
typedef unsigned short bf16_t;
typedef short bf16x8 __attribute__((ext_vector_type(8)));
typedef float f32x4 __attribute__((ext_vector_type(4)));
typedef unsigned u32x4 __attribute__((ext_vector_type(4)));
constexpr int BM = 256, BK = 64, HALF = 128, HTB = HALF * BK * 2  , STAGE_BYTES = 8 * HTB, NXCD = 8, WGM = 8;

__host__ __device__ __forceinline__ int lds_byte(int r, int c) { const int st = (r >> 4) * 2 + (c >> 5), rr = r & 15, cc = c & 31, ob = rr * 64 + cc * 2; return st * 1024 + (ob ^ (((ob >> 9) & 1) << 5)); }
__host__ __device__ __forceinline__ void stage_rc(int b, int& R, int& C) { const int st = b / 1024, sb = b % 1024, swz = sb ^ (((sb >> 9) & 1) << 5); R = (st >> 1) * 16 + swz / 64; C = (st & 1) * 32 + (swz % 64) / 2; }
__host__ __device__ __forceinline__ int perm32(int rho) { const int n = rho >> 4, i = rho & 15; return 8 * (i >> 2) + 4 * n + (i & 3); }

struct Unit { int pm, pn, ui; };
struct Gemm { const bf16_t* A; const bf16_t* Bt; int M, N, K; };

struct StaticOrder {
    int nM, nN, nwg, G, c;
    __host__ __device__ void init(int M, int N, int G_, int c_) { nM = M / BM; nN = N / BM; nwg = nM * nN; G = G_; c = c_; }
    __host__ __device__ bool next(int i, Unit& u) const {
        const long L = (long)i * G + c; if (L >= nwg) return false;
        int wgid = (int)L; { const int q = nwg / NXCD, r = nwg % NXCD, xcd = wgid % NXCD, off = wgid / NXCD; wgid = (xcd < r ? xcd * (q + 1) : r * (q + 1) + (xcd - r) * q) + off; }
        const int nig = WGM * nN, gid = wgid / nig, fm = gid * WGM, gsz = (nM - fm) < WGM ? (nM - fm) : WGM;
        u.pm = fm + ((wgid % nig) % gsz); u.pn = (wgid % nig) / gsz; return true;
    }
    __device__ __forceinline__ void a_ready(const Unit&) const {}
    __device__ __forceinline__ void done(const Unit&) const {}
};

__device__ __forceinline__ unsigned cvt_pk_bf16(float lo, float hi) { unsigned r; asm volatile("v_cvt_pk_bf16_f32 %0, %1, %2" : "=v"(r) : "v"(lo), "v"(hi)); return r; }
typedef float f32x2 __attribute__((ext_vector_type(2)));
typedef unsigned u32x2 __attribute__((ext_vector_type(2)));
#define PG8_GAS __attribute__((address_space(1)))
__device__ __forceinline__ u32x2 pack8_fp8(const float (&x)[8]) { int w0 = 0, w1 = 0; w0 = __builtin_amdgcn_cvt_pk_fp8_f32(x[0], x[1], w0, false); w0 = __builtin_amdgcn_cvt_pk_fp8_f32(x[2], x[3], w0, true);
    w1 = __builtin_amdgcn_cvt_pk_fp8_f32(x[4], x[5], w1, false); w1 = __builtin_amdgcn_cvt_pk_fp8_f32(x[6], x[7], w1, true); u32x2 r; r.x = (unsigned)w0; r.y = (unsigned)w1; return r; }
__device__ __forceinline__ u32x4 split8_hilo(const float (&x)[8]) { const u32x2 h = pack8_fp8(x);
    const f32x2 a = __builtin_amdgcn_cvt_pk_f32_fp8((int)h.x, false), b = __builtin_amdgcn_cvt_pk_f32_fp8((int)h.x, true), c = __builtin_amdgcn_cvt_pk_f32_fp8((int)h.y, false), d = __builtin_amdgcn_cvt_pk_f32_fp8((int)h.y, true);
    const float r[8] = {x[0] - a.x, x[1] - a.y, x[2] - b.x, x[3] - b.y, x[4] - c.x, x[5] - c.y, x[6] - d.x, x[7] - d.y}; const u32x2 l = pack8_fp8(r);
    u32x4 w; w.x = h.x; w.y = h.y; w.z = l.x; w.w = l.y; return w; }
__device__ __forceinline__ float bf_lo(unsigned w) { return __uint_as_float(w << 16); }
__device__ __forceinline__ float bf_hi(unsigned w) { return __uint_as_float(w & 0xffff0000u); }
__device__ __forceinline__ float fast_sigmoid(float x) { return __builtin_amdgcn_rcpf(1.0f + __expf(-x)); }
struct EpiSwiGLU {
    static constexpr bool PERM = true, AFTER_DRAIN = false;
    bf16_t* O; int ldc; const PG8_LAS float* rsl;
    __device__ __forceinline__ void operator()(const f32x4 (&acc)[2][2][4][2], const Unit& u, int wr, int wc, int fr, int fq) const {
        const int col0 = u.pn * HALF + wc * 32 + 8 * fq; const PG8_LAS float* rp = rsl + u.ui * 256 + wr * 64 + fr;
#pragma unroll
        for (int ai = 0; ai < 2; ++ai)
#pragma unroll
            for (int m = 0; m < 4; ++m) {
                const int row = u.pm * BM + ai * HALF + wr * 64 + m * 16 + fr; const float r = rp[ai * HALF + m * 16];
                float h[8];
#pragma unroll
                for (int n = 0; n < 2; ++n)
#pragma unroll
                    for (int j = 0; j < 4; ++j) { const float g = acc[ai][0][m][n][j] * r, up = acc[ai][1][m][n][j] * r; h[n * 4 + j] = g * fast_sigmoid(g) * up; }
                u32x4 w; w.x = cvt_pk_bf16(h[0], h[1]); w.y = cvt_pk_bf16(h[2], h[3]); w.z = cvt_pk_bf16(h[4], h[5]); w.w = cvt_pk_bf16(h[6], h[7]);
                *(PG8_GAS u32x4*)(O + (size_t)row * ldc + col0) = w;
            }
    }
};
struct EpiResid {
    static constexpr bool PERM = false, AFTER_DRAIN = false;
    bf16_t* HB; float* ss; float scale;
    __device__ __forceinline__ void operator()(const f32x4 (&acc)[2][2][4][2], const Unit& u, int wr, int wc, int fr, int fq) const {
        const int col0 = u.pn * BM + wc * 32 + 4 * fq;
        PG8_GAS bf16_t* hb = (PG8_GAS bf16_t*)HB + (size_t)(u.pm * BM + wr * 64 + fr) * 1024 + col0;
        const int L = fr + 16 * fq, perm = 4 * (4 * fr + fq);
        const PG8_GAS bf16_t* hl = (const PG8_GAS bf16_t*)HB + (size_t)(u.pm * BM + wr * 64 + (L >> 2)) * 1024 + u.pn * BM + wc * 32 + 4 * (L & 3);
        u32x2 hv[2][4][2][2];
#pragma unroll
        for (int ai = 0; ai < 2; ++ai)
#pragma unroll
            for (int m = 0; m < 4; ++m)
#pragma unroll
                for (int bj = 0; bj < 2; ++bj)
#pragma unroll
                    for (int n = 0; n < 2; ++n) hv[ai][m][bj][n] = *(const PG8_GAS u32x2*)(hl + (size_t)(ai * HALF + m * 16) * 1024 + bj * HALF + n * 16);

#pragma unroll
        for (int ai = 0; ai < 2; ++ai)
#pragma unroll
            for (int m = 0; m < 4; ++m) {
                const int row = u.pm * BM + ai * HALF + wr * 64 + m * 16 + fr; float sq = 0.f;
#pragma unroll
                for (int bj = 0; bj < 2; ++bj)
#pragma unroll
                    for (int n = 0; n < 2; ++n) {
                        u32x2 x = hv[ai][m][bj][n]; x.x = (unsigned)__builtin_amdgcn_ds_bpermute(perm, (int)x.x); x.y = (unsigned)__builtin_amdgcn_ds_bpermute(perm, (int)x.y);
                        f32x4 h = {bf_lo(x.x), bf_hi(x.x), bf_lo(x.y), bf_hi(x.y)}; h = h + acc[ai][bj][m][n] * scale;
                        u32x2 w; w.x = cvt_pk_bf16(h[0], h[1]); w.y = cvt_pk_bf16(h[2], h[3]); *(PG8_GAS u32x2*)(hb + (size_t)(ai * HALF + m * 16) * 1024 + bj * HALF + n * 16) = w;
                        const float r0 = bf_lo(w.x), r1 = bf_hi(w.x), r2 = bf_lo(w.y), r3 = bf_hi(w.y);
                        sq += (r0 * r0 + r1 * r1) + (r2 * r2 + r3 * r3);
                    }
                sq += __shfl_xor(sq, 16); sq += __shfl_xor(sq, 32);
                if (fq == 0) ((PG8_GAS float*)ss)[(size_t)row * 16 + u.pn * 4 + wc] = sq;
            }
    }
};
template <bool USE_RS> struct EpiScaleBf16 {
    static constexpr bool PERM = true, AFTER_DRAIN = false;
    bf16_t* O; int ldc; const PG8_LAS float* rsl; float cscale;
    __device__ __forceinline__ void operator()(const f32x4 (&acc)[2][2][4][2], const Unit& u, int wr, int wc, int fr, int fq) const {
        const int col0 = u.pn * BM + wc * 32 + 8 * fq; const PG8_LAS float* rp = rsl + u.ui * 256 + wr * 64 + fr;
#pragma unroll
        for (int ai = 0; ai < 2; ++ai)
#pragma unroll
            for (int m = 0; m < 4; ++m) {
                const int row = u.pm * BM + ai * HALF + wr * 64 + m * 16 + fr; const float s = (USE_RS ? rp[ai * HALF + m * 16] : 1.0f) * cscale;
                PG8_GAS bf16_t* rowp = (PG8_GAS bf16_t*)O + (size_t)row * ldc + col0;
#pragma unroll
                for (int bj = 0; bj < 2; ++bj) { const f32x4 v0 = acc[ai][bj][m][0] * s, v1 = acc[ai][bj][m][1] * s;
                    u32x4 w; w.x = cvt_pk_bf16(v0[0], v0[1]); w.y = cvt_pk_bf16(v0[2], v0[3]); w.z = cvt_pk_bf16(v1[0], v1[1]); w.w = cvt_pk_bf16(v1[2], v1[3]);
                    *(PG8_GAS u32x4*)(rowp + bj * HALF) = w; }
            }
    }
};
struct EpiRope {
    static constexpr bool PERM = true, AFTER_DRAIN = false;
    bf16_t* O; const PG8_LAS float* rsl; const float* cA; const float* sA; const float* cI; const float* sI; unsigned char* K8; unsigned char* V8;
    __device__ __forceinline__ void operator()(const f32x4 (&acc)[2][2][4][2], const Unit& u, int wr, int wc, int fr, int fq) const {
        const int x0 = wc * 32 + 8 * fq, pn = u.pn; const PG8_LAS float* rp = rsl + u.ui * 256 + wr * 64 + fr;
        const bool rot = !(pn == 5 || (pn == 8 && x0 >= 32)); const bool tA = pn < 5; const int half = tA ? 64 : 32, i0 = x0 & (half - 1);
#pragma unroll
        for (int ai = 0; ai < 2; ++ai) {
            f32x4 tc[4][2], ts[4][2];
            if (rot) {
#pragma unroll
                for (int m = 0; m < 4; ++m) { const int row = u.pm * BM + ai * HALF + wr * 64 + m * 16 + fr;
                    const PG8_GAS float* cp = (const PG8_GAS float*)(tA ? cA + (size_t)row * 64 : cI + (size_t)row * 32) + i0; const PG8_GAS float* sp = (const PG8_GAS float*)(tA ? sA + (size_t)row * 64 : sI + (size_t)row * 32) + i0;
                    tc[m][0] = *(const PG8_GAS f32x4*)cp; tc[m][1] = *(const PG8_GAS f32x4*)(cp + 4); ts[m][0] = *(const PG8_GAS f32x4*)sp; ts[m][1] = *(const PG8_GAS f32x4*)(sp + 4); }
            }
#pragma unroll
            for (int m = 0; m < 4; ++m) {
                const int row = u.pm * BM + ai * HALF + wr * 64 + m * 16 + fr; const float r = rp[ai * HALF + m * 16];
                PG8_GAS bf16_t* orow = (PG8_GAS bf16_t*)O + (size_t)row * 2304;
                float a[8], b[8];
#pragma unroll
                for (int n = 0; n < 2; ++n)
#pragma unroll
                    for (int j = 0; j < 4; ++j) { a[4 * n + j] = acc[ai][0][m][n][j] * r; b[4 * n + j] = acc[ai][1][m][n][j] * r; }
                if (pn == 5) {
                    const size_t cr = (size_t)((row >> 13) * 2) * 8192 + (row & 8191);
                    *(PG8_GAS u32x2*)(V8 + cr * 128 + x0) = pack8_fp8(a); *(PG8_GAS u32x2*)(V8 + (cr + 8192) * 128 + x0) = pack8_fp8(b);
                } else if (pn == 8 && x0 >= 32) {
                    if (x0 == 32) { u32x4 w0; w0.x = cvt_pk_bf16(a[0], a[1]); w0.y = cvt_pk_bf16(a[2], a[3]); w0.z = cvt_pk_bf16(a[4], a[5]); w0.w = cvt_pk_bf16(a[6], a[7]); *(PG8_GAS u32x4*)(orow + 2112) = w0; }
                } else {
                    const int hh = tA ? (x0 >> 6) : (x0 >> 5);
                    const int base = pn < 4 ? 256 * pn + 128 * hh : (pn == 4 ? 1024 + 128 * hh : (pn == 8 ? 2048 : 1536 + 256 * (pn - 6) + 64 * hh));
                    const float sc = pn < 4 ? 0.08838834764831845f * 32.0f : 1.0f;
                    const f32x4 c0 = tc[m][0], c1 = tc[m][1], s0 = ts[m][0], s1 = ts[m][1];
                    const float cs[8] = {c0[0], c0[1], c0[2], c0[3], c1[0], c1[1], c1[2], c1[3]}, sn[8] = {s0[0], s0[1], s0[2], s0[3], s1[0], s1[1], s1[2], s1[3]};
                    float o1[8], o2[8];
#pragma unroll
                    for (int k = 0; k < 8; ++k) { o1[k] = (a[k] * cs[k] - b[k] * sn[k]) * sc; o2[k] = (b[k] * cs[k] + a[k] * sn[k]) * sc; }
                    u32x4 w0, w1; w0.x = cvt_pk_bf16(o1[0], o1[1]); w0.y = cvt_pk_bf16(o1[2], o1[3]); w0.z = cvt_pk_bf16(o1[4], o1[5]); w0.w = cvt_pk_bf16(o1[6], o1[7]);
                    w1.x = cvt_pk_bf16(o2[0], o2[1]); w1.y = cvt_pk_bf16(o2[2], o2[3]); w1.z = cvt_pk_bf16(o2[4], o2[5]); w1.w = cvt_pk_bf16(o2[6], o2[7]);
                    if (pn < 4) { w0 = split8_hilo(o1); w1 = split8_hilo(o2); }
                    if (pn == 4) { const size_t cr = (size_t)((row >> 13) * 2 + hh) * 8192 + (row & 8191); *(PG8_GAS u32x2*)(K8 + cr * 128 + i0) = pack8_fp8(o1); *(PG8_GAS u32x2*)(K8 + cr * 128 + 64 + i0) = pack8_fp8(o2); }
                    else { *(PG8_GAS u32x4*)(orow + base + i0) = w0; *(PG8_GAS u32x4*)(orow + base + half + i0) = w1; }
                }
            }
        }
    }
};
struct EpiGLU {
    static constexpr bool PERM = true, AFTER_DRAIN = false;
    const bf16_t* Y; const float* bias; bf16_t* CAT;
    __device__ __forceinline__ void operator()(const f32x4 (&acc)[2][2][4][2], const Unit& u, int wr, int wc, int fr, int fq) const {
        const int col0 = u.pn * BM + wc * 32 + 8 * fq;
        const PG8_GAS bf16_t* yb = (const PG8_GAS bf16_t*)Y + (size_t)(u.pm * BM + wr * 64 + fr) * 512 + col0;
        u32x4 yv[2][4][2]; f32x4 bb[2][2];
#pragma unroll
        for (int bj = 0; bj < 2; ++bj) { bb[bj][0] = *(const PG8_GAS f32x4*)(bias + col0 + bj * HALF); bb[bj][1] = *(const PG8_GAS f32x4*)(bias + col0 + bj * HALF + 4); }
#pragma unroll
        for (int ai = 0; ai < 2; ++ai)
#pragma unroll
            for (int m = 0; m < 4; ++m)
#pragma unroll
                for (int bj = 0; bj < 2; ++bj) yv[ai][m][bj] = *(const PG8_GAS u32x4*)(yb + (size_t)(ai * HALF + m * 16) * 512 + bj * HALF);
#pragma unroll
        for (int ai = 0; ai < 2; ++ai)
#pragma unroll
            for (int m = 0; m < 4; ++m) {
                const int row = u.pm * BM + ai * HALF + wr * 64 + m * 16 + fr;
#pragma unroll
                for (int bj = 0; bj < 2; ++bj) { const int c = col0 + bj * HALF; const u32x4 y4 = yv[ai][m][bj];
                    const f32x4 z0 = acc[ai][bj][m][0] + bb[bj][0], z1 = acc[ai][bj][m][1] + bb[bj][1];
                    float o[8];
                    o[0] = bf_lo(y4.x) * fast_sigmoid(z0[0]); o[1] = bf_hi(y4.x) * fast_sigmoid(z0[1]); o[2] = bf_lo(y4.y) * fast_sigmoid(z0[2]); o[3] = bf_hi(y4.y) * fast_sigmoid(z0[3]);
                    o[4] = bf_lo(y4.z) * fast_sigmoid(z1[0]); o[5] = bf_hi(y4.z) * fast_sigmoid(z1[1]); o[6] = bf_lo(y4.w) * fast_sigmoid(z1[2]); o[7] = bf_hi(y4.w) * fast_sigmoid(z1[3]);
                    u32x4 w; w.x = cvt_pk_bf16(o[0], o[1]); w.y = cvt_pk_bf16(o[2], o[3]); w.z = cvt_pk_bf16(o[4], o[5]); w.w = cvt_pk_bf16(o[6], o[7]);
                    *(PG8_GAS u32x4*)(CAT + (size_t)row * 1024 + 512 + c) = w; }
            }
    }
};
template <int NM, int NN> struct TileOrder {
    static constexpr int nwg = NM * NN, WG = NM < 8 ? NM : 8, nig = WG * NN;
    static_assert(nwg % 8 == 0 && NM % WG == 0, "TileOrder shapes");
    int G, c;
    __device__ __forceinline__ bool next(int i, Unit& u) const {
        const int L = i * G + c; if (c < 0 || L >= nwg) return false;
        const int wgid = (L & 7) * (nwg / 8) + (L >> 3), gid = wgid / nig, r = wgid % nig;
        u.pm = gid * WG + (r % WG); u.pn = r / WG; u.ui = i; return true;
    }
    __device__ __forceinline__ void a_ready(const Unit&) const {}
    __device__ __forceinline__ void done(const Unit&) const {}
};
template <class Epi, class Sched, bool ALIGN_EPI = false, bool SP2 = false>
__device__ __forceinline__ void gemm_phase(PG8_LAS unsigned char* lds, const Gemm g, const Sched& S, const Epi& E, int tid_in) {
    int tid_ = tid_in; asm volatile("" : "+v"(tid_));
    const int tid = tid_, wid = __builtin_amdgcn_readfirstlane(tid >> 6), lane = tid & 63, wr = wid >> 2, wc = wid & 3, fr = lane & 15, fq = lane >> 4;
    const int K = g.K, nt = K / BK;
    unsigned voffA[2], voffB[2];
#pragma unroll
    for (int i = 0; i < 2; ++i) { int R, C; stage_rc(tid * 16 + i * 8192, R, C); const int Rb = Epi::PERM ? ((R & ~31) + perm32(R & 31)) : R;
        voffA[i] = (unsigned)(R * K + C) * 2u; voffB[i] = (unsigned)(Rb * K + C) * 2u; }
    const size_t kstep = (size_t)(BK * 2);
    const size_t hstep = (size_t)HALF * K * 2;
    const size_t tstep = 2 * hstep;
    const unsigned ldsw = (unsigned)wid * 1024u;
    const int aoff = lds_byte(wr * 64 + fr, fq * 8), boff = lds_byte(wc * 32 + fr, fq * 8);
#define PG8_SA(b, h) (((b) * 2 + (h)) * HTB)
#define PG8_SB(b, h) ((4 + (b) * 2 + (h)) * HTB)
#define PG8_STAGE(bufoff, gbase, voff) do { _Pragma("unroll") for (int _i = 0; _i < 2; ++_i) \
        __builtin_amdgcn_global_load_lds((const unsigned*)((const char*)(gbase) + (voff)[_i]), (PG8_LAS unsigned*)(lds + (bufoff) + ldsw + _i * 8192), 16, 0, 0); } while (0)
#define PG8_LDA(dst, b, h) do { _Pragma("unroll") for (int m = 0; m < 4; ++m) _Pragma("unroll") for (int k = 0; k < 2; ++k) dst[m][k] = *(const PG8_LAS bf16x8*)(lds + PG8_SA(b, h) + aoff + m * 2048 + k * 1024); } while (0)
#define PG8_LDB(dst, b, h) do { _Pragma("unroll") for (int n = 0; n < 2; ++n) _Pragma("unroll") for (int k = 0; k < 2; ++k) dst[n][k] = *(const PG8_LAS bf16x8*)(lds + PG8_SB(b, h) + boff + n * 2048 + k * 1024); } while (0)
#define PG8_MMA(ai, bj, At, Bt) do { __builtin_amdgcn_s_setprio(1); _Pragma("unroll") for (int m = 0; m < 4; ++m) _Pragma("unroll") for (int n = 0; n < 2; ++n) _Pragma("unroll") for (int k = 0; k < 2; ++k) \
        acc[ai][bj][m][n] = __builtin_amdgcn_mfma_f32_16x16x32_bf16(Bt[n][k], At[m][k], acc[ai][bj][m][n], 0, 0, 0); __builtin_amdgcn_s_setprio(0); } while (0)
#define PG8_WAIT_V(n) asm volatile("s_waitcnt vmcnt(" #n ")" ::: "memory")
#define PG8_WAIT_L(n) asm volatile("s_waitcnt lgkmcnt(" #n ")" ::: "memory")
#define PG8_BAR __builtin_amdgcn_s_barrier()
#define PG8_SCHED __builtin_amdgcn_sched_barrier(0)
    Unit cur, nxt; int ui = 0;
    if (!S.next(0, cur)) return;
    f32x4 acc[2][2][4][2];
#pragma unroll
    for (int a = 0; a < 2; ++a)
#pragma unroll
        for (int b = 0; b < 2; ++b)
#pragma unroll
            for (int m = 0; m < 4; ++m)
#pragma unroll
                for (int n = 0; n < 2; ++n) acc[a][b][m][n] = (f32x4){0.f, 0.f, 0.f, 0.f};
    bf16x8 At[4][2], B0[2][2], B1[2][2];
    const char* cA = (const char*)g.A + (size_t)cur.pm * tstep; const char* cB = (const char*)g.Bt + (size_t)cur.pn * tstep;
    S.a_ready(cur);
    if constexpr (SP2) {
        PG8_STAGE(PG8_SB(0, 0), cB, voffB); PG8_STAGE(PG8_SB(0, 1), cB + hstep, voffB); PG8_STAGE(PG8_SA(0, 0), cA, voffA); PG8_STAGE(PG8_SA(0, 1), cA + hstep, voffA);
        if (wr == 1) PG8_BAR;
        PG8_WAIT_V(2); PG8_BAR;
        PG8_STAGE(PG8_SB(1, 0), cB + kstep, voffB); PG8_STAGE(PG8_SA(1, 0), cA + kstep, voffA); PG8_STAGE(PG8_SB(1, 1), cB + hstep + kstep, voffB);
        PG8_WAIT_V(6); PG8_BAR;
    } else {
        PG8_STAGE(PG8_SB(0, 0), cB, voffB); PG8_STAGE(PG8_SA(0, 0), cA, voffA); PG8_STAGE(PG8_SB(0, 1), cB + hstep, voffB); PG8_STAGE(PG8_SA(0, 1), cA + hstep, voffA);
        if (wr == 1) PG8_BAR;
        PG8_WAIT_V(4); PG8_BAR;
        PG8_STAGE(PG8_SB(1, 0), cB + kstep, voffB); PG8_STAGE(PG8_SA(1, 0), cA + kstep, voffA); PG8_STAGE(PG8_SB(1, 1), cB + hstep + kstep, voffB);
        PG8_WAIT_V(6); PG8_BAR;
    }
    for (;;) {
        const bool has_next = S.next(ui + 1, nxt);
        const char* nA = has_next ? (const char*)g.A + (size_t)nxt.pm * tstep : cA; const char* nB = has_next ? (const char*)g.Bt + (size_t)nxt.pn * tstep : cB;
        for (int t = 0; t < nt; t += 2) {
            const bool last = (t == nt - 2);
            const char* a1 = cA + (size_t)(t + 1) * kstep;
            const char* a2 = last ? nA : cA + (size_t)(t + 2) * kstep; const char* b2 = last ? nB : cB + (size_t)(t + 2) * kstep;
            const char* a3 = a2 + kstep; const char* b3 = b2 + kstep;
            if (last && has_next) S.a_ready(nxt);
            if constexpr (SP2) {
            PG8_LDB(B0, 0, 0); PG8_LDB(B1, 0, 1); PG8_SCHED; PG8_LDA(At, 0, 0); PG8_STAGE(PG8_SA(1, 1), a1 + hstep, voffA);
            PG8_WAIT_V(8); PG8_WAIT_L(0); PG8_BAR; PG8_MMA(0, 0, At, B0); PG8_MMA(0, 1, At, B1); PG8_BAR; PG8_SCHED;
            PG8_LDA(At, 0, 1); PG8_STAGE(PG8_SB(0, 0), b2, voffB); PG8_STAGE(PG8_SB(0, 1), b2 + hstep, voffB); PG8_STAGE(PG8_SA(0, 0), a2, voffA);
            PG8_WAIT_V(8); PG8_WAIT_L(0); PG8_BAR; PG8_MMA(1, 0, At, B0); PG8_MMA(1, 1, At, B1); PG8_BAR; PG8_SCHED;
            PG8_LDB(B0, 1, 0); PG8_LDB(B1, 1, 1); PG8_SCHED; PG8_LDA(At, 1, 0); PG8_STAGE(PG8_SA(0, 1), a2 + hstep, voffA);
            PG8_WAIT_V(8); PG8_WAIT_L(0); PG8_BAR; PG8_MMA(0, 0, At, B0); PG8_MMA(0, 1, At, B1); PG8_BAR; PG8_SCHED;
            PG8_LDA(At, 1, 1); PG8_STAGE(PG8_SB(1, 0), b3, voffB); PG8_STAGE(PG8_SB(1, 1), b3 + hstep, voffB); PG8_STAGE(PG8_SA(1, 0), a3, voffA);
            PG8_WAIT_V(8); PG8_WAIT_L(0); PG8_BAR; PG8_MMA(1, 0, At, B0); PG8_MMA(1, 1, At, B1); PG8_BAR; PG8_SCHED;
            } else {
            PG8_LDB(B0, 0, 0); PG8_SCHED; PG8_LDA(At, 0, 0); PG8_STAGE(PG8_SA(1, 1), a1 + hstep, voffA);
            PG8_WAIT_L(8); PG8_BAR; PG8_WAIT_L(0); PG8_MMA(0, 0, At, B0); PG8_BAR; PG8_SCHED;
            PG8_LDB(B1, 0, 1); PG8_STAGE(PG8_SB(0, 0), b2, voffB);
            PG8_BAR; PG8_WAIT_L(0); PG8_MMA(0, 1, At, B1); PG8_BAR;
            PG8_LDA(At, 0, 1); PG8_STAGE(PG8_SA(0, 0), a2, voffA);
            PG8_BAR; PG8_WAIT_L(0); PG8_MMA(1, 0, At, B0); PG8_BAR; PG8_SCHED;
            PG8_STAGE(PG8_SB(0, 1), b2 + hstep, voffB);
            PG8_WAIT_V(6); PG8_BAR; PG8_MMA(1, 1, At, B1); PG8_BAR;
            PG8_LDB(B0, 1, 0); PG8_SCHED; PG8_LDA(At, 1, 0); PG8_STAGE(PG8_SA(0, 1), a2 + hstep, voffA);
            PG8_WAIT_L(8); PG8_BAR; PG8_WAIT_L(0); PG8_MMA(0, 0, At, B0); PG8_BAR; PG8_SCHED;
            PG8_LDB(B1, 1, 1); PG8_STAGE(PG8_SB(1, 0), b3, voffB);
            PG8_BAR; PG8_WAIT_L(0); PG8_MMA(0, 1, At, B1); PG8_BAR;
            PG8_LDA(At, 1, 1); PG8_STAGE(PG8_SA(1, 0), a3, voffA);
            PG8_BAR; PG8_WAIT_L(0); PG8_MMA(1, 0, At, B0); PG8_BAR; PG8_SCHED;
            PG8_STAGE(PG8_SB(1, 1), b3 + hstep, voffB);
            PG8_WAIT_V(6); PG8_BAR; PG8_MMA(1, 1, At, B1); PG8_BAR;
            }
        }
        if constexpr (ALIGN_EPI) { if (wr == 0) PG8_BAR; }
        if constexpr (!Epi::AFTER_DRAIN) { E(acc, cur, wr, wc, fr, fq); S.done(cur); }
        if (!has_next) break;
#pragma unroll
        for (int a = 0; a < 2; ++a)
#pragma unroll
            for (int b = 0; b < 2; ++b)
#pragma unroll
                for (int m = 0; m < 4; ++m)
#pragma unroll
                    for (int n = 0; n < 2; ++n) acc[a][b][m][n] = (f32x4){0.f, 0.f, 0.f, 0.f};
        cur = nxt; cA = nA; cB = nB; ++ui;
        if constexpr (ALIGN_EPI) { if (wr == 1) PG8_BAR; }
    }
    PG8_WAIT_V(0);
    if constexpr (!ALIGN_EPI) { if (wr == 0) PG8_BAR; }
    PG8_BAR;
    if constexpr (Epi::AFTER_DRAIN) { E.fused(acc, cur, wr, wc, fr, fq, lds, wid, lane); S.done(cur); }
#undef PG8_SA
#undef PG8_SB
#undef PG8_STAGE
#undef PG8_LDA
#undef PG8_LDB
#undef PG8_MMA
#undef PG8_WAIT_V
#undef PG8_WAIT_L
#undef PG8_BAR
#undef PG8_SCHED
}
}

constexpr int NB = 2, SEQ = 8192, DM = 1024, MTOK = NB * SEQ, DEPTH = 4, NMEM = 256, DFF = 2816;
constexpr int PROJW = 2304;
constexpr int EV_IN = 2064, OD_IN = 2120;
constexpr float EPS = 1e-6f;
constexpr int S5T = 64, S5NC = SEQ / S5T;
constexpr int TOPK = 256;
constexpr int PH_LAYER0 = 2, PH_PER_LAYER = 14, PH_FINAL = PH_LAYER0 + DEPTH * PH_PER_LAYER, N_PHASES = PH_FINAL + 1;

constexpr size_t MiB = 1u << 20;
constexpr size_t WS_CTL = 0, CTL_ZERO_BYTES = 1 * MiB;
constexpr size_t WS_H = 1 * MiB, WS_HB = 65 * MiB, WS_SS = 97 * MiB;
constexpr size_t WS_COSA = 98 * MiB, WS_SINA = 102 * MiB, WS_COSI = 106 * MiB, WS_SINI = 108 * MiB;
constexpr size_t WS_MEMN = 110 * MiB, WS_MK = 111 * MiB, WS_MVT = 115 * MiB, WS_S5P = 119 * MiB;
constexpr size_t WS_W = 121 * MiB, WS_SCR = 169 * MiB, WS_END = 345 * MiB;
constexpr size_t WO_GU1 = 0, WO_D1 = 11 * MiB, WO_IN = WO_D1 + 5632 * 1024, WO_OUT = WO_IN + 4608 * 1024, WO_GLU = WO_OUT + 2 * MiB, WO_XQ = WO_GLU + 512 * 1024,
                 WO_XO = WO_XQ + 2 * MiB, WO_GU2 = WO_XO + 2 * MiB, WO_D2 = WO_GU2 + 11 * MiB, WO_END = WO_D2 + 5632 * 1024;
static_assert(WO_END <= 48 * MiB, "weights region");
constexpr size_t SC_HID = 0, SC_PROJ = 0, SC_XQ = 0, SC_XO = 32 * MiB, SC_KVW = 96 * MiB;
constexpr size_t SC_DS = 72 * MiB, SC_BC = 104 * MiB, SC_DEC = 120 * MiB, SC_S5E = 121 * MiB, SC_Y = 125 * MiB, SC_CAT = 141 * MiB;
constexpr size_t SC_SEL = 72 * MiB, SC_SELN = 80 * MiB, SC_K8 = 81 * MiB, SC_V8 = 85 * MiB;
static_assert(SC_CAT + 32 * MiB <= WS_END - WS_SCR, "scratch region");
constexpr int S5P_A = 0, S5P_AT = 2 * 32 * 64 * 2, S5P_BB = 2 * S5P_AT, S5P_BBH = S5P_BB + 2 * 32 * 64 * 16 * 2, S5P_END = S5P_BBH + 2 * 32 * 128 * 16 / 2;
constexpr int CW_BAR = 1024;

constexpr int RING_BYTES = 131072;
constexpr int LDS_BYTES = 163840, LDSCTL_OFF = LDS_BYTES - 1024;

#define GAS __attribute__((address_space(1)))
#define LAS __attribute__((address_space(3)))
#define DI __device__ __forceinline__
typedef unsigned short bf16;
typedef unsigned v4u __attribute__((ext_vector_type(4)));
typedef unsigned v2u __attribute__((ext_vector_type(2)));
typedef float f32x4 __attribute__((ext_vector_type(4)));
typedef float f32x2 __attribute__((ext_vector_type(2)));
typedef short bf16x8 __attribute__((ext_vector_type(8)));
#define LDS_WAIT() asm volatile("s_waitcnt lgkmcnt(0)" ::: "memory")
#define VM_WAIT() asm volatile("s_waitcnt vmcnt(0)" ::: "memory")
DI unsigned f2bf(float f) { unsigned u = __builtin_bit_cast(unsigned, f); return (u + 0x7fffu + ((u >> 16) & 1u)) >> 16; }
DI unsigned pk2(float lo, float hi) { return f2bf(lo) | (f2bf(hi) << 16); }
DI float bflo(unsigned w) { return __uint_as_float(w << 16); }
DI float bfhi(unsigned w) { return __uint_as_float(w & 0xffff0000u); }
DI float bf2f(bf16 x) { return __uint_as_float(((unsigned)x) << 16); }
DI float wave_sum(float v) {
#pragma unroll
    for (int o = 1; o < 64; o <<= 1) v += __shfl_xor(v, o);
    return v;
}
DI f32x4 mfma16(bf16x8 a, bf16x8 b, f32x4 c) { return __builtin_amdgcn_mfma_f32_16x16x32_bf16(a, b, c, 0, 0, 0); }

#define XB_TMO      128
#define XB_XCNT(j)  (256  + 64 * (j))
#define XB_XSUB(j)  (1280 + 64 * (j))
#define XB_XGEN(j)  (2304 + 64 * (j))
#define XB_TOP      3328
#define XB_TOPGEN   3392
#define XCD_BAR_WORDS 3456
#define XB_SPIN_CAP (1u << 18)
__device__ __forceinline__ unsigned xb_ld(unsigned* p)              { return __hip_atomic_load(p, __ATOMIC_RELAXED, __HIP_MEMORY_SCOPE_AGENT); }
__device__ __forceinline__ unsigned xb_add(unsigned* p, unsigned v) { return __hip_atomic_fetch_add(p, v, __ATOMIC_RELAXED, __HIP_MEMORY_SCOPE_AGENT); }
__device__ __forceinline__ unsigned xb_xcc_id() { return (unsigned)__builtin_amdgcn_s_getreg((3 << 11) | 20) & 0xFu; }
#define XB_SPIN(cond, bar) do { unsigned _sp = 0; while (cond) { __builtin_amdgcn_s_sleep(1); \
    if ((++_sp & 255u) == 0u) { if (xb_ld(&(bar)[XB_TMO])) break; if (_sp > XB_SPIN_CAP) { atomicAdd(&(bar)[XB_TMO], 1u); break; } } } } while (0)
struct XcdBarrier { unsigned* bar; unsigned x; volatile LAS unsigned* st; };
__device__ __forceinline__ XcdBarrier xcd_barrier_post(unsigned* bar, volatile LAS unsigned* st) {
    XcdBarrier b; b.bar = bar; b.x = xb_xcc_id(); b.st = st;
    if (threadIdx.x == 0) (void)xb_add(&bar[XB_XCNT(b.x)], 1u);
    return b;
}
__device__ __forceinline__ void xcd_barrier_complete(unsigned* bar, unsigned x, unsigned& nloc, unsigned& nx) {
    const unsigned G = gridDim.x * gridDim.y * gridDim.z;
    unsigned sum, cnt, mine, sp = 0u;
    for (;;) {
        sum = 0u; cnt = 0u; mine = 0u;
#pragma unroll
        for (unsigned j = 0; j < 16; ++j) { const unsigned c = xb_ld(&bar[XB_XCNT(j)]); sum += c; cnt += (c > 0u) ? 1u : 0u; mine = (j == x) ? c : mine; }
        if (sum == G) break;
        __builtin_amdgcn_s_sleep(1);
        if ((++sp & 255u) == 0u) { if (xb_ld(&bar[XB_TMO])) break; if (sp > XB_SPIN_CAP) { atomicAdd(&bar[XB_TMO], 1u); break; } }
    }
    nloc = mine > 0u ? mine : 1u; nx = cnt > 0u ? cnt : 1u;
}
__device__ __forceinline__ void xcd_barrier(const XcdBarrier& b) {
    asm volatile("s_waitcnt vmcnt(0)" ::: "memory");
    __syncthreads();
    if (threadIdx.x == 0) {
        unsigned* bar = b.bar;
        __builtin_amdgcn_s_waitcnt(0);
        unsigned nloc = b.st[0], nx = b.st[1];
        if (nloc == 0u) { xcd_barrier_complete(bar, b.x, nloc, nx); b.st[0] = nloc; b.st[1] = nx; }
        const unsigned old = xb_add(&bar[XB_XSUB(b.x)], 1u);
        const unsigned gen = old / nloc;
        if (old + 1u == (gen + 1u) * nloc) {
            __builtin_amdgcn_fence(__ATOMIC_RELEASE, "agent");
            asm volatile("s_waitcnt vmcnt(0)" ::: "memory");
            const unsigned og = xb_add(&bar[XB_TOP], 1u);
            const unsigned tg = og / nx;
            if (og + 1u == (tg + 1u) * nx) xb_add(&bar[XB_TOPGEN], 1u);
            else XB_SPIN(xb_ld(&bar[XB_TOPGEN]) == tg, bar);
            __builtin_amdgcn_fence(__ATOMIC_ACQUIRE, "agent");
            xb_add(&bar[XB_XGEN(b.x)], 1u);
            asm volatile("s_waitcnt vmcnt(0)" ::: "memory");
        } else {
            XB_SPIN(xb_ld(&bar[XB_XGEN(b.x)]) == gen, bar);
            __builtin_amdgcn_fence(__ATOMIC_ACQUIRE, "agent");
            asm volatile("s_waitcnt vmcnt(0)" ::: "memory");
        }
    }
    __syncthreads();
}

struct Ctx { LAS unsigned char* lds; int tid, lane, wave, vcu, G; };

DI void cvt_store(bf16* dst, int K, int drow0, int k0, LAS float* scr, int lane) {
    LDS_WAIT(); asm volatile("" ::: "memory");
    const int c = lane & 7;
#pragma unroll
    for (int j = 0; j < 4; ++j) { const int n = (lane >> 3) + 8 * j; const LAS float* s = scr + (8 * c) * 33 + n;
        v4u o; o.x = pk2(s[0 * 33], s[1 * 33]); o.y = pk2(s[2 * 33], s[3 * 33]); o.z = pk2(s[4 * 33], s[5 * 33]); o.w = pk2(s[6 * 33], s[7 * 33]);
        *(v4u*)(dst + (size_t)(drow0 + n) * K + k0 + 8 * c) = o; }
    LDS_WAIT(); asm volatile("" ::: "memory");
}
DI void cvt_item(const float* src, int ldsrc, int scol0, int nvalid, const float* gain, bf16* dst, int K, int drow0, int k0, LAS float* scr, int lane) {
    const int kr = lane >> 3, n4 = 4 * (lane & 7); const bool ok = n4 < nvalid;
    const float* sp = src + (size_t)(k0 + kr) * ldsrc + scol0 + n4;
    f32x4 v[8];
#pragma unroll
    for (int i = 0; i < 8; ++i) v[i] = ok ? *(const f32x4*)(sp + (size_t)(8 * i) * ldsrc) : (f32x4){0.f, 0.f, 0.f, 0.f};
    if (gain) {
#pragma unroll
        for (int i = 0; i < 8; ++i) v[i] = v[i] * gain[k0 + kr + 8 * i];
    }
#pragma unroll
    for (int i = 0; i < 8; ++i) { LAS float* d = scr + (kr + 8 * i) * 33 + n4; d[0] = v[i].x; d[1] = v[i].y; d[2] = v[i].z; d[3] = v[i].w; }
    cvt_store(dst, K, drow0, k0, scr, lane);
}
DI void cvt_job(const Ctx& c, const float* src, int ldsrc, int scol0, int nvalid, const float* gain, bf16* dst, int K, int N, int drow0, int rot) {
    LAS float* scr = (LAS float*)(c.lds + c.wave * 8448);
    const int NGW = c.G * 8, gw = (c.vcu * 8 + c.wave + rot) % NGW, nblk = N / 32, nitems = (K / 64) * nblk;
    for (int it = gw; it < nitems; it += NGW) { const int kb = it / nblk, nb = it % nblk; int nv = nvalid - nb * 32; nv = nv < 0 ? 0 : (nv > 32 ? 32 : nv);
        cvt_item(src, ldsrc, scol0 + nb * 32, nv, gain, dst, K, drow0 + nb * 32, kb * 64, scr, c.lane); }
}
DI void cvt_job_gu(const Ctx& c, const float* gate, const float* up, const float* gain, bf16* dst, int rot) {
    LAS float* scr = (LAS float*)(c.lds + c.wave * 8448);
    const int NGW = c.G * 8, gw = (c.vcu * 8 + c.wave + rot) % NGW, nblk = 5632 / 32, nitems = (1024 / 64) * nblk;
    for (int it = gw; it < nitems; it += NGW) { const int kb = it / nblk, nb = it % nblk, n0 = nb * 32;
        const float* src = ((n0 >> 7) & 1) ? up : gate; const int sc = (n0 >> 8) * 128 + (n0 & 127);
        cvt_item(src, DFF, sc, 32, gain, dst, 1024, n0, kb * 64, scr, c.lane); }
}
DI void cvt_job_rope(const Ctx& c, const float* src, const float* gain, bf16* dst, int rot) {
    LAS float* scr = (LAS float*)(c.lds + c.wave * 8448);
    const int NGW = c.G * 8, gw = (c.vcu * 8 + c.wave + rot) % NGW, nblk = PROJW / 32, nitems = (1024 / 64) * nblk;
    for (int it = gw; it < nitems; it += NGW) { const int kb = it / nblk, nb = it % nblk, R = nb * 32, t = R >> 8, bj = (R >> 7) & 1, x = R & 127;
        int L, nv = 32;
        if (t < 4) L = 256 * t + 128 * (x >> 6) + 64 * bj + (x & 63);
        else if (t == 4) L = 1024 + 128 * (x >> 6) + 64 * bj + (x & 63);
        else if (t == 5) L = 1280 + 128 * bj + x;
        else if (t < 8) L = 1536 + 256 * (t - 6) + 64 * (x >> 5) + 32 * bj;
        else { if (x == 0) L = 2048 + 32 * bj; else if (x == 32 && bj == 0) { L = 2112; nv = 8; } else { L = 0; nv = 0; } }
        cvt_item(src, OD_IN, L, nv, gain, dst, 1024, R, kb * 64, scr, c.lane); }
}
DI void cvt_job_comb(const Ctx& c, const float* win, const float* wa, const float* gain, bf16* dst, int drow0, int rot) {
    LAS float* scr = (LAS float*)(c.lds + c.wave * 8448);
    const int NGW = c.G * 8, gw = (c.vcu * 8 + c.wave + rot) % NGW, nblk = 256 / 32, nitems = (1024 / 64) * nblk;
    for (int it = gw; it < nitems; it += NGW) { const int kb = it / nblk, nb = it % nblk, n0 = nb * 32, k0 = kb * 64; const int nn = c.lane & 31;
        float wcol[16];
#pragma unroll
        for (int j = 0; j < 16; ++j) wcol[j] = wa[j * 256 + n0 + nn];
        for (int i = 0; i < 32; ++i) { const int kk = 2 * i + (c.lane >> 5); const float* wr = win + (size_t)(k0 + kk) * EV_IN + 1536; float s = 0.f;
#pragma unroll
            for (int j = 0; j < 16; ++j) s += wr[j] * wcol[j];
            scr[kk * 33 + nn] = s * gain[k0 + kk]; }
        cvt_store(dst, 1024, drow0 + n0, k0, scr, c.lane); }
}

DI void row_init(const float* xrow, bf16* hbrow, float* ssrow, int lane) {
    float s = 0.f;
#pragma unroll
    for (int j = 0; j < 4; ++j) { const f32x4 v = ((const f32x4*)xrow)[lane + 64 * j]; v2u w; w.x = pk2(v.x, v.y); w.y = pk2(v.z, v.w); ((v2u*)hbrow)[lane + 64 * j] = w;
        const float r0 = bflo(w.x), r1 = bfhi(w.x), r2 = bflo(w.y), r3 = bfhi(w.y); s += (r0 * r0 + r1 * r1) + (r2 * r2 + r3 * r3); }
    s = wave_sum(s);
    if (lane < 16) ssrow[lane] = (lane == 0) ? s : 0.f;
}
DI void row_norm_bf16(const float* xrow, const float* g, bf16* orow, int lane) {
    f32x4 v[4]; float s = 0.f;
#pragma unroll
    for (int j = 0; j < 4; ++j) { v[j] = ((const f32x4*)xrow)[lane + 64 * j]; s += (v[j].x * v[j].x + v[j].y * v[j].y) + (v[j].z * v[j].z + v[j].w * v[j].w); }
    const float r = rsqrtf(wave_sum(s) * (1.0f / 1024.0f) + EPS);
#pragma unroll
    for (int j = 0; j < 4; ++j) { const f32x4 gg = ((const f32x4*)g)[lane + 64 * j]; v2u w; w.x = pk2(v[j].x * r * gg.x, v[j].y * r * gg.y); w.y = pk2(v[j].z * r * gg.z, v[j].w * r * gg.w); ((v2u*)orow)[lane + 64 * j] = w; }
}
DI void row_final(const bf16* hrow, const float* ssrow, const float* g, float* orow, int lane) {
    float s = (lane < 16) ? ssrow[lane] : 0.f; s = wave_sum(s);
    const float r = rsqrtf(s * (1.0f / 1024.0f) + EPS);
#pragma unroll
    for (int j = 0; j < 4; ++j) { const v2u w = ((const v2u*)hrow)[lane + 64 * j]; const f32x4 v = {bflo(w.x), bfhi(w.x), bflo(w.y), bfhi(w.y)}, gg = ((const f32x4*)g)[lane + 64 * j]; ((f32x4*)orow)[lane + 64 * j] = v * r * gg; }
}

DI void unpack8(const v4u w, float (&x)[8]) { x[0] = bflo(w.x); x[1] = bfhi(w.x); x[2] = bflo(w.y); x[3] = bfhi(w.y); x[4] = bflo(w.z); x[5] = bfhi(w.z); x[6] = bflo(w.w); x[7] = bfhi(w.w); }
DI void gla1_unit(const Ctx& c, int u, const bf16* PROJ, const float* b_a, float* DS, float* BCg, float* DEC) {
    const int n = u & 127, bh = u >> 7, h = bh & 3, b = bh >> 2, row0 = b * SEQ + n * 64;
    LAS float* BCl = (LAS float*)c.lds; LAS float* SEG = BCl + 4096; LAS unsigned char* KEt = c.lds + 18432; LAS unsigned char* VT = KEt + 9216;
    const int t = c.tid >> 3, s8 = c.tid & 7;
    const bf16* prow = PROJ + (size_t)(row0 + t) * PROJW;
    float kk[8];
    { float x[8]; unpack8(*(const v4u*)(prow + 1536 + h * 64 + s8 * 8), x);
      float ls[8];
#pragma unroll
      for (int j = 0; j < 8; ++j) { const float xx = x[j] + b_a[h * 64 + s8 * 8 + j]; ls[j] = (fminf(xx, 0.f) - __logf(1.0f + __expf(-fabsf(xx)))) * (1.0f / 16.0f); }
      *(LAS f32x4*)(BCl + t * 64 + s8 * 8) = (f32x4){ls[0], ls[1], ls[2], ls[3]}; *(LAS f32x4*)(BCl + t * 64 + s8 * 8 + 4) = (f32x4){ls[4], ls[5], ls[6], ls[7]};
      unpack8(*(const v4u*)(prow + 256 + h * 64 + s8 * 8), kk);
      const v4u v0 = *(const v4u*)(prow + 512 + h * 128 + s8 * 16), v1 = *(const v4u*)(prow + 512 + h * 128 + s8 * 16 + 8);
      const unsigned vw[8] = {v0.x, v0.y, v0.z, v0.w, v1.x, v1.y, v1.z, v1.w};
      LAS unsigned char* vt = VT + (16 * s8) * 144 + t * 2;
#pragma unroll
      for (int j = 0; j < 8; ++j) { *(LAS bf16*)(vt + (2 * j) * 144) = (bf16)(vw[j] & 0xffffu); *(LAS bf16*)(vt + (2 * j + 1) * 144) = (bf16)(vw[j] >> 16); } }
    __syncthreads();
    { const int d = c.tid & 63, seg = c.tid >> 6; float v[8]; float run = 0.f;
#pragma unroll
      for (int j = 0; j < 8; ++j) { run += BCl[(8 * seg + j) * 64 + d]; v[j] = run; }
      SEG[seg * 64 + d] = run;
      __syncthreads();
      float off = 0.f;
#pragma unroll
      for (int q = 0; q < 7; ++q) off += (q < seg) ? SEG[q * 64 + d] : 0.f;
#pragma unroll
      for (int j = 0; j < 8; ++j) BCl[(8 * seg + j) * 64 + d] = v[j] + off; }
    __syncthreads();
    { float bcv[8];
#pragma unroll
      for (int j = 0; j < 8; ++j) { const int d = s8 * 8 + j; const float bc = BCl[t * 64 + d], bl = BCl[63 * 64 + d]; bcv[j] = bc;
          *(LAS bf16*)(KEt + d * 144 + t * 2) = (bf16)f2bf(kk[j] * __expf(bl - bc)); }
      float* bp = BCg + (size_t)(row0 + t) * 256 + h * 64 + s8 * 8;
      *(f32x4*)bp = (f32x4){bcv[0], bcv[1], bcv[2], bcv[3]}; *(f32x4*)(bp + 4) = (f32x4){bcv[4], bcv[5], bcv[6], bcv[7]};
      if (c.tid < 64) DEC[(size_t)u * 64 + c.tid] = __expf(BCl[63 * 64 + c.tid]); }
    __syncthreads();
    { const int r16 = c.lane & 15, q4 = c.lane >> 4, w = c.wave;
      bf16x8 vb[2];
#pragma unroll
      for (int ks = 0; ks < 2; ++ks) vb[ks] = *(const LAS bf16x8*)(VT + (16 * w + r16) * 144 + (32 * ks + 8 * q4) * 2);
#pragma unroll
      for (int df = 0; df < 4; ++df) { f32x4 acc = {0.f, 0.f, 0.f, 0.f};
#pragma unroll
          for (int ks = 0; ks < 2; ++ks) acc = mfma16(*(const LAS bf16x8*)(KEt + (16 * df + r16) * 144 + (32 * ks + 8 * q4) * 2), vb[ks], acc);
          float* dp = DS + (size_t)u * 8192 + (size_t)(16 * df + 4 * q4) * 128 + 16 * w + r16;
#pragma unroll
          for (int i = 0; i < 4; ++i) dp[i * 128] = acc[i]; } }
    __syncthreads();
}
DI void gla2_scan(const Ctx& c, float* DS, const float* DEC) {
    for (int el = c.vcu * 512 + c.tid; el < 8 * 64 * 128; el += c.G * 512) {
        const int bh = el >> 13, d = (el >> 7) & 63, e = el & 127; float S = 0.f;
        float* p0 = DS + (size_t)(bh * 128) * 8192 + d * 128 + e; const float* q0 = DEC + (size_t)(bh * 128) * 64 + d;
        for (int n0 = 0; n0 < 128; n0 += 16) {
            float ds[16], dc[16];
#pragma unroll
            for (int j = 0; j < 16; ++j) { ds[j] = p0[(size_t)(n0 + j) * 8192]; dc[j] = q0[(n0 + j) * 64]; }
#pragma unroll
            for (int j = 0; j < 16; ++j) { p0[(size_t)(n0 + j) * 8192] = S; S = dc[j] * S + ds[j]; }
        }
    }
}
DI bf16x8 pack8(const f32x4 a, const f32x4 b) { v4u w; w.x = pk2(a[0], a[1]); w.y = pk2(a[2], a[3]); w.z = pk2(b[0], b[1]); w.w = pk2(b[2], b[3]); return __builtin_bit_cast(bf16x8, w); }
DI void gla3_unit(const Ctx& c, int u, const bf16* PROJ, const float* BCg, const float* DS, const float* gnorm, bf16* CAT) {
    const int n = u & 127, bh = u >> 7, h = bh & 3, b = bh >> 2, row0 = b * SEQ + n * 64;
    LAS unsigned char* QD = c.lds; LAS unsigned char* KI = QD + 9216; LAS unsigned char* VT = KI + 9216; LAS unsigned char* SPT = VT + 18432; LAS float* PART = (LAS float*)(SPT + 18432);
    { const int t = c.tid >> 3, s8 = c.tid & 7; const bf16* prow = PROJ + (size_t)(row0 + t) * PROJW;
      float q[8], k[8]; unpack8(*(const v4u*)(prow + h * 64 + s8 * 8), q); unpack8(*(const v4u*)(prow + 256 + h * 64 + s8 * 8), k);
      const float* bp = BCg + (size_t)(row0 + t) * 256 + h * 64 + s8 * 8; const f32x4 b0 = *(const f32x4*)bp, b1 = *(const f32x4*)(bp + 4);
      const float bc[8] = {b0.x, b0.y, b0.z, b0.w, b1.x, b1.y, b1.z, b1.w};
#pragma unroll
      for (int j = 0; j < 8; ++j) { q[j] = q[j] * 0.125f * __expf(bc[j]); k[j] = k[j] * __expf(-bc[j]); }
      v4u wq, wk; wq.x = pk2(q[0], q[1]); wq.y = pk2(q[2], q[3]); wq.z = pk2(q[4], q[5]); wq.w = pk2(q[6], q[7]); wk.x = pk2(k[0], k[1]); wk.y = pk2(k[2], k[3]); wk.z = pk2(k[4], k[5]); wk.w = pk2(k[6], k[7]);
      *(LAS v4u*)(QD + t * 144 + s8 * 16) = wq; *(LAS v4u*)(KI + t * 144 + s8 * 16) = wk;
      const v4u v0 = *(const v4u*)(prow + 512 + h * 128 + s8 * 16), v1 = *(const v4u*)(prow + 512 + h * 128 + s8 * 16 + 8);
      const unsigned vw[8] = {v0.x, v0.y, v0.z, v0.w, v1.x, v1.y, v1.z, v1.w};
      LAS unsigned char* vt = VT + (16 * s8) * 144 + t * 2;
#pragma unroll
      for (int j = 0; j < 8; ++j) { *(LAS bf16*)(vt + (2 * j) * 144) = (bf16)(vw[j] & 0xffffu); *(LAS bf16*)(vt + (2 * j + 1) * 144) = (bf16)(vw[j] >> 16); }
      const int d = t; const f32x4* sp = (const f32x4*)(DS + (size_t)u * 8192 + d * 128 + s8 * 16);
      LAS unsigned char* st = SPT + (16 * s8) * 144 + d * 2;
#pragma unroll
      for (int i = 0; i < 4; ++i) { const f32x4 x = sp[i];
#pragma unroll
          for (int j = 0; j < 4; ++j) *(LAS bf16*)(st + (4 * i + j) * 144) = (bf16)f2bf(x[j]); } }
    __syncthreads();
    const int r16 = c.lane & 15, q4 = c.lane >> 4, w = c.wave;
    bf16x8 qd[4][2];
#pragma unroll
    for (int tf = 0; tf < 4; ++tf)
#pragma unroll
        for (int ks = 0; ks < 2; ++ks) qd[tf][ks] = *(const LAS bf16x8*)(QD + (16 * tf + r16) * 144 + (32 * ks + 8 * q4) * 2);
    f32x4 sc[4][4];
#pragma unroll
    for (int sf = 0; sf < 4; ++sf) {
        bf16x8 ki[2];
#pragma unroll
        for (int ks = 0; ks < 2; ++ks) ki[ks] = *(const LAS bf16x8*)(KI + (16 * sf + r16) * 144 + (32 * ks + 8 * q4) * 2);
#pragma unroll
        for (int tf = 0; tf < 4; ++tf) {
            f32x4 a = {0.f, 0.f, 0.f, 0.f};
            if (sf <= tf) {
#pragma unroll
                for (int ks = 0; ks < 2; ++ks) a = mfma16(ki[ks], qd[tf][ks], a);
                if (sf == tf) {
#pragma unroll
                    for (int i = 0; i < 4; ++i) a[i] = (4 * q4 + i <= r16) ? a[i] : 0.f;
                }
            }
            sc[sf][tf] = a;
        }
    }
    f32x4 o[4];
#pragma unroll
    for (int tf = 0; tf < 4; ++tf) o[tf] = (f32x4){0.f, 0.f, 0.f, 0.f};
    const LAS unsigned char* vrow = VT + (16 * w + r16) * 144; const LAS unsigned char* srow = SPT + (16 * w + r16) * 144;
#pragma unroll
    for (int kk = 0; kk < 2; ++kk) {
        const v2u lo = *(const LAS v2u*)(vrow + (32 * kk + 4 * q4) * 2), hi = *(const LAS v2u*)(vrow + (32 * kk + 16 + 4 * q4) * 2);
        v4u aw; aw.x = lo.x; aw.y = lo.y; aw.z = hi.x; aw.w = hi.y; const bf16x8 a = __builtin_bit_cast(bf16x8, aw);
#pragma unroll
        for (int tf = 0; tf < 4; ++tf) if (2 * kk <= tf) o[tf] = mfma16(a, pack8(sc[2 * kk][tf], sc[2 * kk + 1][tf]), o[tf]);
    }
#pragma unroll
    for (int ks = 0; ks < 2; ++ks) { const bf16x8 a = *(const LAS bf16x8*)(srow + (32 * ks + 8 * q4) * 2);
#pragma unroll
        for (int tf = 0; tf < 4; ++tf) o[tf] = mfma16(a, qd[tf][ks], o[tf]); }
#pragma unroll
    for (int tf = 0; tf < 4; ++tf) { float ssq = (o[tf][0] * o[tf][0] + o[tf][1] * o[tf][1]) + (o[tf][2] * o[tf][2] + o[tf][3] * o[tf][3]);
        ssq += __shfl_xor(ssq, 16); ssq += __shfl_xor(ssq, 32); if (q4 == 0) PART[w * 64 + 16 * tf + r16] = ssq; }
    __syncthreads();
    const f32x4 gg = *(const f32x4*)(gnorm + 16 * w + 4 * q4);
#pragma unroll
    for (int tf = 0; tf < 4; ++tf) { const int t = 16 * tf + r16; float ssq = 0.f;
#pragma unroll
        for (int ww = 0; ww < 8; ++ww) ssq += PART[ww * 64 + t];
        const float rn = rsqrtf(ssq * (1.0f / 128.0f) + EPS);
        const v2u rv = *(const v2u*)(PROJ + (size_t)(row0 + t) * PROJW + 1024 + h * 128 + 16 * w + 4 * q4);
        const float rr[4] = {bflo(rv.x), bfhi(rv.x), bflo(rv.y), bfhi(rv.y)}; float res[4];
#pragma unroll
        for (int i = 0; i < 4; ++i) res[i] = o[tf][i] * rn * gg[i] * (rr[i] * __builtin_amdgcn_rcpf(1.0f + __expf(-rr[i])));
        v2u ow; ow.x = pk2(res[0], res[1]); ow.y = pk2(res[2], res[3]);
        *(v2u*)(CAT + (size_t)(row0 + t) * 1024 + h * 128 + 16 * w + 4 * q4) = ow; }
    __syncthreads();
}

DI void s5_params(const Ctx& c, const float* lam_re, const float* lam_im, const float* log_dt, const float* B_re, const float* B_im, float* P) {
    for (int idx = c.vcu * 512 + c.tid; idx < 2 * 32 * 64; idx += c.G * 512) {
        const float lr = fminf(lam_re[idx], -1e-4f), li = lam_im[idx], dt = expf(log_dt[idx >> 6]);
        const float mag = expf(lr * dt), ar = mag * cosf(li * dt), ai = mag * sinf(li * dt);
        const float den = lr * lr + li * li, nr = ar - 1.0f, fre = (nr * lr + ai * li) / den, fim = (ai * lr - nr * li) / den;
        P[S5P_A + 2 * idx] = ar; P[S5P_A + 2 * idx + 1] = ai;
        float tr = ar, ti = ai;
#pragma unroll
        for (int s = 0; s < 6; ++s) { const float nr2 = tr * tr - ti * ti, ni2 = 2.0f * tr * ti; tr = nr2; ti = ni2; }
        P[S5P_AT + 2 * idx] = tr; P[S5P_AT + 2 * idx + 1] = ti;
        bf16* BBH = (bf16*)(P + S5P_BBH); const int eg = idx >> 6, pp = idx & 63;
        for (int cc = 0; cc < 16; ++cc) { const float Br = B_re[idx * 16 + cc], Bi = B_im[idx * 16 + cc]; const float br = fre * Br - fim * Bi, bi = fre * Bi + fim * Br;
            P[S5P_BB + 2 * (idx * 16 + cc)] = br; P[S5P_BB + 2 * (idx * 16 + cc) + 1] = bi;
            BBH[(eg * 128 + pp) * 16 + cc] = (bf16)f2bf(br); BBH[(eg * 128 + 64 + pp) * 16 + cc] = (bf16)f2bf(bi); }
    }
}
DI void s5_load_u(const bf16* PROJ, int row0, int g, LAS float* U, int lane) {
    const bf16* p = PROJ + (size_t)(row0 + lane) * PROJW + 1792 + g * 16; float x[8];
    unpack8(*(const v4u*)p, x); ((LAS f32x4*)(U + lane * 16))[0] = (f32x4){x[0], x[1], x[2], x[3]}; ((LAS f32x4*)(U + lane * 16))[1] = (f32x4){x[4], x[5], x[6], x[7]};
    unpack8(*(const v4u*)(p + 8), x); ((LAS f32x4*)(U + lane * 16))[2] = (f32x4){x[0], x[1], x[2], x[3]}; ((LAS f32x4*)(U + lane * 16))[3] = (f32x4){x[4], x[5], x[6], x[7]};
}
DI void s5_frags(const bf16* PROJ, const float* P, int e, int g, int row0, int r16, int q4, bf16x8 (&ua)[4], bf16x8 (&bb)[8]) {
    const bf16x8 zf = {0, 0, 0, 0, 0, 0, 0, 0}; const bf16* BBH = (const bf16*)(P + S5P_BBH);
#pragma unroll
    for (int tf = 0; tf < 4; ++tf) ua[tf] = (q4 < 2) ? *(const bf16x8*)(PROJ + (size_t)(row0 + 16 * tf + r16) * PROJW + 1792 + g * 16 + 8 * q4) : zf;
#pragma unroll
    for (int pf = 0; pf < 8; ++pf) bb[pf] = (q4 < 2) ? *(const bf16x8*)(BBH + ((size_t)(e * 32 + g) * 128 + 16 * pf + r16) * 16 + 8 * q4) : zf;
}
DI void s5_bu16(const bf16x8 ua, const bf16x8 (&bb)[8], LAS float* BUs, int r16, int q4) {
    LAS float* wp = BUs + (4 * q4) * 128 + r16;
#pragma unroll
    for (int pf = 0; pf < 8; ++pf) { const f32x4 d = mfma16(ua, bb[pf], (f32x4){0.f, 0.f, 0.f, 0.f});
#pragma unroll
        for (int i = 0; i < 4; ++i) wp[i * 128 + 16 * pf] = d[i]; }
}
#define S5_BU(t) do { const LAS f32x4* up_ = (const LAS f32x4*)(U + (t) * 16); const f32x4 u0 = up_[0], u1 = up_[1], u2 = up_[2], u3 = up_[3]; \
    const float uu[16] = {u0.x, u0.y, u0.z, u0.w, u1.x, u1.y, u1.z, u1.w, u2.x, u2.y, u2.z, u2.w, u3.x, u3.y, u3.z, u3.w}; bur = 0.f; bui = 0.f; \
    _Pragma("unroll") for (int cc = 0; cc < 16; ++cc) { bur += bbr[cc] * uu[cc]; bui += bbi[cc] * uu[cc]; } } while (0)
DI void s5_phase1(const Ctx& c, int e, const bf16* PROJ, const float* P, float* S5E) {
    LAS float* U = (LAS float*)(c.lds + c.wave * 4096);
    const int NGW = c.G * 8, gw = c.vcu * 8 + c.wave;
    const bool reg = (NGW == 2 * 32 * S5NC / 4);
    int gcur = -1; float ar = 0.f, ai = 0.f, bbr[16], bbi[16];
#pragma unroll
    for (int cc = 0; cc < 16; ++cc) { bbr[cc] = 0.f; bbi[cc] = 0.f; }
    for (int it = 0;; ++it) {
        int wt; if (reg) { if (it >= 4) break; wt = (gw >> 5) * S5NC + (gw & 31) + 32 * it; } else { wt = gw + it * NGW; if (wt >= 2 * 32 * S5NC) break; }
        const int cch = wt & (S5NC - 1), bg = wt >> 7, g = bg & 31, b = bg >> 5, row0 = b * SEQ + cch * S5T, pi = (e * 32 + g) * 64 + c.lane;
        s5_load_u(PROJ, row0, g, U, c.lane);
        if (g != gcur) { gcur = g; ar = P[S5P_A + 2 * pi]; ai = P[S5P_A + 2 * pi + 1];
#pragma unroll
            for (int cc = 0; cc < 16; ++cc) { bbr[cc] = P[S5P_BB + 2 * (pi * 16 + cc)]; bbi[cc] = P[S5P_BB + 2 * (pi * 16 + cc) + 1]; } }
        LDS_WAIT();
        float xr = 0.f, xi = 0.f, bur, bui;
        for (int t = 0; t < S5T; ++t) { S5_BU(t); const float nxr = ar * xr - ai * xi + bur, nxi = ar * xi + ai * xr + bui; xr = nxr; xi = nxi; }
        *(f32x2*)(S5E + 2 * ((size_t)wt * 64 + c.lane)) = (f32x2){xr, xi};
        LDS_WAIT();
    }
}
DI void s5_phase2(const Ctx& c, int e, const float* P, float* S5E) {
    for (int sq = (c.G - 1 - c.vcu) * 512 + c.tid; sq < 2 * 32 * 64; sq += c.G * 512) {
        const int p = sq & 63, bg = sq >> 6, g = bg & 31, pi = (e * 32 + g) * 64 + p; const float tr = P[S5P_AT + 2 * pi], ti = P[S5P_AT + 2 * pi + 1];
        float xr = 0.f, xi = 0.f; f32x2* q0 = (f32x2*)(S5E + 2 * (((size_t)bg * S5NC) * 64 + p));
        for (int c0 = 0; c0 < S5NC; c0 += 16) {
            f32x2 ev[16];
#pragma unroll
            for (int j = 0; j < 16; ++j) ev[j] = q0[(c0 + j) * 64];
#pragma unroll
            for (int j = 0; j < 16; ++j) { q0[(c0 + j) * 64] = (f32x2){xr, xi}; const float nxr = tr * xr - ti * xi + ev[j].x, nxi = tr * xi + ti * xr + ev[j].y; xr = nxr; xi = nxi; }
        }
    }
}
DI void s5_phase3(const Ctx& c, int e, const bf16* PROJ, const float* P, const float* S5E, const float* C_re, const float* C_im, const float* Dp, bf16* Y) {
    LAS float* BUs = (LAS float*)(c.lds + c.wave * 12544);
    LAS unsigned char* XB = c.lds + c.wave * 12544 + 8192;
    const int NGW = c.G * 8, gw = c.vcu * 8 + c.wave; const int r16 = c.lane & 15, q4 = c.lane >> 4;
    const bool reg = (NGW == 2 * 32 * S5NC / 4);
    const bf16x8 zf = {0, 0, 0, 0, 0, 0, 0, 0};
    int gcur = -1; float ar = 0.f, ai = 0.f, Dg = 0.f; bf16x8 bb[8], cf[4];
#pragma unroll
    for (int pf = 0; pf < 8; ++pf) bb[pf] = zf;
#pragma unroll
    for (int ks = 0; ks < 4; ++ks) cf[ks] = zf;
    for (int it = 0;; ++it) {
        int wt; if (reg) { if (it >= 4) break; wt = (gw >> 5) * S5NC + (gw & 31) + 32 * it; } else { wt = gw + it * NGW; if (wt >= 2 * 32 * S5NC) break; }
        const int cch = wt & (S5NC - 1), bg = wt >> 7, g = bg & 31, b = bg >> 5, row0 = b * SEQ + cch * S5T, pi = (e * 32 + g) * 64 + c.lane;
        bf16x8 ua[4];
#pragma unroll
        for (int tf = 0; tf < 4; ++tf) ua[tf] = (q4 < 2) ? *(const bf16x8*)(PROJ + (size_t)(row0 + 16 * tf + r16) * PROJW + 1792 + g * 16 + 8 * q4) : zf;
        if (g != gcur) { gcur = g;
            const bf16* BBH = (const bf16*)(P + S5P_BBH);
#pragma unroll
            for (int pf = 0; pf < 8; ++pf) bb[pf] = (q4 < 2) ? *(const bf16x8*)(BBH + ((size_t)(e * 32 + g) * 128 + 16 * pf + r16) * 16 + 8 * q4) : zf;
            ar = P[S5P_A + 2 * pi]; ai = P[S5P_A + 2 * pi + 1];
            const size_t gi = ((size_t)(e * 32 + g) * 16 + r16) * 64 + 8 * q4;
#pragma unroll
            for (int ks = 0; ks < 4; ++ks) { const float* src = (ks < 2 ? C_re : C_im) + gi + 32 * (ks & 1); const float sg = ks < 2 ? 1.0f : -1.0f;
                const f32x4 x0 = *(const f32x4*)src, x1 = *(const f32x4*)(src + 4); cf[ks] = pack8(x0 * sg, x1 * sg); }
            Dg = Dp[(e * 32 + g) * 16 + r16]; }
        const f32x2 x0 = *(const f32x2*)(S5E + 2 * ((size_t)wt * 64 + c.lane));
        float xr = x0.x, xi = x0.y;
#pragma unroll
        for (int sc = 0; sc < 4; ++sc) {
            s5_bu16(ua[sc], bb, BUs, r16, q4);
            LDS_WAIT();
#pragma unroll
            for (int tt = 0; tt < 16; ++tt) { const float bur = BUs[tt * 128 + c.lane], bui = BUs[tt * 128 + 64 + c.lane]; const float nxr = ar * xr - ai * xi + bur, nxi = ar * xi + ai * xr + bui; xr = nxr; xi = nxi;
                *(LAS bf16*)(XB + tt * 272 + c.lane * 2) = (bf16)f2bf(xr); *(LAS bf16*)(XB + tt * 272 + 128 + c.lane * 2) = (bf16)f2bf(xi); }
            LDS_WAIT();
            f32x4 y = {0.f, 0.f, 0.f, 0.f};
#pragma unroll
            for (int ks = 0; ks < 4; ++ks) y = mfma16(*(const LAS bf16x8*)(XB + r16 * 272 + (32 * ks + 8 * q4) * 2), cf[ks], y);
#pragma unroll
            for (int i = 0; i < 4; ++i) { const int t = sc * 16 + 4 * q4 + i; const float yy = y[i] + Dg * bf2f(PROJ[(size_t)(row0 + t) * PROJW + 1792 + g * 16 + r16]);
                const float z = 0.7978845608f * (yy + 0.044715f * yy * yy * yy); const float th = 1.0f - 2.0f * __builtin_amdgcn_rcpf(__expf(2.0f * z) + 1.0f);
                Y[(size_t)(row0 + t) * 512 + g * 16 + r16] = (bf16)f2bf(0.5f * yy * (1.0f + th)); }
            LDS_WAIT();
        }
    }
}

constexpr int XA_KSLOT = 256 * 144, XA_VSLOT = 64 * 528, XA_VOFF = 2 * XA_KSLOT;
DI void xattn_unit(const Ctx& c, int uidx, int layer, const bf16* XQ, const bf16* MK, const bf16* MVT, bf16* XO) {
    const int h = uidx & 3, tile = uidx >> 2, b = tile >> 5, row0 = tile * 256;
    LAS unsigned char* KS = c.lds; LAS unsigned char* VS = c.lds + XA_VOFF;
    const int r16 = c.lane & 15, q4 = c.lane >> 4, w = c.wave;
    const bf16* kg = MK + (size_t)(b * 256) * 4096 + layer * 1024 + h * 256;
    const bf16* vg = MVT + (size_t)(layer * 1024 + h * 256) * 512 + b * 256;
    v4u st[4];
#define XA_LOADK(dc_) do { _Pragma("unroll") for (int i = 0; i < 4; ++i) { const int idx = c.tid + 512 * i; st[i] = *(const v4u*)(kg + (size_t)(idx >> 3) * 4096 + (dc_) * 64 + (idx & 7) * 8); } } while (0)
#define XA_STOREK(slot_) do { _Pragma("unroll") for (int i = 0; i < 4; ++i) { const int idx = c.tid + 512 * i; *(LAS v4u*)(KS + (slot_) * XA_KSLOT + (idx >> 3) * 144 + (idx & 7) * 16) = st[i]; } } while (0)
#define XA_LOADV(dc_) do { _Pragma("unroll") for (int i = 0; i < 4; ++i) { const int idx = c.tid + 512 * i; st[i] = *(const v4u*)(vg + (size_t)((dc_) * 64 + (idx >> 5)) * 512 + (idx & 31) * 8); } } while (0)
#define XA_STOREV(slot_) do { _Pragma("unroll") for (int i = 0; i < 4; ++i) { const int idx = c.tid + 512 * i; *(LAS v4u*)(VS + (slot_) * XA_VSLOT + (idx >> 5) * 528 + (idx & 31) * 16) = st[i]; } } while (0)
    __syncthreads();
    XA_LOADK(0); XA_STOREK(0);
    __syncthreads();
    f32x4 sa[16][2];
#pragma unroll
    for (int mf = 0; mf < 16; ++mf) { sa[mf][0] = (f32x4){0.f, 0.f, 0.f, 0.f}; sa[mf][1] = sa[mf][0]; }
    const bf16* qg = XQ + (size_t)(row0 + 32 * w + r16) * 1024 + h * 256 + 8 * q4;
#pragma unroll 1
    for (int dc = 0; dc < 4; ++dc) {
        bf16x8 qf[2][2];
#pragma unroll
        for (int tf = 0; tf < 2; ++tf)
#pragma unroll
            for (int ks = 0; ks < 2; ++ks) qf[tf][ks] = *(const bf16x8*)(qg + (size_t)(16 * tf) * 1024 + dc * 64 + ks * 32);
        if (dc < 3) XA_LOADK(dc + 1); else XA_LOADV(0);
        const LAS unsigned char* kc = KS + (dc & 1) * XA_KSLOT + r16 * 144 + 16 * q4;
#pragma unroll
        for (int mf = 0; mf < 16; ++mf)
#pragma unroll
            for (int ks = 0; ks < 2; ++ks) { const bf16x8 a = *(const LAS bf16x8*)(kc + mf * (16 * 144) + ks * 64);
                sa[mf][0] = mfma16(a, qf[0][ks], sa[mf][0]); sa[mf][1] = mfma16(a, qf[1][ks], sa[mf][1]); }
        if (dc < 3) XA_STOREK((dc + 1) & 1); else XA_STOREV(0);
        __syncthreads();
    }
    bf16x8 pp[8][2];
#pragma unroll
    for (int tf = 0; tf < 2; ++tf) {
        float m = sa[0][tf][0];
#pragma unroll
        for (int mf = 0; mf < 16; ++mf)
#pragma unroll
            for (int i = 0; i < 4; ++i) m = fmaxf(m, sa[mf][tf][i]);
        m = fmaxf(m, __shfl_xor(m, 16)); m = fmaxf(m, __shfl_xor(m, 32));
        float l = 0.f;
#pragma unroll
        for (int mf = 0; mf < 16; ++mf)
#pragma unroll
            for (int i = 0; i < 4; ++i) { const float p = __expf(sa[mf][tf][i] - m); sa[mf][tf][i] = p; l += p; }
        l += __shfl_xor(l, 16); l += __shfl_xor(l, 32);
        const float inv = 1.0f / l;
#pragma unroll
        for (int kk = 0; kk < 8; ++kk) pp[kk][tf] = pack8(sa[2 * kk][tf] * inv, sa[2 * kk + 1][tf] * inv);
    }
    bf16* og = XO + (size_t)(row0 + 32 * w + r16) * 1024 + h * 256 + 4 * q4;
#pragma unroll 1
    for (int dc = 0; dc < 4; ++dc) {
        if (dc < 3) XA_LOADV(dc + 1);
        f32x4 o[4][2];
#pragma unroll
        for (int df = 0; df < 4; ++df) { o[df][0] = (f32x4){0.f, 0.f, 0.f, 0.f}; o[df][1] = o[df][0]; }
        const LAS unsigned char* vc = VS + (dc & 1) * XA_VSLOT + r16 * 528 + 8 * q4;
#pragma unroll
        for (int kk = 0; kk < 8; ++kk)
#pragma unroll
            for (int df = 0; df < 4; ++df) { const v2u lo = *(const LAS v2u*)(vc + df * (16 * 528) + kk * 64), hi = *(const LAS v2u*)(vc + df * (16 * 528) + kk * 64 + 32);
                v4u aw; aw.x = lo.x; aw.y = lo.y; aw.z = hi.x; aw.w = hi.y; const bf16x8 a = __builtin_bit_cast(bf16x8, aw);
                o[df][0] = mfma16(a, pp[kk][0], o[df][0]); o[df][1] = mfma16(a, pp[kk][1], o[df][1]); }
#pragma unroll
        for (int tf = 0; tf < 2; ++tf)
#pragma unroll
            for (int df = 0; df < 4; ++df) { v2u ow; ow.x = pk2(o[df][tf][0], o[df][tf][1]); ow.y = pk2(o[df][tf][2], o[df][tf][3]); *(v2u*)(og + (size_t)(16 * tf) * 1024 + dc * 64 + 16 * df) = ow; }
        if (dc < 3) { XA_STOREV((dc + 1) & 1); __syncthreads(); }
    }
#undef XA_LOADK
#undef XA_STOREK
#undef XA_LOADV
#undef XA_STOREV
}

DI void rope_row(bf16* prow, const float* cA, const float* sA, const float* cI, const float* sI, int lane) {
    int c1[15], hf[15]; float x1[15], x2[15], cs[15], sn[15], sc[15];
#pragma unroll
    for (int k = 0; k < 15; ++k) {
        const int pi = lane + 64 * k; int i; bool tabA; sc[k] = 1.0f;
        if (pi < 512) { i = pi & 63; c1[k] = (pi >> 6) * 128 + i; hf[k] = 64; tabA = true; sc[k] = 0.08838834764831845f; }
        else if (pi < 640) { const int pp = pi - 512; i = pp & 63; c1[k] = 1024 + (pp >> 6) * 128 + i; hf[k] = 64; tabA = true; }
        else if (pi < 896) { const int pp = pi - 640; i = pp & 31; c1[k] = 1536 + (pp >> 5) * 64 + i; hf[k] = 32; tabA = false; }
        else { i = (pi - 896) & 31; c1[k] = 2048 + i; hf[k] = 32; tabA = false; }
        cs[k] = tabA ? cA[i] : cI[i]; sn[k] = tabA ? sA[i] : sI[i];
        x1[k] = bf2f(prow[c1[k]]); x2[k] = bf2f(prow[c1[k] + hf[k]]);
    }
#pragma unroll
    for (int k = 0; k < 15; ++k) { if (lane + 64 * k < 928) { prow[c1[k]] = (bf16)f2bf((x1[k] * cs[k] - x2[k] * sn[k]) * sc[k]); prow[c1[k] + hf[k]] = (bf16)f2bf((x2[k] * cs[k] + x1[k] * sn[k]) * sc[k]); } }
}
DI unsigned wave_select(LAS unsigned* buf, int count, int lane) {
    unsigned k[16];
#pragma unroll
    for (int j = 0; j < 16; ++j) { const int idx = j * 64 + lane; k[j] = idx < count ? buf[idx] : 0u; }
    unsigned tau = 0u;
    for (int bit = 31; bit >= 0; --bit) { const unsigned cand = tau | (1u << bit); int cn = 0;
#pragma unroll
        for (int j = 0; j < 16; ++j) cn += __popcll(__ballot(k[j] >= cand));
        if (cn >= TOPK) tau = cand;
        if (cn == TOPK) break; }
    int off = 0; const unsigned long long lt = (1ull << lane) - 1ull;
#pragma unroll
    for (int j = 0; j < 16; ++j) { const bool pred = k[j] >= tau; const unsigned long long bal = __ballot(pred); if (pred) buf[off + __popcll(bal & lt)] = k[j]; off += __popcll(bal); }
    LDS_WAIT();
    return tau;
}
constexpr int IDX_KT = 131072, IDX_KT_SLOT = 64 * 144, IDX_FL = IDX_KT + 2 * IDX_KT_SLOT;
#define IDX_BODY(slot_, kb_) do { \
    bf16x8 R[4][2]; \
    _Pragma("unroll") for (int jb = 0; jb < 4; ++jb) _Pragma("unroll") for (int ks = 0; ks < 2; ++ks) R[jb][ks] = *(const LAS bf16x8*)((slot_) + (16 * jb + r16) * 144 + (ks * 32 + 8 * q4) * 2); \
    f32x4 lo_[4], hi_[4]; \
    _Pragma("unroll") for (int jb = 0; jb < 4; ++jb) { lo_[jb] = (f32x4){0.f, 0.f, 0.f, 0.f}; hi_[jb] = lo_[jb]; \
        _Pragma("unroll") for (int ks = 0; ks < 2; ++ks) { lo_[jb] = mfma16(Alo[ks], R[jb][ks], lo_[jb]); hi_[jb] = mfma16(Ahi[ks], R[jb][ks], hi_[jb]); } } \
    const int rev0_ = 8191 - r16 - 16 * (kb_); \
    _Pragma("unroll") for (int jb = 0; jb < 4; ++jb) { \
        float s0_ = 0.f, s1_ = 0.f; \
        _Pragma("unroll") for (int i = 0; i < 4; ++i) { s0_ = fmaf(__int_as_float(max(__float_as_int(lo_[jb][i]), 0)), w[i], s0_); s1_ = fmaf(__int_as_float(max(__float_as_int(hi_[jb][i]), 0)), w[4 + i], s1_); } \
        const unsigned u_ = __float_as_uint(s0_ + s1_), mono_ = u_ ^ ((unsigned)((int)u_ >> 31) | 0x80000000u); \
        const int rev_ = rev0_ - 16 * jb; const unsigned key_ = (mono_ & 0xFFFFE000u) | (unsigned)rev_; \
        const bool pred_ = (rev_ >= revq) && (key_ > tau); \
        const unsigned long long bal_ = __ballot(pred_); const unsigned grp_ = (unsigned)(bal_ >> (16 * q4)) & 0xFFFFu; \
        if (MODE == 0) { if (pred_) mybuf[cnt + __popc(grp_ & lmask)] = key_; cnt += __popc(grp_); } else { chk ^= key_ & (pred_ ? 0xffffffffu : 0x0fu); } } } while (0)
template <int MODE> DI void dsa_index_unit(const Ctx& c, int uidx, const bf16* PROJ, unsigned short* SEL, int* SELN) {
    const int pr = uidx & 255, b = pr >> 7, jj = pr & 127, qblk = uidx < 256 ? jj : 255 - jj, t0 = qblk * 32;
    LAS unsigned* CAND = (LAS unsigned*)c.lds;
    LAS unsigned char* KT = c.lds + IDX_KT; LAS unsigned* FL = (LAS unsigned*)(c.lds + IDX_FL);
    const int r16 = c.lane & 15, q4 = c.lane >> 4;
    const bf16* qrowA = PROJ + (size_t)(b * SEQ + t0 + 4 * c.wave + (r16 >> 2)) * PROJW + 1536 + 8 * q4;
    bf16x8 Alo[2], Ahi[2];
#pragma unroll
    for (int ks = 0; ks < 2; ++ks) { Alo[ks] = *(const bf16x8*)(qrowA + (r16 & 3) * 64 + ks * 32); Ahi[ks] = *(const bf16x8*)(qrowA + ((r16 & 3) + 4) * 64 + ks * 32); }
    const int tq = t0 + 4 * c.wave + q4, revq = 8191 - tq; const unsigned lmask = (1u << r16) - 1u;
    float w[8]; unpack8(*(const v4u*)(PROJ + (size_t)(b * SEQ + tq) * PROJW + 2112), w);
#pragma unroll
    for (int j = 0; j < 8; ++j) w[j] *= 0.04419417382415922f;
    int cnt = 0; unsigned tau = 0u, chk = 0u;
    LAS unsigned* mybuf = CAND + (4 * c.wave + q4) * 1024;
    const int nit = (qblk >> 1) + 1;
    const bf16* ksrc = PROJ + (size_t)(b * SEQ + (c.tid >> 3)) * PROJW + 2048 + 8 * (c.tid & 7); const int kdst = (c.tid >> 3) * 144 + (c.tid & 7) * 16;
    __syncthreads();
    v4u pre = *(const v4u*)ksrc;
    *(LAS v4u*)(KT + kdst) = pre;
    if (nit > 1) pre = *(const v4u*)(ksrc + (size_t)64 * PROJW);
    for (int it = 0; it < nit; ++it) {
        LAS unsigned char* slot = KT + (it & 1) * IDX_KT_SLOT;
        { const unsigned long long nb = __ballot(cnt > 1024 - 64); if (c.lane == 0) FL[(it & 1) * 8 + c.wave] = nb != 0ull ? 1u : 0u; }
        __syncthreads();
        { const v4u f0 = *(const LAS v4u*)(FL + (it & 1) * 8), f1 = *(const LAS v4u*)(FL + (it & 1) * 8 + 4);
          if (MODE == 0 && (f0.x | f0.y | f0.z | f0.w | f1.x | f1.y | f1.z | f1.w)) {
#pragma unroll
              for (int g4 = 0; g4 < 4; ++g4) { const int cg = __shfl(cnt, 16 * g4); if (cg > TOPK) { const unsigned tn = wave_select(CAND + (4 * c.wave + g4) * 1024, cg, c.lane); if (q4 == g4) { tau = tn; cnt = TOPK; } } } } }
        IDX_BODY(slot, 4 * it);
        if (it + 1 < nit) { *(LAS v4u*)(KT + ((it + 1) & 1) * IDX_KT_SLOT + kdst) = pre; if (it + 2 < nit) pre = *(const v4u*)(ksrc + (size_t)(64 * (it + 2)) * PROJW); }
    }
    LDS_WAIT();
    if (MODE != 0) { if (chk == 0x12345u) SELN[uidx] = (int)chk; return; }
#pragma unroll
    for (int g4 = 0; g4 < 4; ++g4) {
        int cg = __shfl(cnt, 16 * g4); LAS unsigned* bufg = CAND + (4 * c.wave + g4) * 1024;
        if (cg > TOPK) { (void)wave_select(bufg, cg, c.lane); cg = TOPK; }
        const size_t qg = (size_t)(b * SEQ + t0 + 4 * c.wave + g4);
#pragma unroll
        for (int i = 0; i < 4; ++i) { const int slot = c.lane + 64 * i; if (slot < cg) SEL[qg * 256 + slot] = (unsigned short)(8191u - (bufg[slot] & 0x1FFFu)); }
        if (c.lane == 0) SELN[qg] = cg;
    }
    LDS_WAIT();
}
#define SB() __builtin_amdgcn_sched_barrier(0)
DI f32x4 mfma8(const v2u a, const v2u b, const f32x4 c) { return __builtin_amdgcn_mfma_f32_16x16x32_fp8_fp8(__builtin_bit_cast(long, a), __builtin_bit_cast(long, b), c, 0, 0, 0); }
#define DSA_QS 32.0f
#define DSA_RDW(pb_, tv_) asm volatile("s_waitcnt lgkmcnt(0)" : "+v"(pb_), "+v"(tv_[0]), "+v"(tv_[1]), "+v"(tv_[2]), "+v"(tv_[3]), "+v"(tv_[4]), "+v"(tv_[5]), "+v"(tv_[6]), "+v"(tv_[7]) : : "memory")
#define DSA_VWAIT(n) asm volatile("s_waitcnt vmcnt(" #n ")" ::: "memory")
#define DSA3_WS 17152
#define DSA3_KLD(dst_, off_, imm_, kb_) asm volatile("global_load_dwordx4 %0, %1, %2 offset:" #imm_ : "=&v"(dst_) : "v"(off_), "s"(kb_) : "memory")
#define DSA3_LOADK(dst, blk) do { const unsigned koff_ = kix[blk] * 128u + kofs; DSA3_KLD(dst[0][0], koff_, 0, k8g0); DSA3_KLD(dst[0][1], koff_, 64, k8g0); DSA3_KLD(dst[1][0], koff_, 0, k8g1); DSA3_KLD(dst[1][1], koff_, 64, k8g1); } while (0)
#define DSA3_KWAIT(n, dst) asm volatile("s_waitcnt vmcnt(" #n ")" : "+v"(dst[0][0]), "+v"(dst[0][1]), "+v"(dst[1][0]), "+v"(dst[1][1]) : : "memory")
#define DSA3_KPERM(dst) do { _Pragma("unroll") for (int kvi = 0; kvi < 2; ++kvi) _Pragma("unroll") for (int hf = 0; hf < 2; ++hf) { v4u w_ = dst[kvi][hf]; \
    w_.x = (unsigned)__builtin_amdgcn_ds_bpermute(kperm, (int)w_.x); w_.y = (unsigned)__builtin_amdgcn_ds_bpermute(kperm, (int)w_.y); w_.z = (unsigned)__builtin_amdgcn_ds_bpermute(kperm, (int)w_.z); w_.w = (unsigned)__builtin_amdgcn_ds_bpermute(kperm, (int)w_.w); \
    dst[kvi][hf] = w_; } } while (0)
#define DSA3_QK(blk, src) do { f32x4 a0_ = {0.f, 0.f, 0.f, 0.f}, a1_ = {0.f, 0.f, 0.f, 0.f}; \
    _Pragma("unroll") for (int ks = 0; ks < 4; ++ks) { const v4u w0_ = src[0][ks >> 1], w1_ = src[1][ks >> 1]; v2u p0_, p1_; p0_.x = (ks & 1) ? w0_.z : w0_.x; p0_.y = (ks & 1) ? w0_.w : w0_.y; p1_.x = (ks & 1) ? w1_.z : w1_.x; p1_.y = (ks & 1) ? w1_.w : w1_.y; \
        a0_ = mfma8(p0_, q2[0][ks], a0_); a1_ = mfma8(p1_, q2[1][ks], a1_); } acc[blk] = a0_ + a1_; } while (0)
#define DSA3_DMAV(u_) do { _Pragma("unroll") for (int j = 0; j < 4; ++j) \
    __builtin_amdgcn_global_load_lds((const unsigned*)((((u_) & 1) ? v8b1 : v8b0) + vix[(u_) >> 1][j] * 128u + ((j & 1) ? vsw1 : vsw0)), (LAS unsigned*)(Vb + ((u_) % 3) * 4096 + j * 1024), 16, 0, 0); } while (0)
#define DSA3_RD(pb_, tv_, soff_, poff_) asm volatile( \
    "ds_read_b64 %0, %9 offset:%19\n\tds_read_b64_tr_b8 %1, %10 offset:%18\n\tds_read_b64_tr_b8 %2, %11 offset:%18\n\tds_read_b64_tr_b8 %3, %12 offset:%18\n\tds_read_b64_tr_b8 %4, %13 offset:%18\n\t" \
    "ds_read_b64_tr_b8 %5, %14 offset:%18\n\tds_read_b64_tr_b8 %6, %15 offset:%18\n\tds_read_b64_tr_b8 %7, %16 offset:%18\n\tds_read_b64_tr_b8 %8, %17 offset:%18" \
    : "=&v"(pb_), "=&v"(tv_[0]), "=&v"(tv_[1]), "=&v"(tv_[2]), "=&v"(tv_[3]), "=&v"(tv_[4]), "=&v"(tv_[5]), "=&v"(tv_[6]), "=&v"(tv_[7]) \
    : "v"(prdA), "v"(va[0]), "v"(va[1]), "v"(va[2]), "v"(va[3]), "v"(va[4]), "v"(va[5]), "v"(va[6]), "v"(va[7]), "i"(soff_), "i"(poff_) : "memory")
#define DSA3_PV(u_) do { v2u pA_, tA_[8]; DSA3_RD(pA_, tA_, ((u_) % 3) * 4096, 32 * ((u_) >> 1)); DSA_RDW(pA_, tA_); \
    v2u pm_; pm_.x = (((u_) & 1) == mykv) ? pA_.x : 0u; pm_.y = (((u_) & 1) == mykv) ? pA_.y : 0u; \
    _Pragma("unroll") for (int nt = 0; nt < 8; ++nt) o[nt] = mfma8(tA_[nt], pm_, o[nt]); } while (0)
template <int MODE> DI void dsa_attn_item(const Ctx& c, int qg, const bf16* PROJ, const unsigned char* K8, const unsigned char* V8, const unsigned short* SEL, const int* SELN, bf16* AO) {
    typedef const __attribute__((address_space(1))) char* gcp;
    LAS unsigned char* Vb = c.lds + c.wave * DSA3_WS; LAS unsigned char* Pb = Vb + 12288; LAS unsigned short* IDXw = (LAS unsigned short*)(Vb + 12288 + 4352);
    int ln = c.lane; asm volatile("" : "+v"(ln));
    const int b = qg >> 13, n = __builtin_amdgcn_readfirstlane(SELN[qg]); const int r16 = ln & 15, q4 = ln >> 4;
    { unsigned short sv[4];
#pragma unroll
      for (int i = 0; i < 4; ++i) sv[i] = SEL[(size_t)qg * 256 + ln + 64 * i];
#pragma unroll
      for (int i = 0; i < 4; ++i) { const int slot = ln + 64 * i; IDXw[slot] = slot < n ? sv[i] : (unsigned short)0; } }
    v2u q2[2][4];
#pragma unroll
    for (int ks = 0; ks < 4; ++ks) { const v4u w = *(const v4u*)(PROJ + (size_t)qg * PROJW + (r16 & 7) * 128 + 64 * (ks >> 1) + 16 * q4 + 8 * (ks & 1));
        v2u v_; v_.x = (r16 & 8) ? w.z : w.x; v_.y = (r16 & 8) ? w.w : w.y; const bool k0_ = (r16 & 4) == 0;
        q2[0][ks].x = k0_ ? v_.x : 0u; q2[0][ks].y = k0_ ? v_.y : 0u; q2[1][ks].x = k0_ ? 0u : v_.x; q2[1][ks].y = k0_ ? 0u : v_.y; }
    LDS_WAIT();
    unsigned kix[16], vix[8][4];
#pragma unroll
    for (int blk = 0; blk < 16; ++blk) kix[blk] = IDXw[16 * blk + (ln >> 2)];
#pragma unroll
    for (int cc = 0; cc < 8; ++cc)
#pragma unroll
        for (int j = 0; j < 4; ++j) vix[cc][j] = IDXw[32 * cc + 8 * j + (ln >> 3)];
    LDS_WAIT(); SB();
    const size_t pl0 = (size_t)(b * 2) * SEQ * 128, pl1 = pl0 + (size_t)SEQ * 128;
    const gcp k8g0 = (gcp)((const char*)K8 + pl0), k8g1 = (gcp)((const char*)K8 + pl1); const char* v8b0 = (const char*)V8 + pl0; const char* v8b1 = (const char*)V8 + pl1;
    const unsigned kofs = (unsigned)(16 * (ln & 3)); const int kperm = 4 * (4 * r16 + q4);
    const unsigned vsw0 = 16u * (unsigned)((ln & 7) ^ (ln >> 4)), vsw1 = 16u * (unsigned)((ln & 7) ^ ((ln >> 4) | 4));
    DSA3_DMAV(0); SB(); DSA3_DMAV(1); SB(); DSA3_DMAV(2); SB();
    f32x4 acc[16]; v4u kA[2][2], kB[2][2], kC[2][2];
    DSA3_LOADK(kA, 0); DSA3_LOADK(kB, 1); DSA3_LOADK(kC, 2); SB();
#define DSA3_STEP(blk, kk, w_) do { DSA3_KWAIT(w_, kk); SB(); DSA3_KPERM(kk); DSA3_QK(blk, kk); SB(); if ((blk) + 3 < 16) { DSA3_LOADK(kk, (blk) + 3); SB(); } } while (0)
    DSA3_STEP(0, kA, 8); DSA3_STEP(1, kB, 8); DSA3_STEP(2, kC, 8); DSA3_STEP(3, kA, 8); DSA3_STEP(4, kB, 8); DSA3_STEP(5, kC, 8); DSA3_STEP(6, kA, 8); DSA3_STEP(7, kB, 8);
    DSA3_STEP(8, kC, 8); DSA3_STEP(9, kA, 8); DSA3_STEP(10, kB, 8); DSA3_STEP(11, kC, 8); DSA3_STEP(12, kA, 8); DSA3_STEP(13, kB, 8); DSA3_STEP(14, kC, 4); DSA3_STEP(15, kA, 0);
    float m = -3.0e38f; const int nq = n - 4 * q4; const float cexp = 1.4426950408889634f / DSA_QS;
#pragma unroll
    for (int kb = 0; kb < 16; ++kb)
#pragma unroll
        for (int i = 0; i < 4; ++i) { const bool ok = (16 * kb + i) < nq; const float s_ = acc[kb][i] + __int_as_float(__builtin_amdgcn_update_dpp(0, __float_as_int(acc[kb][i]), 0x128, 0xf, 0xf, false));
            acc[kb][i] = ok ? s_ : -3.0e38f; m = fmaxf(m, acc[kb][i]); }
    m = fmaxf(m, __shfl_xor(m, 16)); m = fmaxf(m, __shfl_xor(m, 32));
    float l = 0.f; const float mc = 8.0f - m * cexp;
#pragma unroll
    for (int kb = 0; kb < 16; ++kb)
#pragma unroll
        for (int i = 0; i < 4; ++i) { const float p = __builtin_amdgcn_exp2f(fmaf(acc[kb][i], cexp, mc)); acc[kb][i] = p; l += p; }
    l += __shfl_xor(l, 16); l += __shfl_xor(l, 32);
    const float oscale = 1.0f / l;
    if (r16 < 8) {
        LAS unsigned char* pwl = Pb + 272 * r16 + 4 * q4; asm volatile("" : "+v"(pwl));
#pragma unroll
        for (int kb = 0; kb < 16; ++kb) {
            const float p0 = acc[kb][0], p1 = acc[kb][1], p2 = acc[kb][2], p3 = acc[kb][3];
            int wh = 0; wh = __builtin_amdgcn_cvt_pk_fp8_f32(p0, p1, wh, false); wh = __builtin_amdgcn_cvt_pk_fp8_f32(p2, p3, wh, true);
            const f32x2 d0 = __builtin_amdgcn_cvt_pk_f32_fp8(wh, false), d1 = __builtin_amdgcn_cvt_pk_f32_fp8(wh, true);
            int wl = 0; wl = __builtin_amdgcn_cvt_pk_fp8_f32(p0 - d0.x, p1 - d0.y, wl, false); wl = __builtin_amdgcn_cvt_pk_fp8_f32(p2 - d1.x, p3 - d1.y, wl, true);
            *(LAS int*)(pwl + 16 * kb) = wh; *(LAS int*)(pwl + 2176 + 16 * kb) = wl; }
    }
    unsigned va[8];
    { const unsigned q_ = (unsigned)(r16 >> 1), rel = 128u * (8u * (unsigned)q4 + q_) + 8u * (unsigned)(ln & 1) + 16u * ((((unsigned)q4 & 1u) << 2) | (q_ >> 1)); const unsigned vb_ = (unsigned)(size_t)Vb;
#pragma unroll
      for (int nt = 0; nt < 8; ++nt) va[nt] = vb_ + (rel ^ (16u * (unsigned)nt)); }
    const unsigned prdA = (unsigned)(size_t)(Pb + 2176 * (r16 >> 3) + 272 * (r16 & 7) + 8 * q4); const int mykv = (r16 >> 2) & 1;
    f32x4 o[8];
#pragma unroll
    for (int nt = 0; nt < 8; ++nt) o[nt] = (f32x4){0.f, 0.f, 0.f, 0.f};
    LDS_WAIT(); SB();
#pragma unroll
    for (int u = 0; u < 16; ++u) {
        if (u < 14) DSA_VWAIT(8); else if (u == 14) DSA_VWAIT(4); else DSA_VWAIT(0);
        SB(); DSA3_PV(u); SB();
        if (u + 3 < 16) { LDS_WAIT(); SB(); DSA3_DMAV(u + 3); SB(); }
    }
#pragma unroll
    for (int nt = 0; nt < 8; ++nt)
#pragma unroll
        for (int i = 0; i < 4; ++i) o[nt][i] += __int_as_float(__builtin_amdgcn_update_dpp(0, __float_as_int(o[nt][i]), 0x128, 0xf, 0xf, false));
    if (r16 < 8) {
        bf16* op = AO + (size_t)qg * 1024 + r16 * 128 + 4 * q4;
#pragma unroll
        for (int nt = 0; nt < 8; ++nt) { v2u w; w.x = pk2(o[nt][0] * oscale, o[nt][1] * oscale); w.y = pk2(o[nt][2] * oscale, o[nt][3] * oscale); *(v2u*)(op + 16 * nt) = w; }
    }
    LDS_WAIT();
}
template <int MODE> DI void dsa_attn_phase(const Ctx& c, const bf16* PROJ, const unsigned char* K8, const unsigned char* V8, const unsigned short* SEL, const int* SELN, bf16* AO) {
    if ((c.G & 7) == 0) { const int per = c.G >> 3, xcd = c.vcu / per, bsel = xcd & 1, rank = (xcd >> 1) * per + (c.vcu - xcd * per);
        for (int x = rank * 8 + c.wave; x < SEQ; x += (c.G >> 1) * 8) dsa_attn_item<MODE>(c, bsel * SEQ + x, PROJ, K8, V8, SEL, SELN, AO); }
    else { for (int x = c.vcu * 8 + c.wave; x < MTOK; x += c.G * 8) dsa_attn_item<MODE>(c, x, PROJ, K8, V8, SEL, SELN, AO); }
}

#ifndef SKIPM
#define SKIPM 0
#endif
#ifndef PROBE_IDX_MODE
#define PROBE_IDX_MODE 0
#endif
#ifndef PROBE_ATTN_MODE
#define PROBE_ATTN_MODE 0
#endif
#ifndef PROBE_MASK
#define PROBE_MASK 0u
#endif
struct Args { const float* in[36]; float* out; unsigned char* ws; int ph_lo, ph_hi, li, pad; };
enum { I_X = 0, I_MEM, I_POS, I_F1N, I_F1G, I_F1U, I_F1D, I_MIXN, I_EVIN, I_EVOUT, I_GLAWA, I_GLABA, I_GLAN, I_S5LR, I_S5LI, I_S5DT, I_S5BR, I_S5BI, I_S5CR, I_S5CI, I_S5D, I_S5WG, I_S5BG,
       I_ODIN, I_ODOUT, I_XAN, I_MEMNORM, I_XAWQ, I_XAWK, I_XAWV, I_XAWO, I_F2N, I_F2G, I_F2U, I_F2D, I_FINN };

#define GEMM_CALL(EPI, A_, Bt_, M_, N_, K_, E_) do { const pg8::Gemm g_{(const pg8::bf16_t*)(A_), (const pg8::bf16_t*)(Bt_), (M_), (N_), (K_)}; typedef pg8::TileOrder<(M_) / 256, (N_) / 256> Ord_; Ord_ S_; S_.G = c.G; S_.c = (int)blockIdx.x; \
    pg8::gemm_phase<EPI, Ord_, true, true>(c.lds, g_, S_, (E_), MYTID()); } while (0)

#define RSL_PTR() ((const PG8_LAS float*)(c.lds + RING_BYTES))
#define GEMM_CALL_RS(EPI, A_, Bt_, M_, N_, K_, E_) do { const pg8::Gemm g_{(const pg8::bf16_t*)(A_), (const pg8::bf16_t*)(Bt_), (M_), (N_), (K_)}; typedef pg8::TileOrder<(M_) / 256, (N_) / 256> Ord_; Ord_ S_; S_.G = c.G; S_.c = (int)blockIdx.x; \
    { const int t_ = MYTID(); LAS float* rsl_ = (LAS float*)(c.lds + RING_BYTES); \
      for (int i0_ = 0; ; i0_ += 2) { pg8::Unit u0_; if (!S_.next(i0_, u0_)) break; pg8::Unit u_; const int i_ = i0_ + (t_ >> 8); \
          if (S_.next(i_, u_)) { const f32x4* sp_ = (const f32x4*)(SS + (size_t)(u_.pm * 256 + (t_ & 255)) * 16); const f32x4 a0_ = sp_[0], a1_ = sp_[1], a2_ = sp_[2], a3_ = sp_[3]; \
              const f32x4 q_ = (a0_ + a1_) + (a2_ + a3_); rsl_[i_ * 256 + (t_ & 255)] = rsqrtf(((q_[0] + q_[1]) + (q_[2] + q_[3])) * (1.0f / 1024.0f) + EPS); } } \
      __syncthreads(); } \
    pg8::gemm_phase<EPI, Ord_, true, true>(c.lds, g_, S_, (E_), MYTID()); } while (0)

#define MK_GAS __attribute__((address_space(1)))
DI unsigned char* launder_ptr(unsigned char* p) { MK_GAS unsigned char* g = (MK_GAS unsigned char*)p; asm volatile("" : "+s"(g)); return (unsigned char*)g; }
DI const float* gin_(const float* p) { MK_GAS const float* g = (MK_GAS const float*)p; asm volatile("" : "+s"(g)); return (const float*)g; }
DI float* gout_(float* p) { MK_GAS float* g = (MK_GAS float*)p; asm volatile("" : "+s"(g)); return (float*)g; }
#define AIN(k) gin_(a.in[launder_idx(k)])
DI int launder_idx(int i) { asm volatile("" : "+s"(i)); return i; }
#define DECL_PTRS() float* H = (float*)(ws + WS_H); bf16* HB = (bf16*)(ws + WS_HB); float* SS = (float*)(ws + WS_SS); \
    float* COSA = (float*)(ws + WS_COSA); float* SINA = (float*)(ws + WS_SINA); float* COSI = (float*)(ws + WS_COSI); float* SINI = (float*)(ws + WS_SINI); \
    bf16* MEMN = (bf16*)(ws + WS_MEMN); bf16* MK = (bf16*)(ws + WS_MK); bf16* MVT = (bf16*)(ws + WS_MVT); float* S5P = (float*)(ws + WS_S5P); \
    unsigned char* scr = ws + WS_SCR; \
    bf16* HID = (bf16*)(scr + SC_HID); bf16* PROJ = (bf16*)(scr + SC_PROJ); bf16* XQ = (bf16*)(scr + SC_XQ); bf16* XO = (bf16*)(scr + SC_XO); bf16* KVW = (bf16*)(scr + SC_KVW); \
    float* DS = (float*)(scr + SC_DS); float* BCg = (float*)(scr + SC_BC); float* DEC = (float*)(scr + SC_DEC); float* S5E = (float*)(scr + SC_S5E); \
    bf16* Y = (bf16*)(scr + SC_Y); bf16* CAT = (bf16*)(scr + SC_CAT); unsigned short* SEL = (unsigned short*)(scr + SC_SEL); int* SELN = (int*)(scr + SC_SELN); \
    unsigned char* W = ws + WS_W; \
    bf16* Wgu1 = (bf16*)(W + WO_GU1); bf16* Wd1 = (bf16*)(W + WO_D1); bf16* Win = (bf16*)(W + WO_IN); bf16* Wout = (bf16*)(W + WO_OUT); bf16* Wglu = (bf16*)(W + WO_GLU); \
    bf16* Wxq = (bf16*)(W + WO_XQ); bf16* Wxo = (bf16*)(W + WO_XO); bf16* Wgu2 = (bf16*)(W + WO_GU2); bf16* Wd2 = (bf16*)(W + WO_D2);
#define CVT_LAYER_BODY() do { const size_t fo = (size_t)l * DM * DFF; cvt_job_gu(c, AIN(I_F1G) + fo, AIN(I_F1U) + fo, AIN(I_F1N) + l * DM, Wgu1, 0); cvt_job(c, AIN(I_F1D) + fo, DM, 0, DM, nullptr, Wd1, DFF, DM, 0, 512); if (even) { const float* win = AIN(I_EVIN) + (size_t)e * DM * EV_IN; const float* gn = AIN(I_MIXN) + l * DM; cvt_job(c, win, EV_IN, 0, 1536, gn, Win, DM, 1536, 0, 1024); cvt_job_comb(c, win, AIN(I_GLAWA) + e * 16 * 256, gn, Win, 1536, 1536); cvt_job(c, win, EV_IN, 1552, 512, gn, Win, DM, 512, 1792, 1664); cvt_job(c, AIN(I_EVOUT) + (size_t)e * DM * DM, DM, 0, DM, nullptr, Wout, DM, DM, 0, 256); cvt_job(c, AIN(I_S5WG) + (size_t)e * 512 * 512, 512, 0, 512, nullptr, Wglu, 512, 512, 0, 1920); } else { cvt_job_rope(c, AIN(I_ODIN) + (size_t)e * DM * OD_IN, AIN(I_MIXN) + l * DM, Win, 1024); cvt_job(c, AIN(I_ODOUT) + (size_t)e * DM * DM, DM, 0, DM, nullptr, Wout, DM, DM, 0, 256); } cvt_job(c, AIN(I_XAWQ) + (size_t)l * DM * DM, DM, 0, DM, AIN(I_XAN) + l * DM, Wxq, DM, DM, 0, 768); cvt_job(c, AIN(I_XAWO) + (size_t)l * DM * DM, DM, 0, DM, nullptr, Wxo, DM, DM, 0, 1280); cvt_job_gu(c, AIN(I_F2G) + fo, AIN(I_F2U) + fo, AIN(I_F2N) + l * DM, Wgu2, 1024); cvt_job(c, AIN(I_F2D) + fo, DM, 0, DM, nullptr, Wd2, DFF, DM, 0, 1536); } while (0)
__global__ void __launch_bounds__(512, 2) mk_fwd(Args a) {
    extern __shared__ __attribute__((aligned(16))) unsigned char lds_raw[];
    Ctx c; c.lds = (LAS unsigned char*)lds_raw;
    c.tid = threadIdx.x; c.lane = c.tid & 63; c.wave = __builtin_amdgcn_readfirstlane(c.tid >> 6);
    const unsigned wave_s = (unsigned)c.wave;
    c.G = gridDim.x; { const int bx = blockIdx.x; c.vcu = (c.G % 8 == 0) ? (bx % 8) * (c.G / 8) + bx / 8 : bx; }
    for (int u = c.tid; u < (LDS_BYTES - LDSCTL_OFF) / 4; u += 512) ((LAS unsigned*)(c.lds + LDSCTL_OFF))[u] = 0u;
    __syncthreads();
    unsigned char* ws0 = a.ws;
    const int lo = a.ph_lo, hi = a.ph_hi;
    XcdBarrier bar; bar.bar = (unsigned*)(ws0 + WS_CTL) + CW_BAR + a.li * XCD_BAR_WORDS; bar.x = 0; bar.st = (volatile LAS unsigned*)(c.lds + LDSCTL_OFF);
    if (hi - lo > 1) bar = xcd_barrier_post(bar.bar, (volatile LAS unsigned*)(c.lds + LDSCTL_OFF));
#define IN(k) (launder_idx(lo) <= (k) && (k) < launder_idx(hi))
#define MYTID() ((int)(wave_s * 64u + __builtin_amdgcn_mbcnt_hi(~0u, __builtin_amdgcn_mbcnt_lo(~0u, 0u))))
#define FRESH() do { int t_ = MYTID(); asm volatile("" : "+v"(t_)); c.tid = t_; c.lane = t_ & 63; c.wave = (int)wave_s; } while (0)
#define SEAM(k) do { if (IN(k) && IN((k) + 1)) xcd_barrier(bar); } while (0)
    const int NGW = c.G * 8, gw = c.vcu * 8 + c.wave;

#define PHASE(k, q, ...) do { if (IN(k)) { { const bool dup_ = false; (void)dup_; unsigned char* ws = launder_ptr(a.ws); DECL_PTRS(); __VA_ARGS__ } if ((PROBE_MASK >> (q)) & 1u) { xcd_barrier(bar); { const bool dup_ = true; (void)dup_; unsigned char* ws = launder_ptr(a.ws); DECL_PTRS(); __VA_ARGS__ } } } SEAM(k); } while (0)
    PHASE(0, 30, {
        FRESH();
        const int* pos = (const int*)AIN(I_POS);
        for (int e = c.vcu * 512 + c.tid; e < MTOK * 96; e += c.G * 512) {
            if (e < MTOK * 64) { const int tok = e >> 6, i = e & 63; const float inv = powf(10000.0f, -(float)(2 * i) / 128.0f), ang = (float)pos[tok] * inv; COSA[e] = cosf(ang); SINA[e] = sinf(ang); }
            else { const int e2 = e - MTOK * 64, tok = e2 >> 5, i = e2 & 31; const float inv = powf(10000.0f, -(float)(2 * i) / 64.0f), ang = (float)pos[tok] * inv; COSI[e2] = cosf(ang); SINI[e2] = sinf(ang); }
        }
        for (int m = gw; m < MTOK; m += NGW) row_init(AIN(I_X) + (size_t)m * DM, HB + (size_t)m * DM, SS + (size_t)m * 16, c.lane);
        for (int m = gw; m < NB * NMEM; m += NGW) row_norm_bf16(AIN(I_MEM) + (size_t)m * DM, AIN(I_MEMNORM), MEMN + (size_t)m * DM, c.lane);
        for (int l = 0; l < DEPTH; ++l) {
            cvt_job(c, AIN(I_XAWK) + (size_t)l * DM * DM, DM, 0, DM, nullptr, KVW, DM, DM, l * DM, l * 256);
            cvt_job(c, AIN(I_XAWV) + (size_t)l * DM * DM, DM, 0, DM, nullptr, KVW + (size_t)4096 * DM, DM, DM, l * DM, l * 256 + 128);
        }
        s5_params(c, AIN(I_S5LR), AIN(I_S5LI), AIN(I_S5DT), AIN(I_S5BR), AIN(I_S5BI), S5P);
        { const int l = 0, e = 0; const bool even = true; CVT_LAYER_BODY(); }
    });
#pragma clang loop unroll(full)
    for (int l = 0; l < DEPTH; ++l) {
        const int pb = PH_LAYER0 + l * PH_PER_LAYER, e = l >> 1; const bool even = (l & 1) == 0;
        if (l > 0) PHASE(pb + 0, 0, { FRESH(); CVT_LAYER_BODY(); });
#define MEMKV_TAIL() if (l == 0) { const int bx_ = (int)blockIdx.x - ((MTOK / 256) * (2 * DFF / 256) - 5 * c.G);     \
            { const pg8::Gemm g{(const pg8::bf16_t*)MEMN, (const pg8::bf16_t*)KVW, 512, 4096, 1024}; typedef pg8::TileOrder<2, 16> Ord; Ord S; S.G = c.G; S.c = (c.G == 256) ? bx_ : (int)blockIdx.x; \
              const pg8::EpiScaleBf16<false> E2{(pg8::bf16_t*)MK, 4096, nullptr, 1.0f}; pg8::gemm_phase<pg8::EpiScaleBf16<false>, Ord, true, true>(c.lds, g, S, E2, MYTID()); } \
            { const pg8::Gemm g{(const pg8::bf16_t*)(KVW + (size_t)4096 * DM), (const pg8::bf16_t*)MEMN, 4096, 512, 1024}; typedef pg8::TileOrder<16, 2> Ord; Ord S; S.G = c.G; S.c = ((c.G == 256) ? bx_ : (int)blockIdx.x) - 32; \
              const pg8::EpiScaleBf16<false> E2{(pg8::bf16_t*)MVT, 512, nullptr, 1.0f}; pg8::gemm_phase<pg8::EpiScaleBf16<false>, Ord, true, true>(c.lds, g, S, E2, MYTID()); } }
        PHASE(pb + 1, 1, { const pg8::EpiSwiGLU E{(pg8::bf16_t*)HID, DFF, RSL_PTR()}; GEMM_CALL_RS(pg8::EpiSwiGLU, HB, Wgu1, MTOK, 2 * DFF, DM, E); MEMKV_TAIL(); });
        PHASE(pb + 2, 2, { const pg8::EpiResid E{(pg8::bf16_t*)HB, SS, dup_ ? 0.f : 0.5f}; GEMM_CALL(pg8::EpiResid, HID, Wd1, MTOK, DM, DFF, E); });
        if (even) PHASE(pb + 3, 3, { const pg8::EpiScaleBf16<true> E{(pg8::bf16_t*)PROJ, PROJW, RSL_PTR(), 1.0f}; GEMM_CALL_RS(pg8::EpiScaleBf16<true>, HB, Win, MTOK, PROJW, DM, E); });
        else PHASE(pb + 3, 3, { const pg8::EpiRope E{(pg8::bf16_t*)PROJ, RSL_PTR(), COSA, SINA, COSI, SINI, scr + SC_K8, scr + SC_V8}; GEMM_CALL_RS(pg8::EpiRope, HB, Win, MTOK, PROJW, DM, E); });
        if (even) {
            PHASE(pb + 4, 4, {
                FRESH();
                for (int u = c.vcu; u < 1024; u += c.G) gla1_unit(c, u, PROJ, AIN(I_GLABA) + e * 256, DS, BCg, DEC);
                s5_phase1(c, e, PROJ, S5P, S5E);
            });
            PHASE(pb + 5, 29, { FRESH(); gla2_scan(c, DS, DEC); s5_phase2(c, e, S5P, S5E); });
            PHASE(pb + 6, 6, {
                FRESH();
                for (int u = c.vcu; u < 1024; u += c.G) gla3_unit(c, u, PROJ, BCg, DS, AIN(I_GLAN) + e * 128, CAT);
                s5_phase3(c, e, PROJ, S5P, S5E, AIN(I_S5CR), AIN(I_S5CI), AIN(I_S5D), Y);
            });
            PHASE(pb + 7, 7, { const pg8::EpiGLU E{(const pg8::bf16_t*)Y, AIN(I_S5BG) + e * 512, (pg8::bf16_t*)CAT}; GEMM_CALL(pg8::EpiGLU, Y, Wglu, MTOK, 512, 512, E); });
        } else {
            PHASE(pb + 5, 15, { FRESH(); if (!dup_) { for (int u = c.vcu; u < 512; u += c.G) dsa_index_unit<0>(c, u, PROJ, SEL, SELN); } else { for (int u = c.vcu; u < 512; u += c.G) dsa_index_unit<PROBE_IDX_MODE>(c, u, PROJ, (unsigned short*)(scr + 81 * MiB), (int*)(scr + 90 * MiB)); } });
            PHASE(pb + 6, 16, { FRESH(); if (!dup_) dsa_attn_phase<0>(c, PROJ, scr + SC_K8, scr + SC_V8, SEL, SELN, CAT); else dsa_attn_phase<PROBE_ATTN_MODE>(c, PROJ, scr + SC_K8, scr + SC_V8, SEL, SELN, (bf16*)(scr + 100 * MiB)); });
        }
        PHASE(pb + 8, 8, { const pg8::EpiResid E{(pg8::bf16_t*)HB, SS, dup_ ? 0.f : 1.0f}; GEMM_CALL(pg8::EpiResid, CAT, Wout, MTOK, DM, DM, E); });
        PHASE(pb + 9, 9, { const pg8::EpiScaleBf16<true> E{(pg8::bf16_t*)XQ, DM, RSL_PTR(), 0.0625f}; GEMM_CALL_RS(pg8::EpiScaleBf16<true>, HB, Wxq, MTOK, DM, DM, E); });
        PHASE(pb + 10, 10, { FRESH(); for (int u = c.vcu; u < 256; u += c.G) xattn_unit(c, u, l, XQ, MK, MVT, XO); });
        PHASE(pb + 11, 11, { const pg8::EpiResid E{(pg8::bf16_t*)HB, SS, dup_ ? 0.f : 1.0f}; GEMM_CALL(pg8::EpiResid, XO, Wxo, MTOK, DM, DM, E); });
        PHASE(pb + 12, 12, { const pg8::EpiSwiGLU E{(pg8::bf16_t*)HID, DFF, RSL_PTR()}; GEMM_CALL_RS(pg8::EpiSwiGLU, HB, Wgu2, MTOK, 2 * DFF, DM, E); });
        PHASE(pb + 13, 13, { const pg8::EpiResid E{(pg8::bf16_t*)HB, SS, dup_ ? 0.f : 0.5f}; GEMM_CALL(pg8::EpiResid, HID, Wd2, MTOK, DM, DFF, E); });
    }
    if (IN(PH_FINAL)) { FRESH(); unsigned char* ws = launder_ptr(a.ws); DECL_PTRS(); for (int m = gw; m < MTOK; m += NGW) row_final(HB + (size_t)m * DM, SS + (size_t)m * 16, AIN(I_FINN), gout_(a.out) + (size_t)m * DM, c.lane); }
#undef PHASE
#undef IN
#undef SEAM
}

#ifndef MK_ONE_LAUNCH
#define MK_ONE_LAUNCH 1
#endif
extern "C" void kernel_launch(void* const* d_in, const int* in_sizes, int n_in, void* d_out, int out_size, void* d_ws, size_t ws_size, hipStream_t stream) {
    static int grid = 0;
    if (grid == 0) {
        if (n_in != 36 || out_size != MTOK * DM || ws_size < WS_END) { fprintf(stderr, "kernel_launch: unexpected shapes (n_in %d out %d ws %zu)\n", n_in, out_size, ws_size); grid = -1; return; }
        int dev = 0, cus = 0, per_cu = 0;
        if (hipGetDevice(&dev) != hipSuccess || hipDeviceGetAttribute(&cus, hipDeviceAttributeMultiprocessorCount, dev) != hipSuccess) { grid = -1; return; }
        if (hipFuncSetAttribute((const void*)mk_fwd, hipFuncAttributeMaxDynamicSharedMemorySize, LDS_BYTES) != hipSuccess) { fprintf(stderr, "kernel_launch: hipFuncSetAttribute failed\n"); grid = -1; return; }
        if (hipOccupancyMaxActiveBlocksPerMultiprocessor(&per_cu, (const void*)mk_fwd, 512, LDS_BYTES) != hipSuccess || per_cu < 1) fprintf(stderr, "kernel_launch: occupancy query reports %d\n", per_cu);
        (void)hipGetLastError();
        grid = cus;
    }
    if (grid < 0) return;
    (void)hipMemsetAsync((char*)d_ws + WS_CTL, 0, CTL_ZERO_BYTES, stream);
    Args a{};
    for (int i = 0; i < 36; ++i) a.in[i] = (const float*)d_in[i];
    a.out = (float*)d_out; a.ws = (unsigned char*)d_ws; a.pad = 0;
#if MK_ONE_LAUNCH
    a.ph_lo = 0; a.ph_hi = N_PHASES; a.li = 0;
    hipLaunchKernelGGL(mk_fwd, dim3(grid), dim3(512), LDS_BYTES, stream, a);
#else
    for (int p = 0; p < N_PHASES; ++p) {
        if (p >= PH_LAYER0 && p < PH_FINAL) { const int l = (p - PH_LAYER0) / PH_PER_LAYER, q = (p - PH_LAYER0) % PH_PER_LAYER; if ((l & 1) && q == 7) continue; }
        a.ph_lo = p; a.ph_hi = p + 1; a.li = 0;
        hipLaunchKernelGGL(mk_fwd, dim3(grid), dim3(512), LDS_BYTES, stream, a);
    }
#endif
}
```

```cpp
#include <hip/hip_runtime.h>
#include <cstdio>
#include <cstdint>
namespace pg8 {
#define PG8_LAS __attribute__((address_space(3)))
typedef unsigned short bf16_t;
typedef short bf16x8 __attribute__((ext_vector_type(8)));
typedef float f32x4 __attribute__((ext_vector_type(4)));
typedef unsigned u32x4 __attribute__((ext_vector_type(4)));
constexpr int BM = 256, BK = 64, HALF = 128, HTB = HALF * BK * 2  , STAGE_BYTES = 8 * HTB, NXCD = 8, WGM = 8;

__host__ __device__ __forceinline__ int lds_byte(int r, int c) { const int st = (r >> 4) * 2 + (c >> 5), rr = r & 15, cc = c & 31, ob = rr * 64 + cc * 2; return st * 1024 + (ob ^ (((ob >> 9) & 1) << 5)); }
__host__ __device__ __forceinline__ void stage_rc(int b, int& R, int& C) { const int st = b / 1024, sb = b % 1024, swz = sb ^ (((sb >> 9) & 1) << 5); R = (st >> 1) * 16 + swz / 64; C = (st & 1) * 32 + (swz % 64) / 2; }
__host__ __device__ __forceinline__ int perm32(int rho) { const int n = rho >> 4, i = rho & 15; return 8 * (i >> 2) + 4 * n + (i & 3); }

struct Unit { int pm, pn, ui; };
struct Gemm { const bf16_t* A; const bf16_t* Bt; int M, N, K; };

struct StaticOrder {
    int nM, nN, nwg, G, c;
    __host__ __device__ void init(int M, int N, int G_, int c_) { nM = M / BM; nN = N / BM; nwg = nM * nN; G = G_; c = c_; }
    __host__ __device__ bool next(int i, Unit& u) const {
        const long L = (long)i * G + c; if (L >= nwg) return false;
        int wgid = (int)L; { const int q = nwg / NXCD, r = nwg % NXCD, xcd = wgid % NXCD, off = wgid / NXCD; wgid = (xcd < r ? xcd * (q + 1) : r * (q + 1) + (xcd - r) * q) + off; }
        const int nig = WGM * nN, gid = wgid / nig, fm = gid * WGM, gsz = (nM - fm) < WGM ? (nM - fm) : WGM;
        u.pm = fm + ((wgid % nig) % gsz); u.pn = (wgid % nig) / gsz; return true;
    }
    __device__ __forceinline__ void a_ready(const Unit&) const {}
    __device__ __forceinline__ void done(const Unit&) const {}
};

__device__ __forceinline__ unsigned cvt_pk_bf16(float lo, float hi) { unsigned r; asm volatile("v_cvt_pk_bf16_f32 %0, %1, %2" : "=v"(r) : "v"(lo), "v"(hi)); return r; }
typedef float f32x2 __attribute__((ext_vector_type(2)));
typedef unsigned u32x2 __attribute__((ext_vector_type(2)));
#define PG8_GAS __attribute__((address_space(1)))
__device__ __forceinline__ u32x2 pack8_fp8(const float (&x)[8]) { int w0 = 0, w1 = 0; w0 = __builtin_amdgcn_cvt_pk_fp8_f32(x[0], x[1], w0, false); w0 = __builtin_amdgcn_cvt_pk_fp8_f32(x[2], x[3], w0, true);
    w1 = __builtin_amdgcn_cvt_pk_fp8_f32(x[4], x[5], w1, false); w1 = __builtin_amdgcn_cvt_pk_fp8_f32(x[6], x[7], w1, true); u32x2 r; r.x = (unsigned)w0; r.y = (unsigned)w1; return r; }
__device__ __forceinline__ u32x4 split8_hilo(const float (&x)[8]) { const u32x2 h = pack8_fp8(x);
    const f32x2 a = __builtin_amdgcn_cvt_pk_f32_fp8((int)h.x, false), b = __builtin_amdgcn_cvt_pk_f32_fp8((int)h.x, true), c = __builtin_amdgcn_cvt_pk_f32_fp8((int)h.y, false), d = __builtin_amdgcn_cvt_pk_f32_fp8((int)h.y, true);
    const float r[8] = {x[0] - a.x, x[1] - a.y, x[2] - b.x, x[3] - b.y, x[4] - c.x, x[5] - c.y, x[6] - d.x, x[7] - d.y}; const u32x2 l = pack8_fp8(r);
    u32x4 w; w.x = h.x; w.y = h.y; w.z = l.x; w.w = l.y; return w; }
__device__ __forceinline__ float bf_lo(unsigned w) { return __uint_as_float(w << 16); }
__device__ __forceinline__ float bf_hi(unsigned w) { return __uint_as_float(w & 0xffff0000u); }
__device__ __forceinline__ float fast_sigmoid(float x) { return __builtin_amdgcn_rcpf(1.0f + __expf(-x)); }
struct EpiSwiGLU {
    static constexpr bool PERM = true, AFTER_DRAIN = false;
    bf16_t* O; int ldc; const PG8_LAS float* rsl;
    __device__ __forceinline__ void operator()(const f32x4 (&acc)[2][2][4][2], const Unit& u, int wr, int wc, int fr, int fq) const {
        const int col0 = u.pn * HALF + wc * 32 + 8 * fq; const PG8_LAS float* rp = rsl + u.ui * 256 + wr * 64 + fr;
#pragma unroll
        for (int ai = 0; ai < 2; ++ai)
#pragma unroll
            for (int m = 0; m < 4; ++m) {
                const int row = u.pm * BM + ai * HALF + wr * 64 + m * 16 + fr; const float r = rp[ai * HALF + m * 16];
                float h[8];
#pragma unroll
                for (int n = 0; n < 2; ++n)
#pragma unroll
                    for (int j = 0; j < 4; ++j) { const float g = acc[ai][0][m][n][j] * r, up = acc[ai][1][m][n][j] * r; h[n * 4 + j] = g * fast_sigmoid(g) * up; }
                u32x4 w; w.x = cvt_pk_bf16(h[0], h[1]); w.y = cvt_pk_bf16(h[2], h[3]); w.z = cvt_pk_bf16(h[4], h[5]); w.w = cvt_pk_bf16(h[6], h[7]);
                *(PG8_GAS u32x4*)(O + (size_t)row * ldc + col0) = w;
            }
    }
};
struct EpiResid {
    static constexpr bool PERM = false, AFTER_DRAIN = false;
    bf16_t* HB; float* ss; float scale;
    __device__ __forceinline__ void operator()(const f32x4 (&acc)[2][2][4][2], const Unit& u, int wr, int wc, int fr, int fq) const {
        const int col0 = u.pn * BM + wc * 32 + 4 * fq;
        PG8_GAS bf16_t* hb = (PG8_GAS bf16_t*)HB + (size_t)(u.pm * BM + wr * 64 + fr) * 1024 + col0;
        const int L = fr + 16 * fq, perm = 4 * (4 * fr + fq);
        const PG8_GAS bf16_t* hl = (const PG8_GAS bf16_t*)HB + (size_t)(u.pm * BM + wr * 64 + (L >> 2)) * 1024 + u.pn * BM + wc * 32 + 4 * (L & 3);
        u32x2 hv[2][4][2][2];
#pragma unroll
        for (int ai = 0; ai < 2; ++ai)
#pragma unroll
            for (int m = 0; m < 4; ++m)
#pragma unroll
                for (int bj = 0; bj < 2; ++bj)
#pragma unroll
                    for (int n = 0; n < 2; ++n) hv[ai][m][bj][n] = *(const PG8_GAS u32x2*)(hl + (size_t)(ai * HALF + m * 16) * 1024 + bj * HALF + n * 16);

#pragma unroll
        for (int ai = 0; ai < 2; ++ai)
#pragma unroll
            for (int m = 0; m < 4; ++m) {
                const int row = u.pm * BM + ai * HALF + wr * 64 + m * 16 + fr; float sq = 0.f;
#pragma unroll
                for (int bj = 0; bj < 2; ++bj)
#pragma unroll
                    for (int n = 0; n < 2; ++n) {
                        u32x2 x = hv[ai][m][bj][n]; x.x = (unsigned)__builtin_amdgcn_ds_bpermute(perm, (int)x.x); x.y = (unsigned)__builtin_amdgcn_ds_bpermute(perm, (int)x.y);
                        f32x4 h = {bf_lo(x.x), bf_hi(x.x), bf_lo(x.y), bf_hi(x.y)}; h = h + acc[ai][bj][m][n] * scale;
                        u32x2 w; w.x = cvt_pk_bf16(h[0], h[1]); w.y = cvt_pk_bf16(h[2], h[3]); *(PG8_GAS u32x2*)(hb + (size_t)(ai * HALF + m * 16) * 1024 + bj * HALF + n * 16) = w;
                        const float r0 = bf_lo(w.x), r1 = bf_hi(w.x), r2 = bf_lo(w.y), r3 = bf_hi(w.y);
                        sq += (r0 * r0 + r1 * r1) + (r2 * r2 + r3 * r3);
                    }
                sq += __shfl_xor(sq, 16); sq += __shfl_xor(sq, 32);
                if (fq == 0) ((PG8_GAS float*)ss)[(size_t)row * 16 + u.pn * 4 + wc] = sq;
            }
    }
};
template <bool USE_RS> struct EpiScaleBf16 {
    static constexpr bool PERM = true, AFTER_DRAIN = false;
    bf16_t* O; int ldc; const PG8_LAS float* rsl; float cscale;
    __device__ __forceinline__ void operator()(const f32x4 (&acc)[2][2][4][2], const Unit& u, int wr, int wc, int fr, int fq) const {
        const int col0 = u.pn * BM + wc * 32 + 8 * fq; const PG8_LAS float* rp = rsl + u.ui * 256 + wr * 64 + fr;
#pragma unroll
        for (int ai = 0; ai < 2; ++ai)
#pragma unroll
            for (int m = 0; m < 4; ++m) {
                const int row = u.pm * BM + ai * HALF + wr * 64 + m * 16 + fr; const float s = (USE_RS ? rp[ai * HALF + m * 16] : 1.0f) * cscale;
                PG8_GAS bf16_t* rowp = (PG8_GAS bf16_t*)O + (size_t)row * ldc + col0;
#pragma unroll
                for (int bj = 0; bj < 2; ++bj) { const f32x4 v0 = acc[ai][bj][m][0] * s, v1 = acc[ai][bj][m][1] * s;
                    u32x4 w; w.x = cvt_pk_bf16(v0[0], v0[1]); w.y = cvt_pk_bf16(v0[2], v0[3]); w.z = cvt_pk_bf16(v1[0], v1[1]); w.w = cvt_pk_bf16(v1[2], v1[3]);
                    *(PG8_GAS u32x4*)(rowp + bj * HALF) = w; }
            }
    }
};
struct EpiRope {
    static constexpr bool PERM = true, AFTER_DRAIN = false;
    bf16_t* O; const PG8_LAS float* rsl; const float* cA; const float* sA; const float* cI; const float* sI; unsigned char* K8; unsigned char* V8;
    __device__ __forceinline__ void operator()(const f32x4 (&acc)[2][2][4][2], const Unit& u, int wr, int wc, int fr, int fq) const {
        const int x0 = wc * 32 + 8 * fq, pn = u.pn; const PG8_LAS float* rp = rsl + u.ui * 256 + wr * 64 + fr;
        const bool rot = !(pn == 5 || (pn == 8 && x0 >= 32)); const bool tA = pn < 5; const int half = tA ? 64 : 32, i0 = x0 & (half - 1);
#pragma unroll
        for (int ai = 0; ai < 2; ++ai) {
            f32x4 tc[4][2], ts[4][2];
            if (rot) {
#pragma unroll
                for (int m = 0; m < 4; ++m) { const int row = u.pm * BM + ai * HALF + wr * 64 + m * 16 + fr;
                    const PG8_GAS float* cp = (const PG8_GAS float*)(tA ? cA + (size_t)row * 64 : cI + (size_t)row * 32) + i0; const PG8_GAS float* sp = (const PG8_GAS float*)(tA ? sA + (size_t)row * 64 : sI + (size_t)row * 32) + i0;
                    tc[m][0] = *(const PG8_GAS f32x4*)cp; tc[m][1] = *(const PG8_GAS f32x4*)(cp + 4); ts[m][0] = *(const PG8_GAS f32x4*)sp; ts[m][1] = *(const PG8_GAS f32x4*)(sp + 4); }
            }
#pragma unroll
            for (int m = 0; m < 4; ++m) {
                const int row = u.pm * BM + ai * HALF + wr * 64 + m * 16 + fr; const float r = rp[ai * HALF + m * 16];
                PG8_GAS bf16_t* orow = (PG8_GAS bf16_t*)O + (size_t)row * 2304;
                float a[8], b[8];
#pragma unroll
                for (int n = 0; n < 2; ++n)
#pragma unroll
                    for (int j = 0; j < 4; ++j) { a[4 * n + j] = acc[ai][0][m][n][j] * r; b[4 * n + j] = acc[ai][1][m][n][j] * r; }
                if (pn == 5) {
                    const size_t cr = (size_t)((row >> 13) * 2) * 8192 + (row & 8191);
                    *(PG8_GAS u32x2*)(V8 + cr * 128 + x0) = pack8_fp8(a); *(PG8_GAS u32x2*)(V8 + (cr + 8192) * 128 + x0) = pack8_fp8(b);
                } else if (pn == 8 && x0 >= 32) {
                    if (x0 == 32) { u32x4 w0; w0.x = cvt_pk_bf16(a[0], a[1]); w0.y = cvt_pk_bf16(a[2], a[3]); w0.z = cvt_pk_bf16(a[4], a[5]); w0.w = cvt_pk_bf16(a[6], a[7]); *(PG8_GAS u32x4*)(orow + 2112) = w0; }
                } else {
                    const int hh = tA ? (x0 >> 6) : (x0 >> 5);
                    const int base = pn < 4 ? 256 * pn + 128 * hh : (pn == 4 ? 1024 + 128 * hh : (pn == 8 ? 2048 : 1536 + 256 * (pn - 6) + 64 * hh));
                    const float sc = pn < 4 ? 0.08838834764831845f * 32.0f : 1.0f;
                    const f32x4 c0 = tc[m][0], c1 = tc[m][1], s0 = ts[m][0], s1 = ts[m][1];
                    const float cs[8] = {c0[0], c0[1], c0[2], c0[3], c1[0], c1[1], c1[2], c1[3]}, sn[8] = {s0[0], s0[1], s0[2], s0[3], s1[0], s1[1], s1[2], s1[3]};
                    float o1[8], o2[8];
#pragma unroll
                    for (int k = 0; k < 8; ++k) { o1[k] = (a[k] * cs[k] - b[k] * sn[k]) * sc; o2[k] = (b[k] * cs[k] + a[k] * sn[k]) * sc; }
                    u32x4 w0, w1; w0.x = cvt_pk_bf16(o1[0], o1[1]); w0.y = cvt_pk_bf16(o1[2], o1[3]); w0.z = cvt_pk_bf16(o1[4], o1[5]); w0.w = cvt_pk_bf16(o1[6], o1[7]);
                    w1.x = cvt_pk_bf16(o2[0], o2[1]); w1.y = cvt_pk_bf16(o2[2], o2[3]); w1.z = cvt_pk_bf16(o2[4], o2[5]); w1.w = cvt_pk_bf16(o2[6], o2[7]);
                    if (pn < 4) { w0 = split8_hilo(o1); w1 = split8_hilo(o2); }
                    if (pn == 4) { const size_t cr = (size_t)((row >> 13) * 2 + hh) * 8192 + (row & 8191); *(PG8_GAS u32x2*)(K8 + cr * 128 + i0) = pack8_fp8(o1); *(PG8_GAS u32x2*)(K8 + cr * 128 + 64 + i0) = pack8_fp8(o2); }
                    else { *(PG8_GAS u32x4*)(orow + base + i0) = w0; *(PG8_GAS u32x4*)(orow + base + half + i0) = w1; }
                }
            }
        }
    }
};
struct EpiGLU {
    static constexpr bool PERM = true, AFTER_DRAIN = false;
    const bf16_t* Y; const float* bias; bf16_t* CAT;
    __device__ __forceinline__ void operator()(const f32x4 (&acc)[2][2][4][2], const Unit& u, int wr, int wc, int fr, int fq) const {
        const int col0 = u.pn * BM + wc * 32 + 8 * fq;
        const PG8_GAS bf16_t* yb = (const PG8_GAS bf16_t*)Y + (size_t)(u.pm * BM + wr * 64 + fr) * 512 + col0;
        u32x4 yv[2][4][2]; f32x4 bb[2][2];
#pragma unroll
        for (int bj = 0; bj < 2; ++bj) { bb[bj][0] = *(const PG8_GAS f32x4*)(bias + col0 + bj * HALF); bb[bj][1] = *(const PG8_GAS f32x4*)(bias + col0 + bj * HALF + 4); }
#pragma unroll
        for (int ai = 0; ai < 2; ++ai)
#pragma unroll
            for (int m = 0; m < 4; ++m)
#pragma unroll
                for (int bj = 0; bj < 2; ++bj) yv[ai][m][bj] = *(const PG8_GAS u32x4*)(yb + (size_t)(ai * HALF + m * 16) * 512 + bj * HALF);
#pragma unroll
        for (int ai = 0; ai < 2; ++ai)
#pragma unroll
            for (int m = 0; m < 4; ++m) {
                const int row = u.pm * BM + ai * HALF + wr * 64 + m * 16 + fr;
#pragma unroll
                for (int bj = 0; bj < 2; ++bj) { const int c = col0 + bj * HALF; const u32x4 y4 = yv[ai][m][bj];
                    const f32x4 z0 = acc[ai][bj][m][0] + bb[bj][0], z1 = acc[ai][bj][m][1] + bb[bj][1];
                    float o[8];
                    o[0] = bf_lo(y4.x) * fast_sigmoid(z0[0]); o[1] = bf_hi(y4.x) * fast_sigmoid(z0[1]); o[2] = bf_lo(y4.y) * fast_sigmoid(z0[2]); o[3] = bf_hi(y4.y) * fast_sigmoid(z0[3]);
                    o[4] = bf_lo(y4.z) * fast_sigmoid(z1[0]); o[5] = bf_hi(y4.z) * fast_sigmoid(z1[1]); o[6] = bf_lo(y4.w) * fast_sigmoid(z1[2]); o[7] = bf_hi(y4.w) * fast_sigmoid(z1[3]);
                    u32x4 w; w.x = cvt_pk_bf16(o[0], o[1]); w.y = cvt_pk_bf16(o[2], o[3]); w.z = cvt_pk_bf16(o[4], o[5]); w.w = cvt_pk_bf16(o[6], o[7]);
                    *(PG8_GAS u32x4*)(CAT + (size_t)row * 1024 + 512 + c) = w; }
            }
    }
};
template <int NM, int NN> struct TileOrder {
    static constexpr int nwg = NM * NN, WG = NM < 8 ? NM : 8, nig = WG * NN;
    static_assert(nwg % 8 == 0 && NM % WG == 0, "TileOrder shapes");
    int G, c;
    __device__ __forceinline__ bool next(int i, Unit& u) const {
        const int L = i * G + c; if (c < 0 || L >= nwg) return false;
        const int wgid = (L & 7) * (nwg / 8) + (L >> 3), gid = wgid / nig, r = wgid % nig;
        u.pm = gid * WG + (r % WG); u.pn = r / WG; u.ui = i; return true;
    }
    __device__ __forceinline__ void a_ready(const Unit&) const {}
    __device__ __forceinline__ void done(const Unit&) const {}
};
template <class Epi, class Sched, bool ALIGN_EPI = false, bool SP2 = false>
__device__ __forceinline__ void gemm_phase(PG8_LAS unsigned char* lds, const Gemm g, const Sched& S, const Epi& E, int tid_in) {
    int tid_ = tid_in; asm volatile("" : "+v"(tid_));
    const int tid = tid_, wid = __builtin_amdgcn_readfirstlane(tid >> 6), lane = tid & 63, wr = wid >> 2, wc = wid & 3, fr = lane & 15, fq = lane >> 4;
    const int K = g.K, nt = K / BK;
    unsigned voffA[2], voffB[2];
#pragma unroll
    for (int i = 0; i < 2; ++i) { int R, C; stage_rc(tid * 16 + i * 8192, R, C); const int Rb = Epi::PERM ? ((R & ~31) + perm32(R & 31)) : R;
        voffA[i] = (unsigned)(R * K + C) * 2u; voffB[i] = (unsigned)(Rb * K + C) * 2u; }
    const size_t kstep = (size_t)(BK * 2);
    const size_t hstep = (size_t)HALF * K * 2;
    const size_t tstep = 2 * hstep;
    const unsigned ldsw = (unsigned)wid * 1024u;
    const int aoff = lds_byte(wr * 64 + fr, fq * 8), boff = lds_byte(wc * 32 + fr, fq * 8);
#define PG8_SA(b, h) (((b) * 2 + (h)) * HTB)
#define PG8_SB(b, h) ((4 + (b) * 2 + (h)) * HTB)
#define PG8_STAGE(bufoff, gbase, voff) do { _Pragma("unroll") for (int _i = 0; _i < 2; ++_i) \
        __builtin_amdgcn_global_load_lds((const unsigned*)((const char*)(gbase) + (voff)[_i]), (PG8_LAS unsigned*)(lds + (bufoff) + ldsw + _i * 8192), 16, 0, 0); } while (0)
#define PG8_LDA(dst, b, h) do { _Pragma("unroll") for (int m = 0; m < 4; ++m) _Pragma("unroll") for (int k = 0; k < 2; ++k) dst[m][k] = *(const PG8_LAS bf16x8*)(lds + PG8_SA(b, h) + aoff + m * 2048 + k * 1024); } while (0)
#define PG8_LDB(dst, b, h) do { _Pragma("unroll") for (int n = 0; n < 2; ++n) _Pragma("unroll") for (int k = 0; k < 2; ++k) dst[n][k] = *(const PG8_LAS bf16x8*)(lds + PG8_SB(b, h) + boff + n * 2048 + k * 1024); } while (0)
#define PG8_MMA(ai, bj, At, Bt) do { __builtin_amdgcn_s_setprio(1); _Pragma("unroll") for (int m = 0; m < 4; ++m) _Pragma("unroll") for (int n = 0; n < 2; ++n) _Pragma("unroll") for (int k = 0; k < 2; ++k) \
        acc[ai][bj][m][n] = __builtin_amdgcn_mfma_f32_16x16x32_bf16(Bt[n][k], At[m][k], acc[ai][bj][m][n], 0, 0, 0); __builtin_amdgcn_s_setprio(0); } while (0)
#define PG8_WAIT_V(n) asm volatile("s_waitcnt vmcnt(" #n ")" ::: "memory")
#define PG8_WAIT_L(n) asm volatile("s_waitcnt lgkmcnt(" #n ")" ::: "memory")
#define PG8_BAR __builtin_amdgcn_s_barrier()
#define PG8_SCHED __builtin_amdgcn_sched_barrier(0)
    Unit cur, nxt; int ui = 0;
    if (!S.next(0, cur)) return;
    f32x4 acc[2][2][4][2];
#pragma unroll
    for (int a = 0; a < 2; ++a)
#pragma unroll
        for (int b = 0; b < 2; ++b)
#pragma unroll
            for (int m = 0; m < 4; ++m)
#pragma unroll
                for (int n = 0; n < 2; ++n) acc[a][b][m][n] = (f32x4){0.f, 0.f, 0.f, 0.f};
    bf16x8 At[4][2], B0[2][2], B1[2][2];
    const char* cA = (const char*)g.A + (size_t)cur.pm * tstep; const char* cB = (const char*)g.Bt + (size_t)cur.pn * tstep;
    S.a_ready(cur);
    if constexpr (SP2) {
        PG8_STAGE(PG8_SB(0, 0), cB, voffB); PG8_STAGE(PG8_SB(0, 1), cB + hstep, voffB); PG8_STAGE(PG8_SA(0, 0), cA, voffA); PG8_STAGE(PG8_SA(0, 1), cA + hstep, voffA);
        if (wr == 1) PG8_BAR;
        PG8_WAIT_V(2); PG8_BAR;
        PG8_STAGE(PG8_SB(1, 0), cB + kstep, voffB); PG8_STAGE(PG8_SA(1, 0), cA + kstep, voffA); PG8_STAGE(PG8_SB(1, 1), cB + hstep + kstep, voffB);
        PG8_WAIT_V(6); PG8_BAR;
    } else {
        PG8_STAGE(PG8_SB(0, 0), cB, voffB); PG8_STAGE(PG8_SA(0, 0), cA, voffA); PG8_STAGE(PG8_SB(0, 1), cB + hstep, voffB); PG8_STAGE(PG8_SA(0, 1), cA + hstep, voffA);
        if (wr == 1) PG8_BAR;
        PG8_WAIT_V(4); PG8_BAR;
        PG8_STAGE(PG8_SB(1, 0), cB + kstep, voffB); PG8_STAGE(PG8_SA(1, 0), cA + kstep, voffA); PG8_STAGE(PG8_SB(1, 1), cB + hstep + kstep, voffB);
        PG8_WAIT_V(6); PG8_BAR;
    }
    for (;;) {
        const bool has_next = S.next(ui + 1, nxt);
        const char* nA = has_next ? (const char*)g.A + (size_t)nxt.pm * tstep : cA; const char* nB = has_next ? (const char*)g.Bt + (size_t)nxt.pn * tstep : cB;
        for (int t = 0; t < nt; t += 2) {
            const bool last = (t == nt - 2);
            const char* a1 = cA + (size_t)(t + 1) * kstep;
            const char* a2 = last ? nA : cA + (size_t)(t + 2) * kstep; const char* b2 = last ? nB : cB + (size_t)(t + 2) * kstep;
            const char* a3 = a2 + kstep; const char* b3 = b2 + kstep;
            if (last && has_next) S.a_ready(nxt);
            if constexpr (SP2) {
            PG8_LDB(B0, 0, 0); PG8_LDB(B1, 0, 1); PG8_SCHED; PG8_LDA(At, 0, 0); PG8_STAGE(PG8_SA(1, 1), a1 + hstep, voffA);
            PG8_WAIT_V(8); PG8_WAIT_L(0); PG8_BAR; PG8_MMA(0, 0, At, B0); PG8_MMA(0, 1, At, B1); PG8_BAR; PG8_SCHED;
            PG8_LDA(At, 0, 1); PG8_STAGE(PG8_SB(0, 0), b2, voffB); PG8_STAGE(PG8_SB(0, 1), b2 + hstep, voffB); PG8_STAGE(PG8_SA(0, 0), a2, voffA);
            PG8_WAIT_V(8); PG8_WAIT_L(0); PG8_BAR; PG8_MMA(1, 0, At, B0); PG8_MMA(1, 1, At, B1); PG8_BAR; PG8_SCHED;
            PG8_LDB(B0, 1, 0); PG8_LDB(B1, 1, 1); PG8_SCHED; PG8_LDA(At, 1, 0); PG8_STAGE(PG8_SA(0, 1), a2 + hstep, voffA);
            PG8_WAIT_V(8); PG8_WAIT_L(0); PG8_BAR; PG8_MMA(0, 0, At, B0); PG8_MMA(0, 1, At, B1); PG8_BAR; PG8_SCHED;
            PG8_LDA(At, 1, 1); PG8_STAGE(PG8_SB(1, 0), b3, voffB); PG8_STAGE(PG8_SB(1, 1), b3 + hstep, voffB); PG8_STAGE(PG8_SA(1, 0), a3, voffA);
            PG8_WAIT_V(8); PG8_WAIT_L(0); PG8_BAR; PG8_MMA(1, 0, At, B0); PG8_MMA(1, 1, At, B1); PG8_BAR; PG8_SCHED;
            } else {
            PG8_LDB(B0, 0, 0); PG8_SCHED; PG8_LDA(At, 0, 0); PG8_STAGE(PG8_SA(1, 1), a1 + hstep, voffA);
            PG8_WAIT_L(8); PG8_BAR; PG8_WAIT_L(0); PG8_MMA(0, 0, At, B0); PG8_BAR; PG8_SCHED;
            PG8_LDB(B1, 0, 1); PG8_STAGE(PG8_SB(0, 0), b2, voffB);
            PG8_BAR; PG8_WAIT_L(0); PG8_MMA(0, 1, At, B1); PG8_BAR;
            PG8_LDA(At, 0, 1); PG8_STAGE(PG8_SA(0, 0), a2, voffA);
            PG8_BAR; PG8_WAIT_L(0); PG8_MMA(1, 0, At, B0); PG8_BAR; PG8_SCHED;
            PG8_STAGE(PG8_SB(0, 1), b2 + hstep, voffB);
            PG8_WAIT_V(6); PG8_BAR; PG8_MMA(1, 1, At, B1); PG8_BAR;
            PG8_LDB(B0, 1, 0); PG8_SCHED; PG8_LDA(At, 1, 0); PG8_STAGE(PG8_SA(0, 1), a2 + hstep, voffA);
            PG8_WAIT_L(8); PG8_BAR; PG8_WAIT_L(0); PG8_MMA(0, 0, At, B0); PG8_BAR; PG8_SCHED;
            PG8_LDB(B1, 1, 1); PG8_STAGE(PG8_SB(1, 0), b3, voffB);
            PG8_BAR; PG8_WAIT_L(0); PG8_MMA(0, 1, At, B1); PG8_BAR;
            PG8_LDA(At, 1, 1); PG8_STAGE(PG8_SA(1, 0), a3, voffA);
            PG8_BAR; PG8_WAIT_L(0); PG8_MMA(1, 0, At, B0); PG8_BAR; PG8_SCHED;
            PG8_STAGE(PG8_SB(1, 1), b3 + hstep, voffB);
            PG8_WAIT_V(6); PG8_BAR; PG8_MMA(1, 1, At, B1); PG8_BAR;
            }
        }
        if constexpr (ALIGN_EPI) { if (wr == 0) PG8_BAR; }
        if constexpr (!Epi::AFTER_DRAIN) { E(acc, cur, wr, wc, fr, fq); S.done(cur); }
        if (!has_next) break;
#pragma unroll
        for (int a = 0; a < 2; ++a)
#pragma unroll
            for (int b = 0; b < 2; ++b)
#pragma unroll
                for (int m = 0; m < 4; ++m)
#pragma unroll
                    for (int n = 0; n < 2; ++n) acc[a][b][m][n] = (f32x4){0.f, 0.f, 0.f, 0.f};
        cur = nxt; cA = nA; cB = nB; ++ui;
        if constexpr (ALIGN_EPI) { if (wr == 1) PG8_BAR; }
    }
    PG8_WAIT_V(0);
    if constexpr (!ALIGN_EPI) { if (wr == 0) PG8_BAR; }
    PG8_BAR;
    if constexpr (Epi::AFTER_DRAIN) { E.fused(acc, cur, wr, wc, fr, fq, lds, wid, lane); S.done(cur); }
#undef PG8_SA
#undef PG8_SB
#undef PG8_STAGE
#undef PG8_LDA
#undef PG8_LDB
#undef PG8_MMA
#undef PG8_WAIT_V
#undef PG8_WAIT_L
#undef PG8_BAR
#undef PG8_SCHED
}
}

constexpr int NB = 2, SEQ = 8192, DM = 1024, MTOK = NB * SEQ, DEPTH = 4, NMEM = 256, DFF = 2816;
constexpr int PROJW = 2304;
constexpr int EV_IN = 2064, OD_IN = 2120;
constexpr float EPS = 1e-6f;
constexpr int S5T = 64, S5NC = SEQ / S5T;
constexpr int TOPK = 256;
constexpr int PH_LAYER0 = 2, PH_PER_LAYER = 14, PH_FINAL = PH_LAYER0 + DEPTH * PH_PER_LAYER, N_PHASES = PH_FINAL + 1;

constexpr size_t MiB = 1u << 20;
constexpr size_t WS_CTL = 0, CTL_ZERO_BYTES = 1 * MiB;
constexpr size_t WS_H = 1 * MiB, WS_HB = 65 * MiB, WS_SS = 97 * MiB;
constexpr size_t WS_COSA = 98 * MiB, WS_SINA = 102 * MiB, WS_COSI = 106 * MiB, WS_SINI = 108 * MiB;
constexpr size_t WS_MEMN = 110 * MiB, WS_MK = 111 * MiB, WS_MVT = 115 * MiB, WS_S5P = 119 * MiB;
constexpr size_t WS_W = 121 * MiB, WS_SCR = 169 * MiB, WS_END = 345 * MiB;
constexpr size_t WO_GU1 = 0, WO_D1 = 11 * MiB, WO_IN = WO_D1 + 5632 * 1024, WO_OUT = WO_IN + 4608 * 1024, WO_GLU = WO_OUT + 2 * MiB, WO_XQ = WO_GLU + 512 * 1024,
                 WO_XO = WO_XQ + 2 * MiB, WO_GU2 = WO_XO + 2 * MiB, WO_D2 = WO_GU2 + 11 * MiB, WO_END = WO_D2 + 5632 * 1024;
static_assert(WO_END <= 48 * MiB, "weights region");
constexpr size_t SC_HID = 0, SC_PROJ = 0, SC_XQ = 0, SC_XO = 32 * MiB, SC_KVW = 96 * MiB;
constexpr size_t SC_DS = 72 * MiB, SC_BC = 104 * MiB, SC_DEC = 120 * MiB, SC_S5E = 121 * MiB, SC_Y = 125 * MiB, SC_CAT = 141 * MiB;
constexpr size_t SC_SEL = 72 * MiB, SC_SELN = 80 * MiB, SC_K8 = 81 * MiB, SC_V8 = 85 * MiB;
static_assert(SC_CAT + 32 * MiB <= WS_END - WS_SCR, "scratch region");
constexpr int S5P_A = 0, S5P_AT = 2 * 32 * 64 * 2, S5P_BB = 2 * S5P_AT, S5P_BBH = S5P_BB + 2 * 32 * 64 * 16 * 2, S5P_END = S5P_BBH + 2 * 32 * 128 * 16 / 2;
constexpr int CW_BAR = 1024;

constexpr int RING_BYTES = 131072;
constexpr int LDS_BYTES = 163840, LDSCTL_OFF = LDS_BYTES - 1024;

#define GAS __attribute__((address_space(1)))
#define LAS __attribute__((address_space(3)))
#define DI __device__ __forceinline__
typedef unsigned short bf16;
typedef unsigned v4u __attribute__((ext_vector_type(4)));
typedef unsigned v2u __attribute__((ext_vector_type(2)));
typedef float f32x4 __attribute__((ext_vector_type(4)));
typedef float f32x2 __attribute__((ext_vector_type(2)));
typedef short bf16x8 __attribute__((ext_vector_type(8)));
#define LDS_WAIT() asm volatile("s_waitcnt lgkmcnt(0)" ::: "memory")
#define VM_WAIT() asm volatile("s_waitcnt vmcnt(0)" ::: "memory")
DI unsigned f2bf(float f) { unsigned u = __builtin_bit_cast(unsigned, f); return (u + 0x7fffu + ((u >> 16) & 1u)) >> 16; }
DI unsigned pk2(float lo, float hi) { return f2bf(lo) | (f2bf(hi) << 16); }
DI float bflo(unsigned w) { return __uint_as_float(w << 16); }
DI float bfhi(unsigned w) { return __uint_as_float(w & 0xffff0000u); }
DI float bf2f(bf16 x) { return __uint_as_float(((unsigned)x) << 16); }
DI float wave_sum(float v) {
#pragma unroll
    for (int o = 1; o < 64; o <<= 1) v += __shfl_xor(v, o);
    return v;
}
DI f32x4 mfma16(bf16x8 a, bf16x8 b, f32x4 c) { return __builtin_amdgcn_mfma_f32_16x16x32_bf16(a, b, c, 0, 0, 0); }

#define XB_TMO      128
#define XB_XCNT(j)  (256  + 64 * (j))
#define XB_XSUB(j)  (1280 + 64 * (j))
#define XB_XGEN(j)  (2304 + 64 * (j))
#define XB_TOP      3328
#define XB_TOPGEN   3392
#define XCD_BAR_WORDS 3456
#define XB_SPIN_CAP (1u << 18)
__device__ __forceinline__ unsigned xb_ld(unsigned* p)              { return __hip_atomic_load(p, __ATOMIC_RELAXED, __HIP_MEMORY_SCOPE_AGENT); }
__device__ __forceinline__ unsigned xb_add(unsigned* p, unsigned v) { return __hip_atomic_fetch_add(p, v, __ATOMIC_RELAXED, __HIP_MEMORY_SCOPE_AGENT); }
__device__ __forceinline__ unsigned xb_xcc_id() { return (unsigned)__builtin_amdgcn_s_getreg((3 << 11) | 20) & 0xFu; }
#define XB_SPIN(cond, bar) do { unsigned _sp = 0; while (cond) { __builtin_amdgcn_s_sleep(1); \
    if ((++_sp & 255u) == 0u) { if (xb_ld(&(bar)[XB_TMO])) break; if (_sp > XB_SPIN_CAP) { atomicAdd(&(bar)[XB_TMO], 1u); break; } } } } while (0)
struct XcdBarrier { unsigned* bar; unsigned x; volatile LAS unsigned* st; };
__device__ __forceinline__ XcdBarrier xcd_barrier_post(unsigned* bar, volatile LAS unsigned* st) {
    XcdBarrier b; b.bar = bar; b.x = xb_xcc_id(); b.st = st;
    if (threadIdx.x == 0) (void)xb_add(&bar[XB_XCNT(b.x)], 1u);
    return b;
}
__device__ __forceinline__ void xcd_barrier_complete(unsigned* bar, unsigned x, unsigned& nloc, unsigned& nx) {
    const unsigned G = gridDim.x * gridDim.y * gridDim.z;
    unsigned sum, cnt, mine, sp = 0u;
    for (;;) {
        sum = 0u; cnt = 0u; mine = 0u;
#pragma unroll
        for (unsigned j = 0; j < 16; ++j) { const unsigned c = xb_ld(&bar[XB_XCNT(j)]); sum += c; cnt += (c > 0u) ? 1u : 0u; mine = (j == x) ? c : mine; }
        if (sum == G) break;
        __builtin_amdgcn_s_sleep(1);
        if ((++sp & 255u) == 0u) { if (xb_ld(&bar[XB_TMO])) break; if (sp > XB_SPIN_CAP) { atomicAdd(&bar[XB_TMO], 1u); break; } }
    }
    nloc = mine > 0u ? mine : 1u; nx = cnt > 0u ? cnt : 1u;
}
__device__ __forceinline__ void xcd_barrier(const XcdBarrier& b) {
    asm volatile("s_waitcnt vmcnt(0)" ::: "memory");
    __syncthreads();
    if (threadIdx.x == 0) {
        unsigned* bar = b.bar;
        __builtin_amdgcn_s_waitcnt(0);
        unsigned nloc = b.st[0], nx = b.st[1];
        if (nloc == 0u) { xcd_barrier_complete(bar, b.x, nloc, nx); b.st[0] = nloc; b.st[1] = nx; }
        const unsigned old = xb_add(&bar[XB_XSUB(b.x)], 1u);
        const unsigned gen = old / nloc;
        if (old + 1u == (gen + 1u) * nloc) {
            __builtin_amdgcn_fence(__ATOMIC_RELEASE, "agent");
            asm volatile("s_waitcnt vmcnt(0)" ::: "memory");
            const unsigned og = xb_add(&bar[XB_TOP], 1u);
            const unsigned tg = og / nx;
            if (og + 1u == (tg + 1u) * nx) xb_add(&bar[XB_TOPGEN], 1u);
            else XB_SPIN(xb_ld(&bar[XB_TOPGEN]) == tg, bar);
            __builtin_amdgcn_fence(__ATOMIC_ACQUIRE, "agent");
            xb_add(&bar[XB_XGEN(b.x)], 1u);
            asm volatile("s_waitcnt vmcnt(0)" ::: "memory");
        } else {
            XB_SPIN(xb_ld(&bar[XB_XGEN(b.x)]) == gen, bar);
            __builtin_amdgcn_fence(__ATOMIC_ACQUIRE, "agent");
            asm volatile("s_waitcnt vmcnt(0)" ::: "memory");
        }
    }
    __syncthreads();
}

struct Ctx { LAS unsigned char* lds; int tid, lane, wave, vcu, G; };

DI void cvt_store(bf16* dst, int K, int drow0, int k0, LAS float* scr, int lane) {
    LDS_WAIT(); asm volatile("" ::: "memory");
    const int c = lane & 7;
#pragma unroll
    for (int j = 0; j < 4; ++j) { const int n = (lane >> 3) + 8 * j; const LAS float* s = scr + (8 * c) * 33 + n;
        v4u o; o.x = pk2(s[0 * 33], s[1 * 33]); o.y = pk2(s[2 * 33], s[3 * 33]); o.z = pk2(s[4 * 33], s[5 * 33]); o.w = pk2(s[6 * 33], s[7 * 33]);
        *(v4u*)(dst + (size_t)(drow0 + n) * K + k0 + 8 * c) = o; }
    LDS_WAIT(); asm volatile("" ::: "memory");
}
DI void cvt_item(const float* src, int ldsrc, int scol0, int nvalid, const float* gain, bf16* dst, int K, int drow0, int k0, LAS float* scr, int lane) {
    const int kr = lane >> 3, n4 = 4 * (lane & 7); const bool ok = n4 < nvalid;
    const float* sp = src + (size_t)(k0 + kr) * ldsrc + scol0 + n4;
    f32x4 v[8];
#pragma unroll
    for (int i = 0; i < 8; ++i) v[i] = ok ? *(const f32x4*)(sp + (size_t)(8 * i) * ldsrc) : (f32x4){0.f, 0.f, 0.f, 0.f};
    if (gain) {
#pragma unroll
        for (int i = 0; i < 8; ++i) v[i] = v[i] * gain[k0 + kr + 8 * i];
    }
#pragma unroll
    for (int i = 0; i < 8; ++i) { LAS float* d = scr + (kr + 8 * i) * 33 + n4; d[0] = v[i].x; d[1] = v[i].y; d[2] = v[i].z; d[3] = v[i].w; }
    cvt_store(dst, K, drow0, k0, scr, lane);
}
DI void cvt_job(const Ctx& c, const float* src, int ldsrc, int scol0, int nvalid, const float* gain, bf16* dst, int K, int N, int drow0, int rot) {
    LAS float* scr = (LAS float*)(c.lds + c.wave * 8448);
    const int NGW = c.G * 8, gw = (c.vcu * 8 + c.wave + rot) % NGW, nblk = N / 32, nitems = (K / 64) * nblk;
    for (int it = gw; it < nitems; it += NGW) { const int kb = it / nblk, nb = it % nblk; int nv = nvalid - nb * 32; nv = nv < 0 ? 0 : (nv > 32 ? 32 : nv);
        cvt_item(src, ldsrc, scol0 + nb * 32, nv, gain, dst, K, drow0 + nb * 32, kb * 64, scr, c.lane); }
}
DI void cvt_job_gu(const Ctx& c, const float* gate, const float* up, const float* gain, bf16* dst, int rot) {
    LAS float* scr = (LAS float*)(c.lds + c.wave * 8448);
    const int NGW = c.G * 8, gw = (c.vcu * 8 + c.wave + rot) % NGW, nblk = 5632 / 32, nitems = (1024 / 64) * nblk;
    for (int it = gw; it < nitems; it += NGW) { const int kb = it / nblk, nb = it % nblk, n0 = nb * 32;
        const float* src = ((n0 >> 7) & 1) ? up : gate; const int sc = (n0 >> 8) * 128 + (n0 & 127);
        cvt_item(src, DFF, sc, 32, gain, dst, 1024, n0, kb * 64, scr, c.lane); }
}
DI void cvt_job_rope(const Ctx& c, const float* src, const float* gain, bf16* dst, int rot) {
    LAS float* scr = (LAS float*)(c.lds + c.wave * 8448);
    const int NGW = c.G * 8, gw = (c.vcu * 8 + c.wave + rot) % NGW, nblk = PROJW / 32, nitems = (1024 / 64) * nblk;
    for (int it = gw; it < nitems; it += NGW) { const int kb = it / nblk, nb = it % nblk, R = nb * 32, t = R >> 8, bj = (R >> 7) & 1, x = R & 127;
        int L, nv = 32;
        if (t < 4) L = 256 * t + 128 * (x >> 6) + 64 * bj + (x & 63);
        else if (t == 4) L = 1024 + 128 * (x >> 6) + 64 * bj + (x & 63);
        else if (t == 5) L = 1280 + 128 * bj + x;
        else if (t < 8) L = 1536 + 256 * (t - 6) + 64 * (x >> 5) + 32 * bj;
        else { if (x == 0) L = 2048 + 32 * bj; else if (x == 32 && bj == 0) { L = 2112; nv = 8; } else { L = 0; nv = 0; } }
        cvt_item(src, OD_IN, L, nv, gain, dst, 1024, R, kb * 64, scr, c.lane); }
}
DI void cvt_job_comb(const Ctx& c, const float* win, const float* wa, const float* gain, bf16* dst, int drow0, int rot) {
    LAS float* scr = (LAS float*)(c.lds + c.wave * 8448);
    const int NGW = c.G * 8, gw = (c.vcu * 8 + c.wave + rot) % NGW, nblk = 256 / 32, nitems = (1024 / 64) * nblk;
    for (int it = gw; it < nitems; it += NGW) { const int kb = it / nblk, nb = it % nblk, n0 = nb * 32, k0 = kb * 64; const int nn = c.lane & 31;
        float wcol[16];
#pragma unroll
        for (int j = 0; j < 16; ++j) wcol[j] = wa[j * 256 + n0 + nn];
        for (int i = 0; i < 32; ++i) { const int kk = 2 * i + (c.lane >> 5); const float* wr = win + (size_t)(k0 + kk) * EV_IN + 1536; float s = 0.f;
#pragma unroll
            for (int j = 0; j < 16; ++j) s += wr[j] * wcol[j];
            scr[kk * 33 + nn] = s * gain[k0 + kk]; }
        cvt_store(dst, 1024, drow0 + n0, k0, scr, c.lane); }
}

DI void row_init(const float* xrow, bf16* hbrow, float* ssrow, int lane) {
    float s = 0.f;
#pragma unroll
    for (int j = 0; j < 4; ++j) { const f32x4 v = ((const f32x4*)xrow)[lane + 64 * j]; v2u w; w.x = pk2(v.x, v.y); w.y = pk2(v.z, v.w); ((v2u*)hbrow)[lane + 64 * j] = w;
        const float r0 = bflo(w.x), r1 = bfhi(w.x), r2 = bflo(w.y), r3 = bfhi(w.y); s += (r0 * r0 + r1 * r1) + (r2 * r2 + r3 * r3); }
    s = wave_sum(s);
    if (lane < 16) ssrow[lane] = (lane == 0) ? s : 0.f;
}
DI void row_norm_bf16(const float* xrow, const float* g, bf16* orow, int lane) {
    f32x4 v[4]; float s = 0.f;
#pragma unroll
    for (int j = 0; j < 4; ++j) { v[j] = ((const f32x4*)xrow)[lane + 64 * j]; s += (v[j].x * v[j].x + v[j].y * v[j].y) + (v[j].z * v[j].z + v[j].w * v[j].w); }
    const float r = rsqrtf(wave_sum(s) * (1.0f / 1024.0f) + EPS);
#pragma unroll
    for (int j = 0; j < 4; ++j) { const f32x4 gg = ((const f32x4*)g)[lane + 64 * j]; v2u w; w.x = pk2(v[j].x * r * gg.x, v[j].y * r * gg.y); w.y = pk2(v[j].z * r * gg.z, v[j].w * r * gg.w); ((v2u*)orow)[lane + 64 * j] = w; }
}
DI void row_final(const bf16* hrow, const float* ssrow, const float* g, float* orow, int lane) {
    float s = (lane < 16) ? ssrow[lane] : 0.f; s = wave_sum(s);
    const float r = rsqrtf(s * (1.0f / 1024.0f) + EPS);
#pragma unroll
    for (int j = 0; j < 4; ++j) { const v2u w = ((const v2u*)hrow)[lane + 64 * j]; const f32x4 v = {bflo(w.x), bfhi(w.x), bflo(w.y), bfhi(w.y)}, gg = ((const f32x4*)g)[lane + 64 * j]; ((f32x4*)orow)[lane + 64 * j] = v * r * gg; }
}

DI void unpack8(const v4u w, float (&x)[8]) { x[0] = bflo(w.x); x[1] = bfhi(w.x); x[2] = bflo(w.y); x[3] = bfhi(w.y); x[4] = bflo(w.z); x[5] = bfhi(w.z); x[6] = bflo(w.w); x[7] = bfhi(w.w); }
DI void gla1_unit(const Ctx& c, int u, const bf16* PROJ, const float* b_a, float* DS, float* BCg, float* DEC) {
    const int n = u & 127, bh = u >> 7, h = bh & 3, b = bh >> 2, row0 = b * SEQ + n * 64;
    LAS float* BCl = (LAS float*)c.lds; LAS float* SEG = BCl + 4096; LAS unsigned char* KEt = c.lds + 18432; LAS unsigned char* VT = KEt + 9216;
    const int t = c.tid >> 3, s8 = c.tid & 7;
    const bf16* prow = PROJ + (size_t)(row0 + t) * PROJW;
    float kk[8];
    { float x[8]; unpack8(*(const v4u*)(prow + 1536 + h * 64 + s8 * 8), x);
      float ls[8];
#pragma unroll
      for (int j = 0; j < 8; ++j) { const float xx = x[j] + b_a[h * 64 + s8 * 8 + j]; ls[j] = (fminf(xx, 0.f) - __logf(1.0f + __expf(-fabsf(xx)))) * (1.0f / 16.0f); }
      *(LAS f32x4*)(BCl + t * 64 + s8 * 8) = (f32x4){ls[0], ls[1], ls[2], ls[3]}; *(LAS f32x4*)(BCl + t * 64 + s8 * 8 + 4) = (f32x4){ls[4], ls[5], ls[6], ls[7]};
      unpack8(*(const v4u*)(prow + 256 + h * 64 + s8 * 8), kk);
      const v4u v0 = *(const v4u*)(prow + 512 + h * 128 + s8 * 16), v1 = *(const v4u*)(prow + 512 + h * 128 + s8 * 16 + 8);
      const unsigned vw[8] = {v0.x, v0.y, v0.z, v0.w, v1.x, v1.y, v1.z, v1.w};
      LAS unsigned char* vt = VT + (16 * s8) * 144 + t * 2;
#pragma unroll
      for (int j = 0; j < 8; ++j) { *(LAS bf16*)(vt + (2 * j) * 144) = (bf16)(vw[j] & 0xffffu); *(LAS bf16*)(vt + (2 * j + 1) * 144) = (bf16)(vw[j] >> 16); } }
    __syncthreads();
    { const int d = c.tid & 63, seg = c.tid >> 6; float v[8]; float run = 0.f;
#pragma unroll
      for (int j = 0; j < 8; ++j) { run += BCl[(8 * seg + j) * 64 + d]; v[j] = run; }
      SEG[seg * 64 + d] = run;
      __syncthreads();
      float off = 0.f;
#pragma unroll
      for (int q = 0; q < 7; ++q) off += (q < seg) ? SEG[q * 64 + d] : 0.f;
#pragma unroll
      for (int j = 0; j < 8; ++j) BCl[(8 * seg + j) * 64 + d] = v[j] + off; }
    __syncthreads();
    { float bcv[8];
#pragma unroll
      for (int j = 0; j < 8; ++j) { const int d = s8 * 8 + j; const float bc = BCl[t * 64 + d], bl = BCl[63 * 64 + d]; bcv[j] = bc;
          *(LAS bf16*)(KEt + d * 144 + t * 2) = (bf16)f2bf(kk[j] * __expf(bl - bc)); }
      float* bp = BCg + (size_t)(row0 + t) * 256 + h * 64 + s8 * 8;
      *(f32x4*)bp = (f32x4){bcv[0], bcv[1], bcv[2], bcv[3]}; *(f32x4*)(bp + 4) = (f32x4){bcv[4], bcv[5], bcv[6], bcv[7]};
      if (c.tid < 64) DEC[(size_t)u * 64 + c.tid] = __expf(BCl[63 * 64 + c.tid]); }
    __syncthreads();
    { const int r16 = c.lane & 15, q4 = c.lane >> 4, w = c.wave;
      bf16x8 vb[2];
#pragma unroll
      for (int ks = 0; ks < 2; ++ks) vb[ks] = *(const LAS bf16x8*)(VT + (16 * w + r16) * 144 + (32 * ks + 8 * q4) * 2);
#pragma unroll
      for (int df = 0; df < 4; ++df) { f32x4 acc = {0.f, 0.f, 0.f, 0.f};
#pragma unroll
          for (int ks = 0; ks < 2; ++ks) acc = mfma16(*(const LAS bf16x8*)(KEt + (16 * df + r16) * 144 + (32 * ks + 8 * q4) * 2), vb[ks], acc);
          float* dp = DS + (size_t)u * 8192 + (size_t)(16 * df + 4 * q4) * 128 + 16 * w + r16;
#pragma unroll
          for (int i = 0; i < 4; ++i) dp[i * 128] = acc[i]; } }
    __syncthreads();
}
DI void gla2_scan(const Ctx& c, float* DS, const float* DEC) {
    for (int el = c.vcu * 512 + c.tid; el < 8 * 64 * 128; el += c.G * 512) {
        const int bh = el >> 13, d = (el >> 7) & 63, e = el & 127; float S = 0.f;
        float* p0 = DS + (size_t)(bh * 128) * 8192 + d * 128 + e; const float* q0 = DEC + (size_t)(bh * 128) * 64 + d;
        for (int n0 = 0; n0 < 128; n0 += 16) {
            float ds[16], dc[16];
#pragma unroll
            for (int j = 0; j < 16; ++j) { ds[j] = p0[(size_t)(n0 + j) * 8192]; dc[j] = q0[(n0 + j) * 64]; }
#pragma unroll
            for (int j = 0; j < 16; ++j) { p0[(size_t)(n0 + j) * 8192] = S; S = dc[j] * S + ds[j]; }
        }
    }
}
DI bf16x8 pack8(const f32x4 a, const f32x4 b) { v4u w; w.x = pk2(a[0], a[1]); w.y = pk2(a[2], a[3]); w.z = pk2(b[0], b[1]); w.w = pk2(b[2], b[3]); return __builtin_bit_cast(bf16x8, w); }
DI void gla3_unit(const Ctx& c, int u, const bf16* PROJ, const float* BCg, const float* DS, const float* gnorm, bf16* CAT) {
    const int n = u & 127, bh = u >> 7, h = bh & 3, b = bh >> 2, row0 = b * SEQ + n * 64;
    LAS unsigned char* QD = c.lds; LAS unsigned char* KI = QD + 9216; LAS unsigned char* VT = KI + 9216; LAS unsigned char* SPT = VT + 18432; LAS float* PART = (LAS float*)(SPT + 18432);
    { const int t = c.tid >> 3, s8 = c.tid & 7; const bf16* prow = PROJ + (size_t)(row0 + t) * PROJW;
      float q[8], k[8]; unpack8(*(const v4u*)(prow + h * 64 + s8 * 8), q); unpack8(*(const v4u*)(prow + 256 + h * 64 + s8 * 8), k);
      const float* bp = BCg + (size_t)(row0 + t) * 256 + h * 64 + s8 * 8; const f32x4 b0 = *(const f32x4*)bp, b1 = *(const f32x4*)(bp + 4);
      const float bc[8] = {b0.x, b0.y, b0.z, b0.w, b1.x, b1.y, b1.z, b1.w};
#pragma unroll
      for (int j = 0; j < 8; ++j) { q[j] = q[j] * 0.125f * __expf(bc[j]); k[j] = k[j] * __expf(-bc[j]); }
      v4u wq, wk; wq.x = pk2(q[0], q[1]); wq.y = pk2(q[2], q[3]); wq.z = pk2(q[4], q[5]); wq.w = pk2(q[6], q[7]); wk.x = pk2(k[0], k[1]); wk.y = pk2(k[2], k[3]); wk.z = pk2(k[4], k[5]); wk.w = pk2(k[6], k[7]);
      *(LAS v4u*)(QD + t * 144 + s8 * 16) = wq; *(LAS v4u*)(KI + t * 144 + s8 * 16) = wk;
      const v4u v0 = *(const v4u*)(prow + 512 + h * 128 + s8 * 16), v1 = *(const v4u*)(prow + 512 + h * 128 + s8 * 16 + 8);
      const unsigned vw[8] = {v0.x, v0.y, v0.z, v0.w, v1.x, v1.y, v1.z, v1.w};
      LAS unsigned char* vt = VT + (16 * s8) * 144 + t * 2;
#pragma unroll
      for (int j = 0; j < 8; ++j) { *(LAS bf16*)(vt + (2 * j) * 144) = (bf16)(vw[j] & 0xffffu); *(LAS bf16*)(vt + (2 * j + 1) * 144) = (bf16)(vw[j] >> 16); }
      const int d = t; const f32x4* sp = (const f32x4*)(DS + (size_t)u * 8192 + d * 128 + s8 * 16);
      LAS unsigned char* st = SPT + (16 * s8) * 144 + d * 2;
#pragma unroll
      for (int i = 0; i < 4; ++i) { const f32x4 x = sp[i];
#pragma unroll
          for (int j = 0; j < 4; ++j) *(LAS bf16*)(st + (4 * i + j) * 144) = (bf16)f2bf(x[j]); } }
    __syncthreads();
    const int r16 = c.lane & 15, q4 = c.lane >> 4, w = c.wave;
    bf16x8 qd[4][2];
#pragma unroll
    for (int tf = 0; tf < 4; ++tf)
#pragma unroll
        for (int ks = 0; ks < 2; ++ks) qd[tf][ks] = *(const LAS bf16x8*)(QD + (16 * tf + r16) * 144 + (32 * ks + 8 * q4) * 2);
    f32x4 sc[4][4];
#pragma unroll
    for (int sf = 0; sf < 4; ++sf) {
        bf16x8 ki[2];
#pragma unroll
        for (int ks = 0; ks < 2; ++ks) ki[ks] = *(const LAS bf16x8*)(KI + (16 * sf + r16) * 144 + (32 * ks + 8 * q4) * 2);
#pragma unroll
        for (int tf = 0; tf < 4; ++tf) {
            f32x4 a = {0.f, 0.f, 0.f, 0.f};
            if (sf <= tf) {
#pragma unroll
                for (int ks = 0; ks < 2; ++ks) a = mfma16(ki[ks], qd[tf][ks], a);
                if (sf == tf) {
#pragma unroll
                    for (int i = 0; i < 4; ++i) a[i] = (4 * q4 + i <= r16) ? a[i] : 0.f;
                }
            }
            sc[sf][tf] = a;
        }
    }
    f32x4 o[4];
#pragma unroll
    for (int tf = 0; tf < 4; ++tf) o[tf] = (f32x4){0.f, 0.f, 0.f, 0.f};
    const LAS unsigned char* vrow = VT + (16 * w + r16) * 144; const LAS unsigned char* srow = SPT + (16 * w + r16) * 144;
#pragma unroll
    for (int kk = 0; kk < 2; ++kk) {
        const v2u lo = *(const LAS v2u*)(vrow + (32 * kk + 4 * q4) * 2), hi = *(const LAS v2u*)(vrow + (32 * kk + 16 + 4 * q4) * 2);
        v4u aw; aw.x = lo.x; aw.y = lo.y; aw.z = hi.x; aw.w = hi.y; const bf16x8 a = __builtin_bit_cast(bf16x8, aw);
#pragma unroll
        for (int tf = 0; tf < 4; ++tf) if (2 * kk <= tf) o[tf] = mfma16(a, pack8(sc[2 * kk][tf], sc[2 * kk + 1][tf]), o[tf]);
    }
#pragma unroll
    for (int ks = 0; ks < 2; ++ks) { const bf16x8 a = *(const LAS bf16x8*)(srow + (32 * ks + 8 * q4) * 2);
#pragma unroll
        for (int tf = 0; tf < 4; ++tf) o[tf] = mfma16(a, qd[tf][ks], o[tf]); }
#pragma unroll
    for (int tf = 0; tf < 4; ++tf) { float ssq = (o[tf][0] * o[tf][0] + o[tf][1] * o[tf][1]) + (o[tf][2] * o[tf][2] + o[tf][3] * o[tf][3]);
        ssq += __shfl_xor(ssq, 16); ssq += __shfl_xor(ssq, 32); if (q4 == 0) PART[w * 64 + 16 * tf + r16] = ssq; }
    __syncthreads();
    const f32x4 gg = *(const f32x4*)(gnorm + 16 * w + 4 * q4);
#pragma unroll
    for (int tf = 0; tf < 4; ++tf) { const int t = 16 * tf + r16; float ssq = 0.f;
#pragma unroll
        for (int ww = 0; ww < 8; ++ww) ssq += PART[ww * 64 + t];
        const float rn = rsqrtf(ssq * (1.0f / 128.0f) + EPS);
        const v2u rv = *(const v2u*)(PROJ + (size_t)(row0 + t) * PROJW + 1024 + h * 128 + 16 * w + 4 * q4);
        const float rr[4] = {bflo(rv.x), bfhi(rv.x), bflo(rv.y), bfhi(rv.y)}; float res[4];
#pragma unroll
        for (int i = 0; i < 4; ++i) res[i] = o[tf][i] * rn * gg[i] * (rr[i] * __builtin_amdgcn_rcpf(1.0f + __expf(-rr[i])));
        v2u ow; ow.x = pk2(res[0], res[1]); ow.y = pk2(res[2], res[3]);
        *(v2u*)(CAT + (size_t)(row0 + t) * 1024 + h * 128 + 16 * w + 4 * q4) = ow; }
    __syncthreads();
}

DI void s5_params(const Ctx& c, const float* lam_re, const float* lam_im, const float* log_dt, const float* B_re, const float* B_im, float* P) {
    for (int idx = c.vcu * 512 + c.tid; idx < 2 * 32 * 64; idx += c.G * 512) {
        const float lr = fminf(lam_re[idx], -1e-4f), li = lam_im[idx], dt = expf(log_dt[idx >> 6]);
        const float mag = expf(lr * dt), ar = mag * cosf(li * dt), ai = mag * sinf(li * dt);
        const float den = lr * lr + li * li, nr = ar - 1.0f, fre = (nr * lr + ai * li) / den, fim = (ai * lr - nr * li) / den;
        P[S5P_A + 2 * idx] = ar; P[S5P_A + 2 * idx + 1] = ai;
        float tr = ar, ti = ai;
#pragma unroll
        for (int s = 0; s < 6; ++s) { const float nr2 = tr * tr - ti * ti, ni2 = 2.0f * tr * ti; tr = nr2; ti = ni2; }
        P[S5P_AT + 2 * idx] = tr; P[S5P_AT + 2 * idx + 1] = ti;
        bf16* BBH = (bf16*)(P + S5P_BBH); const int eg = idx >> 6, pp = idx & 63;
        for (int cc = 0; cc < 16; ++cc) { const float Br = B_re[idx * 16 + cc], Bi = B_im[idx * 16 + cc]; const float br = fre * Br - fim * Bi, bi = fre * Bi + fim * Br;
            P[S5P_BB + 2 * (idx * 16 + cc)] = br; P[S5P_BB + 2 * (idx * 16 + cc) + 1] = bi;
            BBH[(eg * 128 + pp) * 16 + cc] = (bf16)f2bf(br); BBH[(eg * 128 + 64 + pp) * 16 + cc] = (bf16)f2bf(bi); }
    }
}
DI void s5_load_u(const bf16* PROJ, int row0, int g, LAS float* U, int lane) {
    const bf16* p = PROJ + (size_t)(row0 + lane) * PROJW + 1792 + g * 16; float x[8];
    unpack8(*(const v4u*)p, x); ((LAS f32x4*)(U + lane * 16))[0] = (f32x4){x[0], x[1], x[2], x[3]}; ((LAS f32x4*)(U + lane * 16))[1] = (f32x4){x[4], x[5], x[6], x[7]};
    unpack8(*(const v4u*)(p + 8), x); ((LAS f32x4*)(U + lane * 16))[2] = (f32x4){x[0], x[1], x[2], x[3]}; ((LAS f32x4*)(U + lane * 16))[3] = (f32x4){x[4], x[5], x[6], x[7]};
}
DI void s5_frags(const bf16* PROJ, const float* P, int e, int g, int row0, int r16, int q4, bf16x8 (&ua)[4], bf16x8 (&bb)[8]) {
    const bf16x8 zf = {0, 0, 0, 0, 0, 0, 0, 0}; const bf16* BBH = (const bf16*)(P + S5P_BBH);
#pragma unroll
    for (int tf = 0; tf < 4; ++tf) ua[tf] = (q4 < 2) ? *(const bf16x8*)(PROJ + (size_t)(row0 + 16 * tf + r16) * PROJW + 1792 + g * 16 + 8 * q4) : zf;
#pragma unroll
    for (int pf = 0; pf < 8; ++pf) bb[pf] = (q4 < 2) ? *(const bf16x8*)(BBH + ((size_t)(e * 32 + g) * 128 + 16 * pf + r16) * 16 + 8 * q4) : zf;
}
DI void s5_bu16(const bf16x8 ua, const bf16x8 (&bb)[8], LAS float* BUs, int r16, int q4) {
    LAS float* wp = BUs + (4 * q4) * 128 + r16;
#pragma unroll
    for (int pf = 0; pf < 8; ++pf) { const f32x4 d = mfma16(ua, bb[pf], (f32x4){0.f, 0.f, 0.f, 0.f});
#pragma unroll
        for (int i = 0; i < 4; ++i) wp[i * 128 + 16 * pf] = d[i]; }
}
#define S5_BU(t) do { const LAS f32x4* up_ = (const LAS f32x4*)(U + (t) * 16); const f32x4 u0 = up_[0], u1 = up_[1], u2 = up_[2], u3 = up_[3]; \
    const float uu[16] = {u0.x, u0.y, u0.z, u0.w, u1.x, u1.y, u1.z, u1.w, u2.x, u2.y, u2.z, u2.w, u3.x, u3.y, u3.z, u3.w}; bur = 0.f; bui = 0.f; \
    _Pragma("unroll") for (int cc = 0; cc < 16; ++cc) { bur += bbr[cc] * uu[cc]; bui += bbi[cc] * uu[cc]; } } while (0)
DI void s5_phase1(const Ctx& c, int e, const bf16* PROJ, const float* P, float* S5E) {
    LAS float* U = (LAS float*)(c.lds + c.wave * 4096);
    const int NGW = c.G * 8, gw = c.vcu * 8 + c.wave;
    const bool reg = (NGW == 2 * 32 * S5NC / 4);
    int gcur = -1; float ar = 0.f, ai = 0.f, bbr[16], bbi[16];
#pragma unroll
    for (int cc = 0; cc < 16; ++cc) { bbr[cc] = 0.f; bbi[cc] = 0.f; }
    for (int it = 0;; ++it) {
        int wt; if (reg) { if (it >= 4) break; wt = (gw >> 5) * S5NC + (gw & 31) + 32 * it; } else { wt = gw + it * NGW; if (wt >= 2 * 32 * S5NC) break; }
        const int cch = wt & (S5NC - 1), bg = wt >> 7, g = bg & 31, b = bg >> 5, row0 = b * SEQ + cch * S5T, pi = (e * 32 + g) * 64 + c.lane;
        s5_load_u(PROJ, row0, g, U, c.lane);
        if (g != gcur) { gcur = g; ar = P[S5P_A + 2 * pi]; ai = P[S5P_A + 2 * pi + 1];
#pragma unroll
            for (int cc = 0; cc < 16; ++cc) { bbr[cc] = P[S5P_BB + 2 * (pi * 16 + cc)]; bbi[cc] = P[S5P_BB + 2 * (pi * 16 + cc) + 1]; } }
        LDS_WAIT();
        float xr = 0.f, xi = 0.f, bur, bui;
        for (int t = 0; t < S5T; ++t) { S5_BU(t); const float nxr = ar * xr - ai * xi + bur, nxi = ar * xi + ai * xr + bui; xr = nxr; xi = nxi; }
        *(f32x2*)(S5E + 2 * ((size_t)wt * 64 + c.lane)) = (f32x2){xr, xi};
        LDS_WAIT();
    }
}
DI void s5_phase2(const Ctx& c, int e, const float* P, float* S5E) {
    for (int sq = (c.G - 1 - c.vcu) * 512 + c.tid; sq < 2 * 32 * 64; sq += c.G * 512) {
        const int p = sq & 63, bg = sq >> 6, g = bg & 31, pi = (e * 32 + g) * 64 + p; const float tr = P[S5P_AT + 2 * pi], ti = P[S5P_AT + 2 * pi + 1];
        float xr = 0.f, xi = 0.f; f32x2* q0 = (f32x2*)(S5E + 2 * (((size_t)bg * S5NC) * 64 + p));
        for (int c0 = 0; c0 < S5NC; c0 += 16) {
            f32x2 ev[16];
#pragma unroll
            for (int j = 0; j < 16; ++j) ev[j] = q0[(c0 + j) * 64];
#pragma unroll
            for (int j = 0; j < 16; ++j) { q0[(c0 + j) * 64] = (f32x2){xr, xi}; const float nxr = tr * xr - ti * xi + ev[j].x, nxi = tr * xi + ti * xr + ev[j].y; xr = nxr; xi = nxi; }
        }
    }
}
DI void s5_phase3(const Ctx& c, int e, const bf16* PROJ, const float* P, const float* S5E, const float* C_re, const float* C_im, const float* Dp, bf16* Y) {
    LAS float* BUs = (LAS float*)(c.lds + c.wave * 12544);
    LAS unsigned char* XB = c.lds + c.wave * 12544 + 8192;
    const int NGW = c.G * 8, gw = c.vcu * 8 + c.wave; const int r16 = c.lane & 15, q4 = c.lane >> 4;
    const bool reg = (NGW == 2 * 32 * S5NC / 4);
    const bf16x8 zf = {0, 0, 0, 0, 0, 0, 0, 0};
    int gcur = -1; float ar = 0.f, ai = 0.f, Dg = 0.f; bf16x8 bb[8], cf[4];
#pragma unroll
    for (int pf = 0; pf < 8; ++pf) bb[pf] = zf;
#pragma unroll
    for (int ks = 0; ks < 4; ++ks) cf[ks] = zf;
    for (int it = 0;; ++it) {
        int wt; if (reg) { if (it >= 4) break; wt = (gw >> 5) * S5NC + (gw & 31) + 32 * it; } else { wt = gw + it * NGW; if (wt >= 2 * 32 * S5NC) break; }
        const int cch = wt & (S5NC - 1), bg = wt >> 7, g = bg & 31, b = bg >> 5, row0 = b * SEQ + cch * S5T, pi = (e * 32 + g) * 64 + c.lane;
        bf16x8 ua[4];
#pragma unroll
        for (int tf = 0; tf < 4; ++tf) ua[tf] = (q4 < 2) ? *(const bf16x8*)(PROJ + (size_t)(row0 + 16 * tf + r16) * PROJW + 1792 + g * 16 + 8 * q4) : zf;
        if (g != gcur) { gcur = g;
            const bf16* BBH = (const bf16*)(P + S5P_BBH);
#pragma unroll
            for (int pf = 0; pf < 8; ++pf) bb[pf] = (q4 < 2) ? *(const bf16x8*)(BBH + ((size_t)(e * 32 + g) * 128 + 16 * pf + r16) * 16 + 8 * q4) : zf;
            ar = P[S5P_A + 2 * pi]; ai = P[S5P_A + 2 * pi + 1];
            const size_t gi = ((size_t)(e * 32 + g) * 16 + r16) * 64 + 8 * q4;
#pragma unroll
            for (int ks = 0; ks < 4; ++ks) { const float* src = (ks < 2 ? C_re : C_im) + gi + 32 * (ks & 1); const float sg = ks < 2 ? 1.0f : -1.0f;
                const f32x4 x0 = *(const f32x4*)src, x1 = *(const f32x4*)(src + 4); cf[ks] = pack8(x0 * sg, x1 * sg); }
            Dg = Dp[(e * 32 + g) * 16 + r16]; }
        const f32x2 x0 = *(const f32x2*)(S5E + 2 * ((size_t)wt * 64 + c.lane));
        float xr = x0.x, xi = x0.y;
#pragma unroll
        for (int sc = 0; sc < 4; ++sc) {
            s5_bu16(ua[sc], bb, BUs, r16, q4);
            LDS_WAIT();
#pragma unroll
            for (int tt = 0; tt < 16; ++tt) { const float bur = BUs[tt * 128 + c.lane], bui = BUs[tt * 128 + 64 + c.lane]; const float nxr = ar * xr - ai * xi + bur, nxi = ar * xi + ai * xr + bui; xr = nxr; xi = nxi;
                *(LAS bf16*)(XB + tt * 272 + c.lane * 2) = (bf16)f2bf(xr); *(LAS bf16*)(XB + tt * 272 + 128 + c.lane * 2) = (bf16)f2bf(xi); }
            LDS_WAIT();
            f32x4 y = {0.f, 0.f, 0.f, 0.f};
#pragma unroll
            for (int ks = 0; ks < 4; ++ks) y = mfma16(*(const LAS bf16x8*)(XB + r16 * 272 + (32 * ks + 8 * q4) * 2), cf[ks], y);
#pragma unroll
            for (int i = 0; i < 4; ++i) { const int t = sc * 16 + 4 * q4 + i; const float yy = y[i] + Dg * bf2f(PROJ[(size_t)(row0 + t) * PROJW + 1792 + g * 16 + r16]);
                const float z = 0.7978845608f * (yy + 0.044715f * yy * yy * yy); const float th = 1.0f - 2.0f * __builtin_amdgcn_rcpf(__expf(2.0f * z) + 1.0f);
                Y[(size_t)(row0 + t) * 512 + g * 16 + r16] = (bf16)f2bf(0.5f * yy * (1.0f + th)); }
            LDS_WAIT();
        }
    }
}

constexpr int XA_KSLOT = 256 * 144, XA_VSLOT = 64 * 528, XA_VOFF = 2 * XA_KSLOT;
DI void xattn_unit(const Ctx& c, int uidx, int layer, const bf16* XQ, const bf16* MK, const bf16* MVT, bf16* XO) {
    const int h = uidx & 3, tile = uidx >> 2, b = tile >> 5, row0 = tile * 256;
    LAS unsigned char* KS = c.lds; LAS unsigned char* VS = c.lds + XA_VOFF;
    const int r16 = c.lane & 15, q4 = c.lane >> 4, w = c.wave;
    const bf16* kg = MK + (size_t)(b * 256) * 4096 + layer * 1024 + h * 256;
    const bf16* vg = MVT + (size_t)(layer * 1024 + h * 256) * 512 + b * 256;
    v4u st[4];
#define XA_LOADK(dc_) do { _Pragma("unroll") for (int i = 0; i < 4; ++i) { const int idx = c.tid + 512 * i; st[i] = *(const v4u*)(kg + (size_t)(idx >> 3) * 4096 + (dc_) * 64 + (idx & 7) * 8); } } while (0)
#define XA_STOREK(slot_) do { _Pragma("unroll") for (int i = 0; i < 4; ++i) { const int idx = c.tid + 512 * i; *(LAS v4u*)(KS + (slot_) * XA_KSLOT + (idx >> 3) * 144 + (idx & 7) * 16) = st[i]; } } while (0)
#define XA_LOADV(dc_) do { _Pragma("unroll") for (int i = 0; i < 4; ++i) { const int idx = c.tid + 512 * i; st[i] = *(const v4u*)(vg + (size_t)((dc_) * 64 + (idx >> 5)) * 512 + (idx & 31) * 8); } } while (0)
#define XA_STOREV(slot_) do { _Pragma("unroll") for (int i = 0; i < 4; ++i) { const int idx = c.tid + 512 * i; *(LAS v4u*)(VS + (slot_) * XA_VSLOT + (idx >> 5) * 528 + (idx & 31) * 16) = st[i]; } } while (0)
    __syncthreads();
    XA_LOADK(0); XA_STOREK(0);
    __syncthreads();
    f32x4 sa[16][2];
#pragma unroll
    for (int mf = 0; mf < 16; ++mf) { sa[mf][0] = (f32x4){0.f, 0.f, 0.f, 0.f}; sa[mf][1] = sa[mf][0]; }
    const bf16* qg = XQ + (size_t)(row0 + 32 * w + r16) * 1024 + h * 256 + 8 * q4;
#pragma unroll 1
    for (int dc = 0; dc < 4; ++dc) {
        bf16x8 qf[2][2];
#pragma unroll
        for (int tf = 0; tf < 2; ++tf)
#pragma unroll
            for (int ks = 0; ks < 2; ++ks) qf[tf][ks] = *(const bf16x8*)(qg + (size_t)(16 * tf) * 1024 + dc * 64 + ks * 32);
        if (dc < 3) XA_LOADK(dc + 1); else XA_LOADV(0);
        const LAS unsigned char* kc = KS + (dc & 1) * XA_KSLOT + r16 * 144 + 16 * q4;
#pragma unroll
        for (int mf = 0; mf < 16; ++mf)
#pragma unroll
            for (int ks = 0; ks < 2; ++ks) { const bf16x8 a = *(const LAS bf16x8*)(kc + mf * (16 * 144) + ks * 64);
                sa[mf][0] = mfma16(a, qf[0][ks], sa[mf][0]); sa[mf][1] = mfma16(a, qf[1][ks], sa[mf][1]); }
        if (dc < 3) XA_STOREK((dc + 1) & 1); else XA_STOREV(0);
        __syncthreads();
    }
    bf16x8 pp[8][2];
#pragma unroll
    for (int tf = 0; tf < 2; ++tf) {
        float m = sa[0][tf][0];
#pragma unroll
        for (int mf = 0; mf < 16; ++mf)
#pragma unroll
            for (int i = 0; i < 4; ++i) m = fmaxf(m, sa[mf][tf][i]);
        m = fmaxf(m, __shfl_xor(m, 16)); m = fmaxf(m, __shfl_xor(m, 32));
        float l = 0.f;
#pragma unroll
        for (int mf = 0; mf < 16; ++mf)
#pragma unroll
            for (int i = 0; i < 4; ++i) { const float p = __expf(sa[mf][tf][i] - m); sa[mf][tf][i] = p; l += p; }
        l += __shfl_xor(l, 16); l += __shfl_xor(l, 32);
        const float inv = 1.0f / l;
#pragma unroll
        for (int kk = 0; kk < 8; ++kk) pp[kk][tf] = pack8(sa[2 * kk][tf] * inv, sa[2 * kk + 1][tf] * inv);
    }
    bf16* og = XO + (size_t)(row0 + 32 * w + r16) * 1024 + h * 256 + 4 * q4;
#pragma unroll 1
    for (int dc = 0; dc < 4; ++dc) {
        if (dc < 3) XA_LOADV(dc + 1);
        f32x4 o[4][2];
#pragma unroll
        for (int df = 0; df < 4; ++df) { o[df][0] = (f32x4){0.f, 0.f, 0.f, 0.f}; o[df][1] = o[df][0]; }
        const LAS unsigned char* vc = VS + (dc & 1) * XA_VSLOT + r16 * 528 + 8 * q4;
#pragma unroll
        for (int kk = 0; kk < 8; ++kk)
#pragma unroll
            for (int df = 0; df < 4; ++df) { const v2u lo = *(const LAS v2u*)(vc + df * (16 * 528) + kk * 64), hi = *(const LAS v2u*)(vc + df * (16 * 528) + kk * 64 + 32);
                v4u aw; aw.x = lo.x; aw.y = lo.y; aw.z = hi.x; aw.w = hi.y; const bf16x8 a = __builtin_bit_cast(bf16x8, aw);
                o[df][0] = mfma16(a, pp[kk][0], o[df][0]); o[df][1] = mfma16(a, pp[kk][1], o[df][1]); }
#pragma unroll
        for (int tf = 0; tf < 2; ++tf)
#pragma unroll
            for (int df = 0; df < 4; ++df) { v2u ow; ow.x = pk2(o[df][tf][0], o[df][tf][1]); ow.y = pk2(o[df][tf][2], o[df][tf][3]); *(v2u*)(og + (size_t)(16 * tf) * 1024 + dc * 64 + 16 * df) = ow; }
        if (dc < 3) { XA_STOREV((dc + 1) & 1); __syncthreads(); }
    }
#undef XA_LOADK
#undef XA_STOREK
#undef XA_LOADV
#undef XA_STOREV
}

DI void rope_row(bf16* prow, const float* cA, const float* sA, const float* cI, const float* sI, int lane) {
    int c1[15], hf[15]; float x1[15], x2[15], cs[15], sn[15], sc[15];
#pragma unroll
    for (int k = 0; k < 15; ++k) {
        const int pi = lane + 64 * k; int i; bool tabA; sc[k] = 1.0f;
        if (pi < 512) { i = pi & 63; c1[k] = (pi >> 6) * 128 + i; hf[k] = 64; tabA = true; sc[k] = 0.08838834764831845f; }
        else if (pi < 640) { const int pp = pi - 512; i = pp & 63; c1[k] = 1024 + (pp >> 6) * 128 + i; hf[k] = 64; tabA = true; }
        else if (pi < 896) { const int pp = pi - 640; i = pp & 31; c1[k] = 1536 + (pp >> 5) * 64 + i; hf[k] = 32; tabA = false; }
        else { i = (pi - 896) & 31; c1[k] = 2048 + i; hf[k] = 32; tabA = false; }
        cs[k] = tabA ? cA[i] : cI[i]; sn[k] = tabA ? sA[i] : sI[i];
        x1[k] = bf2f(prow[c1[k]]); x2[k] = bf2f(prow[c1[k] + hf[k]]);
    }
#pragma unroll
    for (int k = 0; k < 15; ++k) { if (lane + 64 * k < 928) { prow[c1[k]] = (bf16)f2bf((x1[k] * cs[k] - x2[k] * sn[k]) * sc[k]); prow[c1[k] + hf[k]] = (bf16)f2bf((x2[k] * cs[k] + x1[k] * sn[k]) * sc[k]); } }
}
DI unsigned wave_select(LAS unsigned* buf, int count, int lane) {
    unsigned k[16];
#pragma unroll
    for (int j = 0; j < 16; ++j) { const int idx = j * 64 + lane; k[j] = idx < count ? buf[idx] : 0u; }
    unsigned tau = 0u;
    for (int bit = 31; bit >= 0; --bit) { const unsigned cand = tau | (1u << bit); int cn = 0;
#pragma unroll
        for (int j = 0; j < 16; ++j) cn += __popcll(__ballot(k[j] >= cand));
        if (cn >= TOPK) tau = cand;
        if (cn == TOPK) break; }
    int off = 0; const unsigned long long lt = (1ull << lane) - 1ull;
#pragma unroll
    for (int j = 0; j < 16; ++j) { const bool pred = k[j] >= tau; const unsigned long long bal = __ballot(pred); if (pred) buf[off + __popcll(bal & lt)] = k[j]; off += __popcll(bal); }
    LDS_WAIT();
    return tau;
}
constexpr int IDX_KT = 131072, IDX_KT_SLOT = 64 * 144, IDX_FL = IDX_KT + 2 * IDX_KT_SLOT;
#define IDX_BODY(slot_, kb_) do { \
    bf16x8 R[4][2]; \
    _Pragma("unroll") for (int jb = 0; jb < 4; ++jb) _Pragma("unroll") for (int ks = 0; ks < 2; ++ks) R[jb][ks] = *(const LAS bf16x8*)((slot_) + (16 * jb + r16) * 144 + (ks * 32 + 8 * q4) * 2); \
    f32x4 lo_[4], hi_[4]; \
    _Pragma("unroll") for (int jb = 0; jb < 4; ++jb) { lo_[jb] = (f32x4){0.f, 0.f, 0.f, 0.f}; hi_[jb] = lo_[jb]; \
        _Pragma("unroll") for (int ks = 0; ks < 2; ++ks) { lo_[jb] = mfma16(Alo[ks], R[jb][ks], lo_[jb]); hi_[jb] = mfma16(Ahi[ks], R[jb][ks], hi_[jb]); } } \
    const int rev0_ = 8191 - r16 - 16 * (kb_); \
    _Pragma("unroll") for (int jb = 0; jb < 4; ++jb) { \
        float s0_ = 0.f, s1_ = 0.f; \
        _Pragma("unroll") for (int i = 0; i < 4; ++i) { s0_ = fmaf(__int_as_float(max(__float_as_int(lo_[jb][i]), 0)), w[i], s0_); s1_ = fmaf(__int_as_float(max(__float_as_int(hi_[jb][i]), 0)), w[4 + i], s1_); } \
        const unsigned u_ = __float_as_uint(s0_ + s1_), mono_ = u_ ^ ((unsigned)((int)u_ >> 31) | 0x80000000u); \
        const int rev_ = rev0_ - 16 * jb; const unsigned key_ = (mono_ & 0xFFFFE000u) | (unsigned)rev_; \
        const bool pred_ = (rev_ >= revq) && (key_ > tau); \
        const unsigned long long bal_ = __ballot(pred_); const unsigned grp_ = (unsigned)(bal_ >> (16 * q4)) & 0xFFFFu; \
        if (MODE == 0) { if (pred_) mybuf[cnt + __popc(grp_ & lmask)] = key_; cnt += __popc(grp_); } else { chk ^= key_ & (pred_ ? 0xffffffffu : 0x0fu); } } } while (0)
template <int MODE> DI void dsa_index_unit(const Ctx& c, int uidx, const bf16* PROJ, unsigned short* SEL, int* SELN) {
    const int pr = uidx & 255, b = pr >> 7, jj = pr & 127, qblk = uidx < 256 ? jj : 255 - jj, t0 = qblk * 32;
    LAS unsigned* CAND = (LAS unsigned*)c.lds;
    LAS unsigned char* KT = c.lds + IDX_KT; LAS unsigned* FL = (LAS unsigned*)(c.lds + IDX_FL);
    const int r16 = c.lane & 15, q4 = c.lane >> 4;
    const bf16* qrowA = PROJ + (size_t)(b * SEQ + t0 + 4 * c.wave + (r16 >> 2)) * PROJW + 1536 + 8 * q4;
    bf16x8 Alo[2], Ahi[2];
#pragma unroll
    for (int ks = 0; ks < 2; ++ks) { Alo[ks] = *(const bf16x8*)(qrowA + (r16 & 3) * 64 + ks * 32); Ahi[ks] = *(const bf16x8*)(qrowA + ((r16 & 3) + 4) * 64 + ks * 32); }
    const int tq = t0 + 4 * c.wave + q4, revq = 8191 - tq; const unsigned lmask = (1u << r16) - 1u;
    float w[8]; unpack8(*(const v4u*)(PROJ + (size_t)(b * SEQ + tq) * PROJW + 2112), w);
#pragma unroll
    for (int j = 0; j < 8; ++j) w[j] *= 0.04419417382415922f;
    int cnt = 0; unsigned tau = 0u, chk = 0u;
    LAS unsigned* mybuf = CAND + (4 * c.wave + q4) * 1024;
    const int nit = (qblk >> 1) + 1;
    const bf16* ksrc = PROJ + (size_t)(b * SEQ + (c.tid >> 3)) * PROJW + 2048 + 8 * (c.tid & 7); const int kdst = (c.tid >> 3) * 144 + (c.tid & 7) * 16;
    __syncthreads();
    v4u pre = *(const v4u*)ksrc;
    *(LAS v4u*)(KT + kdst) = pre;
    if (nit > 1) pre = *(const v4u*)(ksrc + (size_t)64 * PROJW);
    for (int it = 0; it < nit; ++it) {
        LAS unsigned char* slot = KT + (it & 1) * IDX_KT_SLOT;
        { const unsigned long long nb = __ballot(cnt > 1024 - 64); if (c.lane == 0) FL[(it & 1) * 8 + c.wave] = nb != 0ull ? 1u : 0u; }
        __syncthreads();
        { const v4u f0 = *(const LAS v4u*)(FL + (it & 1) * 8), f1 = *(const LAS v4u*)(FL + (it & 1) * 8 + 4);
          if (MODE == 0 && (f0.x | f0.y | f0.z | f0.w | f1.x | f1.y | f1.z | f1.w)) {
#pragma unroll
              for (int g4 = 0; g4 < 4; ++g4) { const int cg = __shfl(cnt, 16 * g4); if (cg > TOPK) { const unsigned tn = wave_select(CAND + (4 * c.wave + g4) * 1024, cg, c.lane); if (q4 == g4) { tau = tn; cnt = TOPK; } } } } }
        IDX_BODY(slot, 4 * it);
        if (it + 1 < nit) { *(LAS v4u*)(KT + ((it + 1) & 1) * IDX_KT_SLOT + kdst) = pre; if (it + 2 < nit) pre = *(const v4u*)(ksrc + (size_t)(64 * (it + 2)) * PROJW); }
    }
    LDS_WAIT();
    if (MODE != 0) { if (chk == 0x12345u) SELN[uidx] = (int)chk; return; }
#pragma unroll
    for (int g4 = 0; g4 < 4; ++g4) {
        int cg = __shfl(cnt, 16 * g4); LAS unsigned* bufg = CAND + (4 * c.wave + g4) * 1024;
        if (cg > TOPK) { (void)wave_select(bufg, cg, c.lane); cg = TOPK; }
        const size_t qg = (size_t)(b * SEQ + t0 + 4 * c.wave + g4);
#pragma unroll
        for (int i = 0; i < 4; ++i) { const int slot = c.lane + 64 * i; if (slot < cg) SEL[qg * 256 + slot] = (unsigned short)(8191u - (bufg[slot] & 0x1FFFu)); }
        if (c.lane == 0) SELN[qg] = cg;
    }
    LDS_WAIT();
}
#define SB() __builtin_amdgcn_sched_barrier(0)
DI f32x4 mfma8(const v2u a, const v2u b, const f32x4 c) { return __builtin_amdgcn_mfma_f32_16x16x32_fp8_fp8(__builtin_bit_cast(long, a), __builtin_bit_cast(long, b), c, 0, 0, 0); }
#define DSA_QS 32.0f
#define DSA_RDW(pb_, tv_) asm volatile("s_waitcnt lgkmcnt(0)" : "+v"(pb_), "+v"(tv_[0]), "+v"(tv_[1]), "+v"(tv_[2]), "+v"(tv_[3]), "+v"(tv_[4]), "+v"(tv_[5]), "+v"(tv_[6]), "+v"(tv_[7]) : : "memory")
#define DSA_VWAIT(n) asm volatile("s_waitcnt vmcnt(" #n ")" ::: "memory")
#define DSA3_WS 17152
#define DSA3_KLD(dst_, off_, imm_, kb_) asm volatile("global_load_dwordx4 %0, %1, %2 offset:" #imm_ : "=&v"(dst_) : "v"(off_), "s"(kb_) : "memory")
#define DSA3_LOADK(dst, blk) do { const unsigned koff_ = kix[blk] * 128u + kofs; DSA3_KLD(dst[0][0], koff_, 0, k8g0); DSA3_KLD(dst[0][1], koff_, 64, k8g0); DSA3_KLD(dst[1][0], koff_, 0, k8g1); DSA3_KLD(dst[1][1], koff_, 64, k8g1); } while (0)
#define DSA3_KWAIT(n, dst) asm volatile("s_waitcnt vmcnt(" #n ")" : "+v"(dst[0][0]), "+v"(dst[0][1]), "+v"(dst[1][0]), "+v"(dst[1][1]) : : "memory")
#define DSA3_KPERM(dst) do { _Pragma("unroll") for (int kvi = 0; kvi < 2; ++kvi) _Pragma("unroll") for (int hf = 0; hf < 2; ++hf) { v4u w_ = dst[kvi][hf]; \
    w_.x = (unsigned)__builtin_amdgcn_ds_bpermute(kperm, (int)w_.x); w_.y = (unsigned)__builtin_amdgcn_ds_bpermute(kperm, (int)w_.y); w_.z = (unsigned)__builtin_amdgcn_ds_bpermute(kperm, (int)w_.z); w_.w = (unsigned)__builtin_amdgcn_ds_bpermute(kperm, (int)w_.w); \
    dst[kvi][hf] = w_; } } while (0)
#define DSA3_QK(blk, src) do { f32x4 a0_ = {0.f, 0.f, 0.f, 0.f}, a1_ = {0.f, 0.f, 0.f, 0.f}; __builtin_amdgcn_s_setprio(1);     \
    _Pragma("unroll") for (int ks = 0; ks < 4; ++ks) { const v4u w0_ = src[0][ks >> 1], w1_ = src[1][ks >> 1]; v2u p0_, p1_; p0_.x = (ks & 1) ? w0_.z : w0_.x; p0_.y = (ks & 1) ? w0_.w : w0_.y; p1_.x = (ks & 1) ? w1_.z : w1_.x; p1_.y = (ks & 1) ? w1_.w : w1_.y; \
        a0_ = mfma8(p0_, q2[0][ks], a0_); a1_ = mfma8(p1_, q2[1][ks], a1_); } __builtin_amdgcn_s_setprio(0); acc[blk] = a0_ + a1_; } while (0)
#define DSA3_DMAV(u_) do { _Pragma("unroll") for (int j = 0; j < 4; ++j) \
    __builtin_amdgcn_global_load_lds((const unsigned*)((((u_) & 1) ? v8b1 : v8b0) + vix[(u_) >> 1][j] * 128u + ((j & 1) ? vsw1 : vsw0)), (LAS unsigned*)(Vb + ((u_) % 3) * 4096 + j * 1024), 16, 0, 0); } while (0)
#define DSA3_RD(pb_, tv_, soff_, poff_) asm volatile( \
    "ds_read_b64 %0, %9 offset:%19\n\tds_read_b64_tr_b8 %1, %10 offset:%18\n\tds_read_b64_tr_b8 %2, %11 offset:%18\n\tds_read_b64_tr_b8 %3, %12 offset:%18\n\tds_read_b64_tr_b8 %4, %13 offset:%18\n\t" \
    "ds_read_b64_tr_b8 %5, %14 offset:%18\n\tds_read_b64_tr_b8 %6, %15 offset:%18\n\tds_read_b64_tr_b8 %7, %16 offset:%18\n\tds_read_b64_tr_b8 %8, %17 offset:%18" \
    : "=&v"(pb_), "=&v"(tv_[0]), "=&v"(tv_[1]), "=&v"(tv_[2]), "=&v"(tv_[3]), "=&v"(tv_[4]), "=&v"(tv_[5]), "=&v"(tv_[6]), "=&v"(tv_[7]) \
    : "v"(prdA), "v"(va[0]), "v"(va[1]), "v"(va[2]), "v"(va[3]), "v"(va[4]), "v"(va[5]), "v"(va[6]), "v"(va[7]), "i"(soff_), "i"(poff_) : "memory")
#define DSA3_PV(u_) do { v2u pA_, tA_[8]; DSA3_RD(pA_, tA_, ((u_) % 3) * 4096, 32 * ((u_) >> 1)); DSA_RDW(pA_, tA_); \
    v2u pm_; pm_.x = (((u_) & 1) == mykv) ? pA_.x : 0u; pm_.y = (((u_) & 1) == mykv) ? pA_.y : 0u; \
    __builtin_amdgcn_s_setprio(1); _Pragma("unroll") for (int nt = 0; nt < 8; ++nt) o[nt] = mfma8(tA_[nt], pm_, o[nt]); __builtin_amdgcn_s_setprio(0); } while (0)
template <int MODE> DI void dsa_attn_item(const Ctx& c, int qg, const bf16* PROJ, const unsigned char* K8, const unsigned char* V8, const unsigned short* SEL, const int* SELN, bf16* AO) {
    typedef const __attribute__((address_space(1))) char* gcp;
    LAS unsigned char* Vb = c.lds + c.wave * DSA3_WS; LAS unsigned char* Pb = Vb + 12288; LAS unsigned short* IDXw = (LAS unsigned short*)(Vb + 12288 + 4352);
    int ln = c.lane; asm volatile("" : "+v"(ln));
    const int b = qg >> 13, n = __builtin_amdgcn_readfirstlane(SELN[qg]); const int r16 = ln & 15, q4 = ln >> 4;
    { unsigned short sv[4];
#pragma unroll
      for (int i = 0; i < 4; ++i) sv[i] = SEL[(size_t)qg * 256 + ln + 64 * i];
#pragma unroll
      for (int i = 0; i < 4; ++i) { const int slot = ln + 64 * i; IDXw[slot] = slot < n ? sv[i] : (unsigned short)0; } }
    v2u q2[2][4];
#pragma unroll
    for (int ks = 0; ks < 4; ++ks) { const v4u w = *(const v4u*)(PROJ + (size_t)qg * PROJW + (r16 & 7) * 128 + 64 * (ks >> 1) + 16 * q4 + 8 * (ks & 1));
        v2u v_; v_.x = (r16 & 8) ? w.z : w.x; v_.y = (r16 & 8) ? w.w : w.y; const bool k0_ = (r16 & 4) == 0;
        q2[0][ks].x = k0_ ? v_.x : 0u; q2[0][ks].y = k0_ ? v_.y : 0u; q2[1][ks].x = k0_ ? 0u : v_.x; q2[1][ks].y = k0_ ? 0u : v_.y; }
    LDS_WAIT();
    unsigned kix[16], vix[8][4];
#pragma unroll
    for (int blk = 0; blk < 16; ++blk) kix[blk] = IDXw[16 * blk + (ln >> 2)];
#pragma unroll
    for (int cc = 0; cc < 8; ++cc)
#pragma unroll
        for (int j = 0; j < 4; ++j) vix[cc][j] = IDXw[32 * cc + 8 * j + (ln >> 3)];
    LDS_WAIT(); SB();
    const size_t pl0 = (size_t)(b * 2) * SEQ * 128, pl1 = pl0 + (size_t)SEQ * 128;
    const gcp k8g0 = (gcp)((const char*)K8 + pl0), k8g1 = (gcp)((const char*)K8 + pl1); const char* v8b0 = (const char*)V8 + pl0; const char* v8b1 = (const char*)V8 + pl1;
    const unsigned kofs = (unsigned)(16 * (ln & 3)); const int kperm = 4 * (4 * r16 + q4);
    const unsigned vsw0 = 16u * (unsigned)((ln & 7) ^ (ln >> 4)), vsw1 = 16u * (unsigned)((ln & 7) ^ ((ln >> 4) | 4));
    DSA3_DMAV(0); SB(); DSA3_DMAV(1); SB(); DSA3_DMAV(2); SB();
    f32x4 acc[16]; v4u kA[2][2], kB[2][2], kC[2][2];
    DSA3_LOADK(kA, 0); DSA3_LOADK(kB, 1); DSA3_LOADK(kC, 2); SB();
#define DSA3_STEP(blk, kk, w_) do { DSA3_KWAIT(w_, kk); SB(); DSA3_KPERM(kk); DSA3_QK(blk, kk); SB(); if ((blk) + 3 < 16) { DSA3_LOADK(kk, (blk) + 3); SB(); } } while (0)
    DSA3_STEP(0, kA, 8); DSA3_STEP(1, kB, 8); DSA3_STEP(2, kC, 8); DSA3_STEP(3, kA, 8); DSA3_STEP(4, kB, 8); DSA3_STEP(5, kC, 8); DSA3_STEP(6, kA, 8); DSA3_STEP(7, kB, 8);
    DSA3_STEP(8, kC, 8); DSA3_STEP(9, kA, 8); DSA3_STEP(10, kB, 8); DSA3_STEP(11, kC, 8); DSA3_STEP(12, kA, 8); DSA3_STEP(13, kB, 8); DSA3_STEP(14, kC, 4); DSA3_STEP(15, kA, 0);
    float m = -3.0e38f; const int nq = n - 4 * q4; const float cexp = 1.4426950408889634f / DSA_QS;
#pragma unroll
    for (int kb = 0; kb < 16; ++kb)
#pragma unroll
        for (int i = 0; i < 4; ++i) { const bool ok = (16 * kb + i) < nq; const float s_ = acc[kb][i] + __int_as_float(__builtin_amdgcn_update_dpp(0, __float_as_int(acc[kb][i]), 0x128, 0xf, 0xf, false));
            acc[kb][i] = ok ? s_ : -3.0e38f; m = fmaxf(m, acc[kb][i]); }
    m = fmaxf(m, __shfl_xor(m, 16)); m = fmaxf(m, __shfl_xor(m, 32));
    float l = 0.f; const float mc = 8.0f - m * cexp;
#pragma unroll
    for (int kb = 0; kb < 16; ++kb)
#pragma unroll
        for (int i = 0; i < 4; ++i) { const float p = __builtin_amdgcn_exp2f(fmaf(acc[kb][i], cexp, mc)); acc[kb][i] = p; l += p; }
    l += __shfl_xor(l, 16); l += __shfl_xor(l, 32);
    const float oscale = 1.0f / l;
    if (r16 < 8) {
        LAS unsigned char* pwl = Pb + 272 * r16 + 4 * q4; asm volatile("" : "+v"(pwl));
#pragma unroll
        for (int kb = 0; kb < 16; ++kb) {
            const float p0 = acc[kb][0], p1 = acc[kb][1], p2 = acc[kb][2], p3 = acc[kb][3];
            int wh = 0; wh = __builtin_amdgcn_cvt_pk_fp8_f32(p0, p1, wh, false); wh = __builtin_amdgcn_cvt_pk_fp8_f32(p2, p3, wh, true);
            const f32x2 d0 = __builtin_amdgcn_cvt_pk_f32_fp8(wh, false), d1 = __builtin_amdgcn_cvt_pk_f32_fp8(wh, true);
            int wl = 0; wl = __builtin_amdgcn_cvt_pk_fp8_f32(p0 - d0.x, p1 - d0.y, wl, false); wl = __builtin_amdgcn_cvt_pk_fp8_f32(p2 - d1.x, p3 - d1.y, wl, true);
            *(LAS int*)(pwl + 16 * kb) = wh; *(LAS int*)(pwl + 2176 + 16 * kb) = wl; }
    }
    unsigned va[8];
    { const unsigned q_ = (unsigned)(r16 >> 1), rel = 128u * (8u * (unsigned)q4 + q_) + 8u * (unsigned)(ln & 1) + 16u * ((((unsigned)q4 & 1u) << 2) | (q_ >> 1)); const unsigned vb_ = (unsigned)(size_t)Vb;
#pragma unroll
      for (int nt = 0; nt < 8; ++nt) va[nt] = vb_ + (rel ^ (16u * (unsigned)nt)); }
    const unsigned prdA = (unsigned)(size_t)(Pb + 2176 * (r16 >> 3) + 272 * (r16 & 7) + 8 * q4); const int mykv = (r16 >> 2) & 1;
    f32x4 o[8];
#pragma unroll
    for (int nt = 0; nt < 8; ++nt) o[nt] = (f32x4){0.f, 0.f, 0.f, 0.f};
    LDS_WAIT(); SB();
#pragma unroll
    for (int u = 0; u < 16; ++u) {
        if (u < 14) DSA_VWAIT(8); else if (u == 14) DSA_VWAIT(4); else DSA_VWAIT(0);
        SB(); DSA3_PV(u); SB();
        if (u + 3 < 16) { LDS_WAIT(); SB(); DSA3_DMAV(u + 3); SB(); }
    }
#pragma unroll
    for (int nt = 0; nt < 8; ++nt)
#pragma unroll
        for (int i = 0; i < 4; ++i) o[nt][i] += __int_as_float(__builtin_amdgcn_update_dpp(0, __float_as_int(o[nt][i]), 0x128, 0xf, 0xf, false));
    if (r16 < 8) {
        bf16* op = AO + (size_t)qg * 1024 + r16 * 128 + 4 * q4;
#pragma unroll
        for (int nt = 0; nt < 8; ++nt) { v2u w; w.x = pk2(o[nt][0] * oscale, o[nt][1] * oscale); w.y = pk2(o[nt][2] * oscale, o[nt][3] * oscale); *(v2u*)(op + 16 * nt) = w; }
    }
    LDS_WAIT();
}
template <int MODE> DI void dsa_attn_phase(const Ctx& c, const bf16* PROJ, const unsigned char* K8, const unsigned char* V8, const unsigned short* SEL, const int* SELN, bf16* AO) {
    for (int x = c.vcu * 8 + c.wave; x < MTOK; x += c.G * 8) dsa_attn_item<MODE>(c, x, PROJ, K8, V8, SEL, SELN, AO);
}

#ifndef SKIPM
#define SKIPM 0
#endif
#ifndef PROBE_IDX_MODE
#define PROBE_IDX_MODE 0
#endif
#ifndef PROBE_ATTN_MODE
#define PROBE_ATTN_MODE 0
#endif
#ifndef PROBE_MASK
#define PROBE_MASK 0u
#endif
struct Args { const float* in[36]; float* out; unsigned char* ws; int ph_lo, ph_hi, li, pad; };
enum { I_X = 0, I_MEM, I_POS, I_F1N, I_F1G, I_F1U, I_F1D, I_MIXN, I_EVIN, I_EVOUT, I_GLAWA, I_GLABA, I_GLAN, I_S5LR, I_S5LI, I_S5DT, I_S5BR, I_S5BI, I_S5CR, I_S5CI, I_S5D, I_S5WG, I_S5BG,
       I_ODIN, I_ODOUT, I_XAN, I_MEMNORM, I_XAWQ, I_XAWK, I_XAWV, I_XAWO, I_F2N, I_F2G, I_F2U, I_F2D, I_FINN };

#define GEMM_CALL(EPI, A_, Bt_, M_, N_, K_, E_) do { const pg8::Gemm g_{(const pg8::bf16_t*)(A_), (const pg8::bf16_t*)(Bt_), (M_), (N_), (K_)}; typedef pg8::TileOrder<(M_) / 256, (N_) / 256> Ord_; Ord_ S_; S_.G = c.G; S_.c = (int)blockIdx.x; \
    pg8::gemm_phase<EPI, Ord_, true, true>(c.lds, g_, S_, (E_), MYTID()); } while (0)

#define RSL_PTR() ((const PG8_LAS float*)(c.lds + RING_BYTES))
#define GEMM_CALL_RS(EPI, A_, Bt_, M_, N_, K_, E_) do { const pg8::Gemm g_{(const pg8::bf16_t*)(A_), (const pg8::bf16_t*)(Bt_), (M_), (N_), (K_)}; typedef pg8::TileOrder<(M_) / 256, (N_) / 256> Ord_; Ord_ S_; S_.G = c.G; S_.c = (int)blockIdx.x; \
    { const int t_ = MYTID(); LAS float* rsl_ = (LAS float*)(c.lds + RING_BYTES); \
      for (int i0_ = 0; ; i0_ += 2) { pg8::Unit u0_; if (!S_.next(i0_, u0_)) break; pg8::Unit u_; const int i_ = i0_ + (t_ >> 8); \
          if (S_.next(i_, u_)) { const f32x4* sp_ = (const f32x4*)(SS + (size_t)(u_.pm * 256 + (t_ & 255)) * 16); const f32x4 a0_ = sp_[0], a1_ = sp_[1], a2_ = sp_[2], a3_ = sp_[3]; \
              const f32x4 q_ = (a0_ + a1_) + (a2_ + a3_); rsl_[i_ * 256 + (t_ & 255)] = rsqrtf(((q_[0] + q_[1]) + (q_[2] + q_[3])) * (1.0f / 1024.0f) + EPS); } } \
      __syncthreads(); } \
    pg8::gemm_phase<EPI, Ord_, true, true>(c.lds, g_, S_, (E_), MYTID()); } while (0)

#define MK_GAS __attribute__((address_space(1)))
DI unsigned char* launder_ptr(unsigned char* p) { MK_GAS unsigned char* g = (MK_GAS unsigned char*)p; asm volatile("" : "+s"(g)); return (unsigned char*)g; }
DI const float* gin_(const float* p) { MK_GAS const float* g = (MK_GAS const float*)p; asm volatile("" : "+s"(g)); return (const float*)g; }
DI float* gout_(float* p) { MK_GAS float* g = (MK_GAS float*)p; asm volatile("" : "+s"(g)); return (float*)g; }
#define AIN(k) gin_(a.in[launder_idx(k)])
DI int launder_idx(int i) { asm volatile("" : "+s"(i)); return i; }
#define DECL_PTRS() float* H = (float*)(ws + WS_H); bf16* HB = (bf16*)(ws + WS_HB); float* SS = (float*)(ws + WS_SS); \
    float* COSA = (float*)(ws + WS_COSA); float* SINA = (float*)(ws + WS_SINA); float* COSI = (float*)(ws + WS_COSI); float* SINI = (float*)(ws + WS_SINI); \
    bf16* MEMN = (bf16*)(ws + WS_MEMN); bf16* MK = (bf16*)(ws + WS_MK); bf16* MVT = (bf16*)(ws + WS_MVT); float* S5P = (float*)(ws + WS_S5P); \
    unsigned char* scr = ws + WS_SCR; \
    bf16* HID = (bf16*)(scr + SC_HID); bf16* PROJ = (bf16*)(scr + SC_PROJ); bf16* XQ = (bf16*)(scr + SC_XQ); bf16* XO = (bf16*)(scr + SC_XO); bf16* KVW = (bf16*)(scr + SC_KVW); \
    float* DS = (float*)(scr + SC_DS); float* BCg = (float*)(scr + SC_BC); float* DEC = (float*)(scr + SC_DEC); float* S5E = (float*)(scr + SC_S5E); \
    bf16* Y = (bf16*)(scr + SC_Y); bf16* CAT = (bf16*)(scr + SC_CAT); unsigned short* SEL = (unsigned short*)(scr + SC_SEL); int* SELN = (int*)(scr + SC_SELN); \
    unsigned char* W = ws + WS_W; \
    bf16* Wgu1 = (bf16*)(W + WO_GU1); bf16* Wd1 = (bf16*)(W + WO_D1); bf16* Win = (bf16*)(W + WO_IN); bf16* Wout = (bf16*)(W + WO_OUT); bf16* Wglu = (bf16*)(W + WO_GLU); \
    bf16* Wxq = (bf16*)(W + WO_XQ); bf16* Wxo = (bf16*)(W + WO_XO); bf16* Wgu2 = (bf16*)(W + WO_GU2); bf16* Wd2 = (bf16*)(W + WO_D2);
#define CVT_LAYER_BODY() do { const size_t fo = (size_t)l * DM * DFF; cvt_job_gu(c, AIN(I_F1G) + fo, AIN(I_F1U) + fo, AIN(I_F1N) + l * DM, Wgu1, 0); cvt_job(c, AIN(I_F1D) + fo, DM, 0, DM, nullptr, Wd1, DFF, DM, 0, 512); if (even) { const float* win = AIN(I_EVIN) + (size_t)e * DM * EV_IN; const float* gn = AIN(I_MIXN) + l * DM; cvt_job(c, win, EV_IN, 0, 1536, gn, Win, DM, 1536, 0, 1024); cvt_job_comb(c, win, AIN(I_GLAWA) + e * 16 * 256, gn, Win, 1536, 1536); cvt_job(c, win, EV_IN, 1552, 512, gn, Win, DM, 512, 1792, 1664); cvt_job(c, AIN(I_EVOUT) + (size_t)e * DM * DM, DM, 0, DM, nullptr, Wout, DM, DM, 0, 256); cvt_job(c, AIN(I_S5WG) + (size_t)e * 512 * 512, 512, 0, 512, nullptr, Wglu, 512, 512, 0, 1920); } else { cvt_job_rope(c, AIN(I_ODIN) + (size_t)e * DM * OD_IN, AIN(I_MIXN) + l * DM, Win, 1024); cvt_job(c, AIN(I_ODOUT) + (size_t)e * DM * DM, DM, 0, DM, nullptr, Wout, DM, DM, 0, 256); } cvt_job(c, AIN(I_XAWQ) + (size_t)l * DM * DM, DM, 0, DM, AIN(I_XAN) + l * DM, Wxq, DM, DM, 0, 768); cvt_job(c, AIN(I_XAWO) + (size_t)l * DM * DM, DM, 0, DM, nullptr, Wxo, DM, DM, 0, 1280); cvt_job_gu(c, AIN(I_F2G) + fo, AIN(I_F2U) + fo, AIN(I_F2N) + l * DM, Wgu2, 1024); cvt_job(c, AIN(I_F2D) + fo, DM, 0, DM, nullptr, Wd2, DFF, DM, 0, 1536); } while (0)
__global__ void __launch_bounds__(512, 2) mk_fwd(Args a) {
    extern __shared__ __attribute__((aligned(16))) unsigned char lds_raw[];
    Ctx c; c.lds = (LAS unsigned char*)lds_raw;
    c.tid = threadIdx.x; c.lane = c.tid & 63; c.wave = __builtin_amdgcn_readfirstlane(c.tid >> 6);
    const unsigned wave_s = (unsigned)c.wave;
    c.G = gridDim.x; { const int bx = blockIdx.x; c.vcu = (c.G % 8 == 0) ? (bx % 8) * (c.G / 8) + bx / 8 : bx; }
    for (int u = c.tid; u < (LDS_BYTES - LDSCTL_OFF) / 4; u += 512) ((LAS unsigned*)(c.lds + LDSCTL_OFF))[u] = 0u;
    __syncthreads();
    unsigned char* ws0 = a.ws;
    const int lo = a.ph_lo, hi = a.ph_hi;
    XcdBarrier bar; bar.bar = (unsigned*)(ws0 + WS_CTL) + CW_BAR + a.li * XCD_BAR_WORDS; bar.x = 0; bar.st = (volatile LAS unsigned*)(c.lds + LDSCTL_OFF);
    if (hi - lo > 1) bar = xcd_barrier_post(bar.bar, (volatile LAS unsigned*)(c.lds + LDSCTL_OFF));
#define IN(k) (launder_idx(lo) <= (k) && (k) < launder_idx(hi))
#define MYTID() ((int)(wave_s * 64u + __builtin_amdgcn_mbcnt_hi(~0u, __builtin_amdgcn_mbcnt_lo(~0u, 0u))))
#define FRESH() do { int t_ = MYTID(); asm volatile("" : "+v"(t_)); c.tid = t_; c.lane = t_ & 63; c.wave = (int)wave_s; } while (0)
#define SEAM(k) do { if (IN(k) && IN((k) + 1)) xcd_barrier(bar); } while (0)
    const int NGW = c.G * 8, gw = c.vcu * 8 + c.wave;

#define PHASE(k, q, ...) do { if (IN(k)) { { const bool dup_ = false; (void)dup_; unsigned char* ws = launder_ptr(a.ws); DECL_PTRS(); __VA_ARGS__ } if ((PROBE_MASK >> (q)) & 1u) { xcd_barrier(bar); { const bool dup_ = true; (void)dup_; unsigned char* ws = launder_ptr(a.ws); DECL_PTRS(); __VA_ARGS__ } } } SEAM(k); } while (0)
    PHASE(0, 30, {
        FRESH();
        const int* pos = (const int*)AIN(I_POS);
        for (int e = c.vcu * 512 + c.tid; e < MTOK * 96; e += c.G * 512) {
            if (e < MTOK * 64) { const int tok = e >> 6, i = e & 63; const float inv = powf(10000.0f, -(float)(2 * i) / 128.0f), ang = (float)pos[tok] * inv; COSA[e] = cosf(ang); SINA[e] = sinf(ang); }
            else { const int e2 = e - MTOK * 64, tok = e2 >> 5, i = e2 & 31; const float inv = powf(10000.0f, -(float)(2 * i) / 64.0f), ang = (float)pos[tok] * inv; COSI[e2] = cosf(ang); SINI[e2] = sinf(ang); }
        }
        for (int m = gw; m < MTOK; m += NGW) row_init(AIN(I_X) + (size_t)m * DM, HB + (size_t)m * DM, SS + (size_t)m * 16, c.lane);
        for (int m = gw; m < NB * NMEM; m += NGW) row_norm_bf16(AIN(I_MEM) + (size_t)m * DM, AIN(I_MEMNORM), MEMN + (size_t)m * DM, c.lane);
        for (int l = 0; l < DEPTH; ++l) {
            cvt_job(c, AIN(I_XAWK) + (size_t)l * DM * DM, DM, 0, DM, nullptr, KVW, DM, DM, l * DM, l * 256);
            cvt_job(c, AIN(I_XAWV) + (size_t)l * DM * DM, DM, 0, DM, nullptr, KVW + (size_t)4096 * DM, DM, DM, l * DM, l * 256 + 128);
        }
        s5_params(c, AIN(I_S5LR), AIN(I_S5LI), AIN(I_S5DT), AIN(I_S5BR), AIN(I_S5BI), S5P);
        { const int l = 0, e = 0; const bool even = true; CVT_LAYER_BODY(); }
    });
#pragma clang loop unroll(full)
    for (int l = 0; l < DEPTH; ++l) {
        const int pb = PH_LAYER0 + l * PH_PER_LAYER, e = l >> 1; const bool even = (l & 1) == 0;
        if (l > 0) PHASE(pb + 0, 0, { FRESH(); CVT_LAYER_BODY(); });
#define MEMKV_TAIL() if (l == 0) { const int bx_ = (int)blockIdx.x - ((MTOK / 256) * (2 * DFF / 256) - 5 * c.G);     \
            { const pg8::Gemm g{(const pg8::bf16_t*)MEMN, (const pg8::bf16_t*)KVW, 512, 4096, 1024}; typedef pg8::TileOrder<2, 16> Ord; Ord S; S.G = c.G; S.c = (c.G == 256) ? bx_ : (int)blockIdx.x; \
              const pg8::EpiScaleBf16<false> E2{(pg8::bf16_t*)MK, 4096, nullptr, 1.0f}; pg8::gemm_phase<pg8::EpiScaleBf16<false>, Ord, true, true>(c.lds, g, S, E2, MYTID()); } \
            { const pg8::Gemm g{(const pg8::bf16_t*)(KVW + (size_t)4096 * DM), (const pg8::bf16_t*)MEMN, 4096, 512, 1024}; typedef pg8::TileOrder<16, 2> Ord; Ord S; S.G = c.G; S.c = ((c.G == 256) ? bx_ : (int)blockIdx.x) - 32; \
              const pg8::EpiScaleBf16<false> E2{(pg8::bf16_t*)MVT, 512, nullptr, 1.0f}; pg8::gemm_phase<pg8::EpiScaleBf16<false>, Ord, true, true>(c.lds, g, S, E2, MYTID()); } }
        PHASE(pb + 1, 1, { const pg8::EpiSwiGLU E{(pg8::bf16_t*)HID, DFF, RSL_PTR()}; GEMM_CALL_RS(pg8::EpiSwiGLU, HB, Wgu1, MTOK, 2 * DFF, DM, E); MEMKV_TAIL(); });
        PHASE(pb + 2, 2, { const pg8::EpiResid E{(pg8::bf16_t*)HB, SS, dup_ ? 0.f : 0.5f}; GEMM_CALL(pg8::EpiResid, HID, Wd1, MTOK, DM, DFF, E); });
        if (even) PHASE(pb + 3, 3, { const pg8::EpiScaleBf16<true> E{(pg8::bf16_t*)PROJ, PROJW, RSL_PTR(), 1.0f}; GEMM_CALL_RS(pg8::EpiScaleBf16<true>, HB, Win, MTOK, PROJW, DM, E); });
        else PHASE(pb + 3, 3, { const pg8::EpiRope E{(pg8::bf16_t*)PROJ, RSL_PTR(), COSA, SINA, COSI, SINI, scr + SC_K8, scr + SC_V8}; GEMM_CALL_RS(pg8::EpiRope, HB, Win, MTOK, PROJW, DM, E); });
        if (even) {
            PHASE(pb + 4, 4, {
                FRESH();
                for (int u = c.vcu; u < 1024; u += c.G) gla1_unit(c, u, PROJ, AIN(I_GLABA) + e * 256, DS, BCg, DEC);
                s5_phase1(c, e, PROJ, S5P, S5E);
            });
            PHASE(pb + 5, 29, { FRESH(); gla2_scan(c, DS, DEC); s5_phase2(c, e, S5P, S5E); });
            PHASE(pb + 6, 6, {
                FRESH();
                for (int u = c.vcu; u < 1024; u += c.G) gla3_unit(c, u, PROJ, BCg, DS, AIN(I_GLAN) + e * 128, CAT);
                s5_phase3(c, e, PROJ, S5P, S5E, AIN(I_S5CR), AIN(I_S5CI), AIN(I_S5D), Y);
            });
            PHASE(pb + 7, 7, { const pg8::EpiGLU E{(const pg8::bf16_t*)Y, AIN(I_S5BG) + e * 512, (pg8::bf16_t*)CAT}; GEMM_CALL(pg8::EpiGLU, Y, Wglu, MTOK, 512, 512, E); });
        } else {
            PHASE(pb + 5, 15, { FRESH(); if (!dup_) { for (int u = c.vcu; u < 512; u += c.G) dsa_index_unit<0>(c, u, PROJ, SEL, SELN); } else { for (int u = c.vcu; u < 512; u += c.G) dsa_index_unit<PROBE_IDX_MODE>(c, u, PROJ, (unsigned short*)(scr + 81 * MiB), (int*)(scr + 90 * MiB)); } });
            PHASE(pb + 6, 16, { FRESH(); if (!dup_) dsa_attn_phase<0>(c, PROJ, scr + SC_K8, scr + SC_V8, SEL, SELN, CAT); else dsa_attn_phase<PROBE_ATTN_MODE>(c, PROJ, scr + SC_K8, scr + SC_V8, SEL, SELN, (bf16*)(scr + 100 * MiB)); });
        }
        PHASE(pb + 8, 8, { const pg8::EpiResid E{(pg8::bf16_t*)HB, SS, dup_ ? 0.f : 1.0f}; GEMM_CALL(pg8::EpiResid, CAT, Wout, MTOK, DM, DM, E); });
        PHASE(pb + 9, 9, { const pg8::EpiScaleBf16<true> E{(pg8::bf16_t*)XQ, DM, RSL_PTR(), 0.0625f}; GEMM_CALL_RS(pg8::EpiScaleBf16<true>, HB, Wxq, MTOK, DM, DM, E); });
        PHASE(pb + 10, 10, { FRESH(); for (int u = c.vcu; u < 256; u += c.G) xattn_unit(c, u, l, XQ, MK, MVT, XO); });
        PHASE(pb + 11, 11, { const pg8::EpiResid E{(pg8::bf16_t*)HB, SS, dup_ ? 0.f : 1.0f}; GEMM_CALL(pg8::EpiResid, XO, Wxo, MTOK, DM, DM, E); });
        PHASE(pb + 12, 12, { const pg8::EpiSwiGLU E{(pg8::bf16_t*)HID, DFF, RSL_PTR()}; GEMM_CALL_RS(pg8::EpiSwiGLU, HB, Wgu2, MTOK, 2 * DFF, DM, E); });
        PHASE(pb + 13, 13, { const pg8::EpiResid E{(pg8::bf16_t*)HB, SS, dup_ ? 0.f : 0.5f}; GEMM_CALL(pg8::EpiResid, HID, Wd2, MTOK, DM, DFF, E); });
    }
    if (IN(PH_FINAL)) { FRESH(); unsigned char* ws = launder_ptr(a.ws); DECL_PTRS(); for (int m = gw; m < MTOK; m += NGW) row_final(HB + (size_t)m * DM, SS + (size_t)m * 16, AIN(I_FINN), gout_(a.out) + (size_t)m * DM, c.lane); }
#undef PHASE
#undef IN
#undef SEAM
}

#ifndef MK_ONE_LAUNCH
#define MK_ONE_LAUNCH 1
#endif
extern "C" void kernel_launch(void* const* d_in, const int* in_sizes, int n_in, void* d_out, int out_size, void* d_ws, size_t ws_size, hipStream_t stream) {
    static int grid = 0;
    if (grid == 0) {
        if (n_in != 36 || out_size != MTOK * DM || ws_size < WS_END) { fprintf(stderr, "kernel_launch: unexpected shapes (n_in %d out %d ws %zu)\n", n_in, out_size, ws_size); grid = -1; return; }
        int dev = 0, cus = 0, per_cu = 0;
        if (hipGetDevice(&dev) != hipSuccess || hipDeviceGetAttribute(&cus, hipDeviceAttributeMultiprocessorCount, dev) != hipSuccess) { grid = -1; return; }
        if (hipFuncSetAttribute((const void*)mk_fwd, hipFuncAttributeMaxDynamicSharedMemorySize, LDS_BYTES) != hipSuccess) { fprintf(stderr, "kernel_launch: hipFuncSetAttribute failed\n"); grid = -1; return; }
        if (hipOccupancyMaxActiveBlocksPerMultiprocessor(&per_cu, (const void*)mk_fwd, 512, LDS_BYTES) != hipSuccess || per_cu < 1) fprintf(stderr, "kernel_launch: occupancy query reports %d\n", per_cu);
        (void)hipGetLastError();
        grid = cus;
    }
    if (grid < 0) return;
    (void)hipMemsetAsync((char*)d_ws + WS_CTL, 0, CTL_ZERO_BYTES, stream);
    Args a{};
    for (int i = 0; i < 36; ++i) a.in[i] = (const float*)d_in[i];
    a.out = (float*)d_out; a.ws = (unsigned char*)d_ws; a.pad = 0;
#if MK_ONE_LAUNCH
    a.ph_lo = 0; a.ph_hi = N_PHASES; a.li = 0;
    hipLaunchKernelGGL(mk_fwd, dim3(grid), dim3(512), LDS_BYTES, stream, a);
#else
    for (int p = 0; p < N_PHASES; ++p) {
        if (p >= PH_LAYER0 && p < PH_FINAL) { const int l = (p - PH_LAYER0) / PH_PER_LAYER, q = (p - PH_LAYER0) % PH_PER_LAYER; if ((l & 1) && q == 7) continue; }
        a.ph_lo = p; a.ph_hi = p + 1; a.li = 0;
        hipLaunchKernelGGL(mk_fwd, dim3(grid), dim3(512), LDS_BYTES, stream, a);
    }
#endif
}
```

```cpp
#include <hip/hip_runtime.h>
#include <cstdio>
#include <cstdint>
namespace pg8 {
#define PG8_LAS __attribute__((address_space(3)))
typedef unsigned short bf16_t;
typedef short bf16x8 __attribute__((ext_vector_type(8)));
typedef float f32x4 __attribute__((ext_vector_type(4)));
typedef unsigned u32x4 __attribute__((ext_vector_type(4)));
constexpr int BM = 256, BK = 64, HALF = 128, HTB = HALF * BK * 2  , STAGE_BYTES = 8 * HTB, NXCD = 8, WGM = 8;

__host__ __device__ __forceinline__ int lds_byte(int r, int c) { const int st = (r >> 4) * 2 + (c >> 5), rr = r & 15, cc = c & 31, ob = rr * 64 + cc * 2; return st * 1024 + (ob ^ (((ob >> 9) & 1) << 5)); }
__host__ __device__ __forceinline__ void stage_rc(int b, int& R, int& C) { const int st = b / 1024, sb = b % 1024, swz = sb ^ (((sb >> 9) & 1) << 5); R = (st >> 1) * 16 + swz / 64; C = (st & 1) * 32 + (swz % 64) / 2; }
__host__ __device__ __forceinline__ int perm32(int rho) { const int n = rho >> 4, i = rho & 15; return 8 * (i >> 2) + 4 * n + (i & 3); }

struct Unit { int pm, pn, ui; };
struct Gemm { const bf16_t* A; const bf16_t* Bt; int M, N, K; };

struct StaticOrder {
    int nM, nN, nwg, G, c;
    __host__ __device__ void init(int M, int N, int G_, int c_) { nM = M / BM; nN = N / BM; nwg = nM * nN; G = G_; c = c_; }
    __host__ __device__ bool next(int i, Unit& u) const {
        const long L = (long)i * G + c; if (L >= nwg) return false;
        int wgid = (int)L; { const int q = nwg / NXCD, r = nwg % NXCD, xcd = wgid % NXCD, off = wgid / NXCD; wgid = (xcd < r ? xcd * (q + 1) : r * (q + 1) + (xcd - r) * q) + off; }
        const int nig = WGM * nN, gid = wgid / nig, fm = gid * WGM, gsz = (nM - fm) < WGM ? (nM - fm) : WGM;
        u.pm = fm + ((wgid % nig) % gsz); u.pn = (wgid % nig) / gsz; return true;
    }
    __device__ __forceinline__ void a_ready(const Unit&) const {}
    __device__ __forceinline__ void done(const Unit&) const {}
};

__device__ __forceinline__ unsigned cvt_pk_bf16(float lo, float hi) { unsigned r; asm volatile("v_cvt_pk_bf16_f32 %0, %1, %2" : "=v"(r) : "v"(lo), "v"(hi)); return r; }
typedef float f32x2 __attribute__((ext_vector_type(2)));
typedef unsigned u32x2 __attribute__((ext_vector_type(2)));
#define PG8_GAS __attribute__((address_space(1)))
__device__ __forceinline__ u32x2 pack8_fp8(const float (&x)[8]) { int w0 = 0, w1 = 0; w0 = __builtin_amdgcn_cvt_pk_fp8_f32(x[0], x[1], w0, false); w0 = __builtin_amdgcn_cvt_pk_fp8_f32(x[2], x[3], w0, true);
    w1 = __builtin_amdgcn_cvt_pk_fp8_f32(x[4], x[5], w1, false); w1 = __builtin_amdgcn_cvt_pk_fp8_f32(x[6], x[7], w1, true); u32x2 r; r.x = (unsigned)w0; r.y = (unsigned)w1; return r; }
__device__ __forceinline__ u32x4 split8_hilo(const float (&x)[8]) { const u32x2 h = pack8_fp8(x);
    const f32x2 a = __builtin_amdgcn_cvt_pk_f32_fp8((int)h.x, false), b = __builtin_amdgcn_cvt_pk_f32_fp8((int)h.x, true), c = __builtin_amdgcn_cvt_pk_f32_fp8((int)h.y, false), d = __builtin_amdgcn_cvt_pk_f32_fp8((int)h.y, true);
    const float r[8] = {x[0] - a.x, x[1] - a.y, x[2] - b.x, x[3] - b.y, x[4] - c.x, x[5] - c.y, x[6] - d.x, x[7] - d.y}; const u32x2 l = pack8_fp8(r);
    u32x4 w; w.x = h.x; w.y = h.y; w.z = l.x; w.w = l.y; return w; }
__device__ __forceinline__ float bf_lo(unsigned w) { return __uint_as_float(w << 16); }
__device__ __forceinline__ float bf_hi(unsigned w) { return __uint_as_float(w & 0xffff0000u); }
__device__ __forceinline__ float fast_sigmoid(float x) { return __builtin_amdgcn_rcpf(1.0f + __expf(-x)); }
struct EpiSwiGLU {
    static constexpr bool PERM = true, AFTER_DRAIN = false;
    bf16_t* O; int ldc; const PG8_LAS float* rsl;
    __device__ __forceinline__ void operator()(const f32x4 (&acc)[2][2][4][2], const Unit& u, int wr, int wc, int fr, int fq) const {
        const int col0 = u.pn * HALF + wc * 32 + 8 * fq; const PG8_LAS float* rp = rsl + u.ui * 256 + wr * 64 + fr;
#pragma unroll
        for (int ai = 0; ai < 2; ++ai)
#pragma unroll
            for (int m = 0; m < 4; ++m) {
                const int row = u.pm * BM + ai * HALF + wr * 64 + m * 16 + fr; const float r = rp[ai * HALF + m * 16];
                float h[8];
#pragma unroll
                for (int n = 0; n < 2; ++n)
#pragma unroll
                    for (int j = 0; j < 4; ++j) { const float g = acc[ai][0][m][n][j] * r, up = acc[ai][1][m][n][j] * r; h[n * 4 + j] = g * fast_sigmoid(g) * up; }
                u32x4 w; w.x = cvt_pk_bf16(h[0], h[1]); w.y = cvt_pk_bf16(h[2], h[3]); w.z = cvt_pk_bf16(h[4], h[5]); w.w = cvt_pk_bf16(h[6], h[7]);
                *(PG8_GAS u32x4*)(O + (size_t)row * ldc + col0) = w;
            }
    }
};
struct EpiResid {
    static constexpr bool PERM = false, AFTER_DRAIN = false;
    bf16_t* HB; float* ss; float scale;
    __device__ __forceinline__ void operator()(const f32x4 (&acc)[2][2][4][2], const Unit& u, int wr, int wc, int fr, int fq) const {
        const int col0 = u.pn * BM + wc * 32 + 4 * fq;
        PG8_GAS bf16_t* hb = (PG8_GAS bf16_t*)HB + (size_t)(u.pm * BM + wr * 64 + fr) * 1024 + col0;
        const int L = fr + 16 * fq, perm = 4 * (4 * fr + fq);
        const PG8_GAS bf16_t* hl = (const PG8_GAS bf16_t*)HB + (size_t)(u.pm * BM + wr * 64 + (L >> 2)) * 1024 + u.pn * BM + wc * 32 + 4 * (L & 3);
        u32x2 hv[2][4][2][2];
#pragma unroll
        for (int ai = 0; ai < 2; ++ai)
#pragma unroll
            for (int m = 0; m < 4; ++m)
#pragma unroll
                for (int bj = 0; bj < 2; ++bj)
#pragma unroll
                    for (int n = 0; n < 2; ++n) hv[ai][m][bj][n] = *(const PG8_GAS u32x2*)(hl + (size_t)(ai * HALF + m * 16) * 1024 + bj * HALF + n * 16);

#pragma unroll
        for (int ai = 0; ai < 2; ++ai)
#pragma unroll
            for (int m = 0; m < 4; ++m) {
                const int row = u.pm * BM + ai * HALF + wr * 64 + m * 16 + fr; float sq = 0.f;
#pragma unroll
                for (int bj = 0; bj < 2; ++bj)
#pragma unroll
                    for (int n = 0; n < 2; ++n) {
                        u32x2 x = hv[ai][m][bj][n]; x.x = (unsigned)__builtin_amdgcn_ds_bpermute(perm, (int)x.x); x.y = (unsigned)__builtin_amdgcn_ds_bpermute(perm, (int)x.y);
                        f32x4 h = {bf_lo(x.x), bf_hi(x.x), bf_lo(x.y), bf_hi(x.y)}; h = h + acc[ai][bj][m][n] * scale;
                        u32x2 w; w.x = cvt_pk_bf16(h[0], h[1]); w.y = cvt_pk_bf16(h[2], h[3]); *(PG8_GAS u32x2*)(hb + (size_t)(ai * HALF + m * 16) * 1024 + bj * HALF + n * 16) = w;
                        const float r0 = bf_lo(w.x), r1 = bf_hi(w.x), r2 = bf_lo(w.y), r3 = bf_hi(w.y);
                        sq += (r0 * r0 + r1 * r1) + (r2 * r2 + r3 * r3);
                    }
                sq += __shfl_xor(sq, 16); sq += __shfl_xor(sq, 32);
                if (fq == 0) ((PG8_GAS float*)ss)[(size_t)row * 16 + u.pn * 4 + wc] = sq;
            }
    }
};
template <bool USE_RS> struct EpiScaleBf16 {
    static constexpr bool PERM = true, AFTER_DRAIN = false;
    bf16_t* O; int ldc; const PG8_LAS float* rsl; float cscale;
    __device__ __forceinline__ void operator()(const f32x4 (&acc)[2][2][4][2], const Unit& u, int wr, int wc, int fr, int fq) const {
        const int col0 = u.pn * BM + wc * 32 + 8 * fq; const PG8_LAS float* rp = rsl + u.ui * 256 + wr * 64 + fr;
#pragma unroll
        for (int ai = 0; ai < 2; ++ai)
#pragma unroll
            for (int m = 0; m < 4; ++m) {
                const int row = u.pm * BM + ai * HALF + wr * 64 + m * 16 + fr; const float s = (USE_RS ? rp[ai * HALF + m * 16] : 1.0f) * cscale;
                PG8_GAS bf16_t* rowp = (PG8_GAS bf16_t*)O + (size_t)row * ldc + col0;
#pragma unroll
                for (int bj = 0; bj < 2; ++bj) { const f32x4 v0 = acc[ai][bj][m][0] * s, v1 = acc[ai][bj][m][1] * s;
                    u32x4 w; w.x = cvt_pk_bf16(v0[0], v0[1]); w.y = cvt_pk_bf16(v0[2], v0[3]); w.z = cvt_pk_bf16(v1[0], v1[1]); w.w = cvt_pk_bf16(v1[2], v1[3]);
                    *(PG8_GAS u32x4*)(rowp + bj * HALF) = w; }
            }
    }
};
struct EpiRope {
    static constexpr bool PERM = true, AFTER_DRAIN = false;
    bf16_t* O; const PG8_LAS float* rsl; const float* cA; const float* sA; const float* cI; const float* sI; unsigned char* K8; unsigned char* V8;
    __device__ __forceinline__ void operator()(const f32x4 (&acc)[2][2][4][2], const Unit& u, int wr, int wc, int fr, int fq) const {
        const int x0 = wc * 32 + 8 * fq, pn = u.pn; const PG8_LAS float* rp = rsl + u.ui * 256 + wr * 64 + fr;
        const bool rot = !(pn == 5 || (pn == 8 && x0 >= 32)); const bool tA = pn < 5; const int half = tA ? 64 : 32, i0 = x0 & (half - 1);
#pragma unroll
        for (int ai = 0; ai < 2; ++ai) {
            f32x4 tc[4][2], ts[4][2];
            if (rot) {
#pragma unroll
                for (int m = 0; m < 4; ++m) { const int row = u.pm * BM + ai * HALF + wr * 64 + m * 16 + fr;
                    const PG8_GAS float* cp = (const PG8_GAS float*)(tA ? cA + (size_t)row * 64 : cI + (size_t)row * 32) + i0; const PG8_GAS float* sp = (const PG8_GAS float*)(tA ? sA + (size_t)row * 64 : sI + (size_t)row * 32) + i0;
                    tc[m][0] = *(const PG8_GAS f32x4*)cp; tc[m][1] = *(const PG8_GAS f32x4*)(cp + 4); ts[m][0] = *(const PG8_GAS f32x4*)sp; ts[m][1] = *(const PG8_GAS f32x4*)(sp + 4); }
            }
#pragma unroll
            for (int m = 0; m < 4; ++m) {
                const int row = u.pm * BM + ai * HALF + wr * 64 + m * 16 + fr; const float r = rp[ai * HALF + m * 16];
                PG8_GAS bf16_t* orow = (PG8_GAS bf16_t*)O + (size_t)row * 2304;
                float a[8], b[8];
#pragma unroll
                for (int n = 0; n < 2; ++n)
#pragma unroll
                    for (int j = 0; j < 4; ++j) { a[4 * n + j] = acc[ai][0][m][n][j] * r; b[4 * n + j] = acc[ai][1][m][n][j] * r; }
                if (pn == 5) {
                    const size_t cr = (size_t)((row >> 13) * 2) * 8192 + (row & 8191);
                    *(PG8_GAS u32x2*)(V8 + cr * 128 + x0) = pack8_fp8(a); *(PG8_GAS u32x2*)(V8 + (cr + 8192) * 128 + x0) = pack8_fp8(b);
                } else if (pn == 8 && x0 >= 32) {
                    if (x0 == 32) { u32x4 w0; w0.x = cvt_pk_bf16(a[0], a[1]); w0.y = cvt_pk_bf16(a[2], a[3]); w0.z = cvt_pk_bf16(a[4], a[5]); w0.w = cvt_pk_bf16(a[6], a[7]); *(PG8_GAS u32x4*)(orow + 2112) = w0; }
                } else {
                    const int hh = tA ? (x0 >> 6) : (x0 >> 5);
                    const int base = pn < 4 ? 256 * pn + 128 * hh : (pn == 4 ? 1024 + 128 * hh : (pn == 8 ? 2048 : 1536 + 256 * (pn - 6) + 64 * hh));
                    const float sc = pn < 4 ? 0.08838834764831845f * 32.0f : 1.0f;
                    const f32x4 c0 = tc[m][0], c1 = tc[m][1], s0 = ts[m][0], s1 = ts[m][1];
                    const float cs[8] = {c0[0], c0[1], c0[2], c0[3], c1[0], c1[1], c1[2], c1[3]}, sn[8] = {s0[0], s0[1], s0[2], s0[3], s1[0], s1[1], s1[2], s1[3]};
                    float o1[8], o2[8];
#pragma unroll
                    for (int k = 0; k < 8; ++k) { o1[k] = (a[k] * cs[k] - b[k] * sn[k]) * sc; o2[k] = (b[k] * cs[k] + a[k] * sn[k]) * sc; }
                    u32x4 w0, w1; w0.x = cvt_pk_bf16(o1[0], o1[1]); w0.y = cvt_pk_bf16(o1[2], o1[3]); w0.z = cvt_pk_bf16(o1[4], o1[5]); w0.w = cvt_pk_bf16(o1[6], o1[7]);
                    w1.x = cvt_pk_bf16(o2[0], o2[1]); w1.y = cvt_pk_bf16(o2[2], o2[3]); w1.z = cvt_pk_bf16(o2[4], o2[5]); w1.w = cvt_pk_bf16(o2[6], o2[7]);
                    if (pn < 4) { w0 = split8_hilo(o1); w1 = split8_hilo(o2); }
                    if (pn == 4) { const size_t cr = (size_t)((row >> 13) * 2 + hh) * 8192 + (row & 8191); *(PG8_GAS u32x2*)(K8 + cr * 128 + i0) = pack8_fp8(o1); *(PG8_GAS u32x2*)(K8 + cr * 128 + 64 + i0) = pack8_fp8(o2); }
                    else { *(PG8_GAS u32x4*)(orow + base + i0) = w0; *(PG8_GAS u32x4*)(orow + base + half + i0) = w1; }
                }
            }
        }
    }
};
struct EpiGLU {
    static constexpr bool PERM = true, AFTER_DRAIN = false;
    const bf16_t* Y; const float* bias; bf16_t* CAT;
    __device__ __forceinline__ void operator()(const f32x4 (&acc)[2][2][4][2], const Unit& u, int wr, int wc, int fr, int fq) const {
        const int col0 = u.pn * BM + wc * 32 + 8 * fq;
        const PG8_GAS bf16_t* yb = (const PG8_GAS bf16_t*)Y + (size_t)(u.pm * BM + wr * 64 + fr) * 512 + col0;
        u32x4 yv[2][4][2]; f32x4 bb[2][2];
#pragma unroll
        for (int bj = 0; bj < 2; ++bj) { bb[bj][0] = *(const PG8_GAS f32x4*)(bias + col0 + bj * HALF); bb[bj][1] = *(const PG8_GAS f32x4*)(bias + col0 + bj * HALF + 4); }
#pragma unroll
        for (int ai = 0; ai < 2; ++ai)
#pragma unroll
            for (int m = 0; m < 4; ++m)
#pragma unroll
                for (int bj = 0; bj < 2; ++bj) yv[ai][m][bj] = *(const PG8_GAS u32x4*)(yb + (size_t)(ai * HALF + m * 16) * 512 + bj * HALF);
#pragma unroll
        for (int ai = 0; ai < 2; ++ai)
#pragma unroll
            for (int m = 0; m < 4; ++m) {
                const int row = u.pm * BM + ai * HALF + wr * 64 + m * 16 + fr;
#pragma unroll
                for (int bj = 0; bj < 2; ++bj) { const int c = col0 + bj * HALF; const u32x4 y4 = yv[ai][m][bj];
                    const f32x4 z0 = acc[ai][bj][m][0] + bb[bj][0], z1 = acc[ai][bj][m][1] + bb[bj][1];
                    float o[8];
                    o[0] = bf_lo(y4.x) * fast_sigmoid(z0[0]); o[1] = bf_hi(y4.x) * fast_sigmoid(z0[1]); o[2] = bf_lo(y4.y) * fast_sigmoid(z0[2]); o[3] = bf_hi(y4.y) * fast_sigmoid(z0[3]);
                    o[4] = bf_lo(y4.z) * fast_sigmoid(z1[0]); o[5] = bf_hi(y4.z) * fast_sigmoid(z1[1]); o[6] = bf_lo(y4.w) * fast_sigmoid(z1[2]); o[7] = bf_hi(y4.w) * fast_sigmoid(z1[3]);
                    u32x4 w; w.x = cvt_pk_bf16(o[0], o[1]); w.y = cvt_pk_bf16(o[2], o[3]); w.z = cvt_pk_bf16(o[4], o[5]); w.w = cvt_pk_bf16(o[6], o[7]);
                    *(PG8_GAS u32x4*)(CAT + (size_t)row * 1024 + 512 + c) = w; }
            }
    }
};
template <int NM, int NN> struct TileOrder {
    static constexpr int nwg = NM * NN, WG = NM < 8 ? NM : 8, nig = WG * NN;
    static_assert(nwg % 8 == 0 && NM % WG == 0, "TileOrder shapes");
    int G, c;
    __device__ __forceinline__ bool next(int i, Unit& u) const {
        const int L = i * G + c; if (c < 0 || L >= nwg) return false;
        const int wgid = (L & 7) * (nwg / 8) + (L >> 3), gid = wgid / nig, r = wgid % nig;
        u.pm = gid * WG + (r % WG); u.pn = r / WG; u.ui = i; return true;
    }
    __device__ __forceinline__ void a_ready(const Unit&) const {}
    __device__ __forceinline__ void done(const Unit&) const {}
};
struct NoPre { __device__ __forceinline__ void operator()() const {} };
template <class Epi, class Sched, bool ALIGN_EPI = false, bool SP2 = false, class Pre = NoPre>
__device__ __forceinline__ void gemm_phase(PG8_LAS unsigned char* lds, const Gemm g, const Sched& S, const Epi& E, int tid_in, const Pre& pre = Pre()) {
    int tid_ = tid_in; asm volatile("" : "+v"(tid_));
    const int tid = tid_, wid = __builtin_amdgcn_readfirstlane(tid >> 6), lane = tid & 63, wr = wid >> 2, wc = wid & 3, fr = lane & 15, fq = lane >> 4;
    const int K = g.K, nt = K / BK;
    unsigned voffA[2], voffB[2];
#pragma unroll
    for (int i = 0; i < 2; ++i) { int R, C; stage_rc(tid * 16 + i * 8192, R, C); const int Rb = Epi::PERM ? ((R & ~31) + perm32(R & 31)) : R;
        voffA[i] = (unsigned)(R * K + C) * 2u; voffB[i] = (unsigned)(Rb * K + C) * 2u; }
    const size_t kstep = (size_t)(BK * 2);
    const size_t hstep = (size_t)HALF * K * 2;
    const size_t tstep = 2 * hstep;
    const unsigned ldsw = (unsigned)wid * 1024u;
    const int aoff = lds_byte(wr * 64 + fr, fq * 8), boff = lds_byte(wc * 32 + fr, fq * 8);
#define PG8_SA(b, h) (((b) * 2 + (h)) * HTB)
#define PG8_SB(b, h) ((4 + (b) * 2 + (h)) * HTB)
#define PG8_STAGE(bufoff, gbase, voff) do { _Pragma("unroll") for (int _i = 0; _i < 2; ++_i) \
        __builtin_amdgcn_global_load_lds((const unsigned*)((const char*)(gbase) + (voff)[_i]), (PG8_LAS unsigned*)(lds + (bufoff) + ldsw + _i * 8192), 16, 0, 0); } while (0)
#define PG8_LDA(dst, b, h) do { _Pragma("unroll") for (int m = 0; m < 4; ++m) _Pragma("unroll") for (int k = 0; k < 2; ++k) dst[m][k] = *(const PG8_LAS bf16x8*)(lds + PG8_SA(b, h) + aoff + m * 2048 + k * 1024); } while (0)
#define PG8_LDB(dst, b, h) do { _Pragma("unroll") for (int n = 0; n < 2; ++n) _Pragma("unroll") for (int k = 0; k < 2; ++k) dst[n][k] = *(const PG8_LAS bf16x8*)(lds + PG8_SB(b, h) + boff + n * 2048 + k * 1024); } while (0)
#define PG8_MMA(ai, bj, At, Bt) do { __builtin_amdgcn_s_setprio(1); _Pragma("unroll") for (int m = 0; m < 4; ++m) _Pragma("unroll") for (int n = 0; n < 2; ++n) _Pragma("unroll") for (int k = 0; k < 2; ++k) \
        acc[ai][bj][m][n] = __builtin_amdgcn_mfma_f32_16x16x32_bf16(Bt[n][k], At[m][k], acc[ai][bj][m][n], 0, 0, 0); __builtin_amdgcn_s_setprio(0); } while (0)
#define PG8_WAIT_V(n) asm volatile("s_waitcnt vmcnt(" #n ")" ::: "memory")
#define PG8_WAIT_L(n) asm volatile("s_waitcnt lgkmcnt(" #n ")" ::: "memory")
#define PG8_BAR __builtin_amdgcn_s_barrier()
#define PG8_SCHED __builtin_amdgcn_sched_barrier(0)
    Unit cur, nxt; int ui = 0;
    if (!S.next(0, cur)) return;
    f32x4 acc[2][2][4][2];
#pragma unroll
    for (int a = 0; a < 2; ++a)
#pragma unroll
        for (int b = 0; b < 2; ++b)
#pragma unroll
            for (int m = 0; m < 4; ++m)
#pragma unroll
                for (int n = 0; n < 2; ++n) acc[a][b][m][n] = (f32x4){0.f, 0.f, 0.f, 0.f};
    bf16x8 At[4][2], B0[2][2], B1[2][2];
    const char* cA = (const char*)g.A + (size_t)cur.pm * tstep; const char* cB = (const char*)g.Bt + (size_t)cur.pn * tstep;
    S.a_ready(cur);
    if constexpr (SP2) {
        PG8_STAGE(PG8_SB(0, 0), cB, voffB); PG8_STAGE(PG8_SB(0, 1), cB + hstep, voffB); PG8_STAGE(PG8_SA(0, 0), cA, voffA); PG8_STAGE(PG8_SA(0, 1), cA + hstep, voffA);
        pre();
        if (wr == 1) PG8_BAR;
        PG8_WAIT_V(2); PG8_BAR;
        PG8_STAGE(PG8_SB(1, 0), cB + kstep, voffB); PG8_STAGE(PG8_SA(1, 0), cA + kstep, voffA); PG8_STAGE(PG8_SB(1, 1), cB + hstep + kstep, voffB);
        PG8_WAIT_V(6); PG8_BAR;
    } else {
        PG8_STAGE(PG8_SB(0, 0), cB, voffB); PG8_STAGE(PG8_SA(0, 0), cA, voffA); PG8_STAGE(PG8_SB(0, 1), cB + hstep, voffB); PG8_STAGE(PG8_SA(0, 1), cA + hstep, voffA);
        pre();
        if (wr == 1) PG8_BAR;
        PG8_WAIT_V(4); PG8_BAR;
        PG8_STAGE(PG8_SB(1, 0), cB + kstep, voffB); PG8_STAGE(PG8_SA(1, 0), cA + kstep, voffA); PG8_STAGE(PG8_SB(1, 1), cB + hstep + kstep, voffB);
        PG8_WAIT_V(6); PG8_BAR;
    }
    for (;;) {
        const bool has_next = S.next(ui + 1, nxt);
        const char* nA = has_next ? (const char*)g.A + (size_t)nxt.pm * tstep : cA; const char* nB = has_next ? (const char*)g.Bt + (size_t)nxt.pn * tstep : cB;
        for (int t = 0; t < nt; t += 2) {
            const bool last = (t == nt - 2);
            const char* a1 = cA + (size_t)(t + 1) * kstep;
            const char* a2 = last ? nA : cA + (size_t)(t + 2) * kstep; const char* b2 = last ? nB : cB + (size_t)(t + 2) * kstep;
            const char* a3 = a2 + kstep; const char* b3 = b2 + kstep;
            if (last && has_next) S.a_ready(nxt);
            if constexpr (SP2) {
            PG8_LDB(B0, 0, 0); PG8_LDB(B1, 0, 1); PG8_SCHED; PG8_LDA(At, 0, 0); PG8_STAGE(PG8_SA(1, 1), a1 + hstep, voffA);
            PG8_WAIT_V(8); PG8_WAIT_L(0); PG8_BAR; PG8_MMA(0, 0, At, B0); PG8_MMA(0, 1, At, B1); PG8_BAR; PG8_SCHED;
            PG8_LDA(At, 0, 1); PG8_STAGE(PG8_SB(0, 0), b2, voffB); PG8_STAGE(PG8_SB(0, 1), b2 + hstep, voffB); PG8_STAGE(PG8_SA(0, 0), a2, voffA);
            PG8_WAIT_V(8); PG8_WAIT_L(0); PG8_BAR; PG8_MMA(1, 0, At, B0); PG8_MMA(1, 1, At, B1); PG8_BAR; PG8_SCHED;
            PG8_LDB(B0, 1, 0); PG8_LDB(B1, 1, 1); PG8_SCHED; PG8_LDA(At, 1, 0); PG8_STAGE(PG8_SA(0, 1), a2 + hstep, voffA);
            PG8_WAIT_V(8); PG8_WAIT_L(0); PG8_BAR; PG8_MMA(0, 0, At, B0); PG8_MMA(0, 1, At, B1); PG8_BAR; PG8_SCHED;
            PG8_LDA(At, 1, 1); PG8_STAGE(PG8_SB(1, 0), b3, voffB); PG8_STAGE(PG8_SB(1, 1), b3 + hstep, voffB); PG8_STAGE(PG8_SA(1, 0), a3, voffA);
            PG8_WAIT_V(8); PG8_WAIT_L(0); PG8_BAR; PG8_MMA(1, 0, At, B0); PG8_MMA(1, 1, At, B1); PG8_BAR; PG8_SCHED;
            } else {
            PG8_LDB(B0, 0, 0); PG8_SCHED; PG8_LDA(At, 0, 0); PG8_STAGE(PG8_SA(1, 1), a1 + hstep, voffA);
            PG8_WAIT_L(8); PG8_BAR; PG8_WAIT_L(0); PG8_MMA(0, 0, At, B0); PG8_BAR; PG8_SCHED;
            PG8_LDB(B1, 0, 1); PG8_STAGE(PG8_SB(0, 0), b2, voffB);
            PG8_BAR; PG8_WAIT_L(0); PG8_MMA(0, 1, At, B1); PG8_BAR;
            PG8_LDA(At, 0, 1); PG8_STAGE(PG8_SA(0, 0), a2, voffA);
            PG8_BAR; PG8_WAIT_L(0); PG8_MMA(1, 0, At, B0); PG8_BAR; PG8_SCHED;
            PG8_STAGE(PG8_SB(0, 1), b2 + hstep, voffB);
            PG8_WAIT_V(6); PG8_BAR; PG8_MMA(1, 1, At, B1); PG8_BAR;
            PG8_LDB(B0, 1, 0); PG8_SCHED; PG8_LDA(At, 1, 0); PG8_STAGE(PG8_SA(0, 1), a2 + hstep, voffA);
            PG8_WAIT_L(8); PG8_BAR; PG8_WAIT_L(0); PG8_MMA(0, 0, At, B0); PG8_BAR; PG8_SCHED;
            PG8_LDB(B1, 1, 1); PG8_STAGE(PG8_SB(1, 0), b3, voffB);
            PG8_BAR; PG8_WAIT_L(0); PG8_MMA(0, 1, At, B1); PG8_BAR;
            PG8_LDA(At, 1, 1); PG8_STAGE(PG8_SA(1, 0), a3, voffA);
            PG8_BAR; PG8_WAIT_L(0); PG8_MMA(1, 0, At, B0); PG8_BAR; PG8_SCHED;
            PG8_STAGE(PG8_SB(1, 1), b3 + hstep, voffB);
            PG8_WAIT_V(6); PG8_BAR; PG8_MMA(1, 1, At, B1); PG8_BAR;
            }
        }
        if constexpr (ALIGN_EPI) { if (wr == 0) PG8_BAR; }
        if constexpr (!Epi::AFTER_DRAIN) { E(acc, cur, wr, wc, fr, fq); S.done(cur); }
        if (!has_next) break;
#pragma unroll
        for (int a = 0; a < 2; ++a)
#pragma unroll
            for (int b = 0; b < 2; ++b)
#pragma unroll
                for (int m = 0; m < 4; ++m)
#pragma unroll
                    for (int n = 0; n < 2; ++n) acc[a][b][m][n] = (f32x4){0.f, 0.f, 0.f, 0.f};
        cur = nxt; cA = nA; cB = nB; ++ui;
        if constexpr (ALIGN_EPI) { if (wr == 1) PG8_BAR; }
    }
    PG8_WAIT_V(0);
    if constexpr (!ALIGN_EPI) { if (wr == 0) PG8_BAR; }
    PG8_BAR;
    if constexpr (Epi::AFTER_DRAIN) { E.fused(acc, cur, wr, wc, fr, fq, lds, wid, lane); S.done(cur); }
#undef PG8_SA
#undef PG8_SB
#undef PG8_STAGE
#undef PG8_LDA
#undef PG8_LDB
#undef PG8_MMA
#undef PG8_WAIT_V
#undef PG8_WAIT_L
#undef PG8_BAR
#undef PG8_SCHED
}
}

constexpr int NB = 2, SEQ = 8192, DM = 1024, MTOK = NB * SEQ, DEPTH = 4, NMEM = 256, DFF = 2816;
constexpr int PROJW = 2304;
constexpr int EV_IN = 2064, OD_IN = 2120;
constexpr float EPS = 1e-6f;
constexpr int S5T = 64, S5NC = SEQ / S5T;
constexpr int TOPK = 256;
constexpr int PH_LAYER0 = 2, PH_PER_LAYER = 14, PH_FINAL = PH_LAYER0 + DEPTH * PH_PER_LAYER, N_PHASES = PH_FINAL + 1;

constexpr size_t MiB = 1u << 20;
constexpr size_t WS_CTL = 0, CTL_ZERO_BYTES = 1 * MiB;
constexpr size_t WS_H = 1 * MiB, WS_HB = 65 * MiB, WS_SS = 97 * MiB;
constexpr size_t WS_COSA = 98 * MiB, WS_SINA = 102 * MiB, WS_COSI = 106 * MiB, WS_SINI = 108 * MiB;
constexpr size_t WS_MEMN = 110 * MiB, WS_MK = 111 * MiB, WS_MVT = 115 * MiB, WS_S5P = 119 * MiB;
constexpr size_t WS_W = 121 * MiB, WS_SCR = 169 * MiB, WS_END = 345 * MiB;
constexpr size_t WO_GU1 = 0, WO_D1 = 11 * MiB, WO_IN = WO_D1 + 5632 * 1024, WO_OUT = WO_IN + 4608 * 1024, WO_GLU = WO_OUT + 2 * MiB, WO_XQ = WO_GLU + 512 * 1024,
                 WO_XO = WO_XQ + 2 * MiB, WO_GU2 = WO_XO + 2 * MiB, WO_D2 = WO_GU2 + 11 * MiB, WO_END = WO_D2 + 5632 * 1024;
static_assert(WO_END <= 48 * MiB, "weights region");
constexpr size_t SC_HID = 0, SC_PROJ = 0, SC_XQ = 0, SC_XO = 32 * MiB, SC_KVW = 96 * MiB;
constexpr size_t SC_DS = 72 * MiB, SC_BC = 104 * MiB, SC_DEC = 120 * MiB, SC_S5E = 121 * MiB, SC_Y = 125 * MiB, SC_CAT = 141 * MiB;
constexpr size_t SC_SEL = 72 * MiB, SC_SELN = 80 * MiB, SC_K8 = 81 * MiB, SC_V8 = 85 * MiB;
static_assert(SC_CAT + 32 * MiB <= WS_END - WS_SCR, "scratch region");
constexpr int S5P_A = 0, S5P_AT = 2 * 32 * 64 * 2, S5P_BB = 2 * S5P_AT, S5P_BBH = S5P_BB + 2 * 32 * 64 * 16 * 2, S5P_END = S5P_BBH + 2 * 32 * 128 * 16 / 2;
constexpr int CW_BAR = 1024;

constexpr int RING_BYTES = 131072;
constexpr int LDS_BYTES = 163840, LDSCTL_OFF = LDS_BYTES - 1024;

#define GAS __attribute__((address_space(1)))
#define LAS __attribute__((address_space(3)))
#define DI __device__ __forceinline__
typedef unsigned short bf16;
typedef unsigned v4u __attribute__((ext_vector_type(4)));
typedef unsigned v2u __attribute__((ext_vector_type(2)));
typedef float f32x4 __attribute__((ext_vector_type(4)));
typedef float f32x2 __attribute__((ext_vector_type(2)));
typedef short bf16x8 __attribute__((ext_vector_type(8)));
#define LDS_WAIT() asm volatile("s_waitcnt lgkmcnt(0)" ::: "memory")
#define VM_WAIT() asm volatile("s_waitcnt vmcnt(0)" ::: "memory")
DI unsigned f2bf(float f) { unsigned u = __builtin_bit_cast(unsigned, f); return (u + 0x7fffu + ((u >> 16) & 1u)) >> 16; }
DI unsigned pk2(float lo, float hi) { return f2bf(lo) | (f2bf(hi) << 16); }
DI float bflo(unsigned w) { return __uint_as_float(w << 16); }
DI float bfhi(unsigned w) { return __uint_as_float(w & 0xffff0000u); }
DI float bf2f(bf16 x) { return __uint_as_float(((unsigned)x) << 16); }
DI float wave_sum(float v) {
#pragma unroll
    for (int o = 1; o < 64; o <<= 1) v += __shfl_xor(v, o);
    return v;
}
DI f32x4 mfma16(bf16x8 a, bf16x8 b, f32x4 c) { return __builtin_amdgcn_mfma_f32_16x16x32_bf16(a, b, c, 0, 0, 0); }

#define XB_TMO      128
#define XB_XCNT(j)  (256  + 64 * (j))
#define XB_XSUB(j)  (1280 + 64 * (j))
#define XB_XGEN(j)  (2304 + 64 * (j))
#define XB_TOP      3328
#define XB_TOPGEN   3392
#define XCD_BAR_WORDS 3456
#define XB_SPIN_CAP (1u << 18)
__device__ __forceinline__ unsigned xb_ld(unsigned* p)              { return __hip_atomic_load(p, __ATOMIC_RELAXED, __HIP_MEMORY_SCOPE_AGENT); }
__device__ __forceinline__ unsigned xb_add(unsigned* p, unsigned v) { return __hip_atomic_fetch_add(p, v, __ATOMIC_RELAXED, __HIP_MEMORY_SCOPE_AGENT); }
__device__ __forceinline__ unsigned xb_xcc_id() { return (unsigned)__builtin_amdgcn_s_getreg((3 << 11) | 20) & 0xFu; }
#define XB_SPIN(cond, bar) do { unsigned _sp = 0; while (cond) { __builtin_amdgcn_s_sleep(1); \
    if ((++_sp & 255u) == 0u) { if (xb_ld(&(bar)[XB_TMO])) break; if (_sp > XB_SPIN_CAP) { atomicAdd(&(bar)[XB_TMO], 1u); break; } } } } while (0)
struct XcdBarrier { unsigned* bar; unsigned x; volatile LAS unsigned* st; };
__device__ __forceinline__ XcdBarrier xcd_barrier_post(unsigned* bar, volatile LAS unsigned* st) {
    XcdBarrier b; b.bar = bar; b.x = xb_xcc_id(); b.st = st;
    if (threadIdx.x == 0) (void)xb_add(&bar[XB_XCNT(b.x)], 1u);
    return b;
}
__device__ __forceinline__ void xcd_barrier_complete(unsigned* bar, unsigned x, unsigned& nloc, unsigned& nx) {
    const unsigned G = gridDim.x * gridDim.y * gridDim.z;
    unsigned sum, cnt, mine, sp = 0u;
    for (;;) {
        sum = 0u; cnt = 0u; mine = 0u;
#pragma unroll
        for (unsigned j = 0; j < 16; ++j) { const unsigned c = xb_ld(&bar[XB_XCNT(j)]); sum += c; cnt += (c > 0u) ? 1u : 0u; mine = (j == x) ? c : mine; }
        if (sum == G) break;
        __builtin_amdgcn_s_sleep(1);
        if ((++sp & 255u) == 0u) { if (xb_ld(&bar[XB_TMO])) break; if (sp > XB_SPIN_CAP) { atomicAdd(&bar[XB_TMO], 1u); break; } }
    }
    nloc = mine > 0u ? mine : 1u; nx = cnt > 0u ? cnt : 1u;
}
__device__ __forceinline__ void xcd_barrier(const XcdBarrier& b) {
    asm volatile("s_waitcnt vmcnt(0)" ::: "memory");
    __syncthreads();
    if (threadIdx.x == 0) {
        unsigned* bar = b.bar;
        __builtin_amdgcn_s_waitcnt(0);
        unsigned nloc = b.st[0], nx = b.st[1];
        if (nloc == 0u) { xcd_barrier_complete(bar, b.x, nloc, nx); b.st[0] = nloc; b.st[1] = nx; }
        const unsigned old = xb_add(&bar[XB_XSUB(b.x)], 1u);
        const unsigned gen = old / nloc;
        if (old + 1u == (gen + 1u) * nloc) {
            __builtin_amdgcn_fence(__ATOMIC_RELEASE, "agent");
            asm volatile("s_waitcnt vmcnt(0)" ::: "memory");
            const unsigned og = xb_add(&bar[XB_TOP], 1u);
            const unsigned tg = og / nx;
            if (og + 1u == (tg + 1u) * nx) xb_add(&bar[XB_TOPGEN], 1u);
            else XB_SPIN(xb_ld(&bar[XB_TOPGEN]) == tg, bar);
            __builtin_amdgcn_fence(__ATOMIC_ACQUIRE, "agent");
            xb_add(&bar[XB_XGEN(b.x)], 1u);
            asm volatile("s_waitcnt vmcnt(0)" ::: "memory");
        } else {
            XB_SPIN(xb_ld(&bar[XB_XGEN(b.x)]) == gen, bar);
            __builtin_amdgcn_fence(__ATOMIC_ACQUIRE, "agent");
            asm volatile("s_waitcnt vmcnt(0)" ::: "memory");
        }
    }
    __syncthreads();
}

struct Ctx { LAS unsigned char* lds; int tid, lane, wave, vcu, G; };

DI void cvt_store(bf16* dst, int K, int drow0, int k0, LAS float* scr, int lane) {
    LDS_WAIT(); asm volatile("" ::: "memory");
    const int c = lane & 7;
#pragma unroll
    for (int j = 0; j < 4; ++j) { const int n = (lane >> 3) + 8 * j; const LAS float* s = scr + (8 * c) * 33 + n;
        v4u o; o.x = pk2(s[0 * 33], s[1 * 33]); o.y = pk2(s[2 * 33], s[3 * 33]); o.z = pk2(s[4 * 33], s[5 * 33]); o.w = pk2(s[6 * 33], s[7 * 33]);
        *(v4u*)(dst + (size_t)(drow0 + n) * K + k0 + 8 * c) = o; }
    LDS_WAIT(); asm volatile("" ::: "memory");
}
DI void cvt_item(const float* src, int ldsrc, int scol0, int nvalid, const float* gain, bf16* dst, int K, int drow0, int k0, LAS float* scr, int lane) {
    const int kr = lane >> 3, n4 = 4 * (lane & 7); const bool ok = n4 < nvalid;
    const float* sp = src + (size_t)(k0 + kr) * ldsrc + scol0 + n4;
    f32x4 v[8];
#pragma unroll
    for (int i = 0; i < 8; ++i) v[i] = ok ? *(const f32x4*)(sp + (size_t)(8 * i) * ldsrc) : (f32x4){0.f, 0.f, 0.f, 0.f};
    if (gain) {
#pragma unroll
        for (int i = 0; i < 8; ++i) v[i] = v[i] * gain[k0 + kr + 8 * i];
    }
#pragma unroll
    for (int i = 0; i < 8; ++i) { LAS float* d = scr + (kr + 8 * i) * 33 + n4; d[0] = v[i].x; d[1] = v[i].y; d[2] = v[i].z; d[3] = v[i].w; }
    cvt_store(dst, K, drow0, k0, scr, lane);
}
DI void cvt_job(const Ctx& c, const float* src, int ldsrc, int scol0, int nvalid, const float* gain, bf16* dst, int K, int N, int drow0, int rot) {
    LAS float* scr = (LAS float*)(c.lds + c.wave * 8448);
    const int NGW = c.G * 8, gw = (c.vcu * 8 + c.wave + rot) % NGW, nblk = N / 32, nitems = (K / 64) * nblk;
    for (int it = gw; it < nitems; it += NGW) { const int kb = it / nblk, nb = it % nblk; int nv = nvalid - nb * 32; nv = nv < 0 ? 0 : (nv > 32 ? 32 : nv);
        cvt_item(src, ldsrc, scol0 + nb * 32, nv, gain, dst, K, drow0 + nb * 32, kb * 64, scr, c.lane); }
}
DI void cvt_job_gu(const Ctx& c, const float* gate, const float* up, const float* gain, bf16* dst, int rot) {
    LAS float* scr = (LAS float*)(c.lds + c.wave * 8448);
    const int NGW = c.G * 8, gw = (c.vcu * 8 + c.wave + rot) % NGW, nblk = 5632 / 32, nitems = (1024 / 64) * nblk;
    for (int it = gw; it < nitems; it += NGW) { const int kb = it / nblk, nb = it % nblk, n0 = nb * 32;
        const float* src = ((n0 >> 7) & 1) ? up : gate; const int sc = (n0 >> 8) * 128 + (n0 & 127);
        cvt_item(src, DFF, sc, 32, gain, dst, 1024, n0, kb * 64, scr, c.lane); }
}
DI void cvt_job_rope(const Ctx& c, const float* src, const float* gain, bf16* dst, int rot) {
    LAS float* scr = (LAS float*)(c.lds + c.wave * 8448);
    const int NGW = c.G * 8, gw = (c.vcu * 8 + c.wave + rot) % NGW, nblk = PROJW / 32, nitems = (1024 / 64) * nblk;
    for (int it = gw; it < nitems; it += NGW) { const int kb = it / nblk, nb = it % nblk, R = nb * 32, t = R >> 8, bj = (R >> 7) & 1, x = R & 127;
        int L, nv = 32;
        if (t < 4) L = 256 * t + 128 * (x >> 6) + 64 * bj + (x & 63);
        else if (t == 4) L = 1024 + 128 * (x >> 6) + 64 * bj + (x & 63);
        else if (t == 5) L = 1280 + 128 * bj + x;
        else if (t < 8) L = 1536 + 256 * (t - 6) + 64 * (x >> 5) + 32 * bj;
        else { if (x == 0) L = 2048 + 32 * bj; else if (x == 32 && bj == 0) { L = 2112; nv = 8; } else { L = 0; nv = 0; } }
        cvt_item(src, OD_IN, L, nv, gain, dst, 1024, R, kb * 64, scr, c.lane); }
}
DI void cvt_job_comb(const Ctx& c, const float* win, const float* wa, const float* gain, bf16* dst, int drow0, int rot) {
    LAS float* scr = (LAS float*)(c.lds + c.wave * 8448);
    const int NGW = c.G * 8, gw = (c.vcu * 8 + c.wave + rot) % NGW, nblk = 256 / 32, nitems = (1024 / 64) * nblk;
    for (int it = gw; it < nitems; it += NGW) { const int kb = it / nblk, nb = it % nblk, n0 = nb * 32, k0 = kb * 64; const int nn = c.lane & 31;
        float wcol[16];
#pragma unroll
        for (int j = 0; j < 16; ++j) wcol[j] = wa[j * 256 + n0 + nn];
        for (int i = 0; i < 32; ++i) { const int kk = 2 * i + (c.lane >> 5); const float* wr = win + (size_t)(k0 + kk) * EV_IN + 1536; float s = 0.f;
#pragma unroll
            for (int j = 0; j < 16; ++j) s += wr[j] * wcol[j];
            scr[kk * 33 + nn] = s * gain[k0 + kk]; }
        cvt_store(dst, 1024, drow0 + n0, k0, scr, c.lane); }
}

DI void row_init(const float* xrow, bf16* hbrow, float* ssrow, int lane) {
    float s = 0.f;
#pragma unroll
    for (int j = 0; j < 4; ++j) { const f32x4 v = ((const f32x4*)xrow)[lane + 64 * j]; v2u w; w.x = pk2(v.x, v.y); w.y = pk2(v.z, v.w); ((v2u*)hbrow)[lane + 64 * j] = w;
        const float r0 = bflo(w.x), r1 = bfhi(w.x), r2 = bflo(w.y), r3 = bfhi(w.y); s += (r0 * r0 + r1 * r1) + (r2 * r2 + r3 * r3); }
    s = wave_sum(s);
    if (lane < 16) ssrow[lane] = (lane == 0) ? s : 0.f;
}
DI void row_norm_bf16(const float* xrow, const float* g, bf16* orow, int lane) {
    f32x4 v[4]; float s = 0.f;
#pragma unroll
    for (int j = 0; j < 4; ++j) { v[j] = ((const f32x4*)xrow)[lane + 64 * j]; s += (v[j].x * v[j].x + v[j].y * v[j].y) + (v[j].z * v[j].z + v[j].w * v[j].w); }
    const float r = rsqrtf(wave_sum(s) * (1.0f / 1024.0f) + EPS);
#pragma unroll
    for (int j = 0; j < 4; ++j) { const f32x4 gg = ((const f32x4*)g)[lane + 64 * j]; v2u w; w.x = pk2(v[j].x * r * gg.x, v[j].y * r * gg.y); w.y = pk2(v[j].z * r * gg.z, v[j].w * r * gg.w); ((v2u*)orow)[lane + 64 * j] = w; }
}
DI void row_final(const bf16* hrow, const float* ssrow, const float* g, float* orow, int lane) {
    float s = (lane < 16) ? ssrow[lane] : 0.f; s = wave_sum(s);
    const float r = rsqrtf(s * (1.0f / 1024.0f) + EPS);
#pragma unroll
    for (int j = 0; j < 4; ++j) { const v2u w = ((const v2u*)hrow)[lane + 64 * j]; const f32x4 v = {bflo(w.x), bfhi(w.x), bflo(w.y), bfhi(w.y)}, gg = ((const f32x4*)g)[lane + 64 * j]; ((f32x4*)orow)[lane + 64 * j] = v * r * gg; }
}

DI void unpack8(const v4u w, float (&x)[8]) { x[0] = bflo(w.x); x[1] = bfhi(w.x); x[2] = bflo(w.y); x[3] = bfhi(w.y); x[4] = bflo(w.z); x[5] = bfhi(w.z); x[6] = bflo(w.w); x[7] = bfhi(w.w); }
DI void gla1_unit(const Ctx& c, int u, const bf16* PROJ, const float* b_a, float* DS, float* BCg, float* DEC) {
    const int n = u & 127, bh = u >> 7, h = bh & 3, b = bh >> 2, row0 = b * SEQ + n * 64;
    LAS float* BCl = (LAS float*)c.lds; LAS float* SEG = BCl + 4096; LAS unsigned char* KEt = c.lds + 18432; LAS unsigned char* VT = KEt + 9216;
    const int t = c.tid >> 3, s8 = c.tid & 7;
    const bf16* prow = PROJ + (size_t)(row0 + t) * PROJW;
    float kk[8];
    { float x[8]; unpack8(*(const v4u*)(prow + 1536 + h * 64 + s8 * 8), x);
      float ls[8];
#pragma unroll
      for (int j = 0; j < 8; ++j) { const float xx = x[j] + b_a[h * 64 + s8 * 8 + j]; ls[j] = (fminf(xx, 0.f) - __logf(1.0f + __expf(-fabsf(xx)))) * (1.0f / 16.0f); }
      *(LAS f32x4*)(BCl + t * 64 + s8 * 8) = (f32x4){ls[0], ls[1], ls[2], ls[3]}; *(LAS f32x4*)(BCl + t * 64 + s8 * 8 + 4) = (f32x4){ls[4], ls[5], ls[6], ls[7]};
      unpack8(*(const v4u*)(prow + 256 + h * 64 + s8 * 8), kk);
      const v4u v0 = *(const v4u*)(prow + 512 + h * 128 + s8 * 16), v1 = *(const v4u*)(prow + 512 + h * 128 + s8 * 16 + 8);
      const unsigned vw[8] = {v0.x, v0.y, v0.z, v0.w, v1.x, v1.y, v1.z, v1.w};
      LAS unsigned char* vt = VT + (16 * s8) * 144 + t * 2;
#pragma unroll
      for (int j = 0; j < 8; ++j) { *(LAS bf16*)(vt + (2 * j) * 144) = (bf16)(vw[j] & 0xffffu); *(LAS bf16*)(vt + (2 * j + 1) * 144) = (bf16)(vw[j] >> 16); } }
    __syncthreads();
    { const int d = c.tid & 63, seg = c.tid >> 6; float v[8]; float run = 0.f;
#pragma unroll
      for (int j = 0; j < 8; ++j) { run += BCl[(8 * seg + j) * 64 + d]; v[j] = run; }
      SEG[seg * 64 + d] = run;
      __syncthreads();
      float off = 0.f;
#pragma unroll
      for (int q = 0; q < 7; ++q) off += (q < seg) ? SEG[q * 64 + d] : 0.f;
#pragma unroll
      for (int j = 0; j < 8; ++j) BCl[(8 * seg + j) * 64 + d] = v[j] + off; }
    __syncthreads();
    { float bcv[8];
#pragma unroll
      for (int j = 0; j < 8; ++j) { const int d = s8 * 8 + j; const float bc = BCl[t * 64 + d], bl = BCl[63 * 64 + d]; bcv[j] = bc;
          *(LAS bf16*)(KEt + d * 144 + t * 2) = (bf16)f2bf(kk[j] * __expf(bl - bc)); }
      float* bp = BCg + (size_t)(row0 + t) * 256 + h * 64 + s8 * 8;
      *(f32x4*)bp = (f32x4){bcv[0], bcv[1], bcv[2], bcv[3]}; *(f32x4*)(bp + 4) = (f32x4){bcv[4], bcv[5], bcv[6], bcv[7]};
      if (c.tid < 64) DEC[(size_t)u * 64 + c.tid] = __expf(BCl[63 * 64 + c.tid]); }
    __syncthreads();
    { const int r16 = c.lane & 15, q4 = c.lane >> 4, w = c.wave;
      bf16x8 vb[2];
#pragma unroll
      for (int ks = 0; ks < 2; ++ks) vb[ks] = *(const LAS bf16x8*)(VT + (16 * w + r16) * 144 + (32 * ks + 8 * q4) * 2);
#pragma unroll
      for (int df = 0; df < 4; ++df) { f32x4 acc = {0.f, 0.f, 0.f, 0.f};
#pragma unroll
          for (int ks = 0; ks < 2; ++ks) acc = mfma16(*(const LAS bf16x8*)(KEt + (16 * df + r16) * 144 + (32 * ks + 8 * q4) * 2), vb[ks], acc);
          float* dp = DS + (size_t)u * 8192 + (size_t)(16 * df + 4 * q4) * 128 + 16 * w + r16;
#pragma unroll
          for (int i = 0; i < 4; ++i) dp[i * 128] = acc[i]; } }
    __syncthreads();
}
DI void gla2_scan(const Ctx& c, float* DS, const float* DEC) {
    for (int el = c.vcu * 512 + c.tid; el < 8 * 64 * 128; el += c.G * 512) {
        const int bh = el >> 13, d = (el >> 7) & 63, e = el & 127; float S = 0.f;
        float* p0 = DS + (size_t)(bh * 128) * 8192 + d * 128 + e; const float* q0 = DEC + (size_t)(bh * 128) * 64 + d;
        for (int n0 = 0; n0 < 128; n0 += 16) {
            float ds[16], dc[16];
#pragma unroll
            for (int j = 0; j < 16; ++j) { ds[j] = p0[(size_t)(n0 + j) * 8192]; dc[j] = q0[(n0 + j) * 64]; }
#pragma unroll
            for (int j = 0; j < 16; ++j) { p0[(size_t)(n0 + j) * 8192] = S; S = dc[j] * S + ds[j]; }
        }
    }
}
DI bf16x8 pack8(const f32x4 a, const f32x4 b) { v4u w; w.x = pk2(a[0], a[1]); w.y = pk2(a[2], a[3]); w.z = pk2(b[0], b[1]); w.w = pk2(b[2], b[3]); return __builtin_bit_cast(bf16x8, w); }
DI void gla3_unit(const Ctx& c, int u, const bf16* PROJ, const float* BCg, const float* DS, const float* gnorm, bf16* CAT) {
    const int n = u & 127, bh = u >> 7, h = bh & 3, b = bh >> 2, row0 = b * SEQ + n * 64;
    LAS unsigned char* QD = c.lds; LAS unsigned char* KI = QD + 9216; LAS unsigned char* VT = KI + 9216; LAS unsigned char* SPT = VT + 18432; LAS float* PART = (LAS float*)(SPT + 18432);
    { const int t = c.tid >> 3, s8 = c.tid & 7; const bf16* prow = PROJ + (size_t)(row0 + t) * PROJW;
      float q[8], k[8]; unpack8(*(const v4u*)(prow + h * 64 + s8 * 8), q); unpack8(*(const v4u*)(prow + 256 + h * 64 + s8 * 8), k);
      const float* bp = BCg + (size_t)(row0 + t) * 256 + h * 64 + s8 * 8; const f32x4 b0 = *(const f32x4*)bp, b1 = *(const f32x4*)(bp + 4);
      const float bc[8] = {b0.x, b0.y, b0.z, b0.w, b1.x, b1.y, b1.z, b1.w};
#pragma unroll
      for (int j = 0; j < 8; ++j) { q[j] = q[j] * 0.125f * __expf(bc[j]); k[j] = k[j] * __expf(-bc[j]); }
      v4u wq, wk; wq.x = pk2(q[0], q[1]); wq.y = pk2(q[2], q[3]); wq.z = pk2(q[4], q[5]); wq.w = pk2(q[6], q[7]); wk.x = pk2(k[0], k[1]); wk.y = pk2(k[2], k[3]); wk.z = pk2(k[4], k[5]); wk.w = pk2(k[6], k[7]);
      *(LAS v4u*)(QD + t * 144 + s8 * 16) = wq; *(LAS v4u*)(KI + t * 144 + s8 * 16) = wk;
      const v4u v0 = *(const v4u*)(prow + 512 + h * 128 + s8 * 16), v1 = *(const v4u*)(prow + 512 + h * 128 + s8 * 16 + 8);
      const unsigned vw[8] = {v0.x, v0.y, v0.z, v0.w, v1.x, v1.y, v1.z, v1.w};
      LAS unsigned char* vt = VT + (16 * s8) * 144 + t * 2;
#pragma unroll
      for (int j = 0; j < 8; ++j) { *(LAS bf16*)(vt + (2 * j) * 144) = (bf16)(vw[j] & 0xffffu); *(LAS bf16*)(vt + (2 * j + 1) * 144) = (bf16)(vw[j] >> 16); }
      const int d = t; const f32x4* sp = (const f32x4*)(DS + (size_t)u * 8192 + d * 128 + s8 * 16);
      LAS unsigned char* st = SPT + (16 * s8) * 144 + d * 2;
#pragma unroll
      for (int i = 0; i < 4; ++i) { const f32x4 x = sp[i];
#pragma unroll
          for (int j = 0; j < 4; ++j) *(LAS bf16*)(st + (4 * i + j) * 144) = (bf16)f2bf(x[j]); } }
    __syncthreads();
    const int r16 = c.lane & 15, q4 = c.lane >> 4, w = c.wave;
    bf16x8 qd[4][2];
#pragma unroll
    for (int tf = 0; tf < 4; ++tf)
#pragma unroll
        for (int ks = 0; ks < 2; ++ks) qd[tf][ks] = *(const LAS bf16x8*)(QD + (16 * tf + r16) * 144 + (32 * ks + 8 * q4) * 2);
    f32x4 sc[4][4];
#pragma unroll
    for (int sf = 0; sf < 4; ++sf) {
        bf16x8 ki[2];
#pragma unroll
        for (int ks = 0; ks < 2; ++ks) ki[ks] = *(const LAS bf16x8*)(KI + (16 * sf + r16) * 144 + (32 * ks + 8 * q4) * 2);
#pragma unroll
        for (int tf = 0; tf < 4; ++tf) {
            f32x4 a = {0.f, 0.f, 0.f, 0.f};
            if (sf <= tf) {
#pragma unroll
                for (int ks = 0; ks < 2; ++ks) a = mfma16(ki[ks], qd[tf][ks], a);
                if (sf == tf) {
#pragma unroll
                    for (int i = 0; i < 4; ++i) a[i] = (4 * q4 + i <= r16) ? a[i] : 0.f;
                }
            }
            sc[sf][tf] = a;
        }
    }
    f32x4 o[4];
#pragma unroll
    for (int tf = 0; tf < 4; ++tf) o[tf] = (f32x4){0.f, 0.f, 0.f, 0.f};
    const LAS unsigned char* vrow = VT + (16 * w + r16) * 144; const LAS unsigned char* srow = SPT + (16 * w + r16) * 144;
#pragma unroll
    for (int kk = 0; kk < 2; ++kk) {
        const v2u lo = *(const LAS v2u*)(vrow + (32 * kk + 4 * q4) * 2), hi = *(const LAS v2u*)(vrow + (32 * kk + 16 + 4 * q4) * 2);
        v4u aw; aw.x = lo.x; aw.y = lo.y; aw.z = hi.x; aw.w = hi.y; const bf16x8 a = __builtin_bit_cast(bf16x8, aw);
#pragma unroll
        for (int tf = 0; tf < 4; ++tf) if (2 * kk <= tf) o[tf] = mfma16(a, pack8(sc[2 * kk][tf], sc[2 * kk + 1][tf]), o[tf]);
    }
#pragma unroll
    for (int ks = 0; ks < 2; ++ks) { const bf16x8 a = *(const LAS bf16x8*)(srow + (32 * ks + 8 * q4) * 2);
#pragma unroll
        for (int tf = 0; tf < 4; ++tf) o[tf] = mfma16(a, qd[tf][ks], o[tf]); }
#pragma unroll
    for (int tf = 0; tf < 4; ++tf) { float ssq = (o[tf][0] * o[tf][0] + o[tf][1] * o[tf][1]) + (o[tf][2] * o[tf][2] + o[tf][3] * o[tf][3]);
        ssq += __shfl_xor(ssq, 16); ssq += __shfl_xor(ssq, 32); if (q4 == 0) PART[w * 64 + 16 * tf + r16] = ssq; }
    __syncthreads();
    const f32x4 gg = *(const f32x4*)(gnorm + 16 * w + 4 * q4);
#pragma unroll
    for (int tf = 0; tf < 4; ++tf) { const int t = 16 * tf + r16; float ssq = 0.f;
#pragma unroll
        for (int ww = 0; ww < 8; ++ww) ssq += PART[ww * 64 + t];
        const float rn = rsqrtf(ssq * (1.0f / 128.0f) + EPS);
        const v2u rv = *(const v2u*)(PROJ + (size_t)(row0 + t) * PROJW + 1024 + h * 128 + 16 * w + 4 * q4);
        const float rr[4] = {bflo(rv.x), bfhi(rv.x), bflo(rv.y), bfhi(rv.y)}; float res[4];
#pragma unroll
        for (int i = 0; i < 4; ++i) res[i] = o[tf][i] * rn * gg[i] * (rr[i] * __builtin_amdgcn_rcpf(1.0f + __expf(-rr[i])));
        v2u ow; ow.x = pk2(res[0], res[1]); ow.y = pk2(res[2], res[3]);
        *(v2u*)(CAT + (size_t)(row0 + t) * 1024 + h * 128 + 16 * w + 4 * q4) = ow; }
    __syncthreads();
}

DI void s5_params(const Ctx& c, const float* lam_re, const float* lam_im, const float* log_dt, const float* B_re, const float* B_im, float* P) {
    for (int idx = c.vcu * 512 + c.tid; idx < 2 * 32 * 64; idx += c.G * 512) {
        const float lr = fminf(lam_re[idx], -1e-4f), li = lam_im[idx], dt = expf(log_dt[idx >> 6]);
        const float mag = expf(lr * dt), ar = mag * cosf(li * dt), ai = mag * sinf(li * dt);
        const float den = lr * lr + li * li, nr = ar - 1.0f, fre = (nr * lr + ai * li) / den, fim = (ai * lr - nr * li) / den;
        P[S5P_A + 2 * idx] = ar; P[S5P_A + 2 * idx + 1] = ai;
        float tr = ar, ti = ai;
#pragma unroll
        for (int s = 0; s < 6; ++s) { const float nr2 = tr * tr - ti * ti, ni2 = 2.0f * tr * ti; tr = nr2; ti = ni2; }
        P[S5P_AT + 2 * idx] = tr; P[S5P_AT + 2 * idx + 1] = ti;
        bf16* BBH = (bf16*)(P + S5P_BBH); const int eg = idx >> 6, pp = idx & 63;
        for (int cc = 0; cc < 16; ++cc) { const float Br = B_re[idx * 16 + cc], Bi = B_im[idx * 16 + cc]; const float br = fre * Br - fim * Bi, bi = fre * Bi + fim * Br;
            P[S5P_BB + 2 * (idx * 16 + cc)] = br; P[S5P_BB + 2 * (idx * 16 + cc) + 1] = bi;
            BBH[(eg * 128 + pp) * 16 + cc] = (bf16)f2bf(br); BBH[(eg * 128 + 64 + pp) * 16 + cc] = (bf16)f2bf(bi); }
    }
}
DI void s5_load_u(const bf16* PROJ, int row0, int g, LAS float* U, int lane) {
    const bf16* p = PROJ + (size_t)(row0 + lane) * PROJW + 1792 + g * 16; float x[8];
    unpack8(*(const v4u*)p, x); ((LAS f32x4*)(U + lane * 16))[0] = (f32x4){x[0], x[1], x[2], x[3]}; ((LAS f32x4*)(U + lane * 16))[1] = (f32x4){x[4], x[5], x[6], x[7]};
    unpack8(*(const v4u*)(p + 8), x); ((LAS f32x4*)(U + lane * 16))[2] = (f32x4){x[0], x[1], x[2], x[3]}; ((LAS f32x4*)(U + lane * 16))[3] = (f32x4){x[4], x[5], x[6], x[7]};
}
DI void s5_frags(const bf16* PROJ, const float* P, int e, int g, int row0, int r16, int q4, bf16x8 (&ua)[4], bf16x8 (&bb)[8]) {
    const bf16x8 zf = {0, 0, 0, 0, 0, 0, 0, 0}; const bf16* BBH = (const bf16*)(P + S5P_BBH);
#pragma unroll
    for (int tf = 0; tf < 4; ++tf) ua[tf] = (q4 < 2) ? *(const bf16x8*)(PROJ + (size_t)(row0 + 16 * tf + r16) * PROJW + 1792 + g * 16 + 8 * q4) : zf;
#pragma unroll
    for (int pf = 0; pf < 8; ++pf) bb[pf] = (q4 < 2) ? *(const bf16x8*)(BBH + ((size_t)(e * 32 + g) * 128 + 16 * pf + r16) * 16 + 8 * q4) : zf;
}
DI void s5_bu16(const bf16x8 ua, const bf16x8 (&bb)[8], LAS float* BUs, int r16, int q4) {
    LAS float* wp = BUs + (4 * q4) * 128 + r16;
#pragma unroll
    for (int pf = 0; pf < 8; ++pf) { const f32x4 d = mfma16(ua, bb[pf], (f32x4){0.f, 0.f, 0.f, 0.f});
#pragma unroll
        for (int i = 0; i < 4; ++i) wp[i * 128 + 16 * pf] = d[i]; }
}
#define S5_BU(t) do { const LAS f32x4* up_ = (const LAS f32x4*)(U + (t) * 16); const f32x4 u0 = up_[0], u1 = up_[1], u2 = up_[2], u3 = up_[3]; \
    const float uu[16] = {u0.x, u0.y, u0.z, u0.w, u1.x, u1.y, u1.z, u1.w, u2.x, u2.y, u2.z, u2.w, u3.x, u3.y, u3.z, u3.w}; bur = 0.f; bui = 0.f; \
    _Pragma("unroll") for (int cc = 0; cc < 16; ++cc) { bur += bbr[cc] * uu[cc]; bui += bbi[cc] * uu[cc]; } } while (0)
DI void s5_phase1(const Ctx& c, int e, const bf16* PROJ, const float* P, float* S5E) {
    LAS float* U = (LAS float*)(c.lds + c.wave * 4096);
    const int NGW = c.G * 8, gw = c.vcu * 8 + c.wave;
    const bool reg = (NGW == 2 * 32 * S5NC / 4);
    int gcur = -1; float ar = 0.f, ai = 0.f, bbr[16], bbi[16];
#pragma unroll
    for (int cc = 0; cc < 16; ++cc) { bbr[cc] = 0.f; bbi[cc] = 0.f; }
    for (int it = 0;; ++it) {
        int wt; if (reg) { if (it >= 4) break; wt = (gw >> 5) * S5NC + (gw & 31) + 32 * it; } else { wt = gw + it * NGW; if (wt >= 2 * 32 * S5NC) break; }
        const int cch = wt & (S5NC - 1), bg = wt >> 7, g = bg & 31, b = bg >> 5, row0 = b * SEQ + cch * S5T, pi = (e * 32 + g) * 64 + c.lane;
        s5_load_u(PROJ, row0, g, U, c.lane);
        if (g != gcur) { gcur = g; ar = P[S5P_A + 2 * pi]; ai = P[S5P_A + 2 * pi + 1];
#pragma unroll
            for (int cc = 0; cc < 16; ++cc) { bbr[cc] = P[S5P_BB + 2 * (pi * 16 + cc)]; bbi[cc] = P[S5P_BB + 2 * (pi * 16 + cc) + 1]; } }
        LDS_WAIT();
        float xr = 0.f, xi = 0.f, bur, bui;
        for (int t = 0; t < S5T; ++t) { S5_BU(t); const float nxr = ar * xr - ai * xi + bur, nxi = ar * xi + ai * xr + bui; xr = nxr; xi = nxi; }
        *(f32x2*)(S5E + 2 * ((size_t)wt * 64 + c.lane)) = (f32x2){xr, xi};
        LDS_WAIT();
    }
}
DI void s5_phase2(const Ctx& c, int e, const float* P, float* S5E) {
    for (int sq = (c.G - 1 - c.vcu) * 512 + c.tid; sq < 2 * 32 * 64; sq += c.G * 512) {
        const int p = sq & 63, bg = sq >> 6, g = bg & 31, pi = (e * 32 + g) * 64 + p; const float tr = P[S5P_AT + 2 * pi], ti = P[S5P_AT + 2 * pi + 1];
        float xr = 0.f, xi = 0.f; f32x2* q0 = (f32x2*)(S5E + 2 * (((size_t)bg * S5NC) * 64 + p));
        for (int c0 = 0; c0 < S5NC; c0 += 16) {
            f32x2 ev[16];
#pragma unroll
            for (int j = 0; j < 16; ++j) ev[j] = q0[(c0 + j) * 64];
#pragma unroll
            for (int j = 0; j < 16; ++j) { q0[(c0 + j) * 64] = (f32x2){xr, xi}; const float nxr = tr * xr - ti * xi + ev[j].x, nxi = tr * xi + ti * xr + ev[j].y; xr = nxr; xi = nxi; }
        }
    }
}
DI void s5_phase3(const Ctx& c, int e, const bf16* PROJ, const float* P, const float* S5E, const float* C_re, const float* C_im, const float* Dp, bf16* Y) {
    LAS float* BUs = (LAS float*)(c.lds + c.wave * 12544);
    LAS unsigned char* XB = c.lds + c.wave * 12544 + 8192;
    const int NGW = c.G * 8, gw = c.vcu * 8 + c.wave; const int r16 = c.lane & 15, q4 = c.lane >> 4;
    const bool reg = (NGW == 2 * 32 * S5NC / 4);
    const bf16x8 zf = {0, 0, 0, 0, 0, 0, 0, 0};
    int gcur = -1; float ar = 0.f, ai = 0.f, Dg = 0.f; bf16x8 bb[8], cf[4];
#pragma unroll
    for (int pf = 0; pf < 8; ++pf) bb[pf] = zf;
#pragma unroll
    for (int ks = 0; ks < 4; ++ks) cf[ks] = zf;
    for (int it = 0;; ++it) {
        int wt; if (reg) { if (it >= 4) break; wt = (gw >> 5) * S5NC + (gw & 31) + 32 * it; } else { wt = gw + it * NGW; if (wt >= 2 * 32 * S5NC) break; }
        const int cch = wt & (S5NC - 1), bg = wt >> 7, g = bg & 31, b = bg >> 5, row0 = b * SEQ + cch * S5T, pi = (e * 32 + g) * 64 + c.lane;
        bf16x8 ua[4];
#pragma unroll
        for (int tf = 0; tf < 4; ++tf) ua[tf] = (q4 < 2) ? *(const bf16x8*)(PROJ + (size_t)(row0 + 16 * tf + r16) * PROJW + 1792 + g * 16 + 8 * q4) : zf;
        if (g != gcur) { gcur = g;
            const bf16* BBH = (const bf16*)(P + S5P_BBH);
#pragma unroll
            for (int pf = 0; pf < 8; ++pf) bb[pf] = (q4 < 2) ? *(const bf16x8*)(BBH + ((size_t)(e * 32 + g) * 128 + 16 * pf + r16) * 16 + 8 * q4) : zf;
            ar = P[S5P_A + 2 * pi]; ai = P[S5P_A + 2 * pi + 1];
            const size_t gi = ((size_t)(e * 32 + g) * 16 + r16) * 64 + 8 * q4;
#pragma unroll
            for (int ks = 0; ks < 4; ++ks) { const float* src = (ks < 2 ? C_re : C_im) + gi + 32 * (ks & 1); const float sg = ks < 2 ? 1.0f : -1.0f;
                const f32x4 x0 = *(const f32x4*)src, x1 = *(const f32x4*)(src + 4); cf[ks] = pack8(x0 * sg, x1 * sg); }
            Dg = Dp[(e * 32 + g) * 16 + r16]; }
        const f32x2 x0 = *(const f32x2*)(S5E + 2 * ((size_t)wt * 64 + c.lane));
        float xr = x0.x, xi = x0.y;
#pragma unroll
        for (int sc = 0; sc < 4; ++sc) {
            s5_bu16(ua[sc], bb, BUs, r16, q4);
            LDS_WAIT();
#pragma unroll
            for (int tt = 0; tt < 16; ++tt) { const float bur = BUs[tt * 128 + c.lane], bui = BUs[tt * 128 + 64 + c.lane]; const float nxr = ar * xr - ai * xi + bur, nxi = ar * xi + ai * xr + bui; xr = nxr; xi = nxi;
                *(LAS bf16*)(XB + tt * 272 + c.lane * 2) = (bf16)f2bf(xr); *(LAS bf16*)(XB + tt * 272 + 128 + c.lane * 2) = (bf16)f2bf(xi); }
            LDS_WAIT();
            f32x4 y = {0.f, 0.f, 0.f, 0.f};
#pragma unroll
            for (int ks = 0; ks < 4; ++ks) y = mfma16(*(const LAS bf16x8*)(XB + r16 * 272 + (32 * ks + 8 * q4) * 2), cf[ks], y);
#pragma unroll
            for (int i = 0; i < 4; ++i) { const int t = sc * 16 + 4 * q4 + i; const float yy = y[i] + Dg * bf2f(PROJ[(size_t)(row0 + t) * PROJW + 1792 + g * 16 + r16]);
                const float z = 0.7978845608f * (yy + 0.044715f * yy * yy * yy); const float th = 1.0f - 2.0f * __builtin_amdgcn_rcpf(__expf(2.0f * z) + 1.0f);
                Y[(size_t)(row0 + t) * 512 + g * 16 + r16] = (bf16)f2bf(0.5f * yy * (1.0f + th)); }
            LDS_WAIT();
        }
    }
}

constexpr int XA_KSLOT = 256 * 144, XA_VSLOT = 64 * 528, XA_VOFF = 2 * XA_KSLOT;
DI void xattn_unit(const Ctx& c, int uidx, int layer, const bf16* XQ, const bf16* MK, const bf16* MVT, bf16* XO) {
    const int h = uidx & 3, tile = uidx >> 2, b = tile >> 5, row0 = tile * 256;
    LAS unsigned char* KS = c.lds; LAS unsigned char* VS = c.lds + XA_VOFF;
    const int r16 = c.lane & 15, q4 = c.lane >> 4, w = c.wave;
    const bf16* kg = MK + (size_t)(b * 256) * 4096 + layer * 1024 + h * 256;
    const bf16* vg = MVT + (size_t)(layer * 1024 + h * 256) * 512 + b * 256;
    v4u st[4];
#define XA_LOADK(dc_) do { _Pragma("unroll") for (int i = 0; i < 4; ++i) { const int idx = c.tid + 512 * i; st[i] = *(const v4u*)(kg + (size_t)(idx >> 3) * 4096 + (dc_) * 64 + (idx & 7) * 8); } } while (0)
#define XA_STOREK(slot_) do { _Pragma("unroll") for (int i = 0; i < 4; ++i) { const int idx = c.tid + 512 * i; *(LAS v4u*)(KS + (slot_) * XA_KSLOT + (idx >> 3) * 144 + (idx & 7) * 16) = st[i]; } } while (0)
#define XA_LOADV(dc_) do { _Pragma("unroll") for (int i = 0; i < 4; ++i) { const int idx = c.tid + 512 * i; st[i] = *(const v4u*)(vg + (size_t)((dc_) * 64 + (idx >> 5)) * 512 + (idx & 31) * 8); } } while (0)
#define XA_STOREV(slot_) do { _Pragma("unroll") for (int i = 0; i < 4; ++i) { const int idx = c.tid + 512 * i; *(LAS v4u*)(VS + (slot_) * XA_VSLOT + (idx >> 5) * 528 + (idx & 31) * 16) = st[i]; } } while (0)
    __syncthreads();
    XA_LOADK(0); XA_STOREK(0);
    __syncthreads();
    f32x4 sa[16][2];
#pragma unroll
    for (int mf = 0; mf < 16; ++mf) { sa[mf][0] = (f32x4){0.f, 0.f, 0.f, 0.f}; sa[mf][1] = sa[mf][0]; }
    const bf16* qg = XQ + (size_t)(row0 + 32 * w + r16) * 1024 + h * 256 + 8 * q4;
#pragma unroll 1
    for (int dc = 0; dc < 4; ++dc) {
        bf16x8 qf[2][2];
#pragma unroll
        for (int tf = 0; tf < 2; ++tf)
#pragma unroll
            for (int ks = 0; ks < 2; ++ks) qf[tf][ks] = *(const bf16x8*)(qg + (size_t)(16 * tf) * 1024 + dc * 64 + ks * 32);
        if (dc < 3) XA_LOADK(dc + 1); else XA_LOADV(0);
        const LAS unsigned char* kc = KS + (dc & 1) * XA_KSLOT + r16 * 144 + 16 * q4;
#pragma unroll
        for (int mf = 0; mf < 16; ++mf)
#pragma unroll
            for (int ks = 0; ks < 2; ++ks) { const bf16x8 a = *(const LAS bf16x8*)(kc + mf * (16 * 144) + ks * 64);
                sa[mf][0] = mfma16(a, qf[0][ks], sa[mf][0]); sa[mf][1] = mfma16(a, qf[1][ks], sa[mf][1]); }
        if (dc < 3) XA_STOREK((dc + 1) & 1); else XA_STOREV(0);
        __syncthreads();
    }
    bf16x8 pp[8][2];
#pragma unroll
    for (int tf = 0; tf < 2; ++tf) {
        float m = sa[0][tf][0];
#pragma unroll
        for (int mf = 0; mf < 16; ++mf)
#pragma unroll
            for (int i = 0; i < 4; ++i) m = fmaxf(m, sa[mf][tf][i]);
        m = fmaxf(m, __shfl_xor(m, 16)); m = fmaxf(m, __shfl_xor(m, 32));
        float l = 0.f;
#pragma unroll
        for (int mf = 0; mf < 16; ++mf)
#pragma unroll
            for (int i = 0; i < 4; ++i) { const float p = __expf(sa[mf][tf][i] - m); sa[mf][tf][i] = p; l += p; }
        l += __shfl_xor(l, 16); l += __shfl_xor(l, 32);
        const float inv = 1.0f / l;
#pragma unroll
        for (int kk = 0; kk < 8; ++kk) pp[kk][tf] = pack8(sa[2 * kk][tf] * inv, sa[2 * kk + 1][tf] * inv);
    }
    bf16* og = XO + (size_t)(row0 + 32 * w + r16) * 1024 + h * 256 + 4 * q4;
#pragma unroll 1
    for (int dc = 0; dc < 4; ++dc) {
        if (dc < 3) XA_LOADV(dc + 1);
        f32x4 o[4][2];
#pragma unroll
        for (int df = 0; df < 4; ++df) { o[df][0] = (f32x4){0.f, 0.f, 0.f, 0.f}; o[df][1] = o[df][0]; }
        const LAS unsigned char* vc = VS + (dc & 1) * XA_VSLOT + r16 * 528 + 8 * q4;
#pragma unroll
        for (int kk = 0; kk < 8; ++kk)
#pragma unroll
            for (int df = 0; df < 4; ++df) { const v2u lo = *(const LAS v2u*)(vc + df * (16 * 528) + kk * 64), hi = *(const LAS v2u*)(vc + df * (16 * 528) + kk * 64 + 32);
                v4u aw; aw.x = lo.x; aw.y = lo.y; aw.z = hi.x; aw.w = hi.y; const bf16x8 a = __builtin_bit_cast(bf16x8, aw);
                o[df][0] = mfma16(a, pp[kk][0], o[df][0]); o[df][1] = mfma16(a, pp[kk][1], o[df][1]); }
#pragma unroll
        for (int tf = 0; tf < 2; ++tf)
#pragma unroll
            for (int df = 0; df < 4; ++df) { v2u ow; ow.x = pk2(o[df][tf][0], o[df][tf][1]); ow.y = pk2(o[df][tf][2], o[df][tf][3]); *(v2u*)(og + (size_t)(16 * tf) * 1024 + dc * 64 + 16 * df) = ow; }
        if (dc < 3) { XA_STOREV((dc + 1) & 1); __syncthreads(); }
    }
#undef XA_LOADK
#undef XA_STOREK
#undef XA_LOADV
#undef XA_STOREV
}

DI void rope_row(bf16* prow, const float* cA, const float* sA, const float* cI, const float* sI, int lane) {
    int c1[15], hf[15]; float x1[15], x2[15], cs[15], sn[15], sc[15];
#pragma unroll
    for (int k = 0; k < 15; ++k) {
        const int pi = lane + 64 * k; int i; bool tabA; sc[k] = 1.0f;
        if (pi < 512) { i = pi & 63; c1[k] = (pi >> 6) * 128 + i; hf[k] = 64; tabA = true; sc[k] = 0.08838834764831845f; }
        else if (pi < 640) { const int pp = pi - 512; i = pp & 63; c1[k] = 1024 + (pp >> 6) * 128 + i; hf[k] = 64; tabA = true; }
        else if (pi < 896) { const int pp = pi - 640; i = pp & 31; c1[k] = 1536 + (pp >> 5) * 64 + i; hf[k] = 32; tabA = false; }
        else { i = (pi - 896) & 31; c1[k] = 2048 + i; hf[k] = 32; tabA = false; }
        cs[k] = tabA ? cA[i] : cI[i]; sn[k] = tabA ? sA[i] : sI[i];
        x1[k] = bf2f(prow[c1[k]]); x2[k] = bf2f(prow[c1[k] + hf[k]]);
    }
#pragma unroll
    for (int k = 0; k < 15; ++k) { if (lane + 64 * k < 928) { prow[c1[k]] = (bf16)f2bf((x1[k] * cs[k] - x2[k] * sn[k]) * sc[k]); prow[c1[k] + hf[k]] = (bf16)f2bf((x2[k] * cs[k] + x1[k] * sn[k]) * sc[k]); } }
}
DI unsigned wave_select(LAS unsigned* buf, int count, int lane) {
    unsigned k[16];
#pragma unroll
    for (int j = 0; j < 16; ++j) { const int idx = j * 64 + lane; k[j] = idx < count ? buf[idx] : 0u; }
    unsigned tau = 0u;
    for (int bit = 31; bit >= 0; --bit) { const unsigned cand = tau | (1u << bit); int cn = 0;
#pragma unroll
        for (int j = 0; j < 16; ++j) cn += __popcll(__ballot(k[j] >= cand));
        if (cn >= TOPK) tau = cand;
        if (cn == TOPK) break; }
    int off = 0; const unsigned long long lt = (1ull << lane) - 1ull;
#pragma unroll
    for (int j = 0; j < 16; ++j) { const bool pred = k[j] >= tau; const unsigned long long bal = __ballot(pred); if (pred) buf[off + __popcll(bal & lt)] = k[j]; off += __popcll(bal); }
    LDS_WAIT();
    return tau;
}
constexpr int IDX_KT = 131072, IDX_KT_SLOT = 64 * 144, IDX_FL = IDX_KT + 2 * IDX_KT_SLOT;
#define IDX_BODY(slot_, kb_) do { \
    bf16x8 R[4][2]; \
    _Pragma("unroll") for (int jb = 0; jb < 4; ++jb) _Pragma("unroll") for (int ks = 0; ks < 2; ++ks) R[jb][ks] = *(const LAS bf16x8*)((slot_) + (16 * jb + r16) * 144 + (ks * 32 + 8 * q4) * 2); \
    f32x4 lo_[4], hi_[4]; \
    _Pragma("unroll") for (int jb = 0; jb < 4; ++jb) { lo_[jb] = (f32x4){0.f, 0.f, 0.f, 0.f}; hi_[jb] = lo_[jb]; \
        _Pragma("unroll") for (int ks = 0; ks < 2; ++ks) { lo_[jb] = mfma16(Alo[ks], R[jb][ks], lo_[jb]); hi_[jb] = mfma16(Ahi[ks], R[jb][ks], hi_[jb]); } } \
    const int rev0_ = 8191 - r16 - 16 * (kb_); \
    _Pragma("unroll") for (int jb = 0; jb < 4; ++jb) { \
        float s0_ = 0.f, s1_ = 0.f; \
        _Pragma("unroll") for (int i = 0; i < 4; ++i) { s0_ = fmaf(__int_as_float(max(__float_as_int(lo_[jb][i]), 0)), w[i], s0_); s1_ = fmaf(__int_as_float(max(__float_as_int(hi_[jb][i]), 0)), w[4 + i], s1_); } \
        const unsigned u_ = __float_as_uint(s0_ + s1_), mono_ = u_ ^ ((unsigned)((int)u_ >> 31) | 0x80000000u); \
        const int rev_ = rev0_ - 16 * jb; const unsigned key_ = (mono_ & 0xFFFFE000u) | (unsigned)rev_; \
        const bool pred_ = (rev_ >= revq) && (key_ > tau); \
        const unsigned long long bal_ = __ballot(pred_); const unsigned grp_ = (unsigned)(bal_ >> (16 * q4)) & 0xFFFFu; \
        if (MODE == 0) { if (pred_) mybuf[cnt + __popc(grp_ & lmask)] = key_; cnt += __popc(grp_); } else { chk ^= key_ & (pred_ ? 0xffffffffu : 0x0fu); } } } while (0)
template <int MODE> DI void dsa_index_unit(const Ctx& c, int uidx, const bf16* PROJ, unsigned short* SEL, int* SELN) {
    const int pr = uidx & 255, b = pr >> 7, jj = pr & 127, qblk = uidx < 256 ? jj : 255 - jj, t0 = qblk * 32;
    LAS unsigned* CAND = (LAS unsigned*)c.lds;
    LAS unsigned char* KT = c.lds + IDX_KT; LAS unsigned* FL = (LAS unsigned*)(c.lds + IDX_FL);
    const int r16 = c.lane & 15, q4 = c.lane >> 4;
    const bf16* qrowA = PROJ + (size_t)(b * SEQ + t0 + 4 * c.wave + (r16 >> 2)) * PROJW + 1536 + 8 * q4;
    bf16x8 Alo[2], Ahi[2];
#pragma unroll
    for (int ks = 0; ks < 2; ++ks) { Alo[ks] = *(const bf16x8*)(qrowA + (r16 & 3) * 64 + ks * 32); Ahi[ks] = *(const bf16x8*)(qrowA + ((r16 & 3) + 4) * 64 + ks * 32); }
    const int tq = t0 + 4 * c.wave + q4, revq = 8191 - tq; const unsigned lmask = (1u << r16) - 1u;
    float w[8]; unpack8(*(const v4u*)(PROJ + (size_t)(b * SEQ + tq) * PROJW + 2112), w);
#pragma unroll
    for (int j = 0; j < 8; ++j) w[j] *= 0.04419417382415922f;
    int cnt = 0; unsigned tau = 0u, chk = 0u;
    LAS unsigned* mybuf = CAND + (4 * c.wave + q4) * 1024;
    const int nit = (qblk >> 1) + 1;
    const bf16* ksrc = PROJ + (size_t)(b * SEQ + (c.tid >> 3)) * PROJW + 2048 + 8 * (c.tid & 7); const int kdst = (c.tid >> 3) * 144 + (c.tid & 7) * 16;
    __syncthreads();
    v4u pre = *(const v4u*)ksrc;
    *(LAS v4u*)(KT + kdst) = pre;
    if (nit > 1) pre = *(const v4u*)(ksrc + (size_t)64 * PROJW);
    for (int it = 0; it < nit; ++it) {
        LAS unsigned char* slot = KT + (it & 1) * IDX_KT_SLOT;
        { const unsigned long long nb = __ballot(cnt > 1024 - 64); if (c.lane == 0) FL[(it & 1) * 8 + c.wave] = nb != 0ull ? 1u : 0u; }
        __syncthreads();
        { const v4u f0 = *(const LAS v4u*)(FL + (it & 1) * 8), f1 = *(const LAS v4u*)(FL + (it & 1) * 8 + 4);
          if (MODE == 0 && (f0.x | f0.y | f0.z | f0.w | f1.x | f1.y | f1.z | f1.w)) {
#pragma unroll
              for (int g4 = 0; g4 < 4; ++g4) { const int cg = __shfl(cnt, 16 * g4); if (cg > TOPK) { const unsigned tn = wave_select(CAND + (4 * c.wave + g4) * 1024, cg, c.lane); if (q4 == g4) { tau = tn; cnt = TOPK; } } } } }
        IDX_BODY(slot, 4 * it);
        if (it + 1 < nit) { *(LAS v4u*)(KT + ((it + 1) & 1) * IDX_KT_SLOT + kdst) = pre; if (it + 2 < nit) pre = *(const v4u*)(ksrc + (size_t)(64 * (it + 2)) * PROJW); }
    }
    LDS_WAIT();
    if (MODE != 0) { if (chk == 0x12345u) SELN[uidx] = (int)chk; return; }
#pragma unroll
    for (int g4 = 0; g4 < 4; ++g4) {
        int cg = __shfl(cnt, 16 * g4); LAS unsigned* bufg = CAND + (4 * c.wave + g4) * 1024;
        if (cg > TOPK) { (void)wave_select(bufg, cg, c.lane); cg = TOPK; }
        const size_t qg = (size_t)(b * SEQ + t0 + 4 * c.wave + g4);
#pragma unroll
        for (int i = 0; i < 4; ++i) { const int slot = c.lane + 64 * i; if (slot < cg) SEL[qg * 256 + slot] = (unsigned short)(8191u - (bufg[slot] & 0x1FFFu)); }
        if (c.lane == 0) SELN[qg] = cg;
    }
    LDS_WAIT();
}
#define SB() __builtin_amdgcn_sched_barrier(0)
DI f32x4 mfma8(const v2u a, const v2u b, const f32x4 c) { return __builtin_amdgcn_mfma_f32_16x16x32_fp8_fp8(__builtin_bit_cast(long, a), __builtin_bit_cast(long, b), c, 0, 0, 0); }
#define DSA_QS 32.0f
#define DSA_RDW(pb_, tv_) asm volatile("s_waitcnt lgkmcnt(0)" : "+v"(pb_), "+v"(tv_[0]), "+v"(tv_[1]), "+v"(tv_[2]), "+v"(tv_[3]), "+v"(tv_[4]), "+v"(tv_[5]), "+v"(tv_[6]), "+v"(tv_[7]) : : "memory")
#define DSA_VWAIT(n) asm volatile("s_waitcnt vmcnt(" #n ")" ::: "memory")
#define DSA3_WS 17152
#define DSA3_KLD(dst_, off_, imm_, kb_) asm volatile("global_load_dwordx4 %0, %1, %2 offset:" #imm_ : "=&v"(dst_) : "v"(off_), "s"(kb_) : "memory")
#define DSA3_LOADK(dst, blk) do { const unsigned koff_ = kix[blk] * 128u + kofs; DSA3_KLD(dst[0][0], koff_, 0, k8g0); DSA3_KLD(dst[0][1], koff_, 64, k8g0); DSA3_KLD(dst[1][0], koff_, 0, k8g1); DSA3_KLD(dst[1][1], koff_, 64, k8g1); } while (0)
#define DSA3_KWAIT(n, dst) asm volatile("s_waitcnt vmcnt(" #n ")" : "+v"(dst[0][0]), "+v"(dst[0][1]), "+v"(dst[1][0]), "+v"(dst[1][1]) : : "memory")
#define DSA3_KPERM(dst) do { _Pragma("unroll") for (int kvi = 0; kvi < 2; ++kvi) _Pragma("unroll") for (int hf = 0; hf < 2; ++hf) { v4u w_ = dst[kvi][hf]; \
    w_.x = (unsigned)__builtin_amdgcn_ds_bpermute(kperm, (int)w_.x); w_.y = (unsigned)__builtin_amdgcn_ds_bpermute(kperm, (int)w_.y); w_.z = (unsigned)__builtin_amdgcn_ds_bpermute(kperm, (int)w_.z); w_.w = (unsigned)__builtin_amdgcn_ds_bpermute(kperm, (int)w_.w); \
    dst[kvi][hf] = w_; } } while (0)
#define DSA3_QK(blk, src) do { f32x4 a0_ = {0.f, 0.f, 0.f, 0.f}, a1_ = {0.f, 0.f, 0.f, 0.f}; \
    _Pragma("unroll") for (int ks = 0; ks < 4; ++ks) { const v4u w0_ = src[0][ks >> 1], w1_ = src[1][ks >> 1]; v2u p0_, p1_; p0_.x = (ks & 1) ? w0_.z : w0_.x; p0_.y = (ks & 1) ? w0_.w : w0_.y; p1_.x = (ks & 1) ? w1_.z : w1_.x; p1_.y = (ks & 1) ? w1_.w : w1_.y; \
        a0_ = mfma8(p0_, q2[0][ks], a0_); a1_ = mfma8(p1_, q2[1][ks], a1_); } acc[blk] = a0_ + a1_; } while (0)
#define DSA3_DMAV(u_) do { _Pragma("unroll") for (int j = 0; j < 4; ++j) \
    __builtin_amdgcn_global_load_lds((const unsigned*)((((u_) & 1) ? v8b1 : v8b0) + vix[(u_) >> 1][j] * 128u + ((j & 1) ? vsw1 : vsw0)), (LAS unsigned*)(Vb + ((u_) % 3) * 4096 + j * 1024), 16, 0, 0); } while (0)
#define DSA3_RD(pb_, tv_, soff_, poff_) asm volatile( \
    "ds_read_b64 %0, %9 offset:%19\n\tds_read_b64_tr_b8 %1, %10 offset:%18\n\tds_read_b64_tr_b8 %2, %11 offset:%18\n\tds_read_b64_tr_b8 %3, %12 offset:%18\n\tds_read_b64_tr_b8 %4, %13 offset:%18\n\t" \
    "ds_read_b64_tr_b8 %5, %14 offset:%18\n\tds_read_b64_tr_b8 %6, %15 offset:%18\n\tds_read_b64_tr_b8 %7, %16 offset:%18\n\tds_read_b64_tr_b8 %8, %17 offset:%18" \
    : "=&v"(pb_), "=&v"(tv_[0]), "=&v"(tv_[1]), "=&v"(tv_[2]), "=&v"(tv_[3]), "=&v"(tv_[4]), "=&v"(tv_[5]), "=&v"(tv_[6]), "=&v"(tv_[7]) \
    : "v"(prdA), "v"(va[0]), "v"(va[1]), "v"(va[2]), "v"(va[3]), "v"(va[4]), "v"(va[5]), "v"(va[6]), "v"(va[7]), "i"(soff_), "i"(poff_) : "memory")
#define DSA3_PV(u_) do { v2u pA_, tA_[8]; DSA3_RD(pA_, tA_, ((u_) % 3) * 4096, 32 * ((u_) >> 1)); DSA_RDW(pA_, tA_); \
    v2u pm_; pm_.x = (((u_) & 1) == mykv) ? pA_.x : 0u; pm_.y = (((u_) & 1) == mykv) ? pA_.y : 0u; \
    _Pragma("unroll") for (int nt = 0; nt < 8; ++nt) o[nt] = mfma8(tA_[nt], pm_, o[nt]); } while (0)
template <int MODE> DI void dsa_attn_item(const Ctx& c, int qg, const bf16* PROJ, const unsigned char* K8, const unsigned char* V8, const unsigned short* SEL, const int* SELN, bf16* AO) {
    typedef const __attribute__((address_space(1))) char* gcp;
    LAS unsigned char* Vb = c.lds + c.wave * DSA3_WS; LAS unsigned char* Pb = Vb + 12288; LAS unsigned short* IDXw = (LAS unsigned short*)(Vb + 12288 + 4352);
    int ln = c.lane; asm volatile("" : "+v"(ln));
    const int b = qg >> 13, n = __builtin_amdgcn_readfirstlane(SELN[qg]); const int r16 = ln & 15, q4 = ln >> 4;
    { unsigned short sv[4];
#pragma unroll
      for (int i = 0; i < 4; ++i) sv[i] = SEL[(size_t)qg * 256 + ln + 64 * i];
#pragma unroll
      for (int i = 0; i < 4; ++i) { const int slot = ln + 64 * i; IDXw[slot] = slot < n ? sv[i] : (unsigned short)0; } }
    v2u q2[2][4];
#pragma unroll
    for (int ks = 0; ks < 4; ++ks) { const v4u w = *(const v4u*)(PROJ + (size_t)qg * PROJW + (r16 & 7) * 128 + 64 * (ks >> 1) + 16 * q4 + 8 * (ks & 1));
        v2u v_; v_.x = (r16 & 8) ? w.z : w.x; v_.y = (r16 & 8) ? w.w : w.y; const bool k0_ = (r16 & 4) == 0;
        q2[0][ks].x = k0_ ? v_.x : 0u; q2[0][ks].y = k0_ ? v_.y : 0u; q2[1][ks].x = k0_ ? 0u : v_.x; q2[1][ks].y = k0_ ? 0u : v_.y; }
    LDS_WAIT();
    unsigned kix[16], vix[8][4];
#pragma unroll
    for (int blk = 0; blk < 16; ++blk) kix[blk] = IDXw[16 * blk + (ln >> 2)];
#pragma unroll
    for (int cc = 0; cc < 8; ++cc)
#pragma unroll
        for (int j = 0; j < 4; ++j) vix[cc][j] = IDXw[32 * cc + 8 * j + (ln >> 3)];
    LDS_WAIT(); SB();
    const size_t pl0 = (size_t)(b * 2) * SEQ * 128, pl1 = pl0 + (size_t)SEQ * 128;
    const gcp k8g0 = (gcp)((const char*)K8 + pl0), k8g1 = (gcp)((const char*)K8 + pl1); const char* v8b0 = (const char*)V8 + pl0; const char* v8b1 = (const char*)V8 + pl1;
    const unsigned kofs = (unsigned)(16 * (ln & 3)); const int kperm = 4 * (4 * r16 + q4);
    const unsigned vsw0 = 16u * (unsigned)((ln & 7) ^ (ln >> 4)), vsw1 = 16u * (unsigned)((ln & 7) ^ ((ln >> 4) | 4));
    DSA3_DMAV(0); SB(); DSA3_DMAV(1); SB(); DSA3_DMAV(2); SB();
    f32x4 acc[16]; v4u kA[2][2], kB[2][2], kC[2][2];
    DSA3_LOADK(kA, 0); DSA3_LOADK(kB, 1); DSA3_LOADK(kC, 2); SB();
#define DSA3_STEP(blk, kk, w_) do { DSA3_KWAIT(w_, kk); SB(); DSA3_KPERM(kk); DSA3_QK(blk, kk); SB(); if ((blk) + 3 < 16) { DSA3_LOADK(kk, (blk) + 3); SB(); } } while (0)
    DSA3_STEP(0, kA, 8); DSA3_STEP(1, kB, 8); DSA3_STEP(2, kC, 8); DSA3_STEP(3, kA, 8); DSA3_STEP(4, kB, 8); DSA3_STEP(5, kC, 8); DSA3_STEP(6, kA, 8); DSA3_STEP(7, kB, 8);
    DSA3_STEP(8, kC, 8); DSA3_STEP(9, kA, 8); DSA3_STEP(10, kB, 8); DSA3_STEP(11, kC, 8); DSA3_STEP(12, kA, 8); DSA3_STEP(13, kB, 8); DSA3_STEP(14, kC, 4); DSA3_STEP(15, kA, 0);
    float m = -3.0e38f; const int nq = n - 4 * q4; const float cexp = 1.4426950408889634f / DSA_QS;
#pragma unroll
    for (int kb = 0; kb < 16; ++kb)
#pragma unroll
        for (int i = 0; i < 4; ++i) { const bool ok = (16 * kb + i) < nq; const float s_ = acc[kb][i] + __int_as_float(__builtin_amdgcn_update_dpp(0, __float_as_int(acc[kb][i]), 0x128, 0xf, 0xf, false));
            acc[kb][i] = ok ? s_ : -3.0e38f; m = fmaxf(m, acc[kb][i]); }
    m = fmaxf(m, __shfl_xor(m, 16)); m = fmaxf(m, __shfl_xor(m, 32));
    float l = 0.f; const float mc = 8.0f - m * cexp;
#pragma unroll
    for (int kb = 0; kb < 16; ++kb)
#pragma unroll
        for (int i = 0; i < 4; ++i) { const float p = __builtin_amdgcn_exp2f(fmaf(acc[kb][i], cexp, mc)); acc[kb][i] = p; l += p; }
    l += __shfl_xor(l, 16); l += __shfl_xor(l, 32);
    const float oscale = 1.0f / l;
    if (r16 < 8) {
        LAS unsigned char* pwl = Pb + 272 * r16 + 4 * q4; asm volatile("" : "+v"(pwl));
#pragma unroll
        for (int kb = 0; kb < 16; ++kb) {
            const float p0 = acc[kb][0], p1 = acc[kb][1], p2 = acc[kb][2], p3 = acc[kb][3];
            int wh = 0; wh = __builtin_amdgcn_cvt_pk_fp8_f32(p0, p1, wh, false); wh = __builtin_amdgcn_cvt_pk_fp8_f32(p2, p3, wh, true);
            const f32x2 d0 = __builtin_amdgcn_cvt_pk_f32_fp8(wh, false), d1 = __builtin_amdgcn_cvt_pk_f32_fp8(wh, true);
            int wl = 0; wl = __builtin_amdgcn_cvt_pk_fp8_f32(p0 - d0.x, p1 - d0.y, wl, false); wl = __builtin_amdgcn_cvt_pk_fp8_f32(p2 - d1.x, p3 - d1.y, wl, true);
            *(LAS int*)(pwl + 16 * kb) = wh; *(LAS int*)(pwl + 2176 + 16 * kb) = wl; }
    }
    unsigned va[8];
    { const unsigned q_ = (unsigned)(r16 >> 1), rel = 128u * (8u * (unsigned)q4 + q_) + 8u * (unsigned)(ln & 1) + 16u * ((((unsigned)q4 & 1u) << 2) | (q_ >> 1)); const unsigned vb_ = (unsigned)(size_t)Vb;
#pragma unroll
      for (int nt = 0; nt < 8; ++nt) va[nt] = vb_ + (rel ^ (16u * (unsigned)nt)); }
    const unsigned prdA = (unsigned)(size_t)(Pb + 2176 * (r16 >> 3) + 272 * (r16 & 7) + 8 * q4); const int mykv = (r16 >> 2) & 1;
    f32x4 o[8];
#pragma unroll
    for (int nt = 0; nt < 8; ++nt) o[nt] = (f32x4){0.f, 0.f, 0.f, 0.f};
    LDS_WAIT(); SB();
#pragma unroll
    for (int u = 0; u < 16; ++u) {
        if (u < 14) DSA_VWAIT(8); else if (u == 14) DSA_VWAIT(4); else DSA_VWAIT(0);
        SB(); DSA3_PV(u); SB();
        if (u + 3 < 16) { LDS_WAIT(); SB(); DSA3_DMAV(u + 3); SB(); }
    }
#pragma unroll
    for (int nt = 0; nt < 8; ++nt)
#pragma unroll
        for (int i = 0; i < 4; ++i) o[nt][i] += __int_as_float(__builtin_amdgcn_update_dpp(0, __float_as_int(o[nt][i]), 0x128, 0xf, 0xf, false));
    if (r16 < 8) {
        bf16* op = AO + (size_t)qg * 1024 + r16 * 128 + 4 * q4;
#pragma unroll
        for (int nt = 0; nt < 8; ++nt) { v2u w; w.x = pk2(o[nt][0] * oscale, o[nt][1] * oscale); w.y = pk2(o[nt][2] * oscale, o[nt][3] * oscale); *(v2u*)(op + 16 * nt) = w; }
    }
    LDS_WAIT();
}
template <int MODE> DI void dsa_attn_phase(const Ctx& c, const bf16* PROJ, const unsigned char* K8, const unsigned char* V8, const unsigned short* SEL, const int* SELN, bf16* AO) {
    for (int x = c.vcu * 8 + c.wave; x < MTOK; x += c.G * 8) dsa_attn_item<MODE>(c, x, PROJ, K8, V8, SEL, SELN, AO);
}

#ifndef SKIPM
#define SKIPM 0
#endif
#ifndef PROBE_IDX_MODE
#define PROBE_IDX_MODE 0
#endif
#ifndef PROBE_ATTN_MODE
#define PROBE_ATTN_MODE 0
#endif
#ifndef PROBE_MASK
#define PROBE_MASK 0u
#endif
struct Args { const float* in[36]; float* out; unsigned char* ws; int ph_lo, ph_hi, li, pad; };
enum { I_X = 0, I_MEM, I_POS, I_F1N, I_F1G, I_F1U, I_F1D, I_MIXN, I_EVIN, I_EVOUT, I_GLAWA, I_GLABA, I_GLAN, I_S5LR, I_S5LI, I_S5DT, I_S5BR, I_S5BI, I_S5CR, I_S5CI, I_S5D, I_S5WG, I_S5BG,
       I_ODIN, I_ODOUT, I_XAN, I_MEMNORM, I_XAWQ, I_XAWK, I_XAWV, I_XAWO, I_F2N, I_F2G, I_F2U, I_F2D, I_FINN };

#define GEMM_CALL(EPI, A_, Bt_, M_, N_, K_, E_) do { const pg8::Gemm g_{(const pg8::bf16_t*)(A_), (const pg8::bf16_t*)(Bt_), (M_), (N_), (K_)}; typedef pg8::TileOrder<(M_) / 256, (N_) / 256> Ord_; Ord_ S_; S_.G = c.G; S_.c = (int)blockIdx.x; \
    pg8::gemm_phase<EPI, Ord_, true, true>(c.lds, g_, S_, (E_), MYTID()); } while (0)

#define RSL_PTR() ((const PG8_LAS float*)(c.lds + RING_BYTES))
#define GEMM_CALL_RS(EPI, A_, Bt_, M_, N_, K_, E_) do { const pg8::Gemm g_{(const pg8::bf16_t*)(A_), (const pg8::bf16_t*)(Bt_), (M_), (N_), (K_)}; typedef pg8::TileOrder<(M_) / 256, (N_) / 256> Ord_; Ord_ S_; S_.G = c.G; S_.c = (int)blockIdx.x; \
    const float* ss_ = SS; LAS unsigned char* ldsb_ = c.lds; const int t_ = MYTID(); \
    auto pre_ = [&]() { LAS float* rsl_ = (LAS float*)(ldsb_ + RING_BYTES); \
      for (int i0_ = 0; ; i0_ += 2) { pg8::Unit u0_; if (!S_.next(i0_, u0_)) break; pg8::Unit u_; const int i_ = i0_ + (t_ >> 8); \
          if (S_.next(i_, u_)) { const f32x4* sp_ = (const f32x4*)(ss_ + (size_t)(u_.pm * 256 + (t_ & 255)) * 16); const f32x4 a0_ = sp_[0], a1_ = sp_[1], a2_ = sp_[2], a3_ = sp_[3]; \
              const f32x4 q_ = (a0_ + a1_) + (a2_ + a3_); rsl_[i_ * 256 + (t_ & 255)] = rsqrtf(((q_[0] + q_[1]) + (q_[2] + q_[3])) * (1.0f / 1024.0f) + EPS); } } }; \
    pg8::gemm_phase<EPI, Ord_, true, true, decltype(pre_)>(c.lds, g_, S_, (E_), t_, pre_); } while (0)

#define MK_GAS __attribute__((address_space(1)))
DI unsigned char* launder_ptr(unsigned char* p) { MK_GAS unsigned char* g = (MK_GAS unsigned char*)p; asm volatile("" : "+s"(g)); return (unsigned char*)g; }
DI const float* gin_(const float* p) { MK_GAS const float* g = (MK_GAS const float*)p; asm volatile("" : "+s"(g)); return (const float*)g; }
DI float* gout_(float* p) { MK_GAS float* g = (MK_GAS float*)p; asm volatile("" : "+s"(g)); return (float*)g; }
#define AIN(k) gin_(a.in[launder_idx(k)])
DI int launder_idx(int i) { asm volatile("" : "+s"(i)); return i; }
#define DECL_PTRS() float* H = (float*)(ws + WS_H); bf16* HB = (bf16*)(ws + WS_HB); float* SS = (float*)(ws + WS_SS); \
    float* COSA = (float*)(ws + WS_COSA); float* SINA = (float*)(ws + WS_SINA); float* COSI = (float*)(ws + WS_COSI); float* SINI = (float*)(ws + WS_SINI); \
    bf16* MEMN = (bf16*)(ws + WS_MEMN); bf16* MK = (bf16*)(ws + WS_MK); bf16* MVT = (bf16*)(ws + WS_MVT); float* S5P = (float*)(ws + WS_S5P); \
    unsigned char* scr = ws + WS_SCR; \
    bf16* HID = (bf16*)(scr + SC_HID); bf16* PROJ = (bf16*)(scr + SC_PROJ); bf16* XQ = (bf16*)(scr + SC_XQ); bf16* XO = (bf16*)(scr + SC_XO); bf16* KVW = (bf16*)(scr + SC_KVW); \
    float* DS = (float*)(scr + SC_DS); float* BCg = (float*)(scr + SC_BC); float* DEC = (float*)(scr + SC_DEC); float* S5E = (float*)(scr + SC_S5E); \
    bf16* Y = (bf16*)(scr + SC_Y); bf16* CAT = (bf16*)(scr + SC_CAT); unsigned short* SEL = (unsigned short*)(scr + SC_SEL); int* SELN = (int*)(scr + SC_SELN); \
    unsigned char* W = ws + WS_W; \
    bf16* Wgu1 = (bf16*)(W + WO_GU1); bf16* Wd1 = (bf16*)(W + WO_D1); bf16* Win = (bf16*)(W + WO_IN); bf16* Wout = (bf16*)(W + WO_OUT); bf16* Wglu = (bf16*)(W + WO_GLU); \
    bf16* Wxq = (bf16*)(W + WO_XQ); bf16* Wxo = (bf16*)(W + WO_XO); bf16* Wgu2 = (bf16*)(W + WO_GU2); bf16* Wd2 = (bf16*)(W + WO_D2);
#define CVT_LAYER_BODY() do { const size_t fo = (size_t)l * DM * DFF; cvt_job_gu(c, AIN(I_F1G) + fo, AIN(I_F1U) + fo, AIN(I_F1N) + l * DM, Wgu1, 0); cvt_job(c, AIN(I_F1D) + fo, DM, 0, DM, nullptr, Wd1, DFF, DM, 0, 512); if (even) { const float* win = AIN(I_EVIN) + (size_t)e * DM * EV_IN; const float* gn = AIN(I_MIXN) + l * DM; cvt_job(c, win, EV_IN, 0, 1536, gn, Win, DM, 1536, 0, 1024); cvt_job_comb(c, win, AIN(I_GLAWA) + e * 16 * 256, gn, Win, 1536, 1536); cvt_job(c, win, EV_IN, 1552, 512, gn, Win, DM, 512, 1792, 1664); cvt_job(c, AIN(I_EVOUT) + (size_t)e * DM * DM, DM, 0, DM, nullptr, Wout, DM, DM, 0, 256); cvt_job(c, AIN(I_S5WG) + (size_t)e * 512 * 512, 512, 0, 512, nullptr, Wglu, 512, 512, 0, 1920); } else { cvt_job_rope(c, AIN(I_ODIN) + (size_t)e * DM * OD_IN, AIN(I_MIXN) + l * DM, Win, 1024); cvt_job(c, AIN(I_ODOUT) + (size_t)e * DM * DM, DM, 0, DM, nullptr, Wout, DM, DM, 0, 256); } cvt_job(c, AIN(I_XAWQ) + (size_t)l * DM * DM, DM, 0, DM, AIN(I_XAN) + l * DM, Wxq, DM, DM, 0, 768); cvt_job(c, AIN(I_XAWO) + (size_t)l * DM * DM, DM, 0, DM, nullptr, Wxo, DM, DM, 0, 1280); cvt_job_gu(c, AIN(I_F2G) + fo, AIN(I_F2U) + fo, AIN(I_F2N) + l * DM, Wgu2, 1024); cvt_job(c, AIN(I_F2D) + fo, DM, 0, DM, nullptr, Wd2, DFF, DM, 0, 1536); } while (0)
__global__ void __launch_bounds__(512, 2) mk_fwd(Args a) {
    extern __shared__ __attribute__((aligned(16))) unsigned char lds_raw[];
    Ctx c; c.lds = (LAS unsigned char*)lds_raw;
    c.tid = threadIdx.x; c.lane = c.tid & 63; c.wave = __builtin_amdgcn_readfirstlane(c.tid >> 6);
    const unsigned wave_s = (unsigned)c.wave;
    c.G = gridDim.x; { const int bx = blockIdx.x; c.vcu = (c.G % 8 == 0) ? (bx % 8) * (c.G / 8) + bx / 8 : bx; }
    for (int u = c.tid; u < (LDS_BYTES - LDSCTL_OFF) / 4; u += 512) ((LAS unsigned*)(c.lds + LDSCTL_OFF))[u] = 0u;
    __syncthreads();
    unsigned char* ws0 = a.ws;
    const int lo = a.ph_lo, hi = a.ph_hi;
    XcdBarrier bar; bar.bar = (unsigned*)(ws0 + WS_CTL) + CW_BAR + a.li * XCD_BAR_WORDS; bar.x = 0; bar.st = (volatile LAS unsigned*)(c.lds + LDSCTL_OFF);
    if (hi - lo > 1) bar = xcd_barrier_post(bar.bar, (volatile LAS unsigned*)(c.lds + LDSCTL_OFF));
#define IN(k) (launder_idx(lo) <= (k) && (k) < launder_idx(hi))
#define MYTID() ((int)(wave_s * 64u + __builtin_amdgcn_mbcnt_hi(~0u, __builtin_amdgcn_mbcnt_lo(~0u, 0u))))
#define FRESH() do { int t_ = MYTID(); asm volatile("" : "+v"(t_)); c.tid = t_; c.lane = t_ & 63; c.wave = (int)wave_s; } while (0)
#define SEAM(k) do { if (IN(k) && IN((k) + 1)) xcd_barrier(bar); } while (0)
    const int NGW = c.G * 8, gw = c.vcu * 8 + c.wave;

#define PHASE(k, q, ...) do { if (IN(k)) { { const bool dup_ = false; (void)dup_; unsigned char* ws = launder_ptr(a.ws); DECL_PTRS(); __VA_ARGS__ } if ((PROBE_MASK >> (q)) & 1u) { xcd_barrier(bar); { const bool dup_ = true; (void)dup_; unsigned char* ws = launder_ptr(a.ws); DECL_PTRS(); __VA_ARGS__ } } } SEAM(k); } while (0)
    PHASE(0, 30, {
        FRESH();
        const int* pos = (const int*)AIN(I_POS);
        for (int e = c.vcu * 512 + c.tid; e < MTOK * 96; e += c.G * 512) {
            if (e < MTOK * 64) { const int tok = e >> 6, i = e & 63; const float inv = powf(10000.0f, -(float)(2 * i) / 128.0f), ang = (float)pos[tok] * inv; COSA[e] = cosf(ang); SINA[e] = sinf(ang); }
            else { const int e2 = e - MTOK * 64, tok = e2 >> 5, i = e2 & 31; const float inv = powf(10000.0f, -(float)(2 * i) / 64.0f), ang = (float)pos[tok] * inv; COSI[e2] = cosf(ang); SINI[e2] = sinf(ang); }
        }
        for (int m = gw; m < MTOK; m += NGW) row_init(AIN(I_X) + (size_t)m * DM, HB + (size_t)m * DM, SS + (size_t)m * 16, c.lane);
        for (int m = gw; m < NB * NMEM; m += NGW) row_norm_bf16(AIN(I_MEM) + (size_t)m * DM, AIN(I_MEMNORM), MEMN + (size_t)m * DM, c.lane);
        for (int l = 0; l < DEPTH; ++l) {
            cvt_job(c, AIN(I_XAWK) + (size_t)l * DM * DM, DM, 0, DM, nullptr, KVW, DM, DM, l * DM, l * 256);
            cvt_job(c, AIN(I_XAWV) + (size_t)l * DM * DM, DM, 0, DM, nullptr, KVW + (size_t)4096 * DM, DM, DM, l * DM, l * 256 + 128);
        }
        s5_params(c, AIN(I_S5LR), AIN(I_S5LI), AIN(I_S5DT), AIN(I_S5BR), AIN(I_S5BI), S5P);
        { const int l = 0, e = 0; const bool even = true; CVT_LAYER_BODY(); }
    });
#pragma clang loop unroll(full)
    for (int l = 0; l < DEPTH; ++l) {
        const int pb = PH_LAYER0 + l * PH_PER_LAYER, e = l >> 1; const bool even = (l & 1) == 0;
        if (l > 0) PHASE(pb + 0, 0, { FRESH(); CVT_LAYER_BODY(); });
#define MEMKV_TAIL() if (l == 0) { const int bx_ = (int)blockIdx.x - ((MTOK / 256) * (2 * DFF / 256) - 5 * c.G);     \
            { const pg8::Gemm g{(const pg8::bf16_t*)MEMN, (const pg8::bf16_t*)KVW, 512, 4096, 1024}; typedef pg8::TileOrder<2, 16> Ord; Ord S; S.G = c.G; S.c = (c.G == 256) ? bx_ : (int)blockIdx.x; \
              const pg8::EpiScaleBf16<false> E2{(pg8::bf16_t*)MK, 4096, nullptr, 1.0f}; pg8::gemm_phase<pg8::EpiScaleBf16<false>, Ord, true, true>(c.lds, g, S, E2, MYTID()); } \
            { const pg8::Gemm g{(const pg8::bf16_t*)(KVW + (size_t)4096 * DM), (const pg8::bf16_t*)MEMN, 4096, 512, 1024}; typedef pg8::TileOrder<16, 2> Ord; Ord S; S.G = c.G; S.c = ((c.G == 256) ? bx_ : (int)blockIdx.x) - 32; \
              const pg8::EpiScaleBf16<false> E2{(pg8::bf16_t*)MVT, 512, nullptr, 1.0f}; pg8::gemm_phase<pg8::EpiScaleBf16<false>, Ord, true, true>(c.lds, g, S, E2, MYTID()); } }
        PHASE(pb + 1, 1, { const pg8::EpiSwiGLU E{(pg8::bf16_t*)HID, DFF, RSL_PTR()}; GEMM_CALL_RS(pg8::EpiSwiGLU, HB, Wgu1, MTOK, 2 * DFF, DM, E); MEMKV_TAIL(); });
        PHASE(pb + 2, 2, { const pg8::EpiResid E{(pg8::bf16_t*)HB, SS, dup_ ? 0.f : 0.5f}; GEMM_CALL(pg8::EpiResid, HID, Wd1, MTOK, DM, DFF, E); });
        if (even) PHASE(pb + 3, 3, { const pg8::EpiScaleBf16<true> E{(pg8::bf16_t*)PROJ, PROJW, RSL_PTR(), 1.0f}; GEMM_CALL_RS(pg8::EpiScaleBf16<true>, HB, Win, MTOK, PROJW, DM, E); });
        else PHASE(pb + 3, 3, { const pg8::EpiRope E{(pg8::bf16_t*)PROJ, RSL_PTR(), COSA, SINA, COSI, SINI, scr + SC_K8, scr + SC_V8}; GEMM_CALL_RS(pg8::EpiRope, HB, Win, MTOK, PROJW, DM, E); });
        if (even) {
            PHASE(pb + 4, 4, {
                FRESH();
                for (int u = c.vcu; u < 1024; u += c.G) gla1_unit(c, u, PROJ, AIN(I_GLABA) + e * 256, DS, BCg, DEC);
                s5_phase1(c, e, PROJ, S5P, S5E);
            });
            PHASE(pb + 5, 29, { FRESH(); gla2_scan(c, DS, DEC); s5_phase2(c, e, S5P, S5E); });
            PHASE(pb + 6, 6, {
                FRESH();
                for (int u = c.vcu; u < 1024; u += c.G) gla3_unit(c, u, PROJ, BCg, DS, AIN(I_GLAN) + e * 128, CAT);
                s5_phase3(c, e, PROJ, S5P, S5E, AIN(I_S5CR), AIN(I_S5CI), AIN(I_S5D), Y);
            });
            PHASE(pb + 7, 7, { const pg8::EpiGLU E{(const pg8::bf16_t*)Y, AIN(I_S5BG) + e * 512, (pg8::bf16_t*)CAT}; GEMM_CALL(pg8::EpiGLU, Y, Wglu, MTOK, 512, 512, E); });
        } else {
            PHASE(pb + 5, 15, { FRESH(); if (!dup_) { for (int u = c.vcu; u < 512; u += c.G) dsa_index_unit<0>(c, u, PROJ, SEL, SELN); } else { for (int u = c.vcu; u < 512; u += c.G) dsa_index_unit<PROBE_IDX_MODE>(c, u, PROJ, (unsigned short*)(scr + 81 * MiB), (int*)(scr + 90 * MiB)); } });
            PHASE(pb + 6, 16, { FRESH(); if (!dup_) dsa_attn_phase<0>(c, PROJ, scr + SC_K8, scr + SC_V8, SEL, SELN, CAT); else dsa_attn_phase<PROBE_ATTN_MODE>(c, PROJ, scr + SC_K8, scr + SC_V8, SEL, SELN, (bf16*)(scr + 100 * MiB)); });
        }
        PHASE(pb + 8, 8, { const pg8::EpiResid E{(pg8::bf16_t*)HB, SS, dup_ ? 0.f : 1.0f}; GEMM_CALL(pg8::EpiResid, CAT, Wout, MTOK, DM, DM, E); });
        PHASE(pb + 9, 9, { const pg8::EpiScaleBf16<true> E{(pg8::bf16_t*)XQ, DM, RSL_PTR(), 0.0625f}; GEMM_CALL_RS(pg8::EpiScaleBf16<true>, HB, Wxq, MTOK, DM, DM, E); });
        PHASE(pb + 10, 10, { FRESH(); for (int u = c.vcu; u < 256; u += c.G) xattn_unit(c, u, l, XQ, MK, MVT, XO); });
        PHASE(pb + 11, 11, { const pg8::EpiResid E{(pg8::bf16_t*)HB, SS, dup_ ? 0.f : 1.0f}; GEMM_CALL(pg8::EpiResid, XO, Wxo, MTOK, DM, DM, E); });
        PHASE(pb + 12, 12, { const pg8::EpiSwiGLU E{(pg8::bf16_t*)HID, DFF, RSL_PTR()}; GEMM_CALL_RS(pg8::EpiSwiGLU, HB, Wgu2, MTOK, 2 * DFF, DM, E); });
        PHASE(pb + 13, 13, { const pg8::EpiResid E{(pg8::bf16_t*)HB, SS, dup_ ? 0.f : 0.5f}; GEMM_CALL(pg8::EpiResid, HID, Wd2, MTOK, DM, DFF, E); });
    }
    if (IN(PH_FINAL)) { FRESH(); unsigned char* ws = launder_ptr(a.ws); DECL_PTRS(); for (int m = gw; m < MTOK; m += NGW) row_final(HB + (size_t)m * DM, SS + (size_t)m * 16, AIN(I_FINN), gout_(a.out) + (size_t)m * DM, c.lane); }
#undef PHASE
#undef IN
#undef SEAM
}

#ifndef MK_ONE_LAUNCH
#define MK_ONE_LAUNCH 1
#endif
extern "C" void kernel_launch(void* const* d_in, const int* in_sizes, int n_in, void* d_out, int out_size, void* d_ws, size_t ws_size, hipStream_t stream) {
    static int grid = 0;
    if (grid == 0) {
        if (n_in != 36 || out_size != MTOK * DM || ws_size < WS_END) { fprintf(stderr, "kernel_launch: unexpected shapes (n_in %d out %d ws %zu)\n", n_in, out_size, ws_size); grid = -1; return; }
        int dev = 0, cus = 0, per_cu = 0;
        if (hipGetDevice(&dev) != hipSuccess || hipDeviceGetAttribute(&cus, hipDeviceAttributeMultiprocessorCount, dev) != hipSuccess) { grid = -1; return; }
        if (hipFuncSetAttribute((const void*)mk_fwd, hipFuncAttributeMaxDynamicSharedMemorySize, LDS_BYTES) != hipSuccess) { fprintf(stderr, "kernel_launch: hipFuncSetAttribute failed\n"); grid = -1; return; }
        if (hipOccupancyMaxActiveBlocksPerMultiprocessor(&per_cu, (const void*)mk_fwd, 512, LDS_BYTES) != hipSuccess || per_cu < 1) fprintf(stderr, "kernel_launch: occupancy query reports %d\n", per_cu);
        (void)hipGetLastError();
        grid = cus;
    }
    if (grid < 0) return;
    (void)hipMemsetAsync((char*)d_ws + WS_CTL, 0, CTL_ZERO_BYTES, stream);
    Args a{};
    for (int i = 0; i < 36; ++i) a.in[i] = (const float*)d_in[i];
    a.out = (float*)d_out; a.ws = (unsigned char*)d_ws; a.pad = 0;
#if MK_ONE_LAUNCH
    a.ph_lo = 0; a.ph_hi = N_PHASES; a.li = 0;
    hipLaunchKernelGGL(mk_fwd, dim3(grid), dim3(512), LDS_BYTES, stream, a);
#else
    for (int p = 0; p < N_PHASES; ++p) {
        if (p >= PH_LAYER0 && p < PH_FINAL) { const int l = (p - PH_LAYER0) / PH_PER_LAYER, q = (p - PH_LAYER0) % PH_PER_LAYER; if ((l & 1) && q == 7) continue; }
        a.ph_lo = p; a.ph_hi = p + 1; a.li = 0;
        hipLaunchKernelGGL(mk_fwd, dim3(grid), dim3(512), LDS_BYTES, stream, a);
    }
#endif
}
```

```cpp
#include <hip/hip_runtime.h>
#include <cstdio>
#include <cstdint>
namespace pg8 {
#define PG8_LAS __attribute__((address_space(3)))
typedef unsigned short bf16_t;
typedef short bf16x8 __attribute__((ext_vector_type(8)));
typedef float f32x4 __attribute__((ext_vector_type(4)));
typedef unsigned u32x4 __attribute__((ext_vector_type(4)));
constexpr int BM = 256, BK = 64, HALF = 128, HTB = HALF * BK * 2  , STAGE_BYTES = 8 * HTB, NXCD = 8, WGM = 8;

__host__ __device__ __forceinline__ int lds_byte(int r, int c) { const int st = (r >> 4) * 2 + (c >> 5), rr = r & 15, cc = c & 31, ob = rr * 64 + cc * 2; return st * 1024 + (ob ^ (((ob >> 9) & 1) << 5)); }
__host__ __device__ __forceinline__ void stage_rc(int b, int& R, int& C) { const int st = b / 1024, sb = b % 1024, swz = sb ^ (((sb >> 9) & 1) << 5); R = (st >> 1) * 16 + swz / 64; C = (st & 1) * 32 + (swz % 64) / 2; }
__host__ __device__ __forceinline__ int perm32(int rho) { const int n = rho >> 4, i = rho & 15; return 8 * (i >> 2) + 4 * n + (i & 3); }

struct Unit { int pm, pn, ui; };
struct Gemm { const bf16_t* A; const bf16_t* Bt; int M, N, K; };

struct StaticOrder {
    int nM, nN, nwg, G, c;
    __host__ __device__ void init(int M, int N, int G_, int c_) { nM = M / BM; nN = N / BM; nwg = nM * nN; G = G_; c = c_; }
    __host__ __device__ bool next(int i, Unit& u) const {
        const long L = (long)i * G + c; if (L >= nwg) return false;
        int wgid = (int)L; { const int q = nwg / NXCD, r = nwg % NXCD, xcd = wgid % NXCD, off = wgid / NXCD; wgid = (xcd < r ? xcd * (q + 1) : r * (q + 1) + (xcd - r) * q) + off; }
        const int nig = WGM * nN, gid = wgid / nig, fm = gid * WGM, gsz = (nM - fm) < WGM ? (nM - fm) : WGM;
        u.pm = fm + ((wgid % nig) % gsz); u.pn = (wgid % nig) / gsz; return true;
    }
    __device__ __forceinline__ void a_ready(const Unit&) const {}
    __device__ __forceinline__ void done(const Unit&) const {}
};

__device__ __forceinline__ unsigned cvt_pk_bf16(float lo, float hi) { unsigned r; asm volatile("v_cvt_pk_bf16_f32 %0, %1, %2" : "=v"(r) : "v"(lo), "v"(hi)); return r; }
typedef float f32x2 __attribute__((ext_vector_type(2)));
typedef unsigned u32x2 __attribute__((ext_vector_type(2)));
#define PG8_GAS __attribute__((address_space(1)))
__device__ __forceinline__ u32x2 pack8_fp8(const float (&x)[8]) { int w0 = 0, w1 = 0; w0 = __builtin_amdgcn_cvt_pk_fp8_f32(x[0], x[1], w0, false); w0 = __builtin_amdgcn_cvt_pk_fp8_f32(x[2], x[3], w0, true);
    w1 = __builtin_amdgcn_cvt_pk_fp8_f32(x[4], x[5], w1, false); w1 = __builtin_amdgcn_cvt_pk_fp8_f32(x[6], x[7], w1, true); u32x2 r; r.x = (unsigned)w0; r.y = (unsigned)w1; return r; }
__device__ __forceinline__ u32x4 split8_hilo(const float (&x)[8]) { const u32x2 h = pack8_fp8(x);
    const f32x2 a = __builtin_amdgcn_cvt_pk_f32_fp8((int)h.x, false), b = __builtin_amdgcn_cvt_pk_f32_fp8((int)h.x, true), c = __builtin_amdgcn_cvt_pk_f32_fp8((int)h.y, false), d = __builtin_amdgcn_cvt_pk_f32_fp8((int)h.y, true);
    const float r[8] = {x[0] - a.x, x[1] - a.y, x[2] - b.x, x[3] - b.y, x[4] - c.x, x[5] - c.y, x[6] - d.x, x[7] - d.y}; const u32x2 l = pack8_fp8(r);
    u32x4 w; w.x = h.x; w.y = h.y; w.z = l.x; w.w = l.y; return w; }
__device__ __forceinline__ float bf_lo(unsigned w) { return __uint_as_float(w << 16); }
__device__ __forceinline__ float bf_hi(unsigned w) { return __uint_as_float(w & 0xffff0000u); }
__device__ __forceinline__ float fast_sigmoid(float x) { return __builtin_amdgcn_rcpf(1.0f + __expf(-x)); }
struct EpiSwiGLU {
    static constexpr bool PERM = true, AFTER_DRAIN = false;
    bf16_t* O; int ldc; const PG8_LAS float* rsl;
    __device__ __forceinline__ void operator()(const f32x4 (&acc)[2][2][4][2], const Unit& u, int wr, int wc, int fr, int fq) const {
        const int col0 = u.pn * HALF + wc * 32 + 8 * fq; const PG8_LAS float* rp = rsl + u.ui * 256 + wr * 64 + fr;
#pragma unroll
        for (int ai = 0; ai < 2; ++ai)
#pragma unroll
            for (int m = 0; m < 4; ++m) {
                const int row = u.pm * BM + ai * HALF + wr * 64 + m * 16 + fr; const float r = rp[ai * HALF + m * 16];
                float h[8];
#pragma unroll
                for (int n = 0; n < 2; ++n)
#pragma unroll
                    for (int j = 0; j < 4; ++j) { const float g = acc[ai][0][m][n][j] * r, up = acc[ai][1][m][n][j] * r; h[n * 4 + j] = g * fast_sigmoid(g) * up; }
                u32x4 w; w.x = cvt_pk_bf16(h[0], h[1]); w.y = cvt_pk_bf16(h[2], h[3]); w.z = cvt_pk_bf16(h[4], h[5]); w.w = cvt_pk_bf16(h[6], h[7]);
                *(PG8_GAS u32x4*)(O + (size_t)row * ldc + col0) = w;
            }
    }
};
struct EpiResid {
    static constexpr bool PERM = false, AFTER_DRAIN = false;
    bf16_t* HB; float* ss; float scale;
    __device__ __forceinline__ void operator()(const f32x4 (&acc)[2][2][4][2], const Unit& u, int wr, int wc, int fr, int fq) const {
        const int col0 = u.pn * BM + wc * 32 + 4 * fq;
        PG8_GAS bf16_t* hb = (PG8_GAS bf16_t*)HB + (size_t)(u.pm * BM + wr * 64 + fr) * 1024 + col0;
        const int L = fr + 16 * fq, perm = 4 * (4 * fr + fq);
        const PG8_GAS bf16_t* hl = (const PG8_GAS bf16_t*)HB + (size_t)(u.pm * BM + wr * 64 + (L >> 2)) * 1024 + u.pn * BM + wc * 32 + 4 * (L & 3);
        u32x2 hv[2][4][2][2];
#pragma unroll
        for (int ai = 0; ai < 2; ++ai)
#pragma unroll
            for (int m = 0; m < 4; ++m)
#pragma unroll
                for (int bj = 0; bj < 2; ++bj)
#pragma unroll
                    for (int n = 0; n < 2; ++n) hv[ai][m][bj][n] = *(const PG8_GAS u32x2*)(hl + (size_t)(ai * HALF + m * 16) * 1024 + bj * HALF + n * 16);

#pragma unroll
        for (int ai = 0; ai < 2; ++ai)
#pragma unroll
            for (int m = 0; m < 4; ++m) {
                const int row = u.pm * BM + ai * HALF + wr * 64 + m * 16 + fr; float sq = 0.f;
#pragma unroll
                for (int bj = 0; bj < 2; ++bj)
#pragma unroll
                    for (int n = 0; n < 2; ++n) {
                        u32x2 x = hv[ai][m][bj][n]; x.x = (unsigned)__builtin_amdgcn_ds_bpermute(perm, (int)x.x); x.y = (unsigned)__builtin_amdgcn_ds_bpermute(perm, (int)x.y);
                        f32x4 h = {bf_lo(x.x), bf_hi(x.x), bf_lo(x.y), bf_hi(x.y)}; h = h + acc[ai][bj][m][n] * scale;
                        u32x2 w; w.x = cvt_pk_bf16(h[0], h[1]); w.y = cvt_pk_bf16(h[2], h[3]); *(PG8_GAS u32x2*)(hb + (size_t)(ai * HALF + m * 16) * 1024 + bj * HALF + n * 16) = w;
                        const float r0 = bf_lo(w.x), r1 = bf_hi(w.x), r2 = bf_lo(w.y), r3 = bf_hi(w.y);
                        sq += (r0 * r0 + r1 * r1) + (r2 * r2 + r3 * r3);
                    }
                sq += __shfl_xor(sq, 16); sq += __shfl_xor(sq, 32);
                if (fq == 0) ((PG8_GAS float*)ss)[(size_t)row * 16 + u.pn * 4 + wc] = sq;
            }
    }
};
template <bool USE_RS> struct EpiScaleBf16 {
    static constexpr bool PERM = true, AFTER_DRAIN = false;
    bf16_t* O; int ldc; const PG8_LAS float* rsl; float cscale;
    __device__ __forceinline__ void operator()(const f32x4 (&acc)[2][2][4][2], const Unit& u, int wr, int wc, int fr, int fq) const {
        const int col0 = u.pn * BM + wc * 32 + 8 * fq; const PG8_LAS float* rp = rsl + u.ui * 256 + wr * 64 + fr;
#pragma unroll
        for (int ai = 0; ai < 2; ++ai)
#pragma unroll
            for (int m = 0; m < 4; ++m) {
                const int row = u.pm * BM + ai * HALF + wr * 64 + m * 16 + fr; const float s = (USE_RS ? rp[ai * HALF + m * 16] : 1.0f) * cscale;
                PG8_GAS bf16_t* rowp = (PG8_GAS bf16_t*)O + (size_t)row * ldc + col0;
#pragma unroll
                for (int bj = 0; bj < 2; ++bj) { const f32x4 v0 = acc[ai][bj][m][0] * s, v1 = acc[ai][bj][m][1] * s;
                    u32x4 w; w.x = cvt_pk_bf16(v0[0], v0[1]); w.y = cvt_pk_bf16(v0[2], v0[3]); w.z = cvt_pk_bf16(v1[0], v1[1]); w.w = cvt_pk_bf16(v1[2], v1[3]);
                    *(PG8_GAS u32x4*)(rowp + bj * HALF) = w; }
            }
    }
};
struct EpiRope {
    static constexpr bool PERM = true, AFTER_DRAIN = false;
    bf16_t* O; const PG8_LAS float* rsl; const float* cA; const float* sA; const float* cI; const float* sI; unsigned char* K8; unsigned char* V8;
    __device__ __forceinline__ void operator()(const f32x4 (&acc)[2][2][4][2], const Unit& u, int wr, int wc, int fr, int fq) const {
        const int x0 = wc * 32 + 8 * fq, pn = u.pn; const PG8_LAS float* rp = rsl + u.ui * 256 + wr * 64 + fr;
        const bool rot = !(pn == 5 || (pn == 8 && x0 >= 32)); const bool tA = pn < 5; const int half = tA ? 64 : 32, i0 = x0 & (half - 1);
#pragma unroll
        for (int ai = 0; ai < 2; ++ai) {
            f32x4 tc[4][2], ts[4][2];
            if (rot) {
#pragma unroll
                for (int m = 0; m < 4; ++m) { const int row = u.pm * BM + ai * HALF + wr * 64 + m * 16 + fr;
                    const PG8_GAS float* cp = (const PG8_GAS float*)(tA ? cA + (size_t)row * 64 : cI + (size_t)row * 32) + i0; const PG8_GAS float* sp = (const PG8_GAS float*)(tA ? sA + (size_t)row * 64 : sI + (size_t)row * 32) + i0;
                    tc[m][0] = *(const PG8_GAS f32x4*)cp; tc[m][1] = *(const PG8_GAS f32x4*)(cp + 4); ts[m][0] = *(const PG8_GAS f32x4*)sp; ts[m][1] = *(const PG8_GAS f32x4*)(sp + 4); }
            }
#pragma unroll
            for (int m = 0; m < 4; ++m) {
                const int row = u.pm * BM + ai * HALF + wr * 64 + m * 16 + fr; const float r = rp[ai * HALF + m * 16];
                PG8_GAS bf16_t* orow = (PG8_GAS bf16_t*)O + (size_t)row * 2304;
                float a[8], b[8];
#pragma unroll
                for (int n = 0; n < 2; ++n)
#pragma unroll
                    for (int j = 0; j < 4; ++j) { a[4 * n + j] = acc[ai][0][m][n][j] * r; b[4 * n + j] = acc[ai][1][m][n][j] * r; }
                if (pn == 5) {
                    const size_t cr = (size_t)((row >> 13) * 2) * 8192 + (row & 8191);
                    *(PG8_GAS u32x2*)(V8 + cr * 128 + x0) = pack8_fp8(a); *(PG8_GAS u32x2*)(V8 + (cr + 8192) * 128 + x0) = pack8_fp8(b);
                } else if (pn == 8 && x0 >= 32) {
                    if (x0 == 32) { u32x4 w0; w0.x = cvt_pk_bf16(a[0], a[1]); w0.y = cvt_pk_bf16(a[2], a[3]); w0.z = cvt_pk_bf16(a[4], a[5]); w0.w = cvt_pk_bf16(a[6], a[7]); *(PG8_GAS u32x4*)(orow + 2112) = w0; }
                } else {
                    const int hh = tA ? (x0 >> 6) : (x0 >> 5);
                    const int base = pn < 4 ? 256 * pn + 128 * hh : (pn == 4 ? 1024 + 128 * hh : (pn == 8 ? 2048 : 1536 + 256 * (pn - 6) + 64 * hh));
                    const float sc = pn < 4 ? 0.08838834764831845f * 32.0f : 1.0f;
                    const f32x4 c0 = tc[m][0], c1 = tc[m][1], s0 = ts[m][0], s1 = ts[m][1];
                    const float cs[8] = {c0[0], c0[1], c0[2], c0[3], c1[0], c1[1], c1[2], c1[3]}, sn[8] = {s0[0], s0[1], s0[2], s0[3], s1[0], s1[1], s1[2], s1[3]};
                    float o1[8], o2[8];
#pragma unroll
                    for (int k = 0; k < 8; ++k) { o1[k] = (a[k] * cs[k] - b[k] * sn[k]) * sc; o2[k] = (b[k] * cs[k] + a[k] * sn[k]) * sc; }
                    u32x4 w0, w1; w0.x = cvt_pk_bf16(o1[0], o1[1]); w0.y = cvt_pk_bf16(o1[2], o1[3]); w0.z = cvt_pk_bf16(o1[4], o1[5]); w0.w = cvt_pk_bf16(o1[6], o1[7]);
                    w1.x = cvt_pk_bf16(o2[0], o2[1]); w1.y = cvt_pk_bf16(o2[2], o2[3]); w1.z = cvt_pk_bf16(o2[4], o2[5]); w1.w = cvt_pk_bf16(o2[6], o2[7]);
                    if (pn < 4) { w0 = split8_hilo(o1); w1 = split8_hilo(o2); }
                    if (pn == 4) { const size_t cr = (size_t)((row >> 13) * 2 + hh) * 8192 + (row & 8191); *(PG8_GAS u32x2*)(K8 + cr * 128 + i0) = pack8_fp8(o1); *(PG8_GAS u32x2*)(K8 + cr * 128 + 64 + i0) = pack8_fp8(o2); }
                    else { *(PG8_GAS u32x4*)(orow + base + i0) = w0; *(PG8_GAS u32x4*)(orow + base + half + i0) = w1; }
                }
            }
        }
    }
};
struct EpiGLU {
    static constexpr bool PERM = true, AFTER_DRAIN = false;
    const bf16_t* Y; const float* bias; bf16_t* CAT;
    __device__ __forceinline__ void operator()(const f32x4 (&acc)[2][2][4][2], const Unit& u, int wr, int wc, int fr, int fq) const {
        const int col0 = u.pn * BM + wc * 32 + 8 * fq;
        const PG8_GAS bf16_t* yb = (const PG8_GAS bf16_t*)Y + (size_t)(u.pm * BM + wr * 64 + fr) * 512 + col0;
        u32x4 yv[2][4][2]; f32x4 bb[2][2];
#pragma unroll
        for (int bj = 0; bj < 2; ++bj) { bb[bj][0] = *(const PG8_GAS f32x4*)(bias + col0 + bj * HALF); bb[bj][1] = *(const PG8_GAS f32x4*)(bias + col0 + bj * HALF + 4); }
#pragma unroll
        for (int ai = 0; ai < 2; ++ai)
#pragma unroll
            for (int m = 0; m < 4; ++m)
#pragma unroll
                for (int bj = 0; bj < 2; ++bj) yv[ai][m][bj] = *(const PG8_GAS u32x4*)(yb + (size_t)(ai * HALF + m * 16) * 512 + bj * HALF);
#pragma unroll
        for (int ai = 0; ai < 2; ++ai)
#pragma unroll
            for (int m = 0; m < 4; ++m) {
                const int row = u.pm * BM + ai * HALF + wr * 64 + m * 16 + fr;
#pragma unroll
                for (int bj = 0; bj < 2; ++bj) { const int c = col0 + bj * HALF; const u32x4 y4 = yv[ai][m][bj];
                    const f32x4 z0 = acc[ai][bj][m][0] + bb[bj][0], z1 = acc[ai][bj][m][1] + bb[bj][1];
                    float o[8];
                    o[0] = bf_lo(y4.x) * fast_sigmoid(z0[0]); o[1] = bf_hi(y4.x) * fast_sigmoid(z0[1]); o[2] = bf_lo(y4.y) * fast_sigmoid(z0[2]); o[3] = bf_hi(y4.y) * fast_sigmoid(z0[3]);
                    o[4] = bf_lo(y4.z) * fast_sigmoid(z1[0]); o[5] = bf_hi(y4.z) * fast_sigmoid(z1[1]); o[6] = bf_lo(y4.w) * fast_sigmoid(z1[2]); o[7] = bf_hi(y4.w) * fast_sigmoid(z1[3]);
                    u32x4 w; w.x = cvt_pk_bf16(o[0], o[1]); w.y = cvt_pk_bf16(o[2], o[3]); w.z = cvt_pk_bf16(o[4], o[5]); w.w = cvt_pk_bf16(o[6], o[7]);
                    *(PG8_GAS u32x4*)(CAT + (size_t)row * 1024 + 512 + c) = w; }
            }
    }
};
template <int NM, int NN> struct TileOrder {
    static constexpr int nwg = NM * NN, WG = NM < 8 ? NM : 8, nig = WG * NN;
    static_assert(nwg % 8 == 0 && NM % WG == 0, "TileOrder shapes");
    int G, c;
    __device__ __forceinline__ bool next(int i, Unit& u) const {
        const int L = i * G + c; if (c < 0 || L >= nwg) return false;
        const int wgid = (L & 7) * (nwg / 8) + (L >> 3), gid = wgid / nig, r = wgid % nig;
        u.pm = gid * WG + (r % WG); u.pn = r / WG; u.ui = i; return true;
    }
    __device__ __forceinline__ void a_ready(const Unit&) const {}
    __device__ __forceinline__ void done(const Unit&) const {}
};
template <class Epi, class Sched, bool ALIGN_EPI = false, bool SP2 = false>
__device__ __forceinline__ void gemm_phase(PG8_LAS unsigned char* lds, const Gemm g, const Sched& S, const Epi& E, int tid_in) {
    int tid_ = tid_in; asm volatile("" : "+v"(tid_));
    const int tid = tid_, wid = __builtin_amdgcn_readfirstlane(tid >> 6), lane = tid & 63, wr = wid >> 2, wc = wid & 3, fr = lane & 15, fq = lane >> 4;
    const int K = g.K, nt = K / BK;
    unsigned voffA[2], voffB[2];
#pragma unroll
    for (int i = 0; i < 2; ++i) { int R, C; stage_rc(tid * 16 + i * 8192, R, C); const int Rb = Epi::PERM ? ((R & ~31) + perm32(R & 31)) : R;
        voffA[i] = (unsigned)(R * K + C) * 2u; voffB[i] = (unsigned)(Rb * K + C) * 2u; }
    const size_t kstep = (size_t)(BK * 2);
    const size_t hstep = (size_t)HALF * K * 2;
    const size_t tstep = 2 * hstep;
    const unsigned ldsw = (unsigned)wid * 1024u;
    const int aoff = lds_byte(wr * 64 + fr, fq * 8), boff = lds_byte(wc * 32 + fr, fq * 8);
#define PG8_SA(b, h) (((b) * 2 + (h)) * HTB)
#define PG8_SB(b, h) ((4 + (b) * 2 + (h)) * HTB)
#define PG8_STAGE(bufoff, gbase, voff) do { _Pragma("unroll") for (int _i = 0; _i < 2; ++_i) \
        __builtin_amdgcn_global_load_lds((const unsigned*)((const char*)(gbase) + (voff)[_i]), (PG8_LAS unsigned*)(lds + (bufoff) + ldsw + _i * 8192), 16, 0, 0); } while (0)
#define PG8_LDA(dst, b, h) do { _Pragma("unroll") for (int m = 0; m < 4; ++m) _Pragma("unroll") for (int k = 0; k < 2; ++k) dst[m][k] = *(const PG8_LAS bf16x8*)(lds + PG8_SA(b, h) + aoff + m * 2048 + k * 1024); } while (0)
#define PG8_LDB(dst, b, h) do { _Pragma("unroll") for (int n = 0; n < 2; ++n) _Pragma("unroll") for (int k = 0; k < 2; ++k) dst[n][k] = *(const PG8_LAS bf16x8*)(lds + PG8_SB(b, h) + boff + n * 2048 + k * 1024); } while (0)
#define PG8_MMA(ai, bj, At, Bt) do { __builtin_amdgcn_s_setprio(1); _Pragma("unroll") for (int m = 0; m < 4; ++m) _Pragma("unroll") for (int n = 0; n < 2; ++n) _Pragma("unroll") for (int k = 0; k < 2; ++k) \
        acc[ai][bj][m][n] = __builtin_amdgcn_mfma_f32_16x16x32_bf16(Bt[n][k], At[m][k], acc[ai][bj][m][n], 0, 0, 0); __builtin_amdgcn_s_setprio(0); } while (0)
#define PG8_WAIT_V(n) asm volatile("s_waitcnt vmcnt(" #n ")" ::: "memory")
#define PG8_WAIT_L(n) asm volatile("s_waitcnt lgkmcnt(" #n ")" ::: "memory")
#define PG8_BAR __builtin_amdgcn_s_barrier()
#define PG8_SCHED __builtin_amdgcn_sched_barrier(0)
    Unit cur, nxt; int ui = 0;
    if (!S.next(0, cur)) return;
    f32x4 acc[2][2][4][2];
#pragma unroll
    for (int a = 0; a < 2; ++a)
#pragma unroll
        for (int b = 0; b < 2; ++b)
#pragma unroll
            for (int m = 0; m < 4; ++m)
#pragma unroll
                for (int n = 0; n < 2; ++n) acc[a][b][m][n] = (f32x4){0.f, 0.f, 0.f, 0.f};
    bf16x8 At[4][2], B0[2][2], B1[2][2];
    const char* cA = (const char*)g.A + (size_t)cur.pm * tstep; const char* cB = (const char*)g.Bt + (size_t)cur.pn * tstep;
    S.a_ready(cur);
    if constexpr (SP2) {
        PG8_STAGE(PG8_SB(0, 0), cB, voffB); PG8_STAGE(PG8_SB(0, 1), cB + hstep, voffB); PG8_STAGE(PG8_SA(0, 0), cA, voffA); PG8_STAGE(PG8_SA(0, 1), cA + hstep, voffA);
        if (wr == 1) PG8_BAR;
        PG8_WAIT_V(2); PG8_BAR;
        PG8_STAGE(PG8_SB(1, 0), cB + kstep, voffB); PG8_STAGE(PG8_SA(1, 0), cA + kstep, voffA); PG8_STAGE(PG8_SB(1, 1), cB + hstep + kstep, voffB);
        PG8_WAIT_V(6); PG8_BAR;
    } else {
        PG8_STAGE(PG8_SB(0, 0), cB, voffB); PG8_STAGE(PG8_SA(0, 0), cA, voffA); PG8_STAGE(PG8_SB(0, 1), cB + hstep, voffB); PG8_STAGE(PG8_SA(0, 1), cA + hstep, voffA);
        if (wr == 1) PG8_BAR;
        PG8_WAIT_V(4); PG8_BAR;
        PG8_STAGE(PG8_SB(1, 0), cB + kstep, voffB); PG8_STAGE(PG8_SA(1, 0), cA + kstep, voffA); PG8_STAGE(PG8_SB(1, 1), cB + hstep + kstep, voffB);
        PG8_WAIT_V(6); PG8_BAR;
    }
    for (;;) {
        const bool has_next = S.next(ui + 1, nxt);
        const char* nA = has_next ? (const char*)g.A + (size_t)nxt.pm * tstep : cA; const char* nB = has_next ? (const char*)g.Bt + (size_t)nxt.pn * tstep : cB;
        for (int t = 0; t < nt; t += 2) {
            const bool last = (t == nt - 2);
            const char* a1 = cA + (size_t)(t + 1) * kstep;
            const char* a2 = last ? nA : cA + (size_t)(t + 2) * kstep; const char* b2 = last ? nB : cB + (size_t)(t + 2) * kstep;
            const char* a3 = a2 + kstep; const char* b3 = b2 + kstep;
            if (last && has_next) S.a_ready(nxt);
            if constexpr (SP2) {
            PG8_LDB(B0, 0, 0); PG8_LDB(B1, 0, 1); PG8_SCHED; PG8_LDA(At, 0, 0); PG8_STAGE(PG8_SA(1, 1), a1 + hstep, voffA);
            PG8_WAIT_V(8); PG8_WAIT_L(0); PG8_BAR; PG8_MMA(0, 0, At, B0); PG8_MMA(0, 1, At, B1); PG8_BAR; PG8_SCHED;
            PG8_LDA(At, 0, 1); PG8_STAGE(PG8_SB(0, 0), b2, voffB); PG8_STAGE(PG8_SB(0, 1), b2 + hstep, voffB); PG8_STAGE(PG8_SA(0, 0), a2, voffA);
            PG8_WAIT_V(8); PG8_WAIT_L(0); PG8_BAR; PG8_MMA(1, 0, At, B0); PG8_MMA(1, 1, At, B1); PG8_BAR; PG8_SCHED;
            PG8_LDB(B0, 1, 0); PG8_LDB(B1, 1, 1); PG8_SCHED; PG8_LDA(At, 1, 0); PG8_STAGE(PG8_SA(0, 1), a2 + hstep, voffA);
            PG8_WAIT_V(8); PG8_WAIT_L(0); PG8_BAR; PG8_MMA(0, 0, At, B0); PG8_MMA(0, 1, At, B1); PG8_BAR; PG8_SCHED;
            PG8_LDA(At, 1, 1); PG8_STAGE(PG8_SB(1, 0), b3, voffB); PG8_STAGE(PG8_SB(1, 1), b3 + hstep, voffB); PG8_STAGE(PG8_SA(1, 0), a3, voffA);
            PG8_WAIT_V(8); PG8_WAIT_L(0); PG8_BAR; PG8_MMA(1, 0, At, B0); PG8_MMA(1, 1, At, B1); PG8_BAR; PG8_SCHED;
            } else {
            PG8_LDB(B0, 0, 0); PG8_SCHED; PG8_LDA(At, 0, 0); PG8_STAGE(PG8_SA(1, 1), a1 + hstep, voffA);
            PG8_WAIT_L(8); PG8_BAR; PG8_WAIT_L(0); PG8_MMA(0, 0, At, B0); PG8_BAR; PG8_SCHED;
            PG8_LDB(B1, 0, 1); PG8_STAGE(PG8_SB(0, 0), b2, voffB);
            PG8_BAR; PG8_WAIT_L(0); PG8_MMA(0, 1, At, B1); PG8_BAR;
            PG8_LDA(At, 0, 1); PG8_STAGE(PG8_SA(0, 0), a2, voffA);
            PG8_BAR; PG8_WAIT_L(0); PG8_MMA(1, 0, At, B0); PG8_BAR; PG8_SCHED;
            PG8_STAGE(PG8_SB(0, 1), b2 + hstep, voffB);
            PG8_WAIT_V(6); PG8_BAR; PG8_MMA(1, 1, At, B1); PG8_BAR;
            PG8_LDB(B0, 1, 0); PG8_SCHED; PG8_LDA(At, 1, 0); PG8_STAGE(PG8_SA(0, 1), a2 + hstep, voffA);
            PG8_WAIT_L(8); PG8_BAR; PG8_WAIT_L(0); PG8_MMA(0, 0, At, B0); PG8_BAR; PG8_SCHED;
            PG8_LDB(B1, 1, 1); PG8_STAGE(PG8_SB(1, 0), b3, voffB);
            PG8_BAR; PG8_WAIT_L(0); PG8_MMA(0, 1, At, B1); PG8_BAR;
            PG8_LDA(At, 1, 1); PG8_STAGE(PG8_SA(1, 0), a3, voffA);
            PG8_BAR; PG8_WAIT_L(0); PG8_MMA(1, 0, At, B0); PG8_BAR; PG8_SCHED;
            PG8_STAGE(PG8_SB(1, 1), b3 + hstep, voffB);
            PG8_WAIT_V(6); PG8_BAR; PG8_MMA(1, 1, At, B1); PG8_BAR;
            }
        }
        if constexpr (ALIGN_EPI) { if (wr == 0) PG8_BAR; }
        if constexpr (!Epi::AFTER_DRAIN) { E(acc, cur, wr, wc, fr, fq); S.done(cur); }
        if (!has_next) break;
#pragma unroll
        for (int a = 0; a < 2; ++a)
#pragma unroll
            for (int b = 0; b < 2; ++b)
#pragma unroll
                for (int m = 0; m < 4; ++m)
#pragma unroll
                    for (int n = 0; n < 2; ++n) acc[a][b][m][n] = (f32x4){0.f, 0.f, 0.f, 0.f};
        cur = nxt; cA = nA; cB = nB; ++ui;
        if constexpr (ALIGN_EPI) { if (wr == 1) PG8_BAR; }
    }
    PG8_WAIT_V(0);
    if constexpr (!ALIGN_EPI) { if (wr == 0) PG8_BAR; }
    PG8_BAR;
    if constexpr (Epi::AFTER_DRAIN) { E.fused(acc, cur, wr, wc, fr, fq, lds, wid, lane); S.done(cur); }
#undef PG8_SA
#undef PG8_SB
#undef PG8_STAGE
#undef PG8_LDA
#undef PG8_LDB
#undef PG8_MMA
#undef PG8_WAIT_V
#undef PG8_WAIT_L
#undef PG8_BAR
#undef PG8_SCHED
}
}

constexpr int NB = 2, SEQ = 8192, DM = 1024, MTOK = NB * SEQ, DEPTH = 4, NMEM = 256, DFF = 2816;
constexpr int PROJW = 2304;
constexpr int EV_IN = 2064, OD_IN = 2120;
constexpr float EPS = 1e-6f;
constexpr int S5T = 64, S5NC = SEQ / S5T;
constexpr int TOPK = 256;
constexpr int PH_LAYER0 = 2, PH_PER_LAYER = 14, PH_FINAL = PH_LAYER0 + DEPTH * PH_PER_LAYER, N_PHASES = PH_FINAL + 1;

constexpr size_t MiB = 1u << 20;
constexpr size_t WS_CTL = 0, CTL_ZERO_BYTES = 1 * MiB;
constexpr size_t WS_H = 1 * MiB, WS_HB = 65 * MiB, WS_SS = 97 * MiB;
constexpr size_t WS_COSA = 98 * MiB, WS_SINA = 102 * MiB, WS_COSI = 106 * MiB, WS_SINI = 108 * MiB;
constexpr size_t WS_MEMN = 110 * MiB, WS_MK = 111 * MiB, WS_MVT = 115 * MiB, WS_S5P = 119 * MiB;
constexpr size_t WS_W = 121 * MiB, WS_SCR = 169 * MiB, WS_END = 345 * MiB;
constexpr size_t WO_GU1 = 0, WO_D1 = 11 * MiB, WO_IN = WO_D1 + 5632 * 1024, WO_OUT = WO_IN + 4608 * 1024, WO_GLU = WO_OUT + 2 * MiB, WO_XQ = WO_GLU + 512 * 1024,
                 WO_XO = WO_XQ + 2 * MiB, WO_GU2 = WO_XO + 2 * MiB, WO_D2 = WO_GU2 + 11 * MiB, WO_END = WO_D2 + 5632 * 1024;
static_assert(WO_END <= 48 * MiB, "weights region");
constexpr size_t SC_HID = 0, SC_PROJ = 0, SC_XQ = 0, SC_XO = 32 * MiB, SC_KVW = 96 * MiB;
constexpr size_t SC_DS = 72 * MiB, SC_BC = 104 * MiB, SC_DEC = 120 * MiB, SC_S5E = 121 * MiB, SC_Y = 125 * MiB, SC_CAT = 141 * MiB;
constexpr size_t SC_SEL = 72 * MiB, SC_SELN = 80 * MiB, SC_K8 = 81 * MiB, SC_V8 = 85 * MiB;
static_assert(SC_CAT + 32 * MiB <= WS_END - WS_SCR, "scratch region");
constexpr int S5P_A = 0, S5P_AT = 2 * 32 * 64 * 2, S5P_BB = 2 * S5P_AT, S5P_BBH = S5P_BB + 2 * 32 * 64 * 16 * 2, S5P_END = S5P_BBH + 2 * 32 * 128 * 16 / 2;
constexpr int CW_BAR = 1024;

constexpr int RING_BYTES = 131072;
constexpr int LDS_BYTES = 163840, LDSCTL_OFF = LDS_BYTES - 1024;

#define GAS __attribute__((address_space(1)))
#define LAS __attribute__((address_space(3)))
#define DI __device__ __forceinline__
typedef unsigned short bf16;
typedef unsigned v4u __attribute__((ext_vector_type(4)));
typedef unsigned v2u __attribute__((ext_vector_type(2)));
typedef float f32x4 __attribute__((ext_vector_type(4)));
typedef float f32x2 __attribute__((ext_vector_type(2)));
typedef short bf16x8 __attribute__((ext_vector_type(8)));
#define LDS_WAIT() asm volatile("s_waitcnt lgkmcnt(0)" ::: "memory")
#define VM_WAIT() asm volatile("s_waitcnt vmcnt(0)" ::: "memory")
DI unsigned f2bf(float f) { unsigned u = __builtin_bit_cast(unsigned, f); return (u + 0x7fffu + ((u >> 16) & 1u)) >> 16; }
DI unsigned pk2(float lo, float hi) { return f2bf(lo) | (f2bf(hi) << 16); }
DI float bflo(unsigned w) { return __uint_as_float(w << 16); }
DI float bfhi(unsigned w) { return __uint_as_float(w & 0xffff0000u); }
DI float bf2f(bf16 x) { return __uint_as_float(((unsigned)x) << 16); }
DI float wave_sum(float v) {
#pragma unroll
    for (int o = 1; o < 64; o <<= 1) v += __shfl_xor(v, o);
    return v;
}
DI f32x4 mfma16(bf16x8 a, bf16x8 b, f32x4 c) { return __builtin_amdgcn_mfma_f32_16x16x32_bf16(a, b, c, 0, 0, 0); }

#define XB_TMO      128
#define XB_XCNT(j)  (256  + 64 * (j))
#define XB_XSUB(j)  (1280 + 64 * (j))
#define XB_XGEN(j)  (2304 + 64 * (j))
#define XB_TOP      3328
#define XB_TOPGEN   3392
#define XCD_BAR_WORDS 3456
#define XB_SPIN_CAP (1u << 18)
__device__ __forceinline__ unsigned xb_ld(unsigned* p)              { return __hip_atomic_load(p, __ATOMIC_RELAXED, __HIP_MEMORY_SCOPE_AGENT); }
__device__ __forceinline__ unsigned xb_add(unsigned* p, unsigned v) { return __hip_atomic_fetch_add(p, v, __ATOMIC_RELAXED, __HIP_MEMORY_SCOPE_AGENT); }
__device__ __forceinline__ unsigned xb_xcc_id() { return (unsigned)__builtin_amdgcn_s_getreg((3 << 11) | 20) & 0xFu; }
#define XB_SPIN(cond, bar) do { unsigned _sp = 0; while (cond) { __builtin_amdgcn_s_sleep(1); \
    if ((++_sp & 255u) == 0u) { if (xb_ld(&(bar)[XB_TMO])) break; if (_sp > XB_SPIN_CAP) { atomicAdd(&(bar)[XB_TMO], 1u); break; } } } } while (0)
struct XcdBarrier { unsigned* bar; unsigned x; volatile LAS unsigned* st; };
__device__ __forceinline__ XcdBarrier xcd_barrier_post(unsigned* bar, volatile LAS unsigned* st) {
    XcdBarrier b; b.bar = bar; b.x = xb_xcc_id(); b.st = st;
    if (threadIdx.x == 0) (void)xb_add(&bar[XB_XCNT(b.x)], 1u);
    return b;
}
__device__ __forceinline__ void xcd_barrier_complete(unsigned* bar, unsigned x, unsigned& nloc, unsigned& nx) {
    const unsigned G = gridDim.x * gridDim.y * gridDim.z;
    unsigned sum, cnt, mine, sp = 0u;
    for (;;) {
        sum = 0u; cnt = 0u; mine = 0u;
#pragma unroll
        for (unsigned j = 0; j < 16; ++j) { const unsigned c = xb_ld(&bar[XB_XCNT(j)]); sum += c; cnt += (c > 0u) ? 1u : 0u; mine = (j == x) ? c : mine; }
        if (sum == G) break;
        __builtin_amdgcn_s_sleep(1);
        if ((++sp & 255u) == 0u) { if (xb_ld(&bar[XB_TMO])) break; if (sp > XB_SPIN_CAP) { atomicAdd(&bar[XB_TMO], 1u); break; } }
    }
    nloc = mine > 0u ? mine : 1u; nx = cnt > 0u ? cnt : 1u;
}
__device__ __forceinline__ void xcd_barrier(const XcdBarrier& b) {
    asm volatile("s_waitcnt vmcnt(0)" ::: "memory");
    __syncthreads();
    if (threadIdx.x == 0) {
        unsigned* bar = b.bar;
        __builtin_amdgcn_s_waitcnt(0);
        unsigned nloc = b.st[0], nx = b.st[1];
        if (nloc == 0u) { xcd_barrier_complete(bar, b.x, nloc, nx); b.st[0] = nloc; b.st[1] = nx; }
        const unsigned old = xb_add(&bar[XB_XSUB(b.x)], 1u);
        const unsigned gen = old / nloc;
        if (old + 1u == (gen + 1u) * nloc) {
            __builtin_amdgcn_fence(__ATOMIC_RELEASE, "agent");
            asm volatile("s_waitcnt vmcnt(0)" ::: "memory");
            const unsigned og = xb_add(&bar[XB_TOP], 1u);
            const unsigned tg = og / nx;
            if (og + 1u == (tg + 1u) * nx) xb_add(&bar[XB_TOPGEN], 1u);
            else XB_SPIN(xb_ld(&bar[XB_TOPGEN]) == tg, bar);
            __builtin_amdgcn_fence(__ATOMIC_ACQUIRE, "agent");
            xb_add(&bar[XB_XGEN(b.x)], 1u);
            asm volatile("s_waitcnt vmcnt(0)" ::: "memory");
        } else {
            XB_SPIN(xb_ld(&bar[XB_XGEN(b.x)]) == gen, bar);
            asm volatile("buffer_inv sc0" ::: "memory");
            asm volatile("s_waitcnt vmcnt(0)" ::: "memory");
        }
    }
    __syncthreads();
}

struct Ctx { LAS unsigned char* lds; int tid, lane, wave, vcu, G; };

DI void cvt_store(bf16* dst, int K, int drow0, int k0, LAS float* scr, int lane) {
    LDS_WAIT(); asm volatile("" ::: "memory");
    const int c = lane & 7;
#pragma unroll
    for (int j = 0; j < 4; ++j) { const int n = (lane >> 3) + 8 * j; const LAS float* s = scr + (8 * c) * 33 + n;
        v4u o; o.x = pk2(s[0 * 33], s[1 * 33]); o.y = pk2(s[2 * 33], s[3 * 33]); o.z = pk2(s[4 * 33], s[5 * 33]); o.w = pk2(s[6 * 33], s[7 * 33]);
        *(v4u*)(dst + (size_t)(drow0 + n) * K + k0 + 8 * c) = o; }
    LDS_WAIT(); asm volatile("" ::: "memory");
}
DI void cvt_item(const float* src, int ldsrc, int scol0, int nvalid, const float* gain, bf16* dst, int K, int drow0, int k0, LAS float* scr, int lane) {
    const int kr = lane >> 3, n4 = 4 * (lane & 7); const bool ok = n4 < nvalid;
    const float* sp = src + (size_t)(k0 + kr) * ldsrc + scol0 + n4;
    f32x4 v[8];
#pragma unroll
    for (int i = 0; i < 8; ++i) v[i] = ok ? *(const f32x4*)(sp + (size_t)(8 * i) * ldsrc) : (f32x4){0.f, 0.f, 0.f, 0.f};
    if (gain) {
#pragma unroll
        for (int i = 0; i < 8; ++i) v[i] = v[i] * gain[k0 + kr + 8 * i];
    }
#pragma unroll
    for (int i = 0; i < 8; ++i) { LAS float* d = scr + (kr + 8 * i) * 33 + n4; d[0] = v[i].x; d[1] = v[i].y; d[2] = v[i].z; d[3] = v[i].w; }
    cvt_store(dst, K, drow0, k0, scr, lane);
}
DI void cvt_job(const Ctx& c, const float* src, int ldsrc, int scol0, int nvalid, const float* gain, bf16* dst, int K, int N, int drow0, int rot) {
    LAS float* scr = (LAS float*)(c.lds + c.wave * 8448);
    const int NGW = c.G * 8, gw = (c.vcu * 8 + c.wave + rot) % NGW, nblk = N / 32, nitems = (K / 64) * nblk;
    for (int it = gw; it < nitems; it += NGW) { const int kb = it / nblk, nb = it % nblk; int nv = nvalid - nb * 32; nv = nv < 0 ? 0 : (nv > 32 ? 32 : nv);
        cvt_item(src, ldsrc, scol0 + nb * 32, nv, gain, dst, K, drow0 + nb * 32, kb * 64, scr, c.lane); }
}
DI void cvt_job_gu(const Ctx& c, const float* gate, const float* up, const float* gain, bf16* dst, int rot) {
    LAS float* scr = (LAS float*)(c.lds + c.wave * 8448);
    const int NGW = c.G * 8, gw = (c.vcu * 8 + c.wave + rot) % NGW, nblk = 5632 / 32, nitems = (1024 / 64) * nblk;
    for (int it = gw; it < nitems; it += NGW) { const int kb = it / nblk, nb = it % nblk, n0 = nb * 32;
        const float* src = ((n0 >> 7) & 1) ? up : gate; const int sc = (n0 >> 8) * 128 + (n0 & 127);
        cvt_item(src, DFF, sc, 32, gain, dst, 1024, n0, kb * 64, scr, c.lane); }
}
DI void cvt_job_rope(const Ctx& c, const float* src, const float* gain, bf16* dst, int rot) {
    LAS float* scr = (LAS float*)(c.lds + c.wave * 8448);
    const int NGW = c.G * 8, gw = (c.vcu * 8 + c.wave + rot) % NGW, nblk = PROJW / 32, nitems = (1024 / 64) * nblk;
    for (int it = gw; it < nitems; it += NGW) { const int kb = it / nblk, nb = it % nblk, R = nb * 32, t = R >> 8, bj = (R >> 7) & 1, x = R & 127;
        int L, nv = 32;
        if (t < 4) L = 256 * t + 128 * (x >> 6) + 64 * bj + (x & 63);
        else if (t == 4) L = 1024 + 128 * (x >> 6) + 64 * bj + (x & 63);
        else if (t == 5) L = 1280 + 128 * bj + x;
        else if (t < 8) L = 1536 + 256 * (t - 6) + 64 * (x >> 5) + 32 * bj;
        else { if (x == 0) L = 2048 + 32 * bj; else if (x == 32 && bj == 0) { L = 2112; nv = 8; } else { L = 0; nv = 0; } }
        cvt_item(src, OD_IN, L, nv, gain, dst, 1024, R, kb * 64, scr, c.lane); }
}
DI void cvt_job_comb(const Ctx& c, const float* win, const float* wa, const float* gain, bf16* dst, int drow0, int rot) {
    LAS float* scr = (LAS float*)(c.lds + c.wave * 8448);
    const int NGW = c.G * 8, gw = (c.vcu * 8 + c.wave + rot) % NGW, nblk = 256 / 32, nitems = (1024 / 64) * nblk;
    for (int it = gw; it < nitems; it += NGW) { const int kb = it / nblk, nb = it % nblk, n0 = nb * 32, k0 = kb * 64; const int nn = c.lane & 31;
        float wcol[16];
#pragma unroll
        for (int j = 0; j < 16; ++j) wcol[j] = wa[j * 256 + n0 + nn];
        for (int i = 0; i < 32; ++i) { const int kk = 2 * i + (c.lane >> 5); const float* wr = win + (size_t)(k0 + kk) * EV_IN + 1536; float s = 0.f;
#pragma unroll
            for (int j = 0; j < 16; ++j) s += wr[j] * wcol[j];
            scr[kk * 33 + nn] = s * gain[k0 + kk]; }
        cvt_store(dst, 1024, drow0 + n0, k0, scr, c.lane); }
}

DI void row_init(const float* xrow, bf16* hbrow, float* ssrow, int lane) {
    float s = 0.f;
#pragma unroll
    for (int j = 0; j < 4; ++j) { const f32x4 v = ((const f32x4*)xrow)[lane + 64 * j]; v2u w; w.x = pk2(v.x, v.y); w.y = pk2(v.z, v.w); ((v2u*)hbrow)[lane + 64 * j] = w;
        const float r0 = bflo(w.x), r1 = bfhi(w.x), r2 = bflo(w.y), r3 = bfhi(w.y); s += (r0 * r0 + r1 * r1) + (r2 * r2 + r3 * r3); }
    s = wave_sum(s);
    if (lane < 16) ssrow[lane] = (lane == 0) ? s : 0.f;
}
DI void row_norm_bf16(const float* xrow, const float* g, bf16* orow, int lane) {
    f32x4 v[4]; float s = 0.f;
#pragma unroll
    for (int j = 0; j < 4; ++j) { v[j] = ((const f32x4*)xrow)[lane + 64 * j]; s += (v[j].x * v[j].x + v[j].y * v[j].y) + (v[j].z * v[j].z + v[j].w * v[j].w); }
    const float r = rsqrtf(wave_sum(s) * (1.0f / 1024.0f) + EPS);
#pragma unroll
    for (int j = 0; j < 4; ++j) { const f32x4 gg = ((const f32x4*)g)[lane + 64 * j]; v2u w; w.x = pk2(v[j].x * r * gg.x, v[j].y * r * gg.y); w.y = pk2(v[j].z * r * gg.z, v[j].w * r * gg.w); ((v2u*)orow)[lane + 64 * j] = w; }
}
DI void row_final(const bf16* hrow, const float* ssrow, const float* g, float* orow, int lane) {
    float s = (lane < 16) ? ssrow[lane] : 0.f; s = wave_sum(s);
    const float r = rsqrtf(s * (1.0f / 1024.0f) + EPS);
#pragma unroll
    for (int j = 0; j < 4; ++j) { const v2u w = ((const v2u*)hrow)[lane + 64 * j]; const f32x4 v = {bflo(w.x), bfhi(w.x), bflo(w.y), bfhi(w.y)}, gg = ((const f32x4*)g)[lane + 64 * j]; ((f32x4*)orow)[lane + 64 * j] = v * r * gg; }
}

DI void unpack8(const v4u w, float (&x)[8]) { x[0] = bflo(w.x); x[1] = bfhi(w.x); x[2] = bflo(w.y); x[3] = bfhi(w.y); x[4] = bflo(w.z); x[5] = bfhi(w.z); x[6] = bflo(w.w); x[7] = bfhi(w.w); }
DI void gla1_unit(const Ctx& c, int u, const bf16* PROJ, const float* b_a, float* DS, float* BCg, float* DEC) {
    const int n = u & 127, bh = u >> 7, h = bh & 3, b = bh >> 2, row0 = b * SEQ + n * 64;
    LAS float* BCl = (LAS float*)c.lds; LAS float* SEG = BCl + 4096; LAS unsigned char* KEt = c.lds + 18432; LAS unsigned char* VT = KEt + 9216;
    const int t = c.tid >> 3, s8 = c.tid & 7;
    const bf16* prow = PROJ + (size_t)(row0 + t) * PROJW;
    float kk[8];
    { float x[8]; unpack8(*(const v4u*)(prow + 1536 + h * 64 + s8 * 8), x);
      float ls[8];
#pragma unroll
      for (int j = 0; j < 8; ++j) { const float xx = x[j] + b_a[h * 64 + s8 * 8 + j]; ls[j] = (fminf(xx, 0.f) - __logf(1.0f + __expf(-fabsf(xx)))) * (1.0f / 16.0f); }
      *(LAS f32x4*)(BCl + t * 64 + s8 * 8) = (f32x4){ls[0], ls[1], ls[2], ls[3]}; *(LAS f32x4*)(BCl + t * 64 + s8 * 8 + 4) = (f32x4){ls[4], ls[5], ls[6], ls[7]};
      unpack8(*(const v4u*)(prow + 256 + h * 64 + s8 * 8), kk);
      const v4u v0 = *(const v4u*)(prow + 512 + h * 128 + s8 * 16), v1 = *(const v4u*)(prow + 512 + h * 128 + s8 * 16 + 8);
      const unsigned vw[8] = {v0.x, v0.y, v0.z, v0.w, v1.x, v1.y, v1.z, v1.w};
      LAS unsigned char* vt = VT + (16 * s8) * 144 + t * 2;
#pragma unroll
      for (int j = 0; j < 8; ++j) { *(LAS bf16*)(vt + (2 * j) * 144) = (bf16)(vw[j] & 0xffffu); *(LAS bf16*)(vt + (2 * j + 1) * 144) = (bf16)(vw[j] >> 16); } }
    __syncthreads();
    { const int d = c.tid & 63, seg = c.tid >> 6; float v[8]; float run = 0.f;
#pragma unroll
      for (int j = 0; j < 8; ++j) { run += BCl[(8 * seg + j) * 64 + d]; v[j] = run; }
      SEG[seg * 64 + d] = run;
      __syncthreads();
      float off = 0.f;
#pragma unroll
      for (int q = 0; q < 7; ++q) off += (q < seg) ? SEG[q * 64 + d] : 0.f;
#pragma unroll
      for (int j = 0; j < 8; ++j) BCl[(8 * seg + j) * 64 + d] = v[j] + off; }
    __syncthreads();
    { float bcv[8];
#pragma unroll
      for (int j = 0; j < 8; ++j) { const int d = s8 * 8 + j; const float bc = BCl[t * 64 + d], bl = BCl[63 * 64 + d]; bcv[j] = bc;
          *(LAS bf16*)(KEt + d * 144 + t * 2) = (bf16)f2bf(kk[j] * __expf(bl - bc)); }
      float* bp = BCg + (size_t)(row0 + t) * 256 + h * 64 + s8 * 8;
      *(f32x4*)bp = (f32x4){bcv[0], bcv[1], bcv[2], bcv[3]}; *(f32x4*)(bp + 4) = (f32x4){bcv[4], bcv[5], bcv[6], bcv[7]};
      if (c.tid < 64) DEC[(size_t)u * 64 + c.tid] = __expf(BCl[63 * 64 + c.tid]); }
    __syncthreads();
    { const int r16 = c.lane & 15, q4 = c.lane >> 4, w = c.wave;
      bf16x8 vb[2];
#pragma unroll
      for (int ks = 0; ks < 2; ++ks) vb[ks] = *(const LAS bf16x8*)(VT + (16 * w + r16) * 144 + (32 * ks + 8 * q4) * 2);
#pragma unroll
      for (int df = 0; df < 4; ++df) { f32x4 acc = {0.f, 0.f, 0.f, 0.f};
#pragma unroll
          for (int ks = 0; ks < 2; ++ks) acc = mfma16(*(const LAS bf16x8*)(KEt + (16 * df + r16) * 144 + (32 * ks + 8 * q4) * 2), vb[ks], acc);
          float* dp = DS + (size_t)u * 8192 + (size_t)(16 * df + 4 * q4) * 128 + 16 * w + r16;
#pragma unroll
          for (int i = 0; i < 4; ++i) dp[i * 128] = acc[i]; } }
    __syncthreads();
}
DI void gla2_scan(const Ctx& c, float* DS, const float* DEC) {
    for (int el = c.vcu * 512 + c.tid; el < 8 * 64 * 128; el += c.G * 512) {
        const int bh = el >> 13, d = (el >> 7) & 63, e = el & 127; float S = 0.f;
        float* p0 = DS + (size_t)(bh * 128) * 8192 + d * 128 + e; const float* q0 = DEC + (size_t)(bh * 128) * 64 + d;
        for (int n0 = 0; n0 < 128; n0 += 16) {
            float ds[16], dc[16];
#pragma unroll
            for (int j = 0; j < 16; ++j) { ds[j] = p0[(size_t)(n0 + j) * 8192]; dc[j] = q0[(n0 + j) * 64]; }
#pragma unroll
            for (int j = 0; j < 16; ++j) { p0[(size_t)(n0 + j) * 8192] = S; S = dc[j] * S + ds[j]; }
        }
    }
}
DI bf16x8 pack8(const f32x4 a, const f32x4 b) { v4u w; w.x = pk2(a[0], a[1]); w.y = pk2(a[2], a[3]); w.z = pk2(b[0], b[1]); w.w = pk2(b[2], b[3]); return __builtin_bit_cast(bf16x8, w); }
DI void gla3_unit(const Ctx& c, int u, const bf16* PROJ, const float* BCg, const float* DS, const float* gnorm, bf16* CAT) {
    const int n = u & 127, bh = u >> 7, h = bh & 3, b = bh >> 2, row0 = b * SEQ + n * 64;
    LAS unsigned char* QD = c.lds; LAS unsigned char* KI = QD + 9216; LAS unsigned char* VT = KI + 9216; LAS unsigned char* SPT = VT + 18432; LAS float* PART = (LAS float*)(SPT + 18432);
    { const int t = c.tid >> 3, s8 = c.tid & 7; const bf16* prow = PROJ + (size_t)(row0 + t) * PROJW;
      float q[8], k[8]; unpack8(*(const v4u*)(prow + h * 64 + s8 * 8), q); unpack8(*(const v4u*)(prow + 256 + h * 64 + s8 * 8), k);
      const float* bp = BCg + (size_t)(row0 + t) * 256 + h * 64 + s8 * 8; const f32x4 b0 = *(const f32x4*)bp, b1 = *(const f32x4*)(bp + 4);
      const float bc[8] = {b0.x, b0.y, b0.z, b0.w, b1.x, b1.y, b1.z, b1.w};
#pragma unroll
      for (int j = 0; j < 8; ++j) { q[j] = q[j] * 0.125f * __expf(bc[j]); k[j] = k[j] * __expf(-bc[j]); }
      v4u wq, wk; wq.x = pk2(q[0], q[1]); wq.y = pk2(q[2], q[3]); wq.z = pk2(q[4], q[5]); wq.w = pk2(q[6], q[7]); wk.x = pk2(k[0], k[1]); wk.y = pk2(k[2], k[3]); wk.z = pk2(k[4], k[5]); wk.w = pk2(k[6], k[7]);
      *(LAS v4u*)(QD + t * 144 + s8 * 16) = wq; *(LAS v4u*)(KI + t * 144 + s8 * 16) = wk;
      const v4u v0 = *(const v4u*)(prow + 512 + h * 128 + s8 * 16), v1 = *(const v4u*)(prow + 512 + h * 128 + s8 * 16 + 8);
      const unsigned vw[8] = {v0.x, v0.y, v0.z, v0.w, v1.x, v1.y, v1.z, v1.w};
      LAS unsigned char* vt = VT + (16 * s8) * 144 + t * 2;
#pragma unroll
      for (int j = 0; j < 8; ++j) { *(LAS bf16*)(vt + (2 * j) * 144) = (bf16)(vw[j] & 0xffffu); *(LAS bf16*)(vt + (2 * j + 1) * 144) = (bf16)(vw[j] >> 16); }
      const int d = t; const f32x4* sp = (const f32x4*)(DS + (size_t)u * 8192 + d * 128 + s8 * 16);
      LAS unsigned char* st = SPT + (16 * s8) * 144 + d * 2;
#pragma unroll
      for (int i = 0; i < 4; ++i) { const f32x4 x = sp[i];
#pragma unroll
          for (int j = 0; j < 4; ++j) *(LAS bf16*)(st + (4 * i + j) * 144) = (bf16)f2bf(x[j]); } }
    __syncthreads();
    const int r16 = c.lane & 15, q4 = c.lane >> 4, w = c.wave;
    bf16x8 qd[4][2];
#pragma unroll
    for (int tf = 0; tf < 4; ++tf)
#pragma unroll
        for (int ks = 0; ks < 2; ++ks) qd[tf][ks] = *(const LAS bf16x8*)(QD + (16 * tf + r16) * 144 + (32 * ks + 8 * q4) * 2);
    f32x4 sc[4][4];
#pragma unroll
    for (int sf = 0; sf < 4; ++sf) {
        bf16x8 ki[2];
#pragma unroll
        for (int ks = 0; ks < 2; ++ks) ki[ks] = *(const LAS bf16x8*)(KI + (16 * sf + r16) * 144 + (32 * ks + 8 * q4) * 2);
#pragma unroll
        for (int tf = 0; tf < 4; ++tf) {
            f32x4 a = {0.f, 0.f, 0.f, 0.f};
            if (sf <= tf) {
#pragma unroll
                for (int ks = 0; ks < 2; ++ks) a = mfma16(ki[ks], qd[tf][ks], a);
                if (sf == tf) {
#pragma unroll
                    for (int i = 0; i < 4; ++i) a[i] = (4 * q4 + i <= r16) ? a[i] : 0.f;
                }
            }
            sc[sf][tf] = a;
        }
    }
    f32x4 o[4];
#pragma unroll
    for (int tf = 0; tf < 4; ++tf) o[tf] = (f32x4){0.f, 0.f, 0.f, 0.f};
    const LAS unsigned char* vrow = VT + (16 * w + r16) * 144; const LAS unsigned char* srow = SPT + (16 * w + r16) * 144;
#pragma unroll
    for (int kk = 0; kk < 2; ++kk) {
        const v2u lo = *(const LAS v2u*)(vrow + (32 * kk + 4 * q4) * 2), hi = *(const LAS v2u*)(vrow + (32 * kk + 16 + 4 * q4) * 2);
        v4u aw; aw.x = lo.x; aw.y = lo.y; aw.z = hi.x; aw.w = hi.y; const bf16x8 a = __builtin_bit_cast(bf16x8, aw);
#pragma unroll
        for (int tf = 0; tf < 4; ++tf) if (2 * kk <= tf) o[tf] = mfma16(a, pack8(sc[2 * kk][tf], sc[2 * kk + 1][tf]), o[tf]);
    }
#pragma unroll
    for (int ks = 0; ks < 2; ++ks) { const bf16x8 a = *(const LAS bf16x8*)(srow + (32 * ks + 8 * q4) * 2);
#pragma unroll
        for (int tf = 0; tf < 4; ++tf) o[tf] = mfma16(a, qd[tf][ks], o[tf]); }
#pragma unroll
    for (int tf = 0; tf < 4; ++tf) { float ssq = (o[tf][0] * o[tf][0] + o[tf][1] * o[tf][1]) + (o[tf][2] * o[tf][2] + o[tf][3] * o[tf][3]);
        ssq += __shfl_xor(ssq, 16); ssq += __shfl_xor(ssq, 32); if (q4 == 0) PART[w * 64 + 16 * tf + r16] = ssq; }
    __syncthreads();
    const f32x4 gg = *(const f32x4*)(gnorm + 16 * w + 4 * q4);
#pragma unroll
    for (int tf = 0; tf < 4; ++tf) { const int t = 16 * tf + r16; float ssq = 0.f;
#pragma unroll
        for (int ww = 0; ww < 8; ++ww) ssq += PART[ww * 64 + t];
        const float rn = rsqrtf(ssq * (1.0f / 128.0f) + EPS);
        const v2u rv = *(const v2u*)(PROJ + (size_t)(row0 + t) * PROJW + 1024 + h * 128 + 16 * w + 4 * q4);
        const float rr[4] = {bflo(rv.x), bfhi(rv.x), bflo(rv.y), bfhi(rv.y)}; float res[4];
#pragma unroll
        for (int i = 0; i < 4; ++i) res[i] = o[tf][i] * rn * gg[i] * (rr[i] * __builtin_amdgcn_rcpf(1.0f + __expf(-rr[i])));
        v2u ow; ow.x = pk2(res[0], res[1]); ow.y = pk2(res[2], res[3]);
        *(v2u*)(CAT + (size_t)(row0 + t) * 1024 + h * 128 + 16 * w + 4 * q4) = ow; }
    __syncthreads();
}

DI void s5_params(const Ctx& c, const float* lam_re, const float* lam_im, const float* log_dt, const float* B_re, const float* B_im, float* P) {
    for (int idx = c.vcu * 512 + c.tid; idx < 2 * 32 * 64; idx += c.G * 512) {
        const float lr = fminf(lam_re[idx], -1e-4f), li = lam_im[idx], dt = expf(log_dt[idx >> 6]);
        const float mag = expf(lr * dt), ar = mag * cosf(li * dt), ai = mag * sinf(li * dt);
        const float den = lr * lr + li * li, nr = ar - 1.0f, fre = (nr * lr + ai * li) / den, fim = (ai * lr - nr * li) / den;
        P[S5P_A + 2 * idx] = ar; P[S5P_A + 2 * idx + 1] = ai;
        float tr = ar, ti = ai;
#pragma unroll
        for (int s = 0; s < 6; ++s) { const float nr2 = tr * tr - ti * ti, ni2 = 2.0f * tr * ti; tr = nr2; ti = ni2; }
        P[S5P_AT + 2 * idx] = tr; P[S5P_AT + 2 * idx + 1] = ti;
        bf16* BBH = (bf16*)(P + S5P_BBH); const int eg = idx >> 6, pp = idx & 63;
        for (int cc = 0; cc < 16; ++cc) { const float Br = B_re[idx * 16 + cc], Bi = B_im[idx * 16 + cc]; const float br = fre * Br - fim * Bi, bi = fre * Bi + fim * Br;
            P[S5P_BB + 2 * (idx * 16 + cc)] = br; P[S5P_BB + 2 * (idx * 16 + cc) + 1] = bi;
            BBH[(eg * 128 + pp) * 16 + cc] = (bf16)f2bf(br); BBH[(eg * 128 + 64 + pp) * 16 + cc] = (bf16)f2bf(bi); }
    }
}
DI void s5_load_u(const bf16* PROJ, int row0, int g, LAS float* U, int lane) {
    const bf16* p = PROJ + (size_t)(row0 + lane) * PROJW + 1792 + g * 16; float x[8];
    unpack8(*(const v4u*)p, x); ((LAS f32x4*)(U + lane * 16))[0] = (f32x4){x[0], x[1], x[2], x[3]}; ((LAS f32x4*)(U + lane * 16))[1] = (f32x4){x[4], x[5], x[6], x[7]};
    unpack8(*(const v4u*)(p + 8), x); ((LAS f32x4*)(U + lane * 16))[2] = (f32x4){x[0], x[1], x[2], x[3]}; ((LAS f32x4*)(U + lane * 16))[3] = (f32x4){x[4], x[5], x[6], x[7]};
}
DI void s5_frags(const bf16* PROJ, const float* P, int e, int g, int row0, int r16, int q4, bf16x8 (&ua)[4], bf16x8 (&bb)[8]) {
    const bf16x8 zf = {0, 0, 0, 0, 0, 0, 0, 0}; const bf16* BBH = (const bf16*)(P + S5P_BBH);
#pragma unroll
    for (int tf = 0; tf < 4; ++tf) ua[tf] = (q4 < 2) ? *(const bf16x8*)(PROJ + (size_t)(row0 + 16 * tf + r16) * PROJW + 1792 + g * 16 + 8 * q4) : zf;
#pragma unroll
    for (int pf = 0; pf < 8; ++pf) bb[pf] = (q4 < 2) ? *(const bf16x8*)(BBH + ((size_t)(e * 32 + g) * 128 + 16 * pf + r16) * 16 + 8 * q4) : zf;
}
DI void s5_bu16(const bf16x8 ua, const bf16x8 (&bb)[8], LAS float* BUs, int r16, int q4) {
    LAS float* wp = BUs + (4 * q4) * 128 + r16;
#pragma unroll
    for (int pf = 0; pf < 8; ++pf) { const f32x4 d = mfma16(ua, bb[pf], (f32x4){0.f, 0.f, 0.f, 0.f});
#pragma unroll
        for (int i = 0; i < 4; ++i) wp[i * 128 + 16 * pf] = d[i]; }
}
#define S5_BU(t) do { const LAS f32x4* up_ = (const LAS f32x4*)(U + (t) * 16); const f32x4 u0 = up_[0], u1 = up_[1], u2 = up_[2], u3 = up_[3]; \
    const float uu[16] = {u0.x, u0.y, u0.z, u0.w, u1.x, u1.y, u1.z, u1.w, u2.x, u2.y, u2.z, u2.w, u3.x, u3.y, u3.z, u3.w}; bur = 0.f; bui = 0.f; \
    _Pragma("unroll") for (int cc = 0; cc < 16; ++cc) { bur += bbr[cc] * uu[cc]; bui += bbi[cc] * uu[cc]; } } while (0)
DI void s5_phase1(const Ctx& c, int e, const bf16* PROJ, const float* P, float* S5E) {
    LAS float* U = (LAS float*)(c.lds + c.wave * 4096);
    const int NGW = c.G * 8, gw = c.vcu * 8 + c.wave;
    const bool reg = (NGW == 2 * 32 * S5NC / 4);
    int gcur = -1; float ar = 0.f, ai = 0.f, bbr[16], bbi[16];
#pragma unroll
    for (int cc = 0; cc < 16; ++cc) { bbr[cc] = 0.f; bbi[cc] = 0.f; }
    for (int it = 0;; ++it) {
        int wt; if (reg) { if (it >= 4) break; wt = (gw >> 5) * S5NC + (gw & 31) + 32 * it; } else { wt = gw + it * NGW; if (wt >= 2 * 32 * S5NC) break; }
        const int cch = wt & (S5NC - 1), bg = wt >> 7, g = bg & 31, b = bg >> 5, row0 = b * SEQ + cch * S5T, pi = (e * 32 + g) * 64 + c.lane;
        s5_load_u(PROJ, row0, g, U, c.lane);
        if (g != gcur) { gcur = g; ar = P[S5P_A + 2 * pi]; ai = P[S5P_A + 2 * pi + 1];
#pragma unroll
            for (int cc = 0; cc < 16; ++cc) { bbr[cc] = P[S5P_BB + 2 * (pi * 16 + cc)]; bbi[cc] = P[S5P_BB + 2 * (pi * 16 + cc) + 1]; } }
        LDS_WAIT();
        float xr = 0.f, xi = 0.f, bur, bui;
        for (int t = 0; t < S5T; ++t) { S5_BU(t); const float nxr = ar * xr - ai * xi + bur, nxi = ar * xi + ai * xr + bui; xr = nxr; xi = nxi; }
        *(f32x2*)(S5E + 2 * ((size_t)wt * 64 + c.lane)) = (f32x2){xr, xi};
        LDS_WAIT();
    }
}
DI void s5_phase2(const Ctx& c, int e, const float* P, float* S5E) {
    for (int sq = (c.G - 1 - c.vcu) * 512 + c.tid; sq < 2 * 32 * 64; sq += c.G * 512) {
        const int p = sq & 63, bg = sq >> 6, g = bg & 31, pi = (e * 32 + g) * 64 + p; const float tr = P[S5P_AT + 2 * pi], ti = P[S5P_AT + 2 * pi + 1];
        float xr = 0.f, xi = 0.f; f32x2* q0 = (f32x2*)(S5E + 2 * (((size_t)bg * S5NC) * 64 + p));
        for (int c0 = 0; c0 < S5NC; c0 += 16) {
            f32x2 ev[16];
#pragma unroll
            for (int j = 0; j < 16; ++j) ev[j] = q0[(c0 + j) * 64];
#pragma unroll
            for (int j = 0; j < 16; ++j) { q0[(c0 + j) * 64] = (f32x2){xr, xi}; const float nxr = tr * xr - ti * xi + ev[j].x, nxi = tr * xi + ti * xr + ev[j].y; xr = nxr; xi = nxi; }
        }
    }
}
DI void s5_phase3(const Ctx& c, int e, const bf16* PROJ, const float* P, const float* S5E, const float* C_re, const float* C_im, const float* Dp, bf16* Y) {
    LAS float* BUs = (LAS float*)(c.lds + c.wave * 12544);
    LAS unsigned char* XB = c.lds + c.wave * 12544 + 8192;
    const int NGW = c.G * 8, gw = c.vcu * 8 + c.wave; const int r16 = c.lane & 15, q4 = c.lane >> 4;
    const bool reg = (NGW == 2 * 32 * S5NC / 4);
    const bf16x8 zf = {0, 0, 0, 0, 0, 0, 0, 0};
    int gcur = -1; float ar = 0.f, ai = 0.f, Dg = 0.f; bf16x8 bb[8], cf[4];
#pragma unroll
    for (int pf = 0; pf < 8; ++pf) bb[pf] = zf;
#pragma unroll
    for (int ks = 0; ks < 4; ++ks) cf[ks] = zf;
    for (int it = 0;; ++it) {
        int wt; if (reg) { if (it >= 4) break; wt = (gw >> 5) * S5NC + (gw & 31) + 32 * it; } else { wt = gw + it * NGW; if (wt >= 2 * 32 * S5NC) break; }
        const int cch = wt & (S5NC - 1), bg = wt >> 7, g = bg & 31, b = bg >> 5, row0 = b * SEQ + cch * S5T, pi = (e * 32 + g) * 64 + c.lane;
        bf16x8 ua[4];
#pragma unroll
        for (int tf = 0; tf < 4; ++tf) ua[tf] = (q4 < 2) ? *(const bf16x8*)(PROJ + (size_t)(row0 + 16 * tf + r16) * PROJW + 1792 + g * 16 + 8 * q4) : zf;
        if (g != gcur) { gcur = g;
            const bf16* BBH = (const bf16*)(P + S5P_BBH);
#pragma unroll
            for (int pf = 0; pf < 8; ++pf) bb[pf] = (q4 < 2) ? *(const bf16x8*)(BBH + ((size_t)(e * 32 + g) * 128 + 16 * pf + r16) * 16 + 8 * q4) : zf;
            ar = P[S5P_A + 2 * pi]; ai = P[S5P_A + 2 * pi + 1];
            const size_t gi = ((size_t)(e * 32 + g) * 16 + r16) * 64 + 8 * q4;
#pragma unroll
            for (int ks = 0; ks < 4; ++ks) { const float* src = (ks < 2 ? C_re : C_im) + gi + 32 * (ks & 1); const float sg = ks < 2 ? 1.0f : -1.0f;
                const f32x4 x0 = *(const f32x4*)src, x1 = *(const f32x4*)(src + 4); cf[ks] = pack8(x0 * sg, x1 * sg); }
            Dg = Dp[(e * 32 + g) * 16 + r16]; }
        const f32x2 x0 = *(const f32x2*)(S5E + 2 * ((size_t)wt * 64 + c.lane));
        float xr = x0.x, xi = x0.y;
#pragma unroll
        for (int sc = 0; sc < 4; ++sc) {
            s5_bu16(ua[sc], bb, BUs, r16, q4);
            LDS_WAIT();
#pragma unroll
            for (int tt = 0; tt < 16; ++tt) { const float bur = BUs[tt * 128 + c.lane], bui = BUs[tt * 128 + 64 + c.lane]; const float nxr = ar * xr - ai * xi + bur, nxi = ar * xi + ai * xr + bui; xr = nxr; xi = nxi;
                *(LAS bf16*)(XB + tt * 272 + c.lane * 2) = (bf16)f2bf(xr); *(LAS bf16*)(XB + tt * 272 + 128 + c.lane * 2) = (bf16)f2bf(xi); }
            LDS_WAIT();
            f32x4 y = {0.f, 0.f, 0.f, 0.f};
#pragma unroll
            for (int ks = 0; ks < 4; ++ks) y = mfma16(*(const LAS bf16x8*)(XB + r16 * 272 + (32 * ks + 8 * q4) * 2), cf[ks], y);
#pragma unroll
            for (int i = 0; i < 4; ++i) { const int t = sc * 16 + 4 * q4 + i; const float yy = y[i] + Dg * bf2f(PROJ[(size_t)(row0 + t) * PROJW + 1792 + g * 16 + r16]);
                const float z = 0.7978845608f * (yy + 0.044715f * yy * yy * yy); const float th = 1.0f - 2.0f * __builtin_amdgcn_rcpf(__expf(2.0f * z) + 1.0f);
                Y[(size_t)(row0 + t) * 512 + g * 16 + r16] = (bf16)f2bf(0.5f * yy * (1.0f + th)); }
            LDS_WAIT();
        }
    }
}

constexpr int XA_KSLOT = 256 * 144, XA_VSLOT = 64 * 528, XA_VOFF = 2 * XA_KSLOT;
DI void xattn_unit(const Ctx& c, int uidx, int layer, const bf16* XQ, const bf16* MK, const bf16* MVT, bf16* XO) {
    const int h = uidx & 3, tile = uidx >> 2, b = tile >> 5, row0 = tile * 256;
    LAS unsigned char* KS = c.lds; LAS unsigned char* VS = c.lds + XA_VOFF;
    const int r16 = c.lane & 15, q4 = c.lane >> 4, w = c.wave;
    const bf16* kg = MK + (size_t)(b * 256) * 4096 + layer * 1024 + h * 256;
    const bf16* vg = MVT + (size_t)(layer * 1024 + h * 256) * 512 + b * 256;
    v4u st[4];
#define XA_LOADK(dc_) do { _Pragma("unroll") for (int i = 0; i < 4; ++i) { const int idx = c.tid + 512 * i; st[i] = *(const v4u*)(kg + (size_t)(idx >> 3) * 4096 + (dc_) * 64 + (idx & 7) * 8); } } while (0)
#define XA_STOREK(slot_) do { _Pragma("unroll") for (int i = 0; i < 4; ++i) { const int idx = c.tid + 512 * i; *(LAS v4u*)(KS + (slot_) * XA_KSLOT + (idx >> 3) * 144 + (idx & 7) * 16) = st[i]; } } while (0)
#define XA_LOADV(dc_) do { _Pragma("unroll") for (int i = 0; i < 4; ++i) { const int idx = c.tid + 512 * i; st[i] = *(const v4u*)(vg + (size_t)((dc_) * 64 + (idx >> 5)) * 512 + (idx & 31) * 8); } } while (0)
#define XA_STOREV(slot_) do { _Pragma("unroll") for (int i = 0; i < 4; ++i) { const int idx = c.tid + 512 * i; *(LAS v4u*)(VS + (slot_) * XA_VSLOT + (idx >> 5) * 528 + (idx & 31) * 16) = st[i]; } } while (0)
    __syncthreads();
    XA_LOADK(0); XA_STOREK(0);
    __syncthreads();
    f32x4 sa[16][2];
#pragma unroll
    for (int mf = 0; mf < 16; ++mf) { sa[mf][0] = (f32x4){0.f, 0.f, 0.f, 0.f}; sa[mf][1] = sa[mf][0]; }
    const bf16* qg = XQ + (size_t)(row0 + 32 * w + r16) * 1024 + h * 256 + 8 * q4;
#pragma unroll 1
    for (int dc = 0; dc < 4; ++dc) {
        bf16x8 qf[2][2];
#pragma unroll
        for (int tf = 0; tf < 2; ++tf)
#pragma unroll
            for (int ks = 0; ks < 2; ++ks) qf[tf][ks] = *(const bf16x8*)(qg + (size_t)(16 * tf) * 1024 + dc * 64 + ks * 32);
        if (dc < 3) XA_LOADK(dc + 1); else XA_LOADV(0);
        const LAS unsigned char* kc = KS + (dc & 1) * XA_KSLOT + r16 * 144 + 16 * q4;
#pragma unroll
        for (int mf = 0; mf < 16; ++mf)
#pragma unroll
            for (int ks = 0; ks < 2; ++ks) { const bf16x8 a = *(const LAS bf16x8*)(kc + mf * (16 * 144) + ks * 64);
                sa[mf][0] = mfma16(a, qf[0][ks], sa[mf][0]); sa[mf][1] = mfma16(a, qf[1][ks], sa[mf][1]); }
        if (dc < 3) XA_STOREK((dc + 1) & 1); else XA_STOREV(0);
        __syncthreads();
    }
    bf16x8 pp[8][2];
#pragma unroll
    for (int tf = 0; tf < 2; ++tf) {
        float m = sa[0][tf][0];
#pragma unroll
        for (int mf = 0; mf < 16; ++mf)
#pragma unroll
            for (int i = 0; i < 4; ++i) m = fmaxf(m, sa[mf][tf][i]);
        m = fmaxf(m, __shfl_xor(m, 16)); m = fmaxf(m, __shfl_xor(m, 32));
        float l = 0.f;
#pragma unroll
        for (int mf = 0; mf < 16; ++mf)
#pragma unroll
            for (int i = 0; i < 4; ++i) { const float p = __expf(sa[mf][tf][i] - m); sa[mf][tf][i] = p; l += p; }
        l += __shfl_xor(l, 16); l += __shfl_xor(l, 32);
        const float inv = 1.0f / l;
#pragma unroll
        for (int kk = 0; kk < 8; ++kk) pp[kk][tf] = pack8(sa[2 * kk][tf] * inv, sa[2 * kk + 1][tf] * inv);
    }
    bf16* og = XO + (size_t)(row0 + 32 * w + r16) * 1024 + h * 256 + 4 * q4;
#pragma unroll 1
    for (int dc = 0; dc < 4; ++dc) {
        if (dc < 3) XA_LOADV(dc + 1);
        f32x4 o[4][2];
#pragma unroll
        for (int df = 0; df < 4; ++df) { o[df][0] = (f32x4){0.f, 0.f, 0.f, 0.f}; o[df][1] = o[df][0]; }
        const LAS unsigned char* vc = VS + (dc & 1) * XA_VSLOT + r16 * 528 + 8 * q4;
#pragma unroll
        for (int kk = 0; kk < 8; ++kk)
#pragma unroll
            for (int df = 0; df < 4; ++df) { const v2u lo = *(const LAS v2u*)(vc + df * (16 * 528) + kk * 64), hi = *(const LAS v2u*)(vc + df * (16 * 528) + kk * 64 + 32);
                v4u aw; aw.x = lo.x; aw.y = lo.y; aw.z = hi.x; aw.w = hi.y; const bf16x8 a = __builtin_bit_cast(bf16x8, aw);
                o[df][0] = mfma16(a, pp[kk][0], o[df][0]); o[df][1] = mfma16(a, pp[kk][1], o[df][1]); }
#pragma unroll
        for (int tf = 0; tf < 2; ++tf)
#pragma unroll
            for (int df = 0; df < 4; ++df) { v2u ow; ow.x = pk2(o[df][tf][0], o[df][tf][1]); ow.y = pk2(o[df][tf][2], o[df][tf][3]); *(v2u*)(og + (size_t)(16 * tf) * 1024 + dc * 64 + 16 * df) = ow; }
        if (dc < 3) { XA_STOREV((dc + 1) & 1); __syncthreads(); }
    }
#undef XA_LOADK
#undef XA_STOREK
#undef XA_LOADV
#undef XA_STOREV
}

DI void rope_row(bf16* prow, const float* cA, const float* sA, const float* cI, const float* sI, int lane) {
    int c1[15], hf[15]; float x1[15], x2[15], cs[15], sn[15], sc[15];
#pragma unroll
    for (int k = 0; k < 15; ++k) {
        const int pi = lane + 64 * k; int i; bool tabA; sc[k] = 1.0f;
        if (pi < 512) { i = pi & 63; c1[k] = (pi >> 6) * 128 + i; hf[k] = 64; tabA = true; sc[k] = 0.08838834764831845f; }
        else if (pi < 640) { const int pp = pi - 512; i = pp & 63; c1[k] = 1024 + (pp >> 6) * 128 + i; hf[k] = 64; tabA = true; }
        else if (pi < 896) { const int pp = pi - 640; i = pp & 31; c1[k] = 1536 + (pp >> 5) * 64 + i; hf[k] = 32; tabA = false; }
        else { i = (pi - 896) & 31; c1[k] = 2048 + i; hf[k] = 32; tabA = false; }
        cs[k] = tabA ? cA[i] : cI[i]; sn[k] = tabA ? sA[i] : sI[i];
        x1[k] = bf2f(prow[c1[k]]); x2[k] = bf2f(prow[c1[k] + hf[k]]);
    }
#pragma unroll
    for (int k = 0; k < 15; ++k) { if (lane + 64 * k < 928) { prow[c1[k]] = (bf16)f2bf((x1[k] * cs[k] - x2[k] * sn[k]) * sc[k]); prow[c1[k] + hf[k]] = (bf16)f2bf((x2[k] * cs[k] + x1[k] * sn[k]) * sc[k]); } }
}
DI unsigned wave_select(LAS unsigned* buf, int count, int lane) {
    unsigned k[16];
#pragma unroll
    for (int j = 0; j < 16; ++j) { const int idx = j * 64 + lane; k[j] = idx < count ? buf[idx] : 0u; }
    unsigned tau = 0u;
    for (int bit = 31; bit >= 0; --bit) { const unsigned cand = tau | (1u << bit); int cn = 0;
#pragma unroll
        for (int j = 0; j < 16; ++j) cn += __popcll(__ballot(k[j] >= cand));
        if (cn >= TOPK) tau = cand;
        if (cn == TOPK) break; }
    int off = 0; const unsigned long long lt = (1ull << lane) - 1ull;
#pragma unroll
    for (int j = 0; j < 16; ++j) { const bool pred = k[j] >= tau; const unsigned long long bal = __ballot(pred); if (pred) buf[off + __popcll(bal & lt)] = k[j]; off += __popcll(bal); }
    LDS_WAIT();
    return tau;
}
constexpr int IDX_KT = 131072, IDX_KT_SLOT = 64 * 144, IDX_FL = IDX_KT + 2 * IDX_KT_SLOT;
#define IDX_BODY(slot_, kb_) do { \
    bf16x8 R[4][2]; \
    _Pragma("unroll") for (int jb = 0; jb < 4; ++jb) _Pragma("unroll") for (int ks = 0; ks < 2; ++ks) R[jb][ks] = *(const LAS bf16x8*)((slot_) + (16 * jb + r16) * 144 + (ks * 32 + 8 * q4) * 2); \
    f32x4 lo_[4], hi_[4]; \
    _Pragma("unroll") for (int jb = 0; jb < 4; ++jb) { lo_[jb] = (f32x4){0.f, 0.f, 0.f, 0.f}; hi_[jb] = lo_[jb]; \
        _Pragma("unroll") for (int ks = 0; ks < 2; ++ks) { lo_[jb] = mfma16(Alo[ks], R[jb][ks], lo_[jb]); hi_[jb] = mfma16(Ahi[ks], R[jb][ks], hi_[jb]); } } \
    const int rev0_ = 8191 - r16 - 16 * (kb_); \
    _Pragma("unroll") for (int jb = 0; jb < 4; ++jb) { \
        float s0_ = 0.f, s1_ = 0.f; \
        _Pragma("unroll") for (int i = 0; i < 4; ++i) { s0_ = fmaf(__int_as_float(max(__float_as_int(lo_[jb][i]), 0)), w[i], s0_); s1_ = fmaf(__int_as_float(max(__float_as_int(hi_[jb][i]), 0)), w[4 + i], s1_); } \
        const unsigned u_ = __float_as_uint(s0_ + s1_), mono_ = u_ ^ ((unsigned)((int)u_ >> 31) | 0x80000000u); \
        const int rev_ = rev0_ - 16 * jb; const unsigned key_ = (mono_ & 0xFFFFE000u) | (unsigned)rev_; \
        const bool pred_ = (rev_ >= revq) && (key_ > tau); \
        const unsigned long long bal_ = __ballot(pred_); const unsigned grp_ = (unsigned)(bal_ >> (16 * q4)) & 0xFFFFu; \
        if (MODE == 0) { if (pred_) mybuf[cnt + __popc(grp_ & lmask)] = key_; cnt += __popc(grp_); } else { chk ^= key_ & (pred_ ? 0xffffffffu : 0x0fu); } } } while (0)
template <int MODE> DI void dsa_index_unit(const Ctx& c, int uidx, const bf16* PROJ, unsigned short* SEL, int* SELN) {
    const int pr = uidx & 255, b = pr >> 7, jj = pr & 127, qblk = uidx < 256 ? jj : 255 - jj, t0 = qblk * 32;
    LAS unsigned* CAND = (LAS unsigned*)c.lds;
    LAS unsigned char* KT = c.lds + IDX_KT; LAS unsigned* FL = (LAS unsigned*)(c.lds + IDX_FL);
    const int r16 = c.lane & 15, q4 = c.lane >> 4;
    const bf16* qrowA = PROJ + (size_t)(b * SEQ + t0 + 4 * c.wave + (r16 >> 2)) * PROJW + 1536 + 8 * q4;
    bf16x8 Alo[2], Ahi[2];
#pragma unroll
    for (int ks = 0; ks < 2; ++ks) { Alo[ks] = *(const bf16x8*)(qrowA + (r16 & 3) * 64 + ks * 32); Ahi[ks] = *(const bf16x8*)(qrowA + ((r16 & 3) + 4) * 64 + ks * 32); }
    const int tq = t0 + 4 * c.wave + q4, revq = 8191 - tq; const unsigned lmask = (1u << r16) - 1u;
    float w[8]; unpack8(*(const v4u*)(PROJ + (size_t)(b * SEQ + tq) * PROJW + 2112), w);
#pragma unroll
    for (int j = 0; j < 8; ++j) w[j] *= 0.04419417382415922f;
    int cnt = 0; unsigned tau = 0u, chk = 0u;
    LAS unsigned* mybuf = CAND + (4 * c.wave + q4) * 1024;
    const int nit = (qblk >> 1) + 1;
    const bf16* ksrc = PROJ + (size_t)(b * SEQ + (c.tid >> 3)) * PROJW + 2048 + 8 * (c.tid & 7); const int kdst = (c.tid >> 3) * 144 + (c.tid & 7) * 16;
    __syncthreads();
    v4u pre = *(const v4u*)ksrc;
    *(LAS v4u*)(KT + kdst) = pre;
    if (nit > 1) pre = *(const v4u*)(ksrc + (size_t)64 * PROJW);
    for (int it = 0; it < nit; ++it) {
        LAS unsigned char* slot = KT + (it & 1) * IDX_KT_SLOT;
        { const unsigned long long nb = __ballot(cnt > 1024 - 64); if (c.lane == 0) FL[(it & 1) * 8 + c.wave] = nb != 0ull ? 1u : 0u; }
        __syncthreads();
        { const v4u f0 = *(const LAS v4u*)(FL + (it & 1) * 8), f1 = *(const LAS v4u*)(FL + (it & 1) * 8 + 4);
          if (MODE == 0 && (f0.x | f0.y | f0.z | f0.w | f1.x | f1.y | f1.z | f1.w)) {
#pragma unroll
              for (int g4 = 0; g4 < 4; ++g4) { const int cg = __shfl(cnt, 16 * g4); if (cg > TOPK) { const unsigned tn = wave_select(CAND + (4 * c.wave + g4) * 1024, cg, c.lane); if (q4 == g4) { tau = tn; cnt = TOPK; } } } } }
        IDX_BODY(slot, 4 * it);
        if (it + 1 < nit) { *(LAS v4u*)(KT + ((it + 1) & 1) * IDX_KT_SLOT + kdst) = pre; if (it + 2 < nit) pre = *(const v4u*)(ksrc + (size_t)(64 * (it + 2)) * PROJW); }
    }
    LDS_WAIT();
    if (MODE != 0) { if (chk == 0x12345u) SELN[uidx] = (int)chk; return; }
#pragma unroll
    for (int g4 = 0; g4 < 4; ++g4) {
        int cg = __shfl(cnt, 16 * g4); LAS unsigned* bufg = CAND + (4 * c.wave + g4) * 1024;
        if (cg > TOPK) { (void)wave_select(bufg, cg, c.lane); cg = TOPK; }
        const size_t qg = (size_t)(b * SEQ + t0 + 4 * c.wave + g4);
#pragma unroll
        for (int i = 0; i < 4; ++i) { const int slot = c.lane + 64 * i; if (slot < cg) SEL[qg * 256 + slot] = (unsigned short)(8191u - (bufg[slot] & 0x1FFFu)); }
        if (c.lane == 0) SELN[qg] = cg;
    }
    LDS_WAIT();
}
#define SB() __builtin_amdgcn_sched_barrier(0)
DI f32x4 mfma8(const v2u a, const v2u b, const f32x4 c) { return __builtin_amdgcn_mfma_f32_16x16x32_fp8_fp8(__builtin_bit_cast(long, a), __builtin_bit_cast(long, b), c, 0, 0, 0); }
#define DSA_QS 32.0f
#define DSA_RDW(pb_, tv_) asm volatile("s_waitcnt lgkmcnt(0)" : "+v"(pb_), "+v"(tv_[0]), "+v"(tv_[1]), "+v"(tv_[2]), "+v"(tv_[3]), "+v"(tv_[4]), "+v"(tv_[5]), "+v"(tv_[6]), "+v"(tv_[7]) : : "memory")
#define DSA_VWAIT(n) asm volatile("s_waitcnt vmcnt(" #n ")" ::: "memory")
#define DSA3_WS 17152
#define DSA3_KLD(dst_, off_, imm_, kb_) asm volatile("global_load_dwordx4 %0, %1, %2 offset:" #imm_ : "=&v"(dst_) : "v"(off_), "s"(kb_) : "memory")
#define DSA3_LOADK(dst, blk) do { const unsigned koff_ = kix[blk] * 128u + kofs; DSA3_KLD(dst[0][0], koff_, 0, k8g0); DSA3_KLD(dst[0][1], koff_, 64, k8g0); DSA3_KLD(dst[1][0], koff_, 0, k8g1); DSA3_KLD(dst[1][1], koff_, 64, k8g1); } while (0)
#define DSA3_KWAIT(n, dst) asm volatile("s_waitcnt vmcnt(" #n ")" : "+v"(dst[0][0]), "+v"(dst[0][1]), "+v"(dst[1][0]), "+v"(dst[1][1]) : : "memory")
#define DSA3_KPERM(dst) do { _Pragma("unroll") for (int kvi = 0; kvi < 2; ++kvi) _Pragma("unroll") for (int hf = 0; hf < 2; ++hf) { v4u w_ = dst[kvi][hf]; \
    w_.x = (unsigned)__builtin_amdgcn_ds_bpermute(kperm, (int)w_.x); w_.y = (unsigned)__builtin_amdgcn_ds_bpermute(kperm, (int)w_.y); w_.z = (unsigned)__builtin_amdgcn_ds_bpermute(kperm, (int)w_.z); w_.w = (unsigned)__builtin_amdgcn_ds_bpermute(kperm, (int)w_.w); \
    dst[kvi][hf] = w_; } } while (0)
#define DSA3_QK(blk, src) do { f32x4 a0_ = {0.f, 0.f, 0.f, 0.f}, a1_ = {0.f, 0.f, 0.f, 0.f}; \
    _Pragma("unroll") for (int ks = 0; ks < 4; ++ks) { const v4u w0_ = src[0][ks >> 1], w1_ = src[1][ks >> 1]; v2u p0_, p1_; p0_.x = (ks & 1) ? w0_.z : w0_.x; p0_.y = (ks & 1) ? w0_.w : w0_.y; p1_.x = (ks & 1) ? w1_.z : w1_.x; p1_.y = (ks & 1) ? w1_.w : w1_.y; \
        a0_ = mfma8(p0_, q2[0][ks], a0_); a1_ = mfma8(p1_, q2[1][ks], a1_); } acc[blk] = a0_ + a1_; } while (0)
#define DSA3_DMAV(u_) do { _Pragma("unroll") for (int j = 0; j < 4; ++j) \
    __builtin_amdgcn_global_load_lds((const unsigned*)((((u_) & 1) ? v8b1 : v8b0) + vix[(u_) >> 1][j] * 128u + ((j & 1) ? vsw1 : vsw0)), (LAS unsigned*)(Vb + ((u_) % 3) * 4096 + j * 1024), 16, 0, 0); } while (0)
#define DSA3_RD(pb_, tv_, soff_, poff_) asm volatile( \
    "ds_read_b64 %0, %9 offset:%19\n\tds_read_b64_tr_b8 %1, %10 offset:%18\n\tds_read_b64_tr_b8 %2, %11 offset:%18\n\tds_read_b64_tr_b8 %3, %12 offset:%18\n\tds_read_b64_tr_b8 %4, %13 offset:%18\n\t" \
    "ds_read_b64_tr_b8 %5, %14 offset:%18\n\tds_read_b64_tr_b8 %6, %15 offset:%18\n\tds_read_b64_tr_b8 %7, %16 offset:%18\n\tds_read_b64_tr_b8 %8, %17 offset:%18" \
    : "=&v"(pb_), "=&v"(tv_[0]), "=&v"(tv_[1]), "=&v"(tv_[2]), "=&v"(tv_[3]), "=&v"(tv_[4]), "=&v"(tv_[5]), "=&v"(tv_[6]), "=&v"(tv_[7]) \
    : "v"(prdA), "v"(va[0]), "v"(va[1]), "v"(va[2]), "v"(va[3]), "v"(va[4]), "v"(va[5]), "v"(va[6]), "v"(va[7]), "i"(soff_), "i"(poff_) : "memory")
#define DSA3_PV(u_) do { v2u pA_, tA_[8]; DSA3_RD(pA_, tA_, ((u_) % 3) * 4096, 32 * ((u_) >> 1)); DSA_RDW(pA_, tA_); \
    v2u pm_; pm_.x = (((u_) & 1) == mykv) ? pA_.x : 0u; pm_.y = (((u_) & 1) == mykv) ? pA_.y : 0u; \
    _Pragma("unroll") for (int nt = 0; nt < 8; ++nt) o[nt] = mfma8(tA_[nt], pm_, o[nt]); } while (0)
template <int MODE> DI void dsa_attn_item(const Ctx& c, int qg, const bf16* PROJ, const unsigned char* K8, const unsigned char* V8, const unsigned short* SEL, const int* SELN, bf16* AO) {
    typedef const __attribute__((address_space(1))) char* gcp;
    LAS unsigned char* Vb = c.lds + c.wave * DSA3_WS; LAS unsigned char* Pb = Vb + 12288; LAS unsigned short* IDXw = (LAS unsigned short*)(Vb + 12288 + 4352);
    int ln = c.lane; asm volatile("" : "+v"(ln));
    const int b = qg >> 13, n = __builtin_amdgcn_readfirstlane(SELN[qg]); const int r16 = ln & 15, q4 = ln >> 4;
    { unsigned short sv[4];
#pragma unroll
      for (int i = 0; i < 4; ++i) sv[i] = SEL[(size_t)qg * 256 + ln + 64 * i];
#pragma unroll
      for (int i = 0; i < 4; ++i) { const int slot = ln + 64 * i; IDXw[slot] = slot < n ? sv[i] : (unsigned short)0; } }
    v2u q2[2][4];
#pragma unroll
    for (int ks = 0; ks < 4; ++ks) { const v4u w = *(const v4u*)(PROJ + (size_t)qg * PROJW + (r16 & 7) * 128 + 64 * (ks >> 1) + 16 * q4 + 8 * (ks & 1));
        v2u v_; v_.x = (r16 & 8) ? w.z : w.x; v_.y = (r16 & 8) ? w.w : w.y; const bool k0_ = (r16 & 4) == 0;
        q2[0][ks].x = k0_ ? v_.x : 0u; q2[0][ks].y = k0_ ? v_.y : 0u; q2[1][ks].x = k0_ ? 0u : v_.x; q2[1][ks].y = k0_ ? 0u : v_.y; }
    LDS_WAIT();
    unsigned kix[16], vix[8][4];
#pragma unroll
    for (int blk = 0; blk < 16; ++blk) kix[blk] = IDXw[16 * blk + (ln >> 2)];
#pragma unroll
    for (int cc = 0; cc < 8; ++cc)
#pragma unroll
        for (int j = 0; j < 4; ++j) vix[cc][j] = IDXw[32 * cc + 8 * j + (ln >> 3)];
    LDS_WAIT(); SB();
    const size_t pl0 = (size_t)(b * 2) * SEQ * 128, pl1 = pl0 + (size_t)SEQ * 128;
    const gcp k8g0 = (gcp)((const char*)K8 + pl0), k8g1 = (gcp)((const char*)K8 + pl1); const char* v8b0 = (const char*)V8 + pl0; const char* v8b1 = (const char*)V8 + pl1;
    const unsigned kofs = (unsigned)(16 * (ln & 3)); const int kperm = 4 * (4 * r16 + q4);
    const unsigned vsw0 = 16u * (unsigned)((ln & 7) ^ (ln >> 4)), vsw1 = 16u * (unsigned)((ln & 7) ^ ((ln >> 4) | 4));
    DSA3_DMAV(0); SB(); DSA3_DMAV(1); SB(); DSA3_DMAV(2); SB();
    f32x4 acc[16]; v4u kA[2][2], kB[2][2], kC[2][2];
    DSA3_LOADK(kA, 0); DSA3_LOADK(kB, 1); DSA3_LOADK(kC, 2); SB();
#define DSA3_STEP(blk, kk, w_) do { DSA3_KWAIT(w_, kk); SB(); DSA3_KPERM(kk); DSA3_QK(blk, kk); SB(); if ((blk) + 3 < 16) { DSA3_LOADK(kk, (blk) + 3); SB(); } } while (0)
    DSA3_STEP(0, kA, 8); DSA3_STEP(1, kB, 8); DSA3_STEP(2, kC, 8); DSA3_STEP(3, kA, 8); DSA3_STEP(4, kB, 8); DSA3_STEP(5, kC, 8); DSA3_STEP(6, kA, 8); DSA3_STEP(7, kB, 8);
    DSA3_STEP(8, kC, 8); DSA3_STEP(9, kA, 8); DSA3_STEP(10, kB, 8); DSA3_STEP(11, kC, 8); DSA3_STEP(12, kA, 8); DSA3_STEP(13, kB, 8); DSA3_STEP(14, kC, 4); DSA3_STEP(15, kA, 0);
    float m = -3.0e38f; const int nq = n - 4 * q4; const float cexp = 1.4426950408889634f / DSA_QS;
#pragma unroll
    for (int kb = 0; kb < 16; ++kb)
#pragma unroll
        for (int i = 0; i < 4; ++i) { const bool ok = (16 * kb + i) < nq; const float s_ = acc[kb][i] + __int_as_float(__builtin_amdgcn_update_dpp(0, __float_as_int(acc[kb][i]), 0x128, 0xf, 0xf, false));
            acc[kb][i] = ok ? s_ : -3.0e38f; m = fmaxf(m, acc[kb][i]); }
    m = fmaxf(m, __shfl_xor(m, 16)); m = fmaxf(m, __shfl_xor(m, 32));
    float l = 0.f; const float mc = 8.0f - m * cexp;
#pragma unroll
    for (int kb = 0; kb < 16; ++kb)
#pragma unroll
        for (int i = 0; i < 4; ++i) { const float p = __builtin_amdgcn_exp2f(fmaf(acc[kb][i], cexp, mc)); acc[kb][i] = p; l += p; }
    l += __shfl_xor(l, 16); l += __shfl_xor(l, 32);
    const float oscale = 1.0f / l;
    if (r16 < 8) {
        LAS unsigned char* pwl = Pb + 272 * r16 + 4 * q4; asm volatile("" : "+v"(pwl));
#pragma unroll
        for (int kb = 0; kb < 16; ++kb) {
            const float p0 = acc[kb][0], p1 = acc[kb][1], p2 = acc[kb][2], p3 = acc[kb][3];
            int wh = 0; wh = __builtin_amdgcn_cvt_pk_fp8_f32(p0, p1, wh, false); wh = __builtin_amdgcn_cvt_pk_fp8_f32(p2, p3, wh, true);
            const f32x2 d0 = __builtin_amdgcn_cvt_pk_f32_fp8(wh, false), d1 = __builtin_amdgcn_cvt_pk_f32_fp8(wh, true);
            int wl = 0; wl = __builtin_amdgcn_cvt_pk_fp8_f32(p0 - d0.x, p1 - d0.y, wl, false); wl = __builtin_amdgcn_cvt_pk_fp8_f32(p2 - d1.x, p3 - d1.y, wl, true);
            *(LAS int*)(pwl + 16 * kb) = wh; *(LAS int*)(pwl + 2176 + 16 * kb) = wl; }
    }
    unsigned va[8];
    { const unsigned q_ = (unsigned)(r16 >> 1), rel = 128u * (8u * (unsigned)q4 + q_) + 8u * (unsigned)(ln & 1) + 16u * ((((unsigned)q4 & 1u) << 2) | (q_ >> 1)); const unsigned vb_ = (unsigned)(size_t)Vb;
#pragma unroll
      for (int nt = 0; nt < 8; ++nt) va[nt] = vb_ + (rel ^ (16u * (unsigned)nt)); }
    const unsigned prdA = (unsigned)(size_t)(Pb + 2176 * (r16 >> 3) + 272 * (r16 & 7) + 8 * q4); const int mykv = (r16 >> 2) & 1;
    f32x4 o[8];
#pragma unroll
    for (int nt = 0; nt < 8; ++nt) o[nt] = (f32x4){0.f, 0.f, 0.f, 0.f};
    LDS_WAIT(); SB();
#pragma unroll
    for (int u = 0; u < 16; ++u) {
        if (u < 14) DSA_VWAIT(8); else if (u == 14) DSA_VWAIT(4); else DSA_VWAIT(0);
        SB(); DSA3_PV(u); SB();
        if (u + 3 < 16) { LDS_WAIT(); SB(); DSA3_DMAV(u + 3); SB(); }
    }
#pragma unroll
    for (int nt = 0; nt < 8; ++nt)
#pragma unroll
        for (int i = 0; i < 4; ++i) o[nt][i] += __int_as_float(__builtin_amdgcn_update_dpp(0, __float_as_int(o[nt][i]), 0x128, 0xf, 0xf, false));
    if (r16 < 8) {
        bf16* op = AO + (size_t)qg * 1024 + r16 * 128 + 4 * q4;
#pragma unroll
        for (int nt = 0; nt < 8; ++nt) { v2u w; w.x = pk2(o[nt][0] * oscale, o[nt][1] * oscale); w.y = pk2(o[nt][2] * oscale, o[nt][3] * oscale); *(v2u*)(op + 16 * nt) = w; }
    }
    LDS_WAIT();
}
template <int MODE> DI void dsa_attn_phase(const Ctx& c, const bf16* PROJ, const unsigned char* K8, const unsigned char* V8, const unsigned short* SEL, const int* SELN, bf16* AO) {
    for (int x = c.vcu * 8 + c.wave; x < MTOK; x += c.G * 8) dsa_attn_item<MODE>(c, x, PROJ, K8, V8, SEL, SELN, AO);
}

#ifndef SKIPM
#define SKIPM 0
#endif
#ifndef PROBE_IDX_MODE
#define PROBE_IDX_MODE 0
#endif
#ifndef PROBE_ATTN_MODE
#define PROBE_ATTN_MODE 0
#endif
#ifndef PROBE_MASK
#define PROBE_MASK 0u
#endif
struct Args { const float* in[36]; float* out; unsigned char* ws; int ph_lo, ph_hi, li, pad; };
enum { I_X = 0, I_MEM, I_POS, I_F1N, I_F1G, I_F1U, I_F1D, I_MIXN, I_EVIN, I_EVOUT, I_GLAWA, I_GLABA, I_GLAN, I_S5LR, I_S5LI, I_S5DT, I_S5BR, I_S5BI, I_S5CR, I_S5CI, I_S5D, I_S5WG, I_S5BG,
       I_ODIN, I_ODOUT, I_XAN, I_MEMNORM, I_XAWQ, I_XAWK, I_XAWV, I_XAWO, I_F2N, I_F2G, I_F2U, I_F2D, I_FINN };

#define GEMM_CALL(EPI, A_, Bt_, M_, N_, K_, E_) do { const pg8::Gemm g_{(const pg8::bf16_t*)(A_), (const pg8::bf16_t*)(Bt_), (M_), (N_), (K_)}; typedef pg8::TileOrder<(M_) / 256, (N_) / 256> Ord_; Ord_ S_; S_.G = c.G; S_.c = (int)blockIdx.x; \
    pg8::gemm_phase<EPI, Ord_, true, true>(c.lds, g_, S_, (E_), MYTID()); } while (0)

#define RSL_PTR() ((const PG8_LAS float*)(c.lds + RING_BYTES))
#define GEMM_CALL_RS(EPI, A_, Bt_, M_, N_, K_, E_) do { const pg8::Gemm g_{(const pg8::bf16_t*)(A_), (const pg8::bf16_t*)(Bt_), (M_), (N_), (K_)}; typedef pg8::TileOrder<(M_) / 256, (N_) / 256> Ord_; Ord_ S_; S_.G = c.G; S_.c = (int)blockIdx.x; \
    { const int t_ = MYTID(); LAS float* rsl_ = (LAS float*)(c.lds + RING_BYTES); \
      for (int i0_ = 0; ; i0_ += 2) { pg8::Unit u0_; if (!S_.next(i0_, u0_)) break; pg8::Unit u_; const int i_ = i0_ + (t_ >> 8); \
          if (S_.next(i_, u_)) { const f32x4* sp_ = (const f32x4*)(SS + (size_t)(u_.pm * 256 + (t_ & 255)) * 16); const f32x4 a0_ = sp_[0], a1_ = sp_[1], a2_ = sp_[2], a3_ = sp_[3]; \
              const f32x4 q_ = (a0_ + a1_) + (a2_ + a3_); rsl_[i_ * 256 + (t_ & 255)] = rsqrtf(((q_[0] + q_[1]) + (q_[2] + q_[3])) * (1.0f / 1024.0f) + EPS); } } \
      __syncthreads(); } \
    pg8::gemm_phase<EPI, Ord_, true, true>(c.lds, g_, S_, (E_), MYTID()); } while (0)

#define MK_GAS __attribute__((address_space(1)))
DI unsigned char* launder_ptr(unsigned char* p) { MK_GAS unsigned char* g = (MK_GAS unsigned char*)p; asm volatile("" : "+s"(g)); return (unsigned char*)g; }
DI const float* gin_(const float* p) { MK_GAS const float* g = (MK_GAS const float*)p; asm volatile("" : "+s"(g)); return (const float*)g; }
DI float* gout_(float* p) { MK_GAS float* g = (MK_GAS float*)p; asm volatile("" : "+s"(g)); return (float*)g; }
#define AIN(k) gin_(a.in[launder_idx(k)])
DI int launder_idx(int i) { asm volatile("" : "+s"(i)); return i; }
#define DECL_PTRS() float* H = (float*)(ws + WS_H); bf16* HB = (bf16*)(ws + WS_HB); float* SS = (float*)(ws + WS_SS); \
    float* COSA = (float*)(ws + WS_COSA); float* SINA = (float*)(ws + WS_SINA); float* COSI = (float*)(ws + WS_COSI); float* SINI = (float*)(ws + WS_SINI); \
    bf16* MEMN = (bf16*)(ws + WS_MEMN); bf16* MK = (bf16*)(ws + WS_MK); bf16* MVT = (bf16*)(ws + WS_MVT); float* S5P = (float*)(ws + WS_S5P); \
    unsigned char* scr = ws + WS_SCR; \
    bf16* HID = (bf16*)(scr + SC_HID); bf16* PROJ = (bf16*)(scr + SC_PROJ); bf16* XQ = (bf16*)(scr + SC_XQ); bf16* XO = (bf16*)(scr + SC_XO); bf16* KVW = (bf16*)(scr + SC_KVW); \
    float* DS = (float*)(scr + SC_DS); float* BCg = (float*)(scr + SC_BC); float* DEC = (float*)(scr + SC_DEC); float* S5E = (float*)(scr + SC_S5E); \
    bf16* Y = (bf16*)(scr + SC_Y); bf16* CAT = (bf16*)(scr + SC_CAT); unsigned short* SEL = (unsigned short*)(scr + SC_SEL); int* SELN = (int*)(scr + SC_SELN); \
    unsigned char* W = ws + WS_W; \
    bf16* Wgu1 = (bf16*)(W + WO_GU1); bf16* Wd1 = (bf16*)(W + WO_D1); bf16* Win = (bf16*)(W + WO_IN); bf16* Wout = (bf16*)(W + WO_OUT); bf16* Wglu = (bf16*)(W + WO_GLU); \
    bf16* Wxq = (bf16*)(W + WO_XQ); bf16* Wxo = (bf16*)(W + WO_XO); bf16* Wgu2 = (bf16*)(W + WO_GU2); bf16* Wd2 = (bf16*)(W + WO_D2);
#define CVT_LAYER_BODY() do { const size_t fo = (size_t)l * DM * DFF; cvt_job_gu(c, AIN(I_F1G) + fo, AIN(I_F1U) + fo, AIN(I_F1N) + l * DM, Wgu1, 0); cvt_job(c, AIN(I_F1D) + fo, DM, 0, DM, nullptr, Wd1, DFF, DM, 0, 512); if (even) { const float* win = AIN(I_EVIN) + (size_t)e * DM * EV_IN; const float* gn = AIN(I_MIXN) + l * DM; cvt_job(c, win, EV_IN, 0, 1536, gn, Win, DM, 1536, 0, 1024); cvt_job_comb(c, win, AIN(I_GLAWA) + e * 16 * 256, gn, Win, 1536, 1536); cvt_job(c, win, EV_IN, 1552, 512, gn, Win, DM, 512, 1792, 1664); cvt_job(c, AIN(I_EVOUT) + (size_t)e * DM * DM, DM, 0, DM, nullptr, Wout, DM, DM, 0, 256); cvt_job(c, AIN(I_S5WG) + (size_t)e * 512 * 512, 512, 0, 512, nullptr, Wglu, 512, 512, 0, 1920); } else { cvt_job_rope(c, AIN(I_ODIN) + (size_t)e * DM * OD_IN, AIN(I_MIXN) + l * DM, Win, 1024); cvt_job(c, AIN(I_ODOUT) + (size_t)e * DM * DM, DM, 0, DM, nullptr, Wout, DM, DM, 0, 256); } cvt_job(c, AIN(I_XAWQ) + (size_t)l * DM * DM, DM, 0, DM, AIN(I_XAN) + l * DM, Wxq, DM, DM, 0, 768); cvt_job(c, AIN(I_XAWO) + (size_t)l * DM * DM, DM, 0, DM, nullptr, Wxo, DM, DM, 0, 1280); cvt_job_gu(c, AIN(I_F2G) + fo, AIN(I_F2U) + fo, AIN(I_F2N) + l * DM, Wgu2, 1024); cvt_job(c, AIN(I_F2D) + fo, DM, 0, DM, nullptr, Wd2, DFF, DM, 0, 1536); } while (0)
__global__ void __launch_bounds__(512, 2) mk_fwd(Args a) {
    extern __shared__ __attribute__((aligned(16))) unsigned char lds_raw[];
    Ctx c; c.lds = (LAS unsigned char*)lds_raw;
    c.tid = threadIdx.x; c.lane = c.tid & 63; c.wave = __builtin_amdgcn_readfirstlane(c.tid >> 6);
    const unsigned wave_s = (unsigned)c.wave;
    c.G = gridDim.x; { const int bx = blockIdx.x; c.vcu = (c.G % 8 == 0) ? (bx % 8) * (c.G / 8) + bx / 8 : bx; }
    for (int u = c.tid; u < (LDS_BYTES - LDSCTL_OFF) / 4; u += 512) ((LAS unsigned*)(c.lds + LDSCTL_OFF))[u] = 0u;
    __syncthreads();
    unsigned char* ws0 = a.ws;
    const int lo = a.ph_lo, hi = a.ph_hi;
    XcdBarrier bar; bar.bar = (unsigned*)(ws0 + WS_CTL) + CW_BAR + a.li * XCD_BAR_WORDS; bar.x = 0; bar.st = (volatile LAS unsigned*)(c.lds + LDSCTL_OFF);
    if (hi - lo > 1) bar = xcd_barrier_post(bar.bar, (volatile LAS unsigned*)(c.lds + LDSCTL_OFF));
#define IN(k) (launder_idx(lo) <= (k) && (k) < launder_idx(hi))
#define MYTID() ((int)(wave_s * 64u + __builtin_amdgcn_mbcnt_hi(~0u, __builtin_amdgcn_mbcnt_lo(~0u, 0u))))
#define FRESH() do { int t_ = MYTID(); asm volatile("" : "+v"(t_)); c.tid = t_; c.lane = t_ & 63; c.wave = (int)wave_s; } while (0)
#define SEAM(k) do { if (IN(k) && IN((k) + 1)) xcd_barrier(bar); } while (0)
    const int NGW = c.G * 8, gw = c.vcu * 8 + c.wave;

#define PHASE(k, q, ...) do { if (IN(k)) { { const bool dup_ = false; (void)dup_; unsigned char* ws = launder_ptr(a.ws); DECL_PTRS(); __VA_ARGS__ } if ((PROBE_MASK >> (q)) & 1u) { xcd_barrier(bar); { const bool dup_ = true; (void)dup_; unsigned char* ws = launder_ptr(a.ws); DECL_PTRS(); __VA_ARGS__ } } } SEAM(k); } while (0)
    PHASE(0, 30, {
        FRESH();
        const int* pos = (const int*)AIN(I_POS);
        for (int e = c.vcu * 512 + c.tid; e < MTOK * 96; e += c.G * 512) {
            if (e < MTOK * 64) { const int tok = e >> 6, i = e & 63; const float inv = powf(10000.0f, -(float)(2 * i) / 128.0f), ang = (float)pos[tok] * inv; COSA[e] = cosf(ang); SINA[e] = sinf(ang); }
            else { const int e2 = e - MTOK * 64, tok = e2 >> 5, i = e2 & 31; const float inv = powf(10000.0f, -(float)(2 * i) / 64.0f), ang = (float)pos[tok] * inv; COSI[e2] = cosf(ang); SINI[e2] = sinf(ang); }
        }
        for (int m = gw; m < MTOK; m += NGW) row_init(AIN(I_X) + (size_t)m * DM, HB + (size_t)m * DM, SS + (size_t)m * 16, c.lane);
        for (int m = gw; m < NB * NMEM; m += NGW) row_norm_bf16(AIN(I_MEM) + (size_t)m * DM, AIN(I_MEMNORM), MEMN + (size_t)m * DM, c.lane);
        for (int l = 0; l < DEPTH; ++l) {
            cvt_job(c, AIN(I_XAWK) + (size_t)l * DM * DM, DM, 0, DM, nullptr, KVW, DM, DM, l * DM, l * 256);
            cvt_job(c, AIN(I_XAWV) + (size_t)l * DM * DM, DM, 0, DM, nullptr, KVW + (size_t)4096 * DM, DM, DM, l * DM, l * 256 + 128);
        }
        s5_params(c, AIN(I_S5LR), AIN(I_S5LI), AIN(I_S5DT), AIN(I_S5BR), AIN(I_S5BI), S5P);
        { const int l = 0, e = 0; const bool even = true; CVT_LAYER_BODY(); }
    });
#pragma clang loop unroll(full)
    for (int l = 0; l < DEPTH; ++l) {
        const int pb = PH_LAYER0 + l * PH_PER_LAYER, e = l >> 1; const bool even = (l & 1) == 0;
        if (l > 0) PHASE(pb + 0, 0, { FRESH(); CVT_LAYER_BODY(); });
#define MEMKV_TAIL() if (l == 0) { const int bx_ = (int)blockIdx.x - ((MTOK / 256) * (2 * DFF / 256) - 5 * c.G);     \
            { const pg8::Gemm g{(const pg8::bf16_t*)MEMN, (const pg8::bf16_t*)KVW, 512, 4096, 1024}; typedef pg8::TileOrder<2, 16> Ord; Ord S; S.G = c.G; S.c = (c.G == 256) ? bx_ : (int)blockIdx.x; \
              const pg8::EpiScaleBf16<false> E2{(pg8::bf16_t*)MK, 4096, nullptr, 1.0f}; pg8::gemm_phase<pg8::EpiScaleBf16<false>, Ord, true, true>(c.lds, g, S, E2, MYTID()); } \
            { const pg8::Gemm g{(const pg8::bf16_t*)(KVW + (size_t)4096 * DM), (const pg8::bf16_t*)MEMN, 4096, 512, 1024}; typedef pg8::TileOrder<16, 2> Ord; Ord S; S.G = c.G; S.c = ((c.G == 256) ? bx_ : (int)blockIdx.x) - 32; \
              const pg8::EpiScaleBf16<false> E2{(pg8::bf16_t*)MVT, 512, nullptr, 1.0f}; pg8::gemm_phase<pg8::EpiScaleBf16<false>, Ord, true, true>(c.lds, g, S, E2, MYTID()); } }
        PHASE(pb + 1, 1, { const pg8::EpiSwiGLU E{(pg8::bf16_t*)HID, DFF, RSL_PTR()}; GEMM_CALL_RS(pg8::EpiSwiGLU, HB, Wgu1, MTOK, 2 * DFF, DM, E); MEMKV_TAIL(); });
        PHASE(pb + 2, 2, { const pg8::EpiResid E{(pg8::bf16_t*)HB, SS, dup_ ? 0.f : 0.5f}; GEMM_CALL(pg8::EpiResid, HID, Wd1, MTOK, DM, DFF, E); });
        if (even) PHASE(pb + 3, 3, { const pg8::EpiScaleBf16<true> E{(pg8::bf16_t*)PROJ, PROJW, RSL_PTR(), 1.0f}; GEMM_CALL_RS(pg8::EpiScaleBf16<true>, HB, Win, MTOK, PROJW, DM, E); });
        else PHASE(pb + 3, 3, { const pg8::EpiRope E{(pg8::bf16_t*)PROJ, RSL_PTR(), COSA, SINA, COSI, SINI, scr + SC_K8, scr + SC_V8}; GEMM_CALL_RS(pg8::EpiRope, HB, Win, MTOK, PROJW, DM, E); });
        if (even) {
            PHASE(pb + 4, 4, {
                FRESH();
                for (int u = c.vcu; u < 1024; u += c.G) gla1_unit(c, u, PROJ, AIN(I_GLABA) + e * 256, DS, BCg, DEC);
                s5_phase1(c, e, PROJ, S5P, S5E);
            });
            PHASE(pb + 5, 29, { FRESH(); gla2_scan(c, DS, DEC); s5_phase2(c, e, S5P, S5E); });
            PHASE(pb + 6, 6, {
                FRESH();
                for (int u = c.vcu; u < 1024; u += c.G) gla3_unit(c, u, PROJ, BCg, DS, AIN(I_GLAN) + e * 128, CAT);
                s5_phase3(c, e, PROJ, S5P, S5E, AIN(I_S5CR), AIN(I_S5CI), AIN(I_S5D), Y);
            });
            PHASE(pb + 7, 7, { const pg8::EpiGLU E{(const pg8::bf16_t*)Y, AIN(I_S5BG) + e * 512, (pg8::bf16_t*)CAT}; GEMM_CALL(pg8::EpiGLU, Y, Wglu, MTOK, 512, 512, E); });
        } else {
            PHASE(pb + 5, 15, { FRESH(); if (!dup_) { for (int u = c.vcu; u < 512; u += c.G) dsa_index_unit<0>(c, u, PROJ, SEL, SELN); } else { for (int u = c.vcu; u < 512; u += c.G) dsa_index_unit<PROBE_IDX_MODE>(c, u, PROJ, (unsigned short*)(scr + 81 * MiB), (int*)(scr + 90 * MiB)); } });
            PHASE(pb + 6, 16, { FRESH(); if (!dup_) dsa_attn_phase<0>(c, PROJ, scr + SC_K8, scr + SC_V8, SEL, SELN, CAT); else dsa_attn_phase<PROBE_ATTN_MODE>(c, PROJ, scr + SC_K8, scr + SC_V8, SEL, SELN, (bf16*)(scr + 100 * MiB)); });
        }
        PHASE(pb + 8, 8, { const pg8::EpiResid E{(pg8::bf16_t*)HB, SS, dup_ ? 0.f : 1.0f}; GEMM_CALL(pg8::EpiResid, CAT, Wout, MTOK, DM, DM, E); });
        PHASE(pb + 9, 9, { const pg8::EpiScaleBf16<true> E{(pg8::bf16_t*)XQ, DM, RSL_PTR(), 0.0625f}; GEMM_CALL_RS(pg8::EpiScaleBf16<true>, HB, Wxq, MTOK, DM, DM, E); });
        PHASE(pb + 10, 10, { FRESH(); for (int u = c.vcu; u < 256; u += c.G) xattn_unit(c, u, l, XQ, MK, MVT, XO); });
        PHASE(pb + 11, 11, { const pg8::EpiResid E{(pg8::bf16_t*)HB, SS, dup_ ? 0.f : 1.0f}; GEMM_CALL(pg8::EpiResid, XO, Wxo, MTOK, DM, DM, E); });
        PHASE(pb + 12, 12, { const pg8::EpiSwiGLU E{(pg8::bf16_t*)HID, DFF, RSL_PTR()}; GEMM_CALL_RS(pg8::EpiSwiGLU, HB, Wgu2, MTOK, 2 * DFF, DM, E); });
        PHASE(pb + 13, 13, { const pg8::EpiResid E{(pg8::bf16_t*)HB, SS, dup_ ? 0.f : 0.5f}; GEMM_CALL(pg8::EpiResid, HID, Wd2, MTOK, DM, DFF, E); });
    }
    if (IN(PH_FINAL)) { FRESH(); unsigned char* ws = launder_ptr(a.ws); DECL_PTRS(); for (int m = gw; m < MTOK; m += NGW) row_final(HB + (size_t)m * DM, SS + (size_t)m * 16, AIN(I_FINN), gout_(a.out) + (size_t)m * DM, c.lane); }
#undef PHASE
#undef IN
#undef SEAM
}

#ifndef MK_ONE_LAUNCH
#define MK_ONE_LAUNCH 1
#endif
extern "C" void kernel_launch(void* const* d_in, const int* in_sizes, int n_in, void* d_out, int out_size, void* d_ws, size_t ws_size, hipStream_t stream) {
    static int grid = 0;
    if (grid == 0) {
        if (n_in != 36 || out_size != MTOK * DM || ws_size < WS_END) { fprintf(stderr, "kernel_launch: unexpected shapes (n_in %d out %d ws %zu)\n", n_in, out_size, ws_size); grid = -1; return; }
        int dev = 0, cus = 0, per_cu = 0;
        if (hipGetDevice(&dev) != hipSuccess || hipDeviceGetAttribute(&cus, hipDeviceAttributeMultiprocessorCount, dev) != hipSuccess) { grid = -1; return; }
        if (hipFuncSetAttribute((const void*)mk_fwd, hipFuncAttributeMaxDynamicSharedMemorySize, LDS_BYTES) != hipSuccess) { fprintf(stderr, "kernel_launch: hipFuncSetAttribute failed\n"); grid = -1; return; }
        if (hipOccupancyMaxActiveBlocksPerMultiprocessor(&per_cu, (const void*)mk_fwd, 512, LDS_BYTES) != hipSuccess || per_cu < 1) fprintf(stderr, "kernel_launch: occupancy query reports %d\n", per_cu);
        (void)hipGetLastError();
        grid = cus;
    }
    if (grid < 0) return;
    (void)hipMemsetAsync((char*)d_ws + WS_CTL, 0, CTL_ZERO_BYTES, stream);
    Args a{};
    for (int i = 0; i < 36; ++i) a.in[i] = (const float*)d_in[i];
    a.out = (float*)d_out; a.ws = (unsigned char*)d_ws; a.pad = 0;
#if MK_ONE_LAUNCH
    a.ph_lo = 0; a.ph_hi = N_PHASES; a.li = 0;
    hipLaunchKernelGGL(mk_fwd, dim3(grid), dim3(512), LDS_BYTES, stream, a);
#else
    for (int p = 0; p < N_PHASES; ++p) {
        if (p >= PH_LAYER0 && p < PH_FINAL) { const int l = (p - PH_LAYER0) / PH_PER_LAYER, q = (p - PH_LAYER0) % PH_PER_LAYER; if ((l & 1) && q == 7) continue; }
        a.ph_lo = p; a.ph_hi = p + 1; a.li = 0;
        hipLaunchKernelGGL(mk_fwd, dim3(grid), dim3(512), LDS_BYTES, stream, a);
    }
#endif
}
```

```cpp
#include <hip/hip_runtime.h>
#include <cstdio>
#include <cstdint>
namespace pg8 {
#define PG8_LAS __attribute__((address_space(3)))
typedef unsigned short bf16_t;
typedef short bf16x8 __attribute__((ext_vector_type(8)));
typedef float f32x4 __attribute__((ext_vector_type(4)));
typedef unsigned u32x4 __attribute__((ext_vector_type(4)));
constexpr int BM = 256, BK = 64, HALF = 128, HTB = HALF * BK * 2  , STAGE_BYTES = 8 * HTB, NXCD = 8, WGM = 8;

__host__ __device__ __forceinline__ int lds_byte(int r, int c) { const int st = (r >> 4) * 2 + (c >> 5), rr = r & 15, cc = c & 31, ob = rr * 64 + cc * 2; return st * 1024 + (ob ^ (((ob >> 9) & 1) << 5)); }
__host__ __device__ __forceinline__ void stage_rc(int b, int& R, int& C) { const int st = b / 1024, sb = b % 1024, swz = sb ^ (((sb >> 9) & 1) << 5); R = (st >> 1) * 16 + swz / 64; C = (st & 1) * 32 + (swz % 64) / 2; }
__host__ __device__ __forceinline__ int perm32(int rho) { const int n = rho >> 4, i = rho & 15; return 8 * (i >> 2) + 4 * n + (i & 3); }

struct Unit { int pm, pn, ui; };
struct Gemm { const bf16_t* A; const bf16_t* Bt; int M, N, K; };

struct StaticOrder {
    int nM, nN, nwg, G, c;
    __host__ __device__ void init(int M, int N, int G_, int c_) { nM = M / BM; nN = N / BM; nwg = nM * nN; G = G_; c = c_; }
    __host__ __device__ bool next(int i, Unit& u) const {
        const long L = (long)i * G + c; if (L >= nwg) return false;
        int wgid = (int)L; { const int q = nwg / NXCD, r = nwg % NXCD, xcd = wgid % NXCD, off = wgid / NXCD; wgid = (xcd < r ? xcd * (q + 1) : r * (q + 1) + (xcd - r) * q) + off; }
        const int nig = WGM * nN, gid = wgid / nig, fm = gid * WGM, gsz = (nM - fm) < WGM ? (nM - fm) : WGM;
        u.pm = fm + ((wgid % nig) % gsz); u.pn = (wgid % nig) / gsz; return true;
    }
    __device__ __forceinline__ void a_ready(const Unit&) const {}
    __device__ __forceinline__ void done(const Unit&) const {}
};

__device__ __forceinline__ unsigned cvt_pk_bf16(float lo, float hi) { unsigned r; asm volatile("v_cvt_pk_bf16_f32 %0, %1, %2" : "=v"(r) : "v"(lo), "v"(hi)); return r; }
typedef float f32x2 __attribute__((ext_vector_type(2)));
typedef unsigned u32x2 __attribute__((ext_vector_type(2)));
#define PG8_GAS __attribute__((address_space(1)))
__device__ __forceinline__ u32x2 pack8_fp8(const float (&x)[8]) { int w0 = 0, w1 = 0; w0 = __builtin_amdgcn_cvt_pk_fp8_f32(x[0], x[1], w0, false); w0 = __builtin_amdgcn_cvt_pk_fp8_f32(x[2], x[3], w0, true);
    w1 = __builtin_amdgcn_cvt_pk_fp8_f32(x[4], x[5], w1, false); w1 = __builtin_amdgcn_cvt_pk_fp8_f32(x[6], x[7], w1, true); u32x2 r; r.x = (unsigned)w0; r.y = (unsigned)w1; return r; }
__device__ __forceinline__ u32x4 split8_hilo(const float (&x)[8]) { const u32x2 h = pack8_fp8(x);
    const f32x2 a = __builtin_amdgcn_cvt_pk_f32_fp8((int)h.x, false), b = __builtin_amdgcn_cvt_pk_f32_fp8((int)h.x, true), c = __builtin_amdgcn_cvt_pk_f32_fp8((int)h.y, false), d = __builtin_amdgcn_cvt_pk_f32_fp8((int)h.y, true);
    const float r[8] = {x[0] - a.x, x[1] - a.y, x[2] - b.x, x[3] - b.y, x[4] - c.x, x[5] - c.y, x[6] - d.x, x[7] - d.y}; const u32x2 l = pack8_fp8(r);
    u32x4 w; w.x = h.x; w.y = h.y; w.z = l.x; w.w = l.y; return w; }
__device__ __forceinline__ float bf_lo(unsigned w) { return __uint_as_float(w << 16); }
__device__ __forceinline__ float bf_hi(unsigned w) { return __uint_as_float(w & 0xffff0000u); }
__device__ __forceinline__ float fast_sigmoid(float x) { return __builtin_amdgcn_rcpf(1.0f + __expf(-x)); }
struct EpiSwiGLU {
    static constexpr bool PERM = true, AFTER_DRAIN = false;
    bf16_t* O; int ldc; const PG8_LAS float* rsl;
    __device__ __forceinline__ void operator()(const f32x4 (&acc)[2][2][4][2], const Unit& u, int wr, int wc, int fr, int fq) const {
        const int col0 = u.pn * HALF + wc * 32 + 8 * fq; const PG8_LAS float* rp = rsl + u.ui * 256 + wr * 64 + fr;
#pragma unroll
        for (int ai = 0; ai < 2; ++ai)
#pragma unroll
            for (int m = 0; m < 4; ++m) {
                const int row = u.pm * BM + ai * HALF + wr * 64 + m * 16 + fr; const float r = rp[ai * HALF + m * 16];
                float h[8];
#pragma unroll
                for (int n = 0; n < 2; ++n)
#pragma unroll
                    for (int j = 0; j < 4; ++j) { const float g = acc[ai][0][m][n][j] * r, up = acc[ai][1][m][n][j] * r; h[n * 4 + j] = g * fast_sigmoid(g) * up; }
                u32x4 w; w.x = cvt_pk_bf16(h[0], h[1]); w.y = cvt_pk_bf16(h[2], h[3]); w.z = cvt_pk_bf16(h[4], h[5]); w.w = cvt_pk_bf16(h[6], h[7]);
                *(PG8_GAS u32x4*)(O + (size_t)row * ldc + col0) = w;
            }
    }
};
struct EpiResid {
    static constexpr bool PERM = false, AFTER_DRAIN = false;
    bf16_t* HB; float* ss; float scale;
    __device__ __forceinline__ void operator()(const f32x4 (&acc)[2][2][4][2], const Unit& u, int wr, int wc, int fr, int fq) const {
        const int col0 = u.pn * BM + wc * 32 + 4 * fq;
        PG8_GAS bf16_t* hb = (PG8_GAS bf16_t*)HB + (size_t)(u.pm * BM + wr * 64 + fr) * 1024 + col0;
        const int L = fr + 16 * fq, perm = 4 * (4 * fr + fq);
        const PG8_GAS bf16_t* hl = (const PG8_GAS bf16_t*)HB + (size_t)(u.pm * BM + wr * 64 + (L >> 2)) * 1024 + u.pn * BM + wc * 32 + 4 * (L & 3);
        u32x2 hv[2][4][2][2];
#pragma unroll
        for (int ai = 0; ai < 2; ++ai)
#pragma unroll
            for (int m = 0; m < 4; ++m)
#pragma unroll
                for (int bj = 0; bj < 2; ++bj)
#pragma unroll
                    for (int n = 0; n < 2; ++n) hv[ai][m][bj][n] = *(const PG8_GAS u32x2*)(hl + (size_t)(ai * HALF + m * 16) * 1024 + bj * HALF + n * 16);

#pragma unroll
        for (int ai = 0; ai < 2; ++ai)
#pragma unroll
            for (int m = 0; m < 4; ++m) {
                const int row = u.pm * BM + ai * HALF + wr * 64 + m * 16 + fr; float sq = 0.f;
#pragma unroll
                for (int bj = 0; bj < 2; ++bj)
#pragma unroll
                    for (int n = 0; n < 2; ++n) {
                        u32x2 x = hv[ai][m][bj][n]; x.x = (unsigned)__builtin_amdgcn_ds_bpermute(perm, (int)x.x); x.y = (unsigned)__builtin_amdgcn_ds_bpermute(perm, (int)x.y);
                        f32x4 h = {bf_lo(x.x), bf_hi(x.x), bf_lo(x.y), bf_hi(x.y)}; h = h + acc[ai][bj][m][n] * scale;
                        u32x2 w; w.x = cvt_pk_bf16(h[0], h[1]); w.y = cvt_pk_bf16(h[2], h[3]); *(PG8_GAS u32x2*)(hb + (size_t)(ai * HALF + m * 16) * 1024 + bj * HALF + n * 16) = w;
                        const float r0 = bf_lo(w.x), r1 = bf_hi(w.x), r2 = bf_lo(w.y), r3 = bf_hi(w.y);
                        sq += (r0 * r0 + r1 * r1) + (r2 * r2 + r3 * r3);
                    }
                sq += __shfl_xor(sq, 16); sq += __shfl_xor(sq, 32);
                if (fq == 0) ((PG8_GAS float*)ss)[(size_t)row * 16 + u.pn * 4 + wc] = sq;
            }
    }
};
template <bool USE_RS> struct EpiScaleBf16 {
    static constexpr bool PERM = true, AFTER_DRAIN = false;
    bf16_t* O; int ldc; const PG8_LAS float* rsl; float cscale;
    __device__ __forceinline__ void operator()(const f32x4 (&acc)[2][2][4][2], const Unit& u, int wr, int wc, int fr, int fq) const {
        const int col0 = u.pn * BM + wc * 32 + 8 * fq; const PG8_LAS float* rp = rsl + u.ui * 256 + wr * 64 + fr;
#pragma unroll
        for (int ai = 0; ai < 2; ++ai)
#pragma unroll
            for (int m = 0; m < 4; ++m) {
                const int row = u.pm * BM + ai * HALF + wr * 64 + m * 16 + fr; const float s = (USE_RS ? rp[ai * HALF + m * 16] : 1.0f) * cscale;
                PG8_GAS bf16_t* rowp = (PG8_GAS bf16_t*)O + (size_t)row * ldc + col0;
#pragma unroll
                for (int bj = 0; bj < 2; ++bj) { const f32x4 v0 = acc[ai][bj][m][0] * s, v1 = acc[ai][bj][m][1] * s;
                    u32x4 w; w.x = cvt_pk_bf16(v0[0], v0[1]); w.y = cvt_pk_bf16(v0[2], v0[3]); w.z = cvt_pk_bf16(v1[0], v1[1]); w.w = cvt_pk_bf16(v1[2], v1[3]);
                    *(PG8_GAS u32x4*)(rowp + bj * HALF) = w; }
            }
    }
};
struct EpiRope {
    static constexpr bool PERM = true, AFTER_DRAIN = false;
    bf16_t* O; const PG8_LAS float* rsl; const float* cA; const float* sA; const float* cI; const float* sI; unsigned char* K8; unsigned char* V8;
    __device__ __forceinline__ void operator()(const f32x4 (&acc)[2][2][4][2], const Unit& u, int wr, int wc, int fr, int fq) const {
        const int x0 = wc * 32 + 8 * fq, pn = u.pn; const PG8_LAS float* rp = rsl + u.ui * 256 + wr * 64 + fr;
        const bool rot = !(pn == 5 || (pn == 8 && x0 >= 32)); const bool tA = pn < 5; const int half = tA ? 64 : 32, i0 = x0 & (half - 1);
#pragma unroll
        for (int ai = 0; ai < 2; ++ai) {
            f32x4 tc[4][2], ts[4][2];
            if (rot) {
#pragma unroll
                for (int m = 0; m < 4; ++m) { const int row = u.pm * BM + ai * HALF + wr * 64 + m * 16 + fr;
                    const PG8_GAS float* cp = (const PG8_GAS float*)(tA ? cA + (size_t)row * 64 : cI + (size_t)row * 32) + i0; const PG8_GAS float* sp = (const PG8_GAS float*)(tA ? sA + (size_t)row * 64 : sI + (size_t)row * 32) + i0;
                    tc[m][0] = *(const PG8_GAS f32x4*)cp; tc[m][1] = *(const PG8_GAS f32x4*)(cp + 4); ts[m][0] = *(const PG8_GAS f32x4*)sp; ts[m][1] = *(const PG8_GAS f32x4*)(sp + 4); }
            }
#pragma unroll
            for (int m = 0; m < 4; ++m) {
                const int row = u.pm * BM + ai * HALF + wr * 64 + m * 16 + fr; const float r = rp[ai * HALF + m * 16];
                PG8_GAS bf16_t* orow = (PG8_GAS bf16_t*)O + (size_t)row * 2304;
                float a[8], b[8];
#pragma unroll
                for (int n = 0; n < 2; ++n)
#pragma unroll
                    for (int j = 0; j < 4; ++j) { a[4 * n + j] = acc[ai][0][m][n][j] * r; b[4 * n + j] = acc[ai][1][m][n][j] * r; }
                if (pn == 5) {
                    const size_t cr = (size_t)((row >> 13) * 2) * 8192 + (row & 8191);
                    *(PG8_GAS u32x2*)(V8 + cr * 128 + x0) = pack8_fp8(a); *(PG8_GAS u32x2*)(V8 + (cr + 8192) * 128 + x0) = pack8_fp8(b);
                } else if (pn == 8 && x0 >= 32) {
                    if (x0 == 32) { u32x4 w0; w0.x = cvt_pk_bf16(a[0], a[1]); w0.y = cvt_pk_bf16(a[2], a[3]); w0.z = cvt_pk_bf16(a[4], a[5]); w0.w = cvt_pk_bf16(a[6], a[7]); *(PG8_GAS u32x4*)(orow + 2112) = w0; }
                } else {
                    const int hh = tA ? (x0 >> 6) : (x0 >> 5);
                    const int base = pn < 4 ? 256 * pn + 128 * hh : (pn == 4 ? 1024 + 128 * hh : (pn == 8 ? 2048 : 1536 + 256 * (pn - 6) + 64 * hh));
                    const float sc = pn < 4 ? 0.08838834764831845f * 32.0f : 1.0f;
                    const f32x4 c0 = tc[m][0], c1 = tc[m][1], s0 = ts[m][0], s1 = ts[m][1];
                    const float cs[8] = {c0[0], c0[1], c0[2], c0[3], c1[0], c1[1], c1[2], c1[3]}, sn[8] = {s0[0], s0[1], s0[2], s0[3], s1[0], s1[1], s1[2], s1[3]};
                    float o1[8], o2[8];
#pragma unroll
                    for (int k = 0; k < 8; ++k) { o1[k] = (a[k] * cs[k] - b[k] * sn[k]) * sc; o2[k] = (b[k] * cs[k] + a[k] * sn[k]) * sc; }
                    u32x4 w0, w1; w0.x = cvt_pk_bf16(o1[0], o1[1]); w0.y = cvt_pk_bf16(o1[2], o1[3]); w0.z = cvt_pk_bf16(o1[4], o1[5]); w0.w = cvt_pk_bf16(o1[6], o1[7]);
                    w1.x = cvt_pk_bf16(o2[0], o2[1]); w1.y = cvt_pk_bf16(o2[2], o2[3]); w1.z = cvt_pk_bf16(o2[4], o2[5]); w1.w = cvt_pk_bf16(o2[6], o2[7]);
                    if (pn < 4) { w0 = split8_hilo(o1); w1 = split8_hilo(o2); }
                    if (pn == 4) { const size_t cr = (size_t)((row >> 13) * 2 + hh) * 8192 + (row & 8191); *(PG8_GAS u32x2*)(K8 + cr * 128 + i0) = pack8_fp8(o1); *(PG8_GAS u32x2*)(K8 + cr * 128 + 64 + i0) = pack8_fp8(o2); }
                    else { *(PG8_GAS u32x4*)(orow + base + i0) = w0; *(PG8_GAS u32x4*)(orow + base + half + i0) = w1; }
                }
            }
        }
    }
};
struct EpiGLU {
    static constexpr bool PERM = true, AFTER_DRAIN = false;
    const bf16_t* Y; const float* bias; bf16_t* CAT;
    __device__ __forceinline__ void operator()(const f32x4 (&acc)[2][2][4][2], const Unit& u, int wr, int wc, int fr, int fq) const {
        const int col0 = u.pn * BM + wc * 32 + 8 * fq;
        const PG8_GAS bf16_t* yb = (const PG8_GAS bf16_t*)Y + (size_t)(u.pm * BM + wr * 64 + fr) * 512 + col0;
        u32x4 yv[2][4][2]; f32x4 bb[2][2];
#pragma unroll
        for (int bj = 0; bj < 2; ++bj) { bb[bj][0] = *(const PG8_GAS f32x4*)(bias + col0 + bj * HALF); bb[bj][1] = *(const PG8_GAS f32x4*)(bias + col0 + bj * HALF + 4); }
#pragma unroll
        for (int ai = 0; ai < 2; ++ai)
#pragma unroll
            for (int m = 0; m < 4; ++m)
#pragma unroll
                for (int bj = 0; bj < 2; ++bj) yv[ai][m][bj] = *(const PG8_GAS u32x4*)(yb + (size_t)(ai * HALF + m * 16) * 512 + bj * HALF);
#pragma unroll
        for (int ai = 0; ai < 2; ++ai)
#pragma unroll
            for (int m = 0; m < 4; ++m) {
                const int row = u.pm * BM + ai * HALF + wr * 64 + m * 16 + fr;
#pragma unroll
                for (int bj = 0; bj < 2; ++bj) { const int c = col0 + bj * HALF; const u32x4 y4 = yv[ai][m][bj];
                    const f32x4 z0 = acc[ai][bj][m][0] + bb[bj][0], z1 = acc[ai][bj][m][1] + bb[bj][1];
                    float o[8];
                    o[0] = bf_lo(y4.x) * fast_sigmoid(z0[0]); o[1] = bf_hi(y4.x) * fast_sigmoid(z0[1]); o[2] = bf_lo(y4.y) * fast_sigmoid(z0[2]); o[3] = bf_hi(y4.y) * fast_sigmoid(z0[3]);
                    o[4] = bf_lo(y4.z) * fast_sigmoid(z1[0]); o[5] = bf_hi(y4.z) * fast_sigmoid(z1[1]); o[6] = bf_lo(y4.w) * fast_sigmoid(z1[2]); o[7] = bf_hi(y4.w) * fast_sigmoid(z1[3]);
                    u32x4 w; w.x = cvt_pk_bf16(o[0], o[1]); w.y = cvt_pk_bf16(o[2], o[3]); w.z = cvt_pk_bf16(o[4], o[5]); w.w = cvt_pk_bf16(o[6], o[7]);
                    *(PG8_GAS u32x4*)(CAT + (size_t)row * 1024 + 512 + c) = w; }
            }
    }
};
template <int NM, int NN> struct TileOrder {
    static constexpr int nwg = NM * NN, WG = NM < 8 ? NM : 8, nig = WG * NN;
    static_assert(nwg % 8 == 0 && NM % WG == 0, "TileOrder shapes");
    int G, c;
    __device__ __forceinline__ bool next(int i, Unit& u) const {
        const int L = i * G + c; if (c < 0 || L >= nwg) return false;
        const int wgid = (L & 7) * (nwg / 8) + (L >> 3), gid = wgid / nig, r = wgid % nig;
        u.pm = gid * WG + (r % WG); u.pn = r / WG; u.ui = i; return true;
    }
    __device__ __forceinline__ void a_ready(const Unit&) const {}
    __device__ __forceinline__ void done(const Unit&) const {}
};
template <class Epi, class Sched, bool ALIGN_EPI = false, bool SP2 = false>
__device__ __forceinline__ void gemm_phase(PG8_LAS unsigned char* lds, const Gemm g, const Sched& S, const Epi& E, int tid_in) {
    int tid_ = tid_in; asm volatile("" : "+v"(tid_));
    const int tid = tid_, wid = __builtin_amdgcn_readfirstlane(tid >> 6), lane = tid & 63, wr = wid >> 2, wc = wid & 3, fr = lane & 15, fq = lane >> 4;
    const int K = g.K, nt = K / BK;
    unsigned voffA[2], voffB[2];
#pragma unroll
    for (int i = 0; i < 2; ++i) { int R, C; stage_rc(tid * 16 + i * 8192, R, C); const int Rb = Epi::PERM ? ((R & ~31) + perm32(R & 31)) : R;
        voffA[i] = (unsigned)(R * K + C) * 2u; voffB[i] = (unsigned)(Rb * K + C) * 2u; }
    const size_t kstep = (size_t)(BK * 2);
    const size_t hstep = (size_t)HALF * K * 2;
    const size_t tstep = 2 * hstep;
    const unsigned ldsw = (unsigned)wid * 1024u;
    const int aoff = lds_byte(wr * 64 + fr, fq * 8), boff = lds_byte(wc * 32 + fr, fq * 8);
#define PG8_SA(b, h) (((b) * 2 + (h)) * HTB)
#define PG8_SB(b, h) ((4 + (b) * 2 + (h)) * HTB)
#define PG8_STAGE(bufoff, gbase, voff) do { _Pragma("unroll") for (int _i = 0; _i < 2; ++_i) \
        __builtin_amdgcn_global_load_lds((const unsigned*)((const char*)(gbase) + (voff)[_i]), (PG8_LAS unsigned*)(lds + (bufoff) + ldsw + _i * 8192), 16, 0, 0); } while (0)
#define PG8_LDA(dst, b, h) do { _Pragma("unroll") for (int m = 0; m < 4; ++m) _Pragma("unroll") for (int k = 0; k < 2; ++k) dst[m][k] = *(const PG8_LAS bf16x8*)(lds + PG8_SA(b, h) + aoff + m * 2048 + k * 1024); } while (0)
#define PG8_LDB(dst, b, h) do { _Pragma("unroll") for (int n = 0; n < 2; ++n) _Pragma("unroll") for (int k = 0; k < 2; ++k) dst[n][k] = *(const PG8_LAS bf16x8*)(lds + PG8_SB(b, h) + boff + n * 2048 + k * 1024); } while (0)
#define PG8_MMA(ai, bj, At, Bt) do { __builtin_amdgcn_s_setprio(1); _Pragma("unroll") for (int m = 0; m < 4; ++m) _Pragma("unroll") for (int n = 0; n < 2; ++n) _Pragma("unroll") for (int k = 0; k < 2; ++k) \
        acc[ai][bj][m][n] = __builtin_amdgcn_mfma_f32_16x16x32_bf16(Bt[n][k], At[m][k], acc[ai][bj][m][n], 0, 0, 0); __builtin_amdgcn_s_setprio(0); } while (0)
#define PG8_WAIT_V(n) asm volatile("s_waitcnt vmcnt(" #n ")" ::: "memory")
#define PG8_WAIT_L(n) asm volatile("s_waitcnt lgkmcnt(" #n ")" ::: "memory")
#define PG8_BAR __builtin_amdgcn_s_barrier()
#define PG8_SCHED __builtin_amdgcn_sched_barrier(0)
    Unit cur, nxt; int ui = 0;
    if (!S.next(0, cur)) return;
    f32x4 acc[2][2][4][2];
#pragma unroll
    for (int a = 0; a < 2; ++a)
#pragma unroll
        for (int b = 0; b < 2; ++b)
#pragma unroll
            for (int m = 0; m < 4; ++m)
#pragma unroll
                for (int n = 0; n < 2; ++n) acc[a][b][m][n] = (f32x4){0.f, 0.f, 0.f, 0.f};
    bf16x8 At[4][2], B0[2][2], B1[2][2];
    const char* cA = (const char*)g.A + (size_t)cur.pm * tstep; const char* cB = (const char*)g.Bt + (size_t)cur.pn * tstep;
    S.a_ready(cur);
    if constexpr (SP2) {
        PG8_STAGE(PG8_SB(0, 0), cB, voffB); PG8_STAGE(PG8_SB(0, 1), cB + hstep, voffB); PG8_STAGE(PG8_SA(0, 0), cA, voffA); PG8_STAGE(PG8_SA(0, 1), cA + hstep, voffA);
        if (wr == 1) PG8_BAR;
        PG8_WAIT_V(2); PG8_BAR;
        PG8_STAGE(PG8_SB(1, 0), cB + kstep, voffB); PG8_STAGE(PG8_SA(1, 0), cA + kstep, voffA); PG8_STAGE(PG8_SB(1, 1), cB + hstep + kstep, voffB);
        PG8_WAIT_V(6); PG8_BAR;
    } else {
        PG8_STAGE(PG8_SB(0, 0), cB, voffB); PG8_STAGE(PG8_SA(0, 0), cA, voffA); PG8_STAGE(PG8_SB(0, 1), cB + hstep, voffB); PG8_STAGE(PG8_SA(0, 1), cA + hstep, voffA);
        if (wr == 1) PG8_BAR;
        PG8_WAIT_V(4); PG8_BAR;
        PG8_STAGE(PG8_SB(1, 0), cB + kstep, voffB); PG8_STAGE(PG8_SA(1, 0), cA + kstep, voffA); PG8_STAGE(PG8_SB(1, 1), cB + hstep + kstep, voffB);
        PG8_WAIT_V(6); PG8_BAR;
    }
    for (;;) {
        const bool has_next = S.next(ui + 1, nxt);
        const char* nA = has_next ? (const char*)g.A + (size_t)nxt.pm * tstep : cA; const char* nB = has_next ? (const char*)g.Bt + (size_t)nxt.pn * tstep : cB;
        for (int t = 0; t < nt; t += 2) {
            const bool last = (t == nt - 2);
            const char* a1 = cA + (size_t)(t + 1) * kstep;
            const char* a2 = last ? nA : cA + (size_t)(t + 2) * kstep; const char* b2 = last ? nB : cB + (size_t)(t + 2) * kstep;
            const char* a3 = a2 + kstep; const char* b3 = b2 + kstep;
            if (last && has_next) S.a_ready(nxt);
            if constexpr (SP2) {
            PG8_LDB(B0, 0, 0); PG8_LDB(B1, 0, 1); PG8_SCHED; PG8_LDA(At, 0, 0); PG8_STAGE(PG8_SA(1, 1), a1 + hstep, voffA);
            PG8_WAIT_V(8); PG8_WAIT_L(0); PG8_BAR; PG8_MMA(0, 0, At, B0); PG8_MMA(0, 1, At, B1); PG8_BAR; PG8_SCHED;
            PG8_LDA(At, 0, 1); PG8_STAGE(PG8_SB(0, 0), b2, voffB); PG8_STAGE(PG8_SB(0, 1), b2 + hstep, voffB); PG8_STAGE(PG8_SA(0, 0), a2, voffA);
            PG8_WAIT_V(8); PG8_WAIT_L(0); PG8_BAR; PG8_MMA(1, 0, At, B0); PG8_MMA(1, 1, At, B1); PG8_BAR; PG8_SCHED;
            PG8_LDB(B0, 1, 0); PG8_LDB(B1, 1, 1); PG8_SCHED; PG8_LDA(At, 1, 0); PG8_STAGE(PG8_SA(0, 1), a2 + hstep, voffA);
            PG8_WAIT_V(8); PG8_WAIT_L(0); PG8_BAR; PG8_MMA(0, 0, At, B0); PG8_MMA(0, 1, At, B1); PG8_BAR; PG8_SCHED;
            PG8_LDA(At, 1, 1); PG8_STAGE(PG8_SB(1, 0), b3, voffB); PG8_STAGE(PG8_SB(1, 1), b3 + hstep, voffB); PG8_STAGE(PG8_SA(1, 0), a3, voffA);
            PG8_WAIT_V(8); PG8_WAIT_L(0); PG8_BAR; PG8_MMA(1, 0, At, B0); PG8_MMA(1, 1, At, B1); PG8_BAR; PG8_SCHED;
            } else {
            PG8_LDB(B0, 0, 0); PG8_SCHED; PG8_LDA(At, 0, 0); PG8_STAGE(PG8_SA(1, 1), a1 + hstep, voffA);
            PG8_WAIT_L(8); PG8_BAR; PG8_WAIT_L(0); PG8_MMA(0, 0, At, B0); PG8_BAR; PG8_SCHED;
            PG8_LDB(B1, 0, 1); PG8_STAGE(PG8_SB(0, 0), b2, voffB);
            PG8_BAR; PG8_WAIT_L(0); PG8_MMA(0, 1, At, B1); PG8_BAR;
            PG8_LDA(At, 0, 1); PG8_STAGE(PG8_SA(0, 0), a2, voffA);
            PG8_BAR; PG8_WAIT_L(0); PG8_MMA(1, 0, At, B0); PG8_BAR; PG8_SCHED;
            PG8_STAGE(PG8_SB(0, 1), b2 + hstep, voffB);
            PG8_WAIT_V(6); PG8_BAR; PG8_MMA(1, 1, At, B1); PG8_BAR;
            PG8_LDB(B0, 1, 0); PG8_SCHED; PG8_LDA(At, 1, 0); PG8_STAGE(PG8_SA(0, 1), a2 + hstep, voffA);
            PG8_WAIT_L(8); PG8_BAR; PG8_WAIT_L(0); PG8_MMA(0, 0, At, B0); PG8_BAR; PG8_SCHED;
            PG8_LDB(B1, 1, 1); PG8_STAGE(PG8_SB(1, 0), b3, voffB);
            PG8_BAR; PG8_WAIT_L(0); PG8_MMA(0, 1, At, B1); PG8_BAR;
            PG8_LDA(At, 1, 1); PG8_STAGE(PG8_SA(1, 0), a3, voffA);
            PG8_BAR; PG8_WAIT_L(0); PG8_MMA(1, 0, At, B0); PG8_BAR; PG8_SCHED;
            PG8_STAGE(PG8_SB(1, 1), b3 + hstep, voffB);
            PG8_WAIT_V(6); PG8_BAR; PG8_MMA(1, 1, At, B1); PG8_BAR;
            }
        }
        if constexpr (ALIGN_EPI) { if (wr == 0) PG8_BAR; }
        if constexpr (!Epi::AFTER_DRAIN) { E(acc, cur, wr, wc, fr, fq); S.done(cur); }
        if (!has_next) break;
#pragma unroll
        for (int a = 0; a < 2; ++a)
#pragma unroll
            for (int b = 0; b < 2; ++b)
#pragma unroll
                for (int m = 0; m < 4; ++m)
#pragma unroll
                    for (int n = 0; n < 2; ++n) acc[a][b][m][n] = (f32x4){0.f, 0.f, 0.f, 0.f};
        cur = nxt; cA = nA; cB = nB; ++ui;
        if constexpr (ALIGN_EPI) { if (wr == 1) PG8_BAR; }
    }
    PG8_WAIT_V(0);
    if constexpr (!ALIGN_EPI) { if (wr == 0) PG8_BAR; }
    PG8_BAR;
    if constexpr (Epi::AFTER_DRAIN) { E.fused(acc, cur, wr, wc, fr, fq, lds, wid, lane); S.done(cur); }
#undef PG8_SA
#undef PG8_SB
#undef PG8_STAGE
#undef PG8_LDA
#undef PG8_LDB
#undef PG8_MMA
#undef PG8_WAIT_V
#undef PG8_WAIT_L
#undef PG8_BAR
#undef PG8_SCHED
}
}

constexpr int NB = 2, SEQ = 8192, DM = 1024, MTOK = NB * SEQ, DEPTH = 4, NMEM = 256, DFF = 2816;
constexpr int PROJW = 2304;
constexpr int EV_IN = 2064, OD_IN = 2120;
constexpr float EPS = 1e-6f;
constexpr int S5T = 64, S5NC = SEQ / S5T;
constexpr int TOPK = 256;
constexpr int PH_LAYER0 = 2, PH_PER_LAYER = 14, PH_FINAL = PH_LAYER0 + DEPTH * PH_PER_LAYER, N_PHASES = PH_FINAL + 1;

constexpr size_t MiB = 1u << 20;
constexpr size_t WS_CTL = 0, CTL_ZERO_BYTES = 1 * MiB;
constexpr size_t WS_H = 1 * MiB, WS_HB = 65 * MiB, WS_SS = 97 * MiB;
constexpr size_t WS_COSA = 98 * MiB, WS_SINA = 102 * MiB, WS_COSI = 106 * MiB, WS_SINI = 108 * MiB;
constexpr size_t WS_MEMN = 110 * MiB, WS_MK = 111 * MiB, WS_MVT = 115 * MiB, WS_S5P = 119 * MiB;
constexpr size_t WS_W = 121 * MiB, WS_SCR = 169 * MiB, WS_END = 345 * MiB;
constexpr size_t WO_GU1 = 0, WO_D1 = 11 * MiB, WO_IN = WO_D1 + 5632 * 1024, WO_OUT = WO_IN + 4608 * 1024, WO_GLU = WO_OUT + 2 * MiB, WO_XQ = WO_GLU + 512 * 1024,
                 WO_XO = WO_XQ + 2 * MiB, WO_GU2 = WO_XO + 2 * MiB, WO_D2 = WO_GU2 + 11 * MiB, WO_END = WO_D2 + 5632 * 1024;
static_assert(WO_END <= 48 * MiB, "weights region");
constexpr size_t SC_HID = 0, SC_PROJ = 0, SC_XQ = 0, SC_XO = 32 * MiB, SC_KVW = 96 * MiB;
constexpr size_t SC_DS = 72 * MiB, SC_BC = 104 * MiB, SC_DEC = 120 * MiB, SC_S5E = 121 * MiB, SC_Y = 125 * MiB, SC_CAT = 141 * MiB;
constexpr size_t SC_SEL = 72 * MiB, SC_SELN = 80 * MiB, SC_K8 = 81 * MiB, SC_V8 = 85 * MiB;
static_assert(SC_CAT + 32 * MiB <= WS_END - WS_SCR, "scratch region");
constexpr int S5P_A = 0, S5P_AT = 2 * 32 * 64 * 2, S5P_BB = 2 * S5P_AT, S5P_BBH = S5P_BB + 2 * 32 * 64 * 16 * 2, S5P_END = S5P_BBH + 2 * 32 * 128 * 16 / 2;
constexpr int CW_BAR = 1024;

constexpr int RING_BYTES = 131072;
constexpr int LDS_BYTES = 163840, LDSCTL_OFF = LDS_BYTES - 1024;

#define GAS __attribute__((address_space(1)))
#define LAS __attribute__((address_space(3)))
#define DI __device__ __forceinline__
typedef unsigned short bf16;
typedef unsigned v4u __attribute__((ext_vector_type(4)));
typedef unsigned v2u __attribute__((ext_vector_type(2)));
typedef float f32x4 __attribute__((ext_vector_type(4)));
typedef float f32x2 __attribute__((ext_vector_type(2)));
typedef short bf16x8 __attribute__((ext_vector_type(8)));
#define LDS_WAIT() asm volatile("s_waitcnt lgkmcnt(0)" ::: "memory")
#define VM_WAIT() asm volatile("s_waitcnt vmcnt(0)" ::: "memory")
DI unsigned f2bf(float f) { unsigned u = __builtin_bit_cast(unsigned, f); return (u + 0x7fffu + ((u >> 16) & 1u)) >> 16; }
DI unsigned pk2(float lo, float hi) { return f2bf(lo) | (f2bf(hi) << 16); }
DI float bflo(unsigned w) { return __uint_as_float(w << 16); }
DI float bfhi(unsigned w) { return __uint_as_float(w & 0xffff0000u); }
DI float bf2f(bf16 x) { return __uint_as_float(((unsigned)x) << 16); }
DI float wave_sum(float v) {
#pragma unroll
    for (int o = 1; o < 64; o <<= 1) v += __shfl_xor(v, o);
    return v;
}
DI f32x4 mfma16(bf16x8 a, bf16x8 b, f32x4 c) { return __builtin_amdgcn_mfma_f32_16x16x32_bf16(a, b, c, 0, 0, 0); }

#define XB_TMO      128
#define XB_XCNT(j)  (256  + 64 * (j))
#define XB_XSUB(j)  (1280 + 64 * (j))
#define XB_XGEN(j)  (2304 + 64 * (j))
#define XB_TOP      3328
#define XB_TOPGEN   3392
#define XCD_BAR_WORDS 3456
#define XB_SPIN_CAP (1u << 18)
__device__ __forceinline__ unsigned xb_ld(unsigned* p)              { return __hip_atomic_load(p, __ATOMIC_RELAXED, __HIP_MEMORY_SCOPE_AGENT); }
__device__ __forceinline__ unsigned xb_add(unsigned* p, unsigned v) { return __hip_atomic_fetch_add(p, v, __ATOMIC_RELAXED, __HIP_MEMORY_SCOPE_AGENT); }
__device__ __forceinline__ unsigned xb_xcc_id() { return (unsigned)__builtin_amdgcn_s_getreg((3 << 11) | 20) & 0xFu; }
#define XB_SPIN(cond, bar) do { unsigned _sp = 0; while (cond) { __builtin_amdgcn_s_sleep(1); \
    if ((++_sp & 255u) == 0u) { if (xb_ld(&(bar)[XB_TMO])) break; if (_sp > XB_SPIN_CAP) { atomicAdd(&(bar)[XB_TMO], 1u); break; } } } } while (0)
struct XcdBarrier { unsigned* bar; unsigned x; volatile LAS unsigned* st; };
__device__ __forceinline__ XcdBarrier xcd_barrier_post(unsigned* bar, volatile LAS unsigned* st) {
    XcdBarrier b; b.bar = bar; b.x = xb_xcc_id(); b.st = st;
    if (threadIdx.x == 0) (void)xb_add(&bar[XB_XCNT(b.x)], 1u);
    return b;
}
__device__ __forceinline__ void xcd_barrier_complete(unsigned* bar, unsigned x, unsigned& nloc, unsigned& nx) {
    const unsigned G = gridDim.x * gridDim.y * gridDim.z;
    unsigned sum, cnt, mine, sp = 0u;
    for (;;) {
        sum = 0u; cnt = 0u; mine = 0u;
#pragma unroll
        for (unsigned j = 0; j < 16; ++j) { const unsigned c = xb_ld(&bar[XB_XCNT(j)]); sum += c; cnt += (c > 0u) ? 1u : 0u; mine = (j == x) ? c : mine; }
        if (sum == G) break;
        __builtin_amdgcn_s_sleep(1);
        if ((++sp & 255u) == 0u) { if (xb_ld(&bar[XB_TMO])) break; if (sp > XB_SPIN_CAP) { atomicAdd(&bar[XB_TMO], 1u); break; } }
    }
    nloc = mine > 0u ? mine : 1u; nx = cnt > 0u ? cnt : 1u;
}
__device__ __forceinline__ void xcd_barrier(const XcdBarrier& b, bool local = false) {
    asm volatile("s_waitcnt vmcnt(0)" ::: "memory");
    __syncthreads();
    if (threadIdx.x == 0) {
        unsigned* bar = b.bar;
        __builtin_amdgcn_s_waitcnt(0);
        unsigned nloc = b.st[0], nx = b.st[1];
        if (nloc == 0u) { xcd_barrier_complete(bar, b.x, nloc, nx); b.st[0] = nloc; b.st[1] = nx; }
        const unsigned old = xb_add(&bar[XB_XSUB(b.x)], 1u);
        const unsigned gen = old / nloc;
        if (old + 1u == (gen + 1u) * nloc) {
            if (!local) __builtin_amdgcn_fence(__ATOMIC_RELEASE, "agent");
            asm volatile("s_waitcnt vmcnt(0)" ::: "memory");
            const unsigned og = xb_add(&bar[XB_TOP], 1u);
            const unsigned tg = og / nx;
            if (og + 1u == (tg + 1u) * nx) xb_add(&bar[XB_TOPGEN], 1u);
            else XB_SPIN(xb_ld(&bar[XB_TOPGEN]) == tg, bar);
            if (!local) __builtin_amdgcn_fence(__ATOMIC_ACQUIRE, "agent"); else asm volatile("buffer_inv sc0" ::: "memory");
            xb_add(&bar[XB_XGEN(b.x)], 1u);
            asm volatile("s_waitcnt vmcnt(0)" ::: "memory");
        } else {
            XB_SPIN(xb_ld(&bar[XB_XGEN(b.x)]) == gen, bar);
            asm volatile("buffer_inv sc0" ::: "memory");
            asm volatile("s_waitcnt vmcnt(0)" ::: "memory");
        }
    }
    __syncthreads();
}

struct Ctx { LAS unsigned char* lds; int tid, lane, wave, vcu, G; };

DI void cvt_store(bf16* dst, int K, int drow0, int k0, LAS float* scr, int lane) {
    LDS_WAIT(); asm volatile("" ::: "memory");
    const int c = lane & 7;
#pragma unroll
    for (int j = 0; j < 4; ++j) { const int n = (lane >> 3) + 8 * j; const LAS float* s = scr + (8 * c) * 33 + n;
        v4u o; o.x = pk2(s[0 * 33], s[1 * 33]); o.y = pk2(s[2 * 33], s[3 * 33]); o.z = pk2(s[4 * 33], s[5 * 33]); o.w = pk2(s[6 * 33], s[7 * 33]);
        *(v4u*)(dst + (size_t)(drow0 + n) * K + k0 + 8 * c) = o; }
    LDS_WAIT(); asm volatile("" ::: "memory");
}
DI void cvt_item(const float* src, int ldsrc, int scol0, int nvalid, const float* gain, bf16* dst, int K, int drow0, int k0, LAS float* scr, int lane) {
    const int kr = lane >> 3, n4 = 4 * (lane & 7); const bool ok = n4 < nvalid;
    const float* sp = src + (size_t)(k0 + kr) * ldsrc + scol0 + n4;
    f32x4 v[8];
#pragma unroll
    for (int i = 0; i < 8; ++i) v[i] = ok ? *(const f32x4*)(sp + (size_t)(8 * i) * ldsrc) : (f32x4){0.f, 0.f, 0.f, 0.f};
    if (gain) {
#pragma unroll
        for (int i = 0; i < 8; ++i) v[i] = v[i] * gain[k0 + kr + 8 * i];
    }
#pragma unroll
    for (int i = 0; i < 8; ++i) { LAS float* d = scr + (kr + 8 * i) * 33 + n4; d[0] = v[i].x; d[1] = v[i].y; d[2] = v[i].z; d[3] = v[i].w; }
    cvt_store(dst, K, drow0, k0, scr, lane);
}
DI void cvt_job(const Ctx& c, const float* src, int ldsrc, int scol0, int nvalid, const float* gain, bf16* dst, int K, int N, int drow0, int rot) {
    LAS float* scr = (LAS float*)(c.lds + c.wave * 8448);
    const int NGW = c.G * 8, gw = (c.vcu * 8 + c.wave + rot) % NGW, nblk = N / 32, nitems = (K / 64) * nblk;
    for (int it = gw; it < nitems; it += NGW) { const int kb = it / nblk, nb = it % nblk; int nv = nvalid - nb * 32; nv = nv < 0 ? 0 : (nv > 32 ? 32 : nv);
        cvt_item(src, ldsrc, scol0 + nb * 32, nv, gain, dst, K, drow0 + nb * 32, kb * 64, scr, c.lane); }
}
DI void cvt_job_gu(const Ctx& c, const float* gate, const float* up, const float* gain, bf16* dst, int rot) {
    LAS float* scr = (LAS float*)(c.lds + c.wave * 8448);
    const int NGW = c.G * 8, gw = (c.vcu * 8 + c.wave + rot) % NGW, nblk = 5632 / 32, nitems = (1024 / 64) * nblk;
    for (int it = gw; it < nitems; it += NGW) { const int kb = it / nblk, nb = it % nblk, n0 = nb * 32;
        const float* src = ((n0 >> 7) & 1) ? up : gate; const int sc = (n0 >> 8) * 128 + (n0 & 127);
        cvt_item(src, DFF, sc, 32, gain, dst, 1024, n0, kb * 64, scr, c.lane); }
}
DI void cvt_job_rope(const Ctx& c, const float* src, const float* gain, bf16* dst, int rot) {
    LAS float* scr = (LAS float*)(c.lds + c.wave * 8448);
    const int NGW = c.G * 8, gw = (c.vcu * 8 + c.wave + rot) % NGW, nblk = PROJW / 32, nitems = (1024 / 64) * nblk;
    for (int it = gw; it < nitems; it += NGW) { const int kb = it / nblk, nb = it % nblk, R = nb * 32, t = R >> 8, bj = (R >> 7) & 1, x = R & 127;
        int L, nv = 32;
        if (t < 4) L = 256 * t + 128 * (x >> 6) + 64 * bj + (x & 63);
        else if (t == 4) L = 1024 + 128 * (x >> 6) + 64 * bj + (x & 63);
        else if (t == 5) L = 1280 + 128 * bj + x;
        else if (t < 8) L = 1536 + 256 * (t - 6) + 64 * (x >> 5) + 32 * bj;
        else { if (x == 0) L = 2048 + 32 * bj; else if (x == 32 && bj == 0) { L = 2112; nv = 8; } else { L = 0; nv = 0; } }
        cvt_item(src, OD_IN, L, nv, gain, dst, 1024, R, kb * 64, scr, c.lane); }
}
DI void cvt_job_comb(const Ctx& c, const float* win, const float* wa, const float* gain, bf16* dst, int drow0, int rot) {
    LAS float* scr = (LAS float*)(c.lds + c.wave * 8448);
    const int NGW = c.G * 8, gw = (c.vcu * 8 + c.wave + rot) % NGW, nblk = 256 / 32, nitems = (1024 / 64) * nblk;
    for (int it = gw; it < nitems; it += NGW) { const int kb = it / nblk, nb = it % nblk, n0 = nb * 32, k0 = kb * 64; const int nn = c.lane & 31;
        float wcol[16];
#pragma unroll
        for (int j = 0; j < 16; ++j) wcol[j] = wa[j * 256 + n0 + nn];
        for (int i = 0; i < 32; ++i) { const int kk = 2 * i + (c.lane >> 5); const float* wr = win + (size_t)(k0 + kk) * EV_IN + 1536; float s = 0.f;
#pragma unroll
            for (int j = 0; j < 16; ++j) s += wr[j] * wcol[j];
            scr[kk * 33 + nn] = s * gain[k0 + kk]; }
        cvt_store(dst, 1024, drow0 + n0, k0, scr, c.lane); }
}

DI void row_init(const float* xrow, bf16* hbrow, float* ssrow, int lane) {
    float s = 0.f;
#pragma unroll
    for (int j = 0; j < 4; ++j) { const f32x4 v = ((const f32x4*)xrow)[lane + 64 * j]; v2u w; w.x = pk2(v.x, v.y); w.y = pk2(v.z, v.w); ((v2u*)hbrow)[lane + 64 * j] = w;
        const float r0 = bflo(w.x), r1 = bfhi(w.x), r2 = bflo(w.y), r3 = bfhi(w.y); s += (r0 * r0 + r1 * r1) + (r2 * r2 + r3 * r3); }
    s = wave_sum(s);
    if (lane < 16) ssrow[lane] = (lane == 0) ? s : 0.f;
}
DI void row_norm_bf16(const float* xrow, const float* g, bf16* orow, int lane) {
    f32x4 v[4]; float s = 0.f;
#pragma unroll
    for (int j = 0; j < 4; ++j) { v[j] = ((const f32x4*)xrow)[lane + 64 * j]; s += (v[j].x * v[j].x + v[j].y * v[j].y) + (v[j].z * v[j].z + v[j].w * v[j].w); }
    const float r = rsqrtf(wave_sum(s) * (1.0f / 1024.0f) + EPS);
#pragma unroll
    for (int j = 0; j < 4; ++j) { const f32x4 gg = ((const f32x4*)g)[lane + 64 * j]; v2u w; w.x = pk2(v[j].x * r * gg.x, v[j].y * r * gg.y); w.y = pk2(v[j].z * r * gg.z, v[j].w * r * gg.w); ((v2u*)orow)[lane + 64 * j] = w; }
}
DI void row_final(const bf16* hrow, const float* ssrow, const float* g, float* orow, int lane) {
    float s = (lane < 16) ? ssrow[lane] : 0.f; s = wave_sum(s);
    const float r = rsqrtf(s * (1.0f / 1024.0f) + EPS);
#pragma unroll
    for (int j = 0; j < 4; ++j) { const v2u w = ((const v2u*)hrow)[lane + 64 * j]; const f32x4 v = {bflo(w.x), bfhi(w.x), bflo(w.y), bfhi(w.y)}, gg = ((const f32x4*)g)[lane + 64 * j]; ((f32x4*)orow)[lane + 64 * j] = v * r * gg; }
}

DI void unpack8(const v4u w, float (&x)[8]) { x[0] = bflo(w.x); x[1] = bfhi(w.x); x[2] = bflo(w.y); x[3] = bfhi(w.y); x[4] = bflo(w.z); x[5] = bfhi(w.z); x[6] = bflo(w.w); x[7] = bfhi(w.w); }
DI void gla1_unit(const Ctx& c, int u, const bf16* PROJ, const float* b_a, float* DS, float* BCg, float* DEC) {
    const int n = u & 127, bh = u >> 7, h = bh & 3, b = bh >> 2, row0 = b * SEQ + n * 64;
    LAS float* BCl = (LAS float*)c.lds; LAS float* SEG = BCl + 4096; LAS unsigned char* KEt = c.lds + 18432; LAS unsigned char* VT = KEt + 9216;
    const int t = c.tid >> 3, s8 = c.tid & 7;
    const bf16* prow = PROJ + (size_t)(row0 + t) * PROJW;
    float kk[8];
    { float x[8]; unpack8(*(const v4u*)(prow + 1536 + h * 64 + s8 * 8), x);
      float ls[8];
#pragma unroll
      for (int j = 0; j < 8; ++j) { const float xx = x[j] + b_a[h * 64 + s8 * 8 + j]; ls[j] = (fminf(xx, 0.f) - __logf(1.0f + __expf(-fabsf(xx)))) * (1.0f / 16.0f); }
      *(LAS f32x4*)(BCl + t * 64 + s8 * 8) = (f32x4){ls[0], ls[1], ls[2], ls[3]}; *(LAS f32x4*)(BCl + t * 64 + s8 * 8 + 4) = (f32x4){ls[4], ls[5], ls[6], ls[7]};
      unpack8(*(const v4u*)(prow + 256 + h * 64 + s8 * 8), kk);
      const v4u v0 = *(const v4u*)(prow + 512 + h * 128 + s8 * 16), v1 = *(const v4u*)(prow + 512 + h * 128 + s8 * 16 + 8);
      const unsigned vw[8] = {v0.x, v0.y, v0.z, v0.w, v1.x, v1.y, v1.z, v1.w};
      LAS unsigned char* vt = VT + (16 * s8) * 144 + t * 2;
#pragma unroll
      for (int j = 0; j < 8; ++j) { *(LAS bf16*)(vt + (2 * j) * 144) = (bf16)(vw[j] & 0xffffu); *(LAS bf16*)(vt + (2 * j + 1) * 144) = (bf16)(vw[j] >> 16); } }
    __syncthreads();
    { const int d = c.tid & 63, seg = c.tid >> 6; float v[8]; float run = 0.f;
#pragma unroll
      for (int j = 0; j < 8; ++j) { run += BCl[(8 * seg + j) * 64 + d]; v[j] = run; }
      SEG[seg * 64 + d] = run;
      __syncthreads();
      float off = 0.f;
#pragma unroll
      for (int q = 0; q < 7; ++q) off += (q < seg) ? SEG[q * 64 + d] : 0.f;
#pragma unroll
      for (int j = 0; j < 8; ++j) BCl[(8 * seg + j) * 64 + d] = v[j] + off; }
    __syncthreads();
    { float bcv[8];
#pragma unroll
      for (int j = 0; j < 8; ++j) { const int d = s8 * 8 + j; const float bc = BCl[t * 64 + d], bl = BCl[63 * 64 + d]; bcv[j] = bc;
          *(LAS bf16*)(KEt + d * 144 + t * 2) = (bf16)f2bf(kk[j] * __expf(bl - bc)); }
      float* bp = BCg + (size_t)(row0 + t) * 256 + h * 64 + s8 * 8;
      *(f32x4*)bp = (f32x4){bcv[0], bcv[1], bcv[2], bcv[3]}; *(f32x4*)(bp + 4) = (f32x4){bcv[4], bcv[5], bcv[6], bcv[7]};
      if (c.tid < 64) DEC[(size_t)u * 64 + c.tid] = __expf(BCl[63 * 64 + c.tid]); }
    __syncthreads();
    { const int r16 = c.lane & 15, q4 = c.lane >> 4, w = c.wave;
      bf16x8 vb[2];
#pragma unroll
      for (int ks = 0; ks < 2; ++ks) vb[ks] = *(const LAS bf16x8*)(VT + (16 * w + r16) * 144 + (32 * ks + 8 * q4) * 2);
#pragma unroll
      for (int df = 0; df < 4; ++df) { f32x4 acc = {0.f, 0.f, 0.f, 0.f};
#pragma unroll
          for (int ks = 0; ks < 2; ++ks) acc = mfma16(*(const LAS bf16x8*)(KEt + (16 * df + r16) * 144 + (32 * ks + 8 * q4) * 2), vb[ks], acc);
          float* dp = DS + (size_t)u * 8192 + (size_t)(16 * df + 4 * q4) * 128 + 16 * w + r16;
#pragma unroll
          for (int i = 0; i < 4; ++i) dp[i * 128] = acc[i]; } }
    __syncthreads();
}
DI void gla2_scan(const Ctx& c, float* DS, const float* DEC) {
    for (int el = c.vcu * 512 + c.tid; el < 8 * 64 * 128; el += c.G * 512) {
        const int bh = el >> 13, d = (el >> 7) & 63, e = el & 127; float S = 0.f;
        float* p0 = DS + (size_t)(bh * 128) * 8192 + d * 128 + e; const float* q0 = DEC + (size_t)(bh * 128) * 64 + d;
        for (int n0 = 0; n0 < 128; n0 += 16) {
            float ds[16], dc[16];
#pragma unroll
            for (int j = 0; j < 16; ++j) { ds[j] = p0[(size_t)(n0 + j) * 8192]; dc[j] = q0[(n0 + j) * 64]; }
#pragma unroll
            for (int j = 0; j < 16; ++j) { p0[(size_t)(n0 + j) * 8192] = S; S = dc[j] * S + ds[j]; }
        }
    }
}
DI bf16x8 pack8(const f32x4 a, const f32x4 b) { v4u w; w.x = pk2(a[0], a[1]); w.y = pk2(a[2], a[3]); w.z = pk2(b[0], b[1]); w.w = pk2(b[2], b[3]); return __builtin_bit_cast(bf16x8, w); }
DI void gla3_unit(const Ctx& c, int u, const bf16* PROJ, const float* BCg, const float* DS, const float* gnorm, bf16* CAT) {
    const int n = u & 127, bh = u >> 7, h = bh & 3, b = bh >> 2, row0 = b * SEQ + n * 64;
    LAS unsigned char* QD = c.lds; LAS unsigned char* KI = QD + 9216; LAS unsigned char* VT = KI + 9216; LAS unsigned char* SPT = VT + 18432; LAS float* PART = (LAS float*)(SPT + 18432);
    { const int t = c.tid >> 3, s8 = c.tid & 7; const bf16* prow = PROJ + (size_t)(row0 + t) * PROJW;
      float q[8], k[8]; unpack8(*(const v4u*)(prow + h * 64 + s8 * 8), q); unpack8(*(const v4u*)(prow + 256 + h * 64 + s8 * 8), k);
      const float* bp = BCg + (size_t)(row0 + t) * 256 + h * 64 + s8 * 8; const f32x4 b0 = *(const f32x4*)bp, b1 = *(const f32x4*)(bp + 4);
      const float bc[8] = {b0.x, b0.y, b0.z, b0.w, b1.x, b1.y, b1.z, b1.w};
#pragma unroll
      for (int j = 0; j < 8; ++j) { q[j] = q[j] * 0.125f * __expf(bc[j]); k[j] = k[j] * __expf(-bc[j]); }
      v4u wq, wk; wq.x = pk2(q[0], q[1]); wq.y = pk2(q[2], q[3]); wq.z = pk2(q[4], q[5]); wq.w = pk2(q[6], q[7]); wk.x = pk2(k[0], k[1]); wk.y = pk2(k[2], k[3]); wk.z = pk2(k[4], k[5]); wk.w = pk2(k[6], k[7]);
      *(LAS v4u*)(QD + t * 144 + s8 * 16) = wq; *(LAS v4u*)(KI + t * 144 + s8 * 16) = wk;
      const v4u v0 = *(const v4u*)(prow + 512 + h * 128 + s8 * 16), v1 = *(const v4u*)(prow + 512 + h * 128 + s8 * 16 + 8);
      const unsigned vw[8] = {v0.x, v0.y, v0.z, v0.w, v1.x, v1.y, v1.z, v1.w};
      LAS unsigned char* vt = VT + (16 * s8) * 144 + t * 2;
#pragma unroll
      for (int j = 0; j < 8; ++j) { *(LAS bf16*)(vt + (2 * j) * 144) = (bf16)(vw[j] & 0xffffu); *(LAS bf16*)(vt + (2 * j + 1) * 144) = (bf16)(vw[j] >> 16); }
      const int d = t; const f32x4* sp = (const f32x4*)(DS + (size_t)u * 8192 + d * 128 + s8 * 16);
      LAS unsigned char* st = SPT + (16 * s8) * 144 + d * 2;
#pragma unroll
      for (int i = 0; i < 4; ++i) { const f32x4 x = sp[i];
#pragma unroll
          for (int j = 0; j < 4; ++j) *(LAS bf16*)(st + (4 * i + j) * 144) = (bf16)f2bf(x[j]); } }
    __syncthreads();
    const int r16 = c.lane & 15, q4 = c.lane >> 4, w = c.wave;
    bf16x8 qd[4][2];
#pragma unroll
    for (int tf = 0; tf < 4; ++tf)
#pragma unroll
        for (int ks = 0; ks < 2; ++ks) qd[tf][ks] = *(const LAS bf16x8*)(QD + (16 * tf + r16) * 144 + (32 * ks + 8 * q4) * 2);
    f32x4 sc[4][4];
#pragma unroll
    for (int sf = 0; sf < 4; ++sf) {
        bf16x8 ki[2];
#pragma unroll
        for (int ks = 0; ks < 2; ++ks) ki[ks] = *(const LAS bf16x8*)(KI + (16 * sf + r16) * 144 + (32 * ks + 8 * q4) * 2);
#pragma unroll
        for (int tf = 0; tf < 4; ++tf) {
            f32x4 a = {0.f, 0.f, 0.f, 0.f};
            if (sf <= tf) {
#pragma unroll
                for (int ks = 0; ks < 2; ++ks) a = mfma16(ki[ks], qd[tf][ks], a);
                if (sf == tf) {
#pragma unroll
                    for (int i = 0; i < 4; ++i) a[i] = (4 * q4 + i <= r16) ? a[i] : 0.f;
                }
            }
            sc[sf][tf] = a;
        }
    }
    f32x4 o[4];
#pragma unroll
    for (int tf = 0; tf < 4; ++tf) o[tf] = (f32x4){0.f, 0.f, 0.f, 0.f};
    const LAS unsigned char* vrow = VT + (16 * w + r16) * 144; const LAS unsigned char* srow = SPT + (16 * w + r16) * 144;
#pragma unroll
    for (int kk = 0; kk < 2; ++kk) {
        const v2u lo = *(const LAS v2u*)(vrow + (32 * kk + 4 * q4) * 2), hi = *(const LAS v2u*)(vrow + (32 * kk + 16 + 4 * q4) * 2);
        v4u aw; aw.x = lo.x; aw.y = lo.y; aw.z = hi.x; aw.w = hi.y; const bf16x8 a = __builtin_bit_cast(bf16x8, aw);
#pragma unroll
        for (int tf = 0; tf < 4; ++tf) if (2 * kk <= tf) o[tf] = mfma16(a, pack8(sc[2 * kk][tf], sc[2 * kk + 1][tf]), o[tf]);
    }
#pragma unroll
    for (int ks = 0; ks < 2; ++ks) { const bf16x8 a = *(const LAS bf16x8*)(srow + (32 * ks + 8 * q4) * 2);
#pragma unroll
        for (int tf = 0; tf < 4; ++tf) o[tf] = mfma16(a, qd[tf][ks], o[tf]); }
#pragma unroll
    for (int tf = 0; tf < 4; ++tf) { float ssq = (o[tf][0] * o[tf][0] + o[tf][1] * o[tf][1]) + (o[tf][2] * o[tf][2] + o[tf][3] * o[tf][3]);
        ssq += __shfl_xor(ssq, 16); ssq += __shfl_xor(ssq, 32); if (q4 == 0) PART[w * 64 + 16 * tf + r16] = ssq; }
    __syncthreads();
    const f32x4 gg = *(const f32x4*)(gnorm + 16 * w + 4 * q4);
#pragma unroll
    for (int tf = 0; tf < 4; ++tf) { const int t = 16 * tf + r16; float ssq = 0.f;
#pragma unroll
        for (int ww = 0; ww < 8; ++ww) ssq += PART[ww * 64 + t];
        const float rn = rsqrtf(ssq * (1.0f / 128.0f) + EPS);
        const v2u rv = *(const v2u*)(PROJ + (size_t)(row0 + t) * PROJW + 1024 + h * 128 + 16 * w + 4 * q4);
        const float rr[4] = {bflo(rv.x), bfhi(rv.x), bflo(rv.y), bfhi(rv.y)}; float res[4];
#pragma unroll
        for (int i = 0; i < 4; ++i) res[i] = o[tf][i] * rn * gg[i] * (rr[i] * __builtin_amdgcn_rcpf(1.0f + __expf(-rr[i])));
        v2u ow; ow.x = pk2(res[0], res[1]); ow.y = pk2(res[2], res[3]);
        *(v2u*)(CAT + (size_t)(row0 + t) * 1024 + h * 128 + 16 * w + 4 * q4) = ow; }
    __syncthreads();
}

DI void s5_params(const Ctx& c, const float* lam_re, const float* lam_im, const float* log_dt, const float* B_re, const float* B_im, float* P) {
    for (int idx = c.vcu * 512 + c.tid; idx < 2 * 32 * 64; idx += c.G * 512) {
        const float lr = fminf(lam_re[idx], -1e-4f), li = lam_im[idx], dt = expf(log_dt[idx >> 6]);
        const float mag = expf(lr * dt), ar = mag * cosf(li * dt), ai = mag * sinf(li * dt);
        const float den = lr * lr + li * li, nr = ar - 1.0f, fre = (nr * lr + ai * li) / den, fim = (ai * lr - nr * li) / den;
        P[S5P_A + 2 * idx] = ar; P[S5P_A + 2 * idx + 1] = ai;
        float tr = ar, ti = ai;
#pragma unroll
        for (int s = 0; s < 6; ++s) { const float nr2 = tr * tr - ti * ti, ni2 = 2.0f * tr * ti; tr = nr2; ti = ni2; }
        P[S5P_AT + 2 * idx] = tr; P[S5P_AT + 2 * idx + 1] = ti;
        bf16* BBH = (bf16*)(P + S5P_BBH); const int eg = idx >> 6, pp = idx & 63;
        for (int cc = 0; cc < 16; ++cc) { const float Br = B_re[idx * 16 + cc], Bi = B_im[idx * 16 + cc]; const float br = fre * Br - fim * Bi, bi = fre * Bi + fim * Br;
            P[S5P_BB + 2 * (idx * 16 + cc)] = br; P[S5P_BB + 2 * (idx * 16 + cc) + 1] = bi;
            BBH[(eg * 128 + pp) * 16 + cc] = (bf16)f2bf(br); BBH[(eg * 128 + 64 + pp) * 16 + cc] = (bf16)f2bf(bi); }
    }
}
DI void s5_load_u(const bf16* PROJ, int row0, int g, LAS float* U, int lane) {
    const bf16* p = PROJ + (size_t)(row0 + lane) * PROJW + 1792 + g * 16; float x[8];
    unpack8(*(const v4u*)p, x); ((LAS f32x4*)(U + lane * 16))[0] = (f32x4){x[0], x[1], x[2], x[3]}; ((LAS f32x4*)(U + lane * 16))[1] = (f32x4){x[4], x[5], x[6], x[7]};
    unpack8(*(const v4u*)(p + 8), x); ((LAS f32x4*)(U + lane * 16))[2] = (f32x4){x[0], x[1], x[2], x[3]}; ((LAS f32x4*)(U + lane * 16))[3] = (f32x4){x[4], x[5], x[6], x[7]};
}
DI void s5_frags(const bf16* PROJ, const float* P, int e, int g, int row0, int r16, int q4, bf16x8 (&ua)[4], bf16x8 (&bb)[8]) {
    const bf16x8 zf = {0, 0, 0, 0, 0, 0, 0, 0}; const bf16* BBH = (const bf16*)(P + S5P_BBH);
#pragma unroll
    for (int tf = 0; tf < 4; ++tf) ua[tf] = (q4 < 2) ? *(const bf16x8*)(PROJ + (size_t)(row0 + 16 * tf + r16) * PROJW + 1792 + g * 16 + 8 * q4) : zf;
#pragma unroll
    for (int pf = 0; pf < 8; ++pf) bb[pf] = (q4 < 2) ? *(const bf16x8*)(BBH + ((size_t)(e * 32 + g) * 128 + 16 * pf + r16) * 16 + 8 * q4) : zf;
}
DI void s5_bu16(const bf16x8 ua, const bf16x8 (&bb)[8], LAS float* BUs, int r16, int q4) {
    LAS float* wp = BUs + (4 * q4) * 128 + r16;
#pragma unroll
    for (int pf = 0; pf < 8; ++pf) { const f32x4 d = mfma16(ua, bb[pf], (f32x4){0.f, 0.f, 0.f, 0.f});
#pragma unroll
        for (int i = 0; i < 4; ++i) wp[i * 128 + 16 * pf] = d[i]; }
}
#define S5_BU(t) do { const LAS f32x4* up_ = (const LAS f32x4*)(U + (t) * 16); const f32x4 u0 = up_[0], u1 = up_[1], u2 = up_[2], u3 = up_[3]; \
    const float uu[16] = {u0.x, u0.y, u0.z, u0.w, u1.x, u1.y, u1.z, u1.w, u2.x, u2.y, u2.z, u2.w, u3.x, u3.y, u3.z, u3.w}; bur = 0.f; bui = 0.f; \
    _Pragma("unroll") for (int cc = 0; cc < 16; ++cc) { bur += bbr[cc] * uu[cc]; bui += bbi[cc] * uu[cc]; } } while (0)
DI void s5_phase1(const Ctx& c, int e, const bf16* PROJ, const float* P, float* S5E) {
    LAS float* U = (LAS float*)(c.lds + c.wave * 4096);
    const int NGW = c.G * 8, gw = c.vcu * 8 + c.wave;
    const bool reg = (NGW == 2 * 32 * S5NC / 4);
    int gcur = -1; float ar = 0.f, ai = 0.f, bbr[16], bbi[16];
#pragma unroll
    for (int cc = 0; cc < 16; ++cc) { bbr[cc] = 0.f; bbi[cc] = 0.f; }
    for (int it = 0;; ++it) {
        int wt; if (reg) { if (it >= 4) break; wt = (gw >> 5) * S5NC + (gw & 31) + 32 * it; } else { wt = gw + it * NGW; if (wt >= 2 * 32 * S5NC) break; }
        const int cch = wt & (S5NC - 1), bg = wt >> 7, g = bg & 31, b = bg >> 5, row0 = b * SEQ + cch * S5T, pi = (e * 32 + g) * 64 + c.lane;
        s5_load_u(PROJ, row0, g, U, c.lane);
        if (g != gcur) { gcur = g; ar = P[S5P_A + 2 * pi]; ai = P[S5P_A + 2 * pi + 1];
#pragma unroll
            for (int cc = 0; cc < 16; ++cc) { bbr[cc] = P[S5P_BB + 2 * (pi * 16 + cc)]; bbi[cc] = P[S5P_BB + 2 * (pi * 16 + cc) + 1]; } }
        LDS_WAIT();
        float xr = 0.f, xi = 0.f, bur, bui;
        for (int t = 0; t < S5T; ++t) { S5_BU(t); const float nxr = ar * xr - ai * xi + bur, nxi = ar * xi + ai * xr + bui; xr = nxr; xi = nxi; }
        *(f32x2*)(S5E + 2 * ((size_t)wt * 64 + c.lane)) = (f32x2){xr, xi};
        LDS_WAIT();
    }
}
DI void s5_phase2(const Ctx& c, int e, const float* P, float* S5E) {
    for (int sq = (c.G - 1 - c.vcu) * 512 + c.tid; sq < 2 * 32 * 64; sq += c.G * 512) {
        const int p = sq & 63, bg = sq >> 6, g = bg & 31, pi = (e * 32 + g) * 64 + p; const float tr = P[S5P_AT + 2 * pi], ti = P[S5P_AT + 2 * pi + 1];
        float xr = 0.f, xi = 0.f; f32x2* q0 = (f32x2*)(S5E + 2 * (((size_t)bg * S5NC) * 64 + p));
        for (int c0 = 0; c0 < S5NC; c0 += 16) {
            f32x2 ev[16];
#pragma unroll
            for (int j = 0; j < 16; ++j) ev[j] = q0[(c0 + j) * 64];
#pragma unroll
            for (int j = 0; j < 16; ++j) { q0[(c0 + j) * 64] = (f32x2){xr, xi}; const float nxr = tr * xr - ti * xi + ev[j].x, nxi = tr * xi + ti * xr + ev[j].y; xr = nxr; xi = nxi; }
        }
    }
}
DI void s5_phase3(const Ctx& c, int e, const bf16* PROJ, const float* P, const float* S5E, const float* C_re, const float* C_im, const float* Dp, bf16* Y) {
    LAS float* BUs = (LAS float*)(c.lds + c.wave * 12544);
    LAS unsigned char* XB = c.lds + c.wave * 12544 + 8192;
    const int NGW = c.G * 8, gw = c.vcu * 8 + c.wave; const int r16 = c.lane & 15, q4 = c.lane >> 4;
    const bool reg = (NGW == 2 * 32 * S5NC / 4);
    const bf16x8 zf = {0, 0, 0, 0, 0, 0, 0, 0};
    int gcur = -1; float ar = 0.f, ai = 0.f, Dg = 0.f; bf16x8 bb[8], cf[4];
#pragma unroll
    for (int pf = 0; pf < 8; ++pf) bb[pf] = zf;
#pragma unroll
    for (int ks = 0; ks < 4; ++ks) cf[ks] = zf;
    for (int it = 0;; ++it) {
        int wt; if (reg) { if (it >= 4) break; wt = (gw >> 5) * S5NC + (gw & 31) + 32 * it; } else { wt = gw + it * NGW; if (wt >= 2 * 32 * S5NC) break; }
        const int cch = wt & (S5NC - 1), bg = wt >> 7, g = bg & 31, b = bg >> 5, row0 = b * SEQ + cch * S5T, pi = (e * 32 + g) * 64 + c.lane;
        bf16x8 ua[4];
#pragma unroll
        for (int tf = 0; tf < 4; ++tf) ua[tf] = (q4 < 2) ? *(const bf16x8*)(PROJ + (size_t)(row0 + 16 * tf + r16) * PROJW + 1792 + g * 16 + 8 * q4) : zf;
        if (g != gcur) { gcur = g;
            const bf16* BBH = (const bf16*)(P + S5P_BBH);
#pragma unroll
            for (int pf = 0; pf < 8; ++pf) bb[pf] = (q4 < 2) ? *(const bf16x8*)(BBH + ((size_t)(e * 32 + g) * 128 + 16 * pf + r16) * 16 + 8 * q4) : zf;
            ar = P[S5P_A + 2 * pi]; ai = P[S5P_A + 2 * pi + 1];
            const size_t gi = ((size_t)(e * 32 + g) * 16 + r16) * 64 + 8 * q4;
#pragma unroll
            for (int ks = 0; ks < 4; ++ks) { const float* src = (ks < 2 ? C_re : C_im) + gi + 32 * (ks & 1); const float sg = ks < 2 ? 1.0f : -1.0f;
                const f32x4 x0 = *(const f32x4*)src, x1 = *(const f32x4*)(src + 4); cf[ks] = pack8(x0 * sg, x1 * sg); }
            Dg = Dp[(e * 32 + g) * 16 + r16]; }
        const f32x2 x0 = *(const f32x2*)(S5E + 2 * ((size_t)wt * 64 + c.lane));
        float xr = x0.x, xi = x0.y;
#pragma unroll
        for (int sc = 0; sc < 4; ++sc) {
            s5_bu16(ua[sc], bb, BUs, r16, q4);
            LDS_WAIT();
#pragma unroll
            for (int tt = 0; tt < 16; ++tt) { const float bur = BUs[tt * 128 + c.lane], bui = BUs[tt * 128 + 64 + c.lane]; const float nxr = ar * xr - ai * xi + bur, nxi = ar * xi + ai * xr + bui; xr = nxr; xi = nxi;
                *(LAS bf16*)(XB + tt * 272 + c.lane * 2) = (bf16)f2bf(xr); *(LAS bf16*)(XB + tt * 272 + 128 + c.lane * 2) = (bf16)f2bf(xi); }
            LDS_WAIT();
            f32x4 y = {0.f, 0.f, 0.f, 0.f};
#pragma unroll
            for (int ks = 0; ks < 4; ++ks) y = mfma16(*(const LAS bf16x8*)(XB + r16 * 272 + (32 * ks + 8 * q4) * 2), cf[ks], y);
#pragma unroll
            for (int i = 0; i < 4; ++i) { const int t = sc * 16 + 4 * q4 + i; const float yy = y[i] + Dg * bf2f(PROJ[(size_t)(row0 + t) * PROJW + 1792 + g * 16 + r16]);
                const float z = 0.7978845608f * (yy + 0.044715f * yy * yy * yy); const float th = 1.0f - 2.0f * __builtin_amdgcn_rcpf(__expf(2.0f * z) + 1.0f);
                Y[(size_t)(row0 + t) * 512 + g * 16 + r16] = (bf16)f2bf(0.5f * yy * (1.0f + th)); }
            LDS_WAIT();
        }
    }
}

constexpr int XA_KSLOT = 256 * 144, XA_VSLOT = 64 * 528, XA_VOFF = 2 * XA_KSLOT;
DI void xattn_unit(const Ctx& c, int uidx, int layer, const bf16* XQ, const bf16* MK, const bf16* MVT, bf16* XO) {
    const int h = uidx & 3, tile = uidx >> 2, b = tile >> 5, row0 = tile * 256;
    LAS unsigned char* KS = c.lds; LAS unsigned char* VS = c.lds + XA_VOFF;
    const int r16 = c.lane & 15, q4 = c.lane >> 4, w = c.wave;
    const bf16* kg = MK + (size_t)(b * 256) * 4096 + layer * 1024 + h * 256;
    const bf16* vg = MVT + (size_t)(layer * 1024 + h * 256) * 512 + b * 256;
    v4u st[4];
#define XA_LOADK(dc_) do { _Pragma("unroll") for (int i = 0; i < 4; ++i) { const int idx = c.tid + 512 * i; st[i] = *(const v4u*)(kg + (size_t)(idx >> 3) * 4096 + (dc_) * 64 + (idx & 7) * 8); } } while (0)
#define XA_STOREK(slot_) do { _Pragma("unroll") for (int i = 0; i < 4; ++i) { const int idx = c.tid + 512 * i; *(LAS v4u*)(KS + (slot_) * XA_KSLOT + (idx >> 3) * 144 + (idx & 7) * 16) = st[i]; } } while (0)
#define XA_LOADV(dc_) do { _Pragma("unroll") for (int i = 0; i < 4; ++i) { const int idx = c.tid + 512 * i; st[i] = *(const v4u*)(vg + (size_t)((dc_) * 64 + (idx >> 5)) * 512 + (idx & 31) * 8); } } while (0)
#define XA_STOREV(slot_) do { _Pragma("unroll") for (int i = 0; i < 4; ++i) { const int idx = c.tid + 512 * i; *(LAS v4u*)(VS + (slot_) * XA_VSLOT + (idx >> 5) * 528 + (idx & 31) * 16) = st[i]; } } while (0)
    __syncthreads();
    XA_LOADK(0); XA_STOREK(0);
    __syncthreads();
    f32x4 sa[16][2];
#pragma unroll
    for (int mf = 0; mf < 16; ++mf) { sa[mf][0] = (f32x4){0.f, 0.f, 0.f, 0.f}; sa[mf][1] = sa[mf][0]; }
    const bf16* qg = XQ + (size_t)(row0 + 32 * w + r16) * 1024 + h * 256 + 8 * q4;
#pragma unroll 1
    for (int dc = 0; dc < 4; ++dc) {
        bf16x8 qf[2][2];
#pragma unroll
        for (int tf = 0; tf < 2; ++tf)
#pragma unroll
            for (int ks = 0; ks < 2; ++ks) qf[tf][ks] = *(const bf16x8*)(qg + (size_t)(16 * tf) * 1024 + dc * 64 + ks * 32);
        if (dc < 3) XA_LOADK(dc + 1); else XA_LOADV(0);
        const LAS unsigned char* kc = KS + (dc & 1) * XA_KSLOT + r16 * 144 + 16 * q4;
#pragma unroll
        for (int mf = 0; mf < 16; ++mf)
#pragma unroll
            for (int ks = 0; ks < 2; ++ks) { const bf16x8 a = *(const LAS bf16x8*)(kc + mf * (16 * 144) + ks * 64);
                sa[mf][0] = mfma16(a, qf[0][ks], sa[mf][0]); sa[mf][1] = mfma16(a, qf[1][ks], sa[mf][1]); }
        if (dc < 3) XA_STOREK((dc + 1) & 1); else XA_STOREV(0);
        __syncthreads();
    }
    bf16x8 pp[8][2];
#pragma unroll
    for (int tf = 0; tf < 2; ++tf) {
        float m = sa[0][tf][0];
#pragma unroll
        for (int mf = 0; mf < 16; ++mf)
#pragma unroll
            for (int i = 0; i < 4; ++i) m = fmaxf(m, sa[mf][tf][i]);
        m = fmaxf(m, __shfl_xor(m, 16)); m = fmaxf(m, __shfl_xor(m, 32));
        float l = 0.f;
#pragma unroll
        for (int mf = 0; mf < 16; ++mf)
#pragma unroll
            for (int i = 0; i < 4; ++i) { const float p = __expf(sa[mf][tf][i] - m); sa[mf][tf][i] = p; l += p; }
        l += __shfl_xor(l, 16); l += __shfl_xor(l, 32);
        const float inv = 1.0f / l;
#pragma unroll
        for (int kk = 0; kk < 8; ++kk) pp[kk][tf] = pack8(sa[2 * kk][tf] * inv, sa[2 * kk + 1][tf] * inv);
    }
    bf16* og = XO + (size_t)(row0 + 32 * w + r16) * 1024 + h * 256 + 4 * q4;
#pragma unroll 1
    for (int dc = 0; dc < 4; ++dc) {
        if (dc < 3) XA_LOADV(dc + 1);
        f32x4 o[4][2];
#pragma unroll
        for (int df = 0; df < 4; ++df) { o[df][0] = (f32x4){0.f, 0.f, 0.f, 0.f}; o[df][1] = o[df][0]; }
        const LAS unsigned char* vc = VS + (dc & 1) * XA_VSLOT + r16 * 528 + 8 * q4;
#pragma unroll
        for (int kk = 0; kk < 8; ++kk)
#pragma unroll
            for (int df = 0; df < 4; ++df) { const v2u lo = *(const LAS v2u*)(vc + df * (16 * 528) + kk * 64), hi = *(const LAS v2u*)(vc + df * (16 * 528) + kk * 64 + 32);
                v4u aw; aw.x = lo.x; aw.y = lo.y; aw.z = hi.x; aw.w = hi.y; const bf16x8 a = __builtin_bit_cast(bf16x8, aw);
                o[df][0] = mfma16(a, pp[kk][0], o[df][0]); o[df][1] = mfma16(a, pp[kk][1], o[df][1]); }
#pragma unroll
        for (int tf = 0; tf < 2; ++tf)
#pragma unroll
            for (int df = 0; df < 4; ++df) { v2u ow; ow.x = pk2(o[df][tf][0], o[df][tf][1]); ow.y = pk2(o[df][tf][2], o[df][tf][3]); *(v2u*)(og + (size_t)(16 * tf) * 1024 + dc * 64 + 16 * df) = ow; }
        if (dc < 3) { XA_STOREV((dc + 1) & 1); __syncthreads(); }
    }
#undef XA_LOADK
#undef XA_STOREK
#undef XA_LOADV
#undef XA_STOREV
}

DI void rope_row(bf16* prow, const float* cA, const float* sA, const float* cI, const float* sI, int lane) {
    int c1[15], hf[15]; float x1[15], x2[15], cs[15], sn[15], sc[15];
#pragma unroll
    for (int k = 0; k < 15; ++k) {
        const int pi = lane + 64 * k; int i; bool tabA; sc[k] = 1.0f;
        if (pi < 512) { i = pi & 63; c1[k] = (pi >> 6) * 128 + i; hf[k] = 64; tabA = true; sc[k] = 0.08838834764831845f; }
        else if (pi < 640) { const int pp = pi - 512; i = pp & 63; c1[k] = 1024 + (pp >> 6) * 128 + i; hf[k] = 64; tabA = true; }
        else if (pi < 896) { const int pp = pi - 640; i = pp & 31; c1[k] = 1536 + (pp >> 5) * 64 + i; hf[k] = 32; tabA = false; }
        else { i = (pi - 896) & 31; c1[k] = 2048 + i; hf[k] = 32; tabA = false; }
        cs[k] = tabA ? cA[i] : cI[i]; sn[k] = tabA ? sA[i] : sI[i];
        x1[k] = bf2f(prow[c1[k]]); x2[k] = bf2f(prow[c1[k] + hf[k]]);
    }
#pragma unroll
    for (int k = 0; k < 15; ++k) { if (lane + 64 * k < 928) { prow[c1[k]] = (bf16)f2bf((x1[k] * cs[k] - x2[k] * sn[k]) * sc[k]); prow[c1[k] + hf[k]] = (bf16)f2bf((x2[k] * cs[k] + x1[k] * sn[k]) * sc[k]); } }
}
DI unsigned wave_select(LAS unsigned* buf, int count, int lane) {
    unsigned k[16];
#pragma unroll
    for (int j = 0; j < 16; ++j) { const int idx = j * 64 + lane; k[j] = idx < count ? buf[idx] : 0u; }
    unsigned tau = 0u;
    for (int bit = 31; bit >= 0; --bit) { const unsigned cand = tau | (1u << bit); int cn = 0;
#pragma unroll
        for (int j = 0; j < 16; ++j) cn += __popcll(__ballot(k[j] >= cand));
        if (cn >= TOPK) tau = cand;
        if (cn == TOPK) break; }
    int off = 0; const unsigned long long lt = (1ull << lane) - 1ull;
#pragma unroll
    for (int j = 0; j < 16; ++j) { const bool pred = k[j] >= tau; const unsigned long long bal = __ballot(pred); if (pred) buf[off + __popcll(bal & lt)] = k[j]; off += __popcll(bal); }
    LDS_WAIT();
    return tau;
}
constexpr int IDX_KT = 131072, IDX_KT_SLOT = 64 * 144, IDX_FL = IDX_KT + 2 * IDX_KT_SLOT;
#define IDX_BODY(slot_, kb_) do { \
    bf16x8 R[4][2]; \
    _Pragma("unroll") for (int jb = 0; jb < 4; ++jb) _Pragma("unroll") for (int ks = 0; ks < 2; ++ks) R[jb][ks] = *(const LAS bf16x8*)((slot_) + (16 * jb + r16) * 144 + (ks * 32 + 8 * q4) * 2); \
    f32x4 lo_[4], hi_[4]; \
    _Pragma("unroll") for (int jb = 0; jb < 4; ++jb) { lo_[jb] = (f32x4){0.f, 0.f, 0.f, 0.f}; hi_[jb] = lo_[jb]; \
        _Pragma("unroll") for (int ks = 0; ks < 2; ++ks) { lo_[jb] = mfma16(Alo[ks], R[jb][ks], lo_[jb]); hi_[jb] = mfma16(Ahi[ks], R[jb][ks], hi_[jb]); } } \
    const int rev0_ = 8191 - r16 - 16 * (kb_); \
    _Pragma("unroll") for (int jb = 0; jb < 4; ++jb) { \
        float s0_ = 0.f, s1_ = 0.f; \
        _Pragma("unroll") for (int i = 0; i < 4; ++i) { s0_ = fmaf(__int_as_float(max(__float_as_int(lo_[jb][i]), 0)), w[i], s0_); s1_ = fmaf(__int_as_float(max(__float_as_int(hi_[jb][i]), 0)), w[4 + i], s1_); } \
        const unsigned u_ = __float_as_uint(s0_ + s1_), mono_ = u_ ^ ((unsigned)((int)u_ >> 31) | 0x80000000u); \
        const int rev_ = rev0_ - 16 * jb; const unsigned key_ = (mono_ & 0xFFFFE000u) | (unsigned)rev_; \
        const bool pred_ = (rev_ >= revq) && (key_ > tau); \
        const unsigned long long bal_ = __ballot(pred_); const unsigned grp_ = (unsigned)(bal_ >> (16 * q4)) & 0xFFFFu; \
        if (MODE == 0) { if (pred_) mybuf[cnt + __popc(grp_ & lmask)] = key_; cnt += __popc(grp_); } else { chk ^= key_ & (pred_ ? 0xffffffffu : 0x0fu); } } } while (0)
template <int MODE> DI void dsa_index_unit(const Ctx& c, int uidx, const bf16* PROJ, unsigned short* SEL, int* SELN) {
    const int pr = uidx & 255, b = pr >> 7, jj = pr & 127, qblk = uidx < 256 ? jj : 255 - jj, t0 = qblk * 32;
    LAS unsigned* CAND = (LAS unsigned*)c.lds;
    LAS unsigned char* KT = c.lds + IDX_KT; LAS unsigned* FL = (LAS unsigned*)(c.lds + IDX_FL);
    const int r16 = c.lane & 15, q4 = c.lane >> 4;
    const bf16* qrowA = PROJ + (size_t)(b * SEQ + t0 + 4 * c.wave + (r16 >> 2)) * PROJW + 1536 + 8 * q4;
    bf16x8 Alo[2], Ahi[2];
#pragma unroll
    for (int ks = 0; ks < 2; ++ks) { Alo[ks] = *(const bf16x8*)(qrowA + (r16 & 3) * 64 + ks * 32); Ahi[ks] = *(const bf16x8*)(qrowA + ((r16 & 3) + 4) * 64 + ks * 32); }
    const int tq = t0 + 4 * c.wave + q4, revq = 8191 - tq; const unsigned lmask = (1u << r16) - 1u;
    float w[8]; unpack8(*(const v4u*)(PROJ + (size_t)(b * SEQ + tq) * PROJW + 2112), w);
#pragma unroll
    for (int j = 0; j < 8; ++j) w[j] *= 0.04419417382415922f;
    int cnt = 0; unsigned tau = 0u, chk = 0u;
    LAS unsigned* mybuf = CAND + (4 * c.wave + q4) * 1024;
    const int nit = (qblk >> 1) + 1;
    const bf16* ksrc = PROJ + (size_t)(b * SEQ + (c.tid >> 3)) * PROJW + 2048 + 8 * (c.tid & 7); const int kdst = (c.tid >> 3) * 144 + (c.tid & 7) * 16;
    __syncthreads();
    v4u pre = *(const v4u*)ksrc;
    *(LAS v4u*)(KT + kdst) = pre;
    if (nit > 1) pre = *(const v4u*)(ksrc + (size_t)64 * PROJW);
    for (int it = 0; it < nit; ++it) {
        LAS unsigned char* slot = KT + (it & 1) * IDX_KT_SLOT;
        { const unsigned long long nb = __ballot(cnt > 1024 - 64); if (c.lane == 0) FL[(it & 1) * 8 + c.wave] = nb != 0ull ? 1u : 0u; }
        __syncthreads();
        { const v4u f0 = *(const LAS v4u*)(FL + (it & 1) * 8), f1 = *(const LAS v4u*)(FL + (it & 1) * 8 + 4);
          if (MODE == 0 && (f0.x | f0.y | f0.z | f0.w | f1.x | f1.y | f1.z | f1.w)) {
#pragma unroll
              for (int g4 = 0; g4 < 4; ++g4) { const int cg = __shfl(cnt, 16 * g4); if (cg > TOPK) { const unsigned tn = wave_select(CAND + (4 * c.wave + g4) * 1024, cg, c.lane); if (q4 == g4) { tau = tn; cnt = TOPK; } } } } }
        IDX_BODY(slot, 4 * it);
        if (it + 1 < nit) { *(LAS v4u*)(KT + ((it + 1) & 1) * IDX_KT_SLOT + kdst) = pre; if (it + 2 < nit) pre = *(const v4u*)(ksrc + (size_t)(64 * (it + 2)) * PROJW); }
    }
    LDS_WAIT();
    if (MODE != 0) { if (chk == 0x12345u) SELN[uidx] = (int)chk; return; }
#pragma unroll
    for (int g4 = 0; g4 < 4; ++g4) {
        int cg = __shfl(cnt, 16 * g4); LAS unsigned* bufg = CAND + (4 * c.wave + g4) * 1024;
        if (cg > TOPK) { (void)wave_select(bufg, cg, c.lane); cg = TOPK; }
        const size_t qg = (size_t)(b * SEQ + t0 + 4 * c.wave + g4);
#pragma unroll
        for (int i = 0; i < 4; ++i) { const int slot = c.lane + 64 * i; if (slot < cg) SEL[qg * 256 + slot] = (unsigned short)(8191u - (bufg[slot] & 0x1FFFu)); }
        if (c.lane == 0) SELN[qg] = cg;
    }
    LDS_WAIT();
}
#define SB() __builtin_amdgcn_sched_barrier(0)
DI f32x4 mfma8(const v2u a, const v2u b, const f32x4 c) { return __builtin_amdgcn_mfma_f32_16x16x32_fp8_fp8(__builtin_bit_cast(long, a), __builtin_bit_cast(long, b), c, 0, 0, 0); }
#define DSA_QS 32.0f
#define DSA_RDW(pb_, tv_) asm volatile("s_waitcnt lgkmcnt(0)" : "+v"(pb_), "+v"(tv_[0]), "+v"(tv_[1]), "+v"(tv_[2]), "+v"(tv_[3]), "+v"(tv_[4]), "+v"(tv_[5]), "+v"(tv_[6]), "+v"(tv_[7]) : : "memory")
#define DSA_VWAIT(n) asm volatile("s_waitcnt vmcnt(" #n ")" ::: "memory")
#define DSA3_WS 17152
#define DSA3_KLD(dst_, off_, imm_, kb_) asm volatile("global_load_dwordx4 %0, %1, %2 offset:" #imm_ : "=&v"(dst_) : "v"(off_), "s"(kb_) : "memory")
#define DSA3_LOADK(dst, blk) do { const unsigned koff_ = kix[blk] * 128u + kofs; DSA3_KLD(dst[0][0], koff_, 0, k8g0); DSA3_KLD(dst[0][1], koff_, 64, k8g0); DSA3_KLD(dst[1][0], koff_, 0, k8g1); DSA3_KLD(dst[1][1], koff_, 64, k8g1); } while (0)
#define DSA3_KWAIT(n, dst) asm volatile("s_waitcnt vmcnt(" #n ")" : "+v"(dst[0][0]), "+v"(dst[0][1]), "+v"(dst[1][0]), "+v"(dst[1][1]) : : "memory")
#define DSA3_KPERM(dst) do { _Pragma("unroll") for (int kvi = 0; kvi < 2; ++kvi) _Pragma("unroll") for (int hf = 0; hf < 2; ++hf) { v4u w_ = dst[kvi][hf]; \
    w_.x = (unsigned)__builtin_amdgcn_ds_bpermute(kperm, (int)w_.x); w_.y = (unsigned)__builtin_amdgcn_ds_bpermute(kperm, (int)w_.y); w_.z = (unsigned)__builtin_amdgcn_ds_bpermute(kperm, (int)w_.z); w_.w = (unsigned)__builtin_amdgcn_ds_bpermute(kperm, (int)w_.w); \
    dst[kvi][hf] = w_; } } while (0)
#define DSA3_QK(blk, src) do { f32x4 a0_ = {0.f, 0.f, 0.f, 0.f}, a1_ = {0.f, 0.f, 0.f, 0.f}; \
    _Pragma("unroll") for (int ks = 0; ks < 4; ++ks) { const v4u w0_ = src[0][ks >> 1], w1_ = src[1][ks >> 1]; v2u p0_, p1_; p0_.x = (ks & 1) ? w0_.z : w0_.x; p0_.y = (ks & 1) ? w0_.w : w0_.y; p1_.x = (ks & 1) ? w1_.z : w1_.x; p1_.y = (ks & 1) ? w1_.w : w1_.y; \
        a0_ = mfma8(p0_, q2[0][ks], a0_); a1_ = mfma8(p1_, q2[1][ks], a1_); } acc[blk] = a0_ + a1_; } while (0)
#define DSA3_DMAV(u_) do { _Pragma("unroll") for (int j = 0; j < 4; ++j) \
    __builtin_amdgcn_global_load_lds((const unsigned*)((((u_) & 1) ? v8b1 : v8b0) + vix[(u_) >> 1][j] * 128u + ((j & 1) ? vsw1 : vsw0)), (LAS unsigned*)(Vb + ((u_) % 3) * 4096 + j * 1024), 16, 0, 0); } while (0)
#define DSA3_RD(pb_, tv_, soff_, poff_) asm volatile( \
    "ds_read_b64 %0, %9 offset:%19\n\tds_read_b64_tr_b8 %1, %10 offset:%18\n\tds_read_b64_tr_b8 %2, %11 offset:%18\n\tds_read_b64_tr_b8 %3, %12 offset:%18\n\tds_read_b64_tr_b8 %4, %13 offset:%18\n\t" \
    "ds_read_b64_tr_b8 %5, %14 offset:%18\n\tds_read_b64_tr_b8 %6, %15 offset:%18\n\tds_read_b64_tr_b8 %7, %16 offset:%18\n\tds_read_b64_tr_b8 %8, %17 offset:%18" \
    : "=&v"(pb_), "=&v"(tv_[0]), "=&v"(tv_[1]), "=&v"(tv_[2]), "=&v"(tv_[3]), "=&v"(tv_[4]), "=&v"(tv_[5]), "=&v"(tv_[6]), "=&v"(tv_[7]) \
    : "v"(prdA), "v"(va[0]), "v"(va[1]), "v"(va[2]), "v"(va[3]), "v"(va[4]), "v"(va[5]), "v"(va[6]), "v"(va[7]), "i"(soff_), "i"(poff_) : "memory")
#define DSA3_PV(u_) do { v2u pA_, tA_[8]; DSA3_RD(pA_, tA_, ((u_) % 3) * 4096, 32 * ((u_) >> 1)); DSA_RDW(pA_, tA_); \
    v2u pm_; pm_.x = (((u_) & 1) == mykv) ? pA_.x : 0u; pm_.y = (((u_) & 1) == mykv) ? pA_.y : 0u; \
    _Pragma("unroll") for (int nt = 0; nt < 8; ++nt) o[nt] = mfma8(tA_[nt], pm_, o[nt]); } while (0)
template <int MODE> DI void dsa_attn_item(const Ctx& c, int qg, const bf16* PROJ, const unsigned char* K8, const unsigned char* V8, const unsigned short* SEL, const int* SELN, bf16* AO) {
    typedef const __attribute__((address_space(1))) char* gcp;
    LAS unsigned char* Vb = c.lds + c.wave * DSA3_WS; LAS unsigned char* Pb = Vb + 12288; LAS unsigned short* IDXw = (LAS unsigned short*)(Vb + 12288 + 4352);
    int ln = c.lane; asm volatile("" : "+v"(ln));
    const int b = qg >> 13, n = __builtin_amdgcn_readfirstlane(SELN[qg]); const int r16 = ln & 15, q4 = ln >> 4;
    { unsigned short sv[4];
#pragma unroll
      for (int i = 0; i < 4; ++i) sv[i] = SEL[(size_t)qg * 256 + ln + 64 * i];
#pragma unroll
      for (int i = 0; i < 4; ++i) { const int slot = ln + 64 * i; IDXw[slot] = slot < n ? sv[i] : (unsigned short)0; } }
    v2u q2[2][4];
#pragma unroll
    for (int ks = 0; ks < 4; ++ks) { const v4u w = *(const v4u*)(PROJ + (size_t)qg * PROJW + (r16 & 7) * 128 + 64 * (ks >> 1) + 16 * q4 + 8 * (ks & 1));
        v2u v_; v_.x = (r16 & 8) ? w.z : w.x; v_.y = (r16 & 8) ? w.w : w.y; const bool k0_ = (r16 & 4) == 0;
        q2[0][ks].x = k0_ ? v_.x : 0u; q2[0][ks].y = k0_ ? v_.y : 0u; q2[1][ks].x = k0_ ? 0u : v_.x; q2[1][ks].y = k0_ ? 0u : v_.y; }
    LDS_WAIT();
    unsigned kix[16], vix[8][4];
#pragma unroll
    for (int blk = 0; blk < 16; ++blk) kix[blk] = IDXw[16 * blk + (ln >> 2)];
#pragma unroll
    for (int cc = 0; cc < 8; ++cc)
#pragma unroll
        for (int j = 0; j < 4; ++j) vix[cc][j] = IDXw[32 * cc + 8 * j + (ln >> 3)];
    LDS_WAIT(); SB();
    const size_t pl0 = (size_t)(b * 2) * SEQ * 128, pl1 = pl0 + (size_t)SEQ * 128;
    const gcp k8g0 = (gcp)((const char*)K8 + pl0), k8g1 = (gcp)((const char*)K8 + pl1); const char* v8b0 = (const char*)V8 + pl0; const char* v8b1 = (const char*)V8 + pl1;
    const unsigned kofs = (unsigned)(16 * (ln & 3)); const int kperm = 4 * (4 * r16 + q4);
    const unsigned vsw0 = 16u * (unsigned)((ln & 7) ^ (ln >> 4)), vsw1 = 16u * (unsigned)((ln & 7) ^ ((ln >> 4) | 4));
    DSA3_DMAV(0); SB(); DSA3_DMAV(1); SB(); DSA3_DMAV(2); SB();
    f32x4 acc[16]; v4u kA[2][2], kB[2][2], kC[2][2];
    DSA3_LOADK(kA, 0); DSA3_LOADK(kB, 1); DSA3_LOADK(kC, 2); SB();
#define DSA3_STEP(blk, kk, w_) do { DSA3_KWAIT(w_, kk); SB(); DSA3_KPERM(kk); DSA3_QK(blk, kk); SB(); if ((blk) + 3 < 16) { DSA3_LOADK(kk, (blk) + 3); SB(); } } while (0)
    DSA3_STEP(0, kA, 8); DSA3_STEP(1, kB, 8); DSA3_STEP(2, kC, 8); DSA3_STEP(3, kA, 8); DSA3_STEP(4, kB, 8); DSA3_STEP(5, kC, 8); DSA3_STEP(6, kA, 8); DSA3_STEP(7, kB, 8);
    DSA3_STEP(8, kC, 8); DSA3_STEP(9, kA, 8); DSA3_STEP(10, kB, 8); DSA3_STEP(11, kC, 8); DSA3_STEP(12, kA, 8); DSA3_STEP(13, kB, 8); DSA3_STEP(14, kC, 4); DSA3_STEP(15, kA, 0);
    float m = -3.0e38f; const int nq = n - 4 * q4; const float cexp = 1.4426950408889634f / DSA_QS;
#pragma unroll
    for (int kb = 0; kb < 16; ++kb)
#pragma unroll
        for (int i = 0; i < 4; ++i) { const bool ok = (16 * kb + i) < nq; const float s_ = acc[kb][i] + __int_as_float(__builtin_amdgcn_update_dpp(0, __float_as_int(acc[kb][i]), 0x128, 0xf, 0xf, false));
            acc[kb][i] = ok ? s_ : -3.0e38f; m = fmaxf(m, acc[kb][i]); }
    m = fmaxf(m, __shfl_xor(m, 16)); m = fmaxf(m, __shfl_xor(m, 32));
    float l = 0.f; const float mc = 8.0f - m * cexp;
#pragma unroll
    for (int kb = 0; kb < 16; ++kb)
#pragma unroll
        for (int i = 0; i < 4; ++i) { const float p = __builtin_amdgcn_exp2f(fmaf(acc[kb][i], cexp, mc)); acc[kb][i] = p; l += p; }
    l += __shfl_xor(l, 16); l += __shfl_xor(l, 32);
    const float oscale = 1.0f / l;
    if (r16 < 8) {
        LAS unsigned char* pwl = Pb + 272 * r16 + 4 * q4; asm volatile("" : "+v"(pwl));
#pragma unroll
        for (int kb = 0; kb < 16; ++kb) {
            const float p0 = acc[kb][0], p1 = acc[kb][1], p2 = acc[kb][2], p3 = acc[kb][3];
            int wh = 0; wh = __builtin_amdgcn_cvt_pk_fp8_f32(p0, p1, wh, false); wh = __builtin_amdgcn_cvt_pk_fp8_f32(p2, p3, wh, true);
            const f32x2 d0 = __builtin_amdgcn_cvt_pk_f32_fp8(wh, false), d1 = __builtin_amdgcn_cvt_pk_f32_fp8(wh, true);
            int wl = 0; wl = __builtin_amdgcn_cvt_pk_fp8_f32(p0 - d0.x, p1 - d0.y, wl, false); wl = __builtin_amdgcn_cvt_pk_fp8_f32(p2 - d1.x, p3 - d1.y, wl, true);
            *(LAS int*)(pwl + 16 * kb) = wh; *(LAS int*)(pwl + 2176 + 16 * kb) = wl; }
    }
    unsigned va[8];
    { const unsigned q_ = (unsigned)(r16 >> 1), rel = 128u * (8u * (unsigned)q4 + q_) + 8u * (unsigned)(ln & 1) + 16u * ((((unsigned)q4 & 1u) << 2) | (q_ >> 1)); const unsigned vb_ = (unsigned)(size_t)Vb;
#pragma unroll
      for (int nt = 0; nt < 8; ++nt) va[nt] = vb_ + (rel ^ (16u * (unsigned)nt)); }
    const unsigned prdA = (unsigned)(size_t)(Pb + 2176 * (r16 >> 3) + 272 * (r16 & 7) + 8 * q4); const int mykv = (r16 >> 2) & 1;
    f32x4 o[8];
#pragma unroll
    for (int nt = 0; nt < 8; ++nt) o[nt] = (f32x4){0.f, 0.f, 0.f, 0.f};
    LDS_WAIT(); SB();
#pragma unroll
    for (int u = 0; u < 16; ++u) {
        if (u < 14) DSA_VWAIT(8); else if (u == 14) DSA_VWAIT(4); else DSA_VWAIT(0);
        SB(); DSA3_PV(u); SB();
        if (u + 3 < 16) { LDS_WAIT(); SB(); DSA3_DMAV(u + 3); SB(); }
    }
#pragma unroll
    for (int nt = 0; nt < 8; ++nt)
#pragma unroll
        for (int i = 0; i < 4; ++i) o[nt][i] += __int_as_float(__builtin_amdgcn_update_dpp(0, __float_as_int(o[nt][i]), 0x128, 0xf, 0xf, false));
    if (r16 < 8) {
        bf16* op = AO + (size_t)qg * 1024 + r16 * 128 + 4 * q4;
#pragma unroll
        for (int nt = 0; nt < 8; ++nt) { v2u w; w.x = pk2(o[nt][0] * oscale, o[nt][1] * oscale); w.y = pk2(o[nt][2] * oscale, o[nt][3] * oscale); *(v2u*)(op + 16 * nt) = w; }
    }
    LDS_WAIT();
}
template <int MODE> DI void dsa_attn_phase(const Ctx& c, const bf16* PROJ, const unsigned char* K8, const unsigned char* V8, const unsigned short* SEL, const int* SELN, bf16* AO) {
    for (int x = c.vcu * 8 + c.wave; x < MTOK; x += c.G * 8) dsa_attn_item<MODE>(c, x, PROJ, K8, V8, SEL, SELN, AO);
}

#ifndef SKIPM
#define SKIPM 0
#endif
#ifndef PROBE_IDX_MODE
#define PROBE_IDX_MODE 0
#endif
#ifndef PROBE_ATTN_MODE
#define PROBE_ATTN_MODE 0
#endif
#ifndef PROBE_MASK
#define PROBE_MASK 0u
#endif
struct Args { const float* in[36]; float* out; unsigned char* ws; int ph_lo, ph_hi, li, pad; };
enum { I_X = 0, I_MEM, I_POS, I_F1N, I_F1G, I_F1U, I_F1D, I_MIXN, I_EVIN, I_EVOUT, I_GLAWA, I_GLABA, I_GLAN, I_S5LR, I_S5LI, I_S5DT, I_S5BR, I_S5BI, I_S5CR, I_S5CI, I_S5D, I_S5WG, I_S5BG,
       I_ODIN, I_ODOUT, I_XAN, I_MEMNORM, I_XAWQ, I_XAWK, I_XAWV, I_XAWO, I_F2N, I_F2G, I_F2U, I_F2D, I_FINN };

#define GEMM_CALL(EPI, A_, Bt_, M_, N_, K_, E_) do { const pg8::Gemm g_{(const pg8::bf16_t*)(A_), (const pg8::bf16_t*)(Bt_), (M_), (N_), (K_)}; typedef pg8::TileOrder<(M_) / 256, (N_) / 256> Ord_; Ord_ S_; S_.G = c.G; S_.c = (int)blockIdx.x; \
    pg8::gemm_phase<EPI, Ord_, true, true>(c.lds, g_, S_, (E_), MYTID()); } while (0)

#define RSL_PTR() ((const PG8_LAS float*)(c.lds + RING_BYTES))
#define GEMM_CALL_RS(EPI, A_, Bt_, M_, N_, K_, E_) do { const pg8::Gemm g_{(const pg8::bf16_t*)(A_), (const pg8::bf16_t*)(Bt_), (M_), (N_), (K_)}; typedef pg8::TileOrder<(M_) / 256, (N_) / 256> Ord_; Ord_ S_; S_.G = c.G; S_.c = (int)blockIdx.x; \
    { const int t_ = MYTID(); LAS float* rsl_ = (LAS float*)(c.lds + RING_BYTES); \
      for (int i0_ = 0; ; i0_ += 2) { pg8::Unit u0_; if (!S_.next(i0_, u0_)) break; pg8::Unit u_; const int i_ = i0_ + (t_ >> 8); \
          if (S_.next(i_, u_)) { const f32x4* sp_ = (const f32x4*)(SS + (size_t)(u_.pm * 256 + (t_ & 255)) * 16); const f32x4 a0_ = sp_[0], a1_ = sp_[1], a2_ = sp_[2], a3_ = sp_[3]; \
              const f32x4 q_ = (a0_ + a1_) + (a2_ + a3_); rsl_[i_ * 256 + (t_ & 255)] = rsqrtf(((q_[0] + q_[1]) + (q_[2] + q_[3])) * (1.0f / 1024.0f) + EPS); } } \
      __syncthreads(); } \
    pg8::gemm_phase<EPI, Ord_, true, true>(c.lds, g_, S_, (E_), MYTID()); } while (0)

#define MK_GAS __attribute__((address_space(1)))
DI unsigned char* launder_ptr(unsigned char* p) { MK_GAS unsigned char* g = (MK_GAS unsigned char*)p; asm volatile("" : "+s"(g)); return (unsigned char*)g; }
DI const float* gin_(const float* p) { MK_GAS const float* g = (MK_GAS const float*)p; asm volatile("" : "+s"(g)); return (const float*)g; }
DI float* gout_(float* p) { MK_GAS float* g = (MK_GAS float*)p; asm volatile("" : "+s"(g)); return (float*)g; }
#define AIN(k) gin_(a.in[launder_idx(k)])
DI int launder_idx(int i) { asm volatile("" : "+s"(i)); return i; }
#define DECL_PTRS() float* H = (float*)(ws + WS_H); bf16* HB = (bf16*)(ws + WS_HB); float* SS = (float*)(ws + WS_SS); \
    float* COSA = (float*)(ws + WS_COSA); float* SINA = (float*)(ws + WS_SINA); float* COSI = (float*)(ws + WS_COSI); float* SINI = (float*)(ws + WS_SINI); \
    bf16* MEMN = (bf16*)(ws + WS_MEMN); bf16* MK = (bf16*)(ws + WS_MK); bf16* MVT = (bf16*)(ws + WS_MVT); float* S5P = (float*)(ws + WS_S5P); \
    unsigned char* scr = ws + WS_SCR; \
    bf16* HID = (bf16*)(scr + SC_HID); bf16* PROJ = (bf16*)(scr + SC_PROJ); bf16* XQ = (bf16*)(scr + SC_XQ); bf16* XO = (bf16*)(scr + SC_XO); bf16* KVW = (bf16*)(scr + SC_KVW); \
    float* DS = (float*)(scr + SC_DS); float* BCg = (float*)(scr + SC_BC); float* DEC = (float*)(scr + SC_DEC); float* S5E = (float*)(scr + SC_S5E); \
    bf16* Y = (bf16*)(scr + SC_Y); bf16* CAT = (bf16*)(scr + SC_CAT); unsigned short* SEL = (unsigned short*)(scr + SC_SEL); int* SELN = (int*)(scr + SC_SELN); \
    unsigned char* W = ws + WS_W; \
    bf16* Wgu1 = (bf16*)(W + WO_GU1); bf16* Wd1 = (bf16*)(W + WO_D1); bf16* Win = (bf16*)(W + WO_IN); bf16* Wout = (bf16*)(W + WO_OUT); bf16* Wglu = (bf16*)(W + WO_GLU); \
    bf16* Wxq = (bf16*)(W + WO_XQ); bf16* Wxo = (bf16*)(W + WO_XO); bf16* Wgu2 = (bf16*)(W + WO_GU2); bf16* Wd2 = (bf16*)(W + WO_D2);
#define CVT_LAYER_BODY() do { const size_t fo = (size_t)l * DM * DFF; cvt_job_gu(c, AIN(I_F1G) + fo, AIN(I_F1U) + fo, AIN(I_F1N) + l * DM, Wgu1, 0); cvt_job(c, AIN(I_F1D) + fo, DM, 0, DM, nullptr, Wd1, DFF, DM, 0, 512); if (even) { const float* win = AIN(I_EVIN) + (size_t)e * DM * EV_IN; const float* gn = AIN(I_MIXN) + l * DM; cvt_job(c, win, EV_IN, 0, 1536, gn, Win, DM, 1536, 0, 1024); cvt_job_comb(c, win, AIN(I_GLAWA) + e * 16 * 256, gn, Win, 1536, 1536); cvt_job(c, win, EV_IN, 1552, 512, gn, Win, DM, 512, 1792, 1664); cvt_job(c, AIN(I_EVOUT) + (size_t)e * DM * DM, DM, 0, DM, nullptr, Wout, DM, DM, 0, 256); cvt_job(c, AIN(I_S5WG) + (size_t)e * 512 * 512, 512, 0, 512, nullptr, Wglu, 512, 512, 0, 1920); } else { cvt_job_rope(c, AIN(I_ODIN) + (size_t)e * DM * OD_IN, AIN(I_MIXN) + l * DM, Win, 1024); cvt_job(c, AIN(I_ODOUT) + (size_t)e * DM * DM, DM, 0, DM, nullptr, Wout, DM, DM, 0, 256); } cvt_job(c, AIN(I_XAWQ) + (size_t)l * DM * DM, DM, 0, DM, AIN(I_XAN) + l * DM, Wxq, DM, DM, 0, 768); cvt_job(c, AIN(I_XAWO) + (size_t)l * DM * DM, DM, 0, DM, nullptr, Wxo, DM, DM, 0, 1280); cvt_job_gu(c, AIN(I_F2G) + fo, AIN(I_F2U) + fo, AIN(I_F2N) + l * DM, Wgu2, 1024); cvt_job(c, AIN(I_F2D) + fo, DM, 0, DM, nullptr, Wd2, DFF, DM, 0, 1536); } while (0)
__global__ void __launch_bounds__(512, 2) mk_fwd(Args a) {
    extern __shared__ __attribute__((aligned(16))) unsigned char lds_raw[];
    Ctx c; c.lds = (LAS unsigned char*)lds_raw;
    c.tid = threadIdx.x; c.lane = c.tid & 63; c.wave = __builtin_amdgcn_readfirstlane(c.tid >> 6);
    const unsigned wave_s = (unsigned)c.wave;
    c.G = gridDim.x; { const int bx = blockIdx.x; c.vcu = (c.G % 8 == 0) ? (bx % 8) * (c.G / 8) + bx / 8 : bx; }
    for (int u = c.tid; u < (LDS_BYTES - LDSCTL_OFF) / 4; u += 512) ((LAS unsigned*)(c.lds + LDSCTL_OFF))[u] = 0u;
    __syncthreads();
    unsigned char* ws0 = a.ws;
    const int lo = a.ph_lo, hi = a.ph_hi;
    XcdBarrier bar; bar.bar = (unsigned*)(ws0 + WS_CTL) + CW_BAR + a.li * XCD_BAR_WORDS; bar.x = 0; bar.st = (volatile LAS unsigned*)(c.lds + LDSCTL_OFF);
    if (hi - lo > 1) bar = xcd_barrier_post(bar.bar, (volatile LAS unsigned*)(c.lds + LDSCTL_OFF));
    unsigned* mapbad = (unsigned*)(ws0 + WS_CTL) + 256;
    if (hi - lo > 1 && threadIdx.x == 0 && bar.x != (blockIdx.x & 7u)) atomicOr(mapbad, 1u);
    bool fast_ok = false;
#define IN(k) (launder_idx(lo) <= (k) && (k) < launder_idx(hi))
#define MYTID() ((int)(wave_s * 64u + __builtin_amdgcn_mbcnt_hi(~0u, __builtin_amdgcn_mbcnt_lo(~0u, 0u))))
#define FRESH() do { int t_ = MYTID(); asm volatile("" : "+v"(t_)); c.tid = t_; c.lane = t_ & 63; c.wave = (int)wave_s; } while (0)
#define SEAM(k) do { if (IN(k) && IN((k) + 1)) xcd_barrier(bar); } while (0)
#define SEAM_L(k) do { if (IN(k) && IN((k) + 1)) xcd_barrier(bar, fast_ok); } while (0)
    const int NGW = c.G * 8, gw = c.vcu * 8 + c.wave;

#define PHASE(k, q, ...) do { if (IN(k)) { { const bool dup_ = false; (void)dup_; unsigned char* ws = launder_ptr(a.ws); DECL_PTRS(); __VA_ARGS__ } if ((PROBE_MASK >> (q)) & 1u) { xcd_barrier(bar); { const bool dup_ = true; (void)dup_; unsigned char* ws = launder_ptr(a.ws); DECL_PTRS(); __VA_ARGS__ } } } SEAM(k); } while (0)
#define PHASEL(k, q, ...) do { if (IN(k)) { { const bool dup_ = false; (void)dup_; unsigned char* ws = launder_ptr(a.ws); DECL_PTRS(); __VA_ARGS__ } if ((PROBE_MASK >> (q)) & 1u) { xcd_barrier(bar); { const bool dup_ = true; (void)dup_; unsigned char* ws = launder_ptr(a.ws); DECL_PTRS(); __VA_ARGS__ } } } SEAM_L(k); } while (0)
    PHASE(0, 30, {
        FRESH();
        const int* pos = (const int*)AIN(I_POS);
        for (int e = c.vcu * 512 + c.tid; e < MTOK * 96; e += c.G * 512) {
            if (e < MTOK * 64) { const int tok = e >> 6, i = e & 63; const float inv = powf(10000.0f, -(float)(2 * i) / 128.0f), ang = (float)pos[tok] * inv; COSA[e] = cosf(ang); SINA[e] = sinf(ang); }
            else { const int e2 = e - MTOK * 64, tok = e2 >> 5, i = e2 & 31; const float inv = powf(10000.0f, -(float)(2 * i) / 64.0f), ang = (float)pos[tok] * inv; COSI[e2] = cosf(ang); SINI[e2] = sinf(ang); }
        }
        for (int m = gw; m < MTOK; m += NGW) row_init(AIN(I_X) + (size_t)m * DM, HB + (size_t)m * DM, SS + (size_t)m * 16, c.lane);
        for (int m = gw; m < NB * NMEM; m += NGW) row_norm_bf16(AIN(I_MEM) + (size_t)m * DM, AIN(I_MEMNORM), MEMN + (size_t)m * DM, c.lane);
        for (int l = 0; l < DEPTH; ++l) {
            cvt_job(c, AIN(I_XAWK) + (size_t)l * DM * DM, DM, 0, DM, nullptr, KVW, DM, DM, l * DM, l * 256);
            cvt_job(c, AIN(I_XAWV) + (size_t)l * DM * DM, DM, 0, DM, nullptr, KVW + (size_t)4096 * DM, DM, DM, l * DM, l * 256 + 128);
        }
        s5_params(c, AIN(I_S5LR), AIN(I_S5LI), AIN(I_S5DT), AIN(I_S5BR), AIN(I_S5BI), S5P);
        { const int l = 0, e = 0; const bool even = true; CVT_LAYER_BODY(); }
    });
    if (IN(0) && IN(1)) fast_ok = (c.G == 256) && (__builtin_amdgcn_readfirstlane((int)xb_ld(mapbad)) == 0);
#pragma clang loop unroll(full)
    for (int l = 0; l < DEPTH; ++l) {
        const int pb = PH_LAYER0 + l * PH_PER_LAYER, e = l >> 1; const bool even = (l & 1) == 0;
        if (l > 0) PHASE(pb + 0, 0, { FRESH(); CVT_LAYER_BODY(); });
#define MEMKV_TAIL() if (l == 0) { const int bx_ = (int)blockIdx.x - ((MTOK / 256) * (2 * DFF / 256) - 5 * c.G);     \
            { const pg8::Gemm g{(const pg8::bf16_t*)MEMN, (const pg8::bf16_t*)KVW, 512, 4096, 1024}; typedef pg8::TileOrder<2, 16> Ord; Ord S; S.G = c.G; S.c = (c.G == 256) ? bx_ : (int)blockIdx.x; \
              const pg8::EpiScaleBf16<false> E2{(pg8::bf16_t*)MK, 4096, nullptr, 1.0f}; pg8::gemm_phase<pg8::EpiScaleBf16<false>, Ord, true, true>(c.lds, g, S, E2, MYTID()); } \
            { const pg8::Gemm g{(const pg8::bf16_t*)(KVW + (size_t)4096 * DM), (const pg8::bf16_t*)MEMN, 4096, 512, 1024}; typedef pg8::TileOrder<16, 2> Ord; Ord S; S.G = c.G; S.c = ((c.G == 256) ? bx_ : (int)blockIdx.x) - 32; \
              const pg8::EpiScaleBf16<false> E2{(pg8::bf16_t*)MVT, 512, nullptr, 1.0f}; pg8::gemm_phase<pg8::EpiScaleBf16<false>, Ord, true, true>(c.lds, g, S, E2, MYTID()); } }
        PHASEL(pb + 1, 1, { const pg8::EpiSwiGLU E{(pg8::bf16_t*)HID, DFF, RSL_PTR()}; GEMM_CALL_RS(pg8::EpiSwiGLU, HB, Wgu1, MTOK, 2 * DFF, DM, E); MEMKV_TAIL(); });
        PHASEL(pb + 2, 2, { const pg8::EpiResid E{(pg8::bf16_t*)HB, SS, dup_ ? 0.f : 0.5f}; GEMM_CALL(pg8::EpiResid, HID, Wd1, MTOK, DM, DFF, E); });
        if (even) PHASE(pb + 3, 3, { const pg8::EpiScaleBf16<true> E{(pg8::bf16_t*)PROJ, PROJW, RSL_PTR(), 1.0f}; GEMM_CALL_RS(pg8::EpiScaleBf16<true>, HB, Win, MTOK, PROJW, DM, E); });
        else PHASE(pb + 3, 3, { const pg8::EpiRope E{(pg8::bf16_t*)PROJ, RSL_PTR(), COSA, SINA, COSI, SINI, scr + SC_K8, scr + SC_V8}; GEMM_CALL_RS(pg8::EpiRope, HB, Win, MTOK, PROJW, DM, E); });
        if (even) {
            PHASE(pb + 4, 4, {
                FRESH();
                for (int u = c.vcu; u < 1024; u += c.G) gla1_unit(c, u, PROJ, AIN(I_GLABA) + e * 256, DS, BCg, DEC);
                s5_phase1(c, e, PROJ, S5P, S5E);
            });
            PHASE(pb + 5, 29, { FRESH(); gla2_scan(c, DS, DEC); s5_phase2(c, e, S5P, S5E); });
            PHASE(pb + 6, 6, {
                FRESH();
                for (int u = c.vcu; u < 1024; u += c.G) gla3_unit(c, u, PROJ, BCg, DS, AIN(I_GLAN) + e * 128, CAT);
                s5_phase3(c, e, PROJ, S5P, S5E, AIN(I_S5CR), AIN(I_S5CI), AIN(I_S5D), Y);
            });
            PHASE(pb + 7, 7, { const pg8::EpiGLU E{(const pg8::bf16_t*)Y, AIN(I_S5BG) + e * 512, (pg8::bf16_t*)CAT}; GEMM_CALL(pg8::EpiGLU, Y, Wglu, MTOK, 512, 512, E); });
        } else {
            PHASE(pb + 5, 15, { FRESH(); if (!dup_) { for (int u = c.vcu; u < 512; u += c.G) dsa_index_unit<0>(c, u, PROJ, SEL, SELN); } else { for (int u = c.vcu; u < 512; u += c.G) dsa_index_unit<PROBE_IDX_MODE>(c, u, PROJ, (unsigned short*)(scr + 81 * MiB), (int*)(scr + 90 * MiB)); } });
            PHASE(pb + 6, 16, { FRESH(); if (!dup_) dsa_attn_phase<0>(c, PROJ, scr + SC_K8, scr + SC_V8, SEL, SELN, CAT); else dsa_attn_phase<PROBE_ATTN_MODE>(c, PROJ, scr + SC_K8, scr + SC_V8, SEL, SELN, (bf16*)(scr + 100 * MiB)); });
        }
        PHASEL(pb + 8, 8, { const pg8::EpiResid E{(pg8::bf16_t*)HB, SS, dup_ ? 0.f : 1.0f}; GEMM_CALL(pg8::EpiResid, CAT, Wout, MTOK, DM, DM, E); });
        PHASEL(pb + 9, 9, { const pg8::EpiScaleBf16<true> E{(pg8::bf16_t*)XQ, DM, RSL_PTR(), 0.0625f}; GEMM_CALL_RS(pg8::EpiScaleBf16<true>, HB, Wxq, MTOK, DM, DM, E); });
        PHASEL(pb + 10, 10, { FRESH(); for (int u = c.vcu; u < 256; u += c.G) xattn_unit(c, u, l, XQ, MK, MVT, XO); });
        PHASEL(pb + 11, 11, { const pg8::EpiResid E{(pg8::bf16_t*)HB, SS, dup_ ? 0.f : 1.0f}; GEMM_CALL(pg8::EpiResid, XO, Wxo, MTOK, DM, DM, E); });
        PHASEL(pb + 12, 12, { const pg8::EpiSwiGLU E{(pg8::bf16_t*)HID, DFF, RSL_PTR()}; GEMM_CALL_RS(pg8::EpiSwiGLU, HB, Wgu2, MTOK, 2 * DFF, DM, E); });
        PHASE(pb + 13, 13, { const pg8::EpiResid E{(pg8::bf16_t*)HB, SS, dup_ ? 0.f : 0.5f}; GEMM_CALL(pg8::EpiResid, HID, Wd2, MTOK, DM, DFF, E); });
    }
    if (IN(PH_FINAL)) { FRESH(); unsigned char* ws = launder_ptr(a.ws); DECL_PTRS(); for (int m = gw; m < MTOK; m += NGW) row_final(HB + (size_t)m * DM, SS + (size_t)m * 16, AIN(I_FINN), gout_(a.out) + (size_t)m * DM, c.lane); }
#undef PHASE
#undef PHASEL
#undef IN
#undef SEAM
}

#ifndef MK_ONE_LAUNCH
#define MK_ONE_LAUNCH 1
#endif
extern "C" void kernel_launch(void* const* d_in, const int* in_sizes, int n_in, void* d_out, int out_size, void* d_ws, size_t ws_size, hipStream_t stream) {
    static int grid = 0;
    if (grid == 0) {
        if (n_in != 36 || out_size != MTOK * DM || ws_size < WS_END) { fprintf(stderr, "kernel_launch: unexpected shapes (n_in %d out %d ws %zu)\n", n_in, out_size, ws_size); grid = -1; return; }
        int dev = 0, cus = 0, per_cu = 0;
        if (hipGetDevice(&dev) != hipSuccess || hipDeviceGetAttribute(&cus, hipDeviceAttributeMultiprocessorCount, dev) != hipSuccess) { grid = -1; return; }
        if (hipFuncSetAttribute((const void*)mk_fwd, hipFuncAttributeMaxDynamicSharedMemorySize, LDS_BYTES) != hipSuccess) { fprintf(stderr, "kernel_launch: hipFuncSetAttribute failed\n"); grid = -1; return; }
        if (hipOccupancyMaxActiveBlocksPerMultiprocessor(&per_cu, (const void*)mk_fwd, 512, LDS_BYTES) != hipSuccess || per_cu < 1) fprintf(stderr, "kernel_launch: occupancy query reports %d\n", per_cu);
        (void)hipGetLastError();
        grid = cus;
    }
    if (grid < 0) return;
    (void)hipMemsetAsync((char*)d_ws + WS_CTL, 0, CTL_ZERO_BYTES, stream);
    Args a{};
    for (int i = 0; i < 36; ++i) a.in[i] = (const float*)d_in[i];
    a.out = (float*)d_out; a.ws = (unsigned char*)d_ws; a.pad = 0;
#if MK_ONE_LAUNCH
    a.ph_lo = 0; a.ph_hi = N_PHASES; a.li = 0;
    hipLaunchKernelGGL(mk_fwd, dim3(grid), dim3(512), LDS_BYTES, stream, a);
#else
    for (int p = 0; p < N_PHASES; ++p) {
        if (p >= PH_LAYER0 && p < PH_FINAL) { const int l = (p - PH_LAYER0) / PH_PER_LAYER, q = (p - PH_LAYER0) % PH_PER_LAYER; if ((l & 1) && q == 7) continue; }
        a.ph_lo = p; a.ph_hi = p + 1; a.li = 0;
        hipLaunchKernelGGL(mk_fwd, dim3(grid), dim3(512), LDS_BYTES, stream, a);
    }
#endif
}
```
